# Optimizing an MI355X kernel written in HIP

```python
import math
import jax, jax.numpy as jnp
from jax import lax
import numpy as np

D_MODEL = 2048
BATCH = 2
SEQ = 4096
DEPTH = 4

PLE_DIM = 256

RWKV_HEADS = 12
RWKV_HEAD_DIM = 64
RWKV_DIM = RWKV_HEADS * RWKV_HEAD_DIM
RWKV_DECAY_LORA = 64
RWKV_AAA_LORA = 64
RWKV_GATE_LORA = 128
RWKV_GN_EPS = 64e-5
RWKV_IN_SIZES = (RWKV_DIM, RWKV_DIM, RWKV_DIM, RWKV_DECAY_LORA, RWKV_AAA_LORA, RWKV_GATE_LORA)
RWKV_IN_DIM = sum(RWKV_IN_SIZES)

DIL_PATTERNS = ((128, 1), (512, 4), (2048, 16))
DIL_N_GROUPS = 3
DIL_HEADS_PER_GROUP = 4
DIL_HEADS = DIL_N_GROUPS * DIL_HEADS_PER_GROUP
DIL_HEAD_DIM = 128
DIL_QKV_DIM = DIL_HEADS * DIL_HEAD_DIM
DIL_OUT_DIM = DIL_HEADS_PER_GROUP * DIL_HEAD_DIM
DIL_BLOCK = 128
ALIBI_MAX_BIAS = 8.0

MLA_HEADS = 6
MLA_NOPE_DIM = 128
MLA_ROPE_DIM = 64
MLA_V_DIM = 128
MLA_Q_LORA = 512
MLA_KV_LORA = 256
MLA_OUT_DIM = MLA_HEADS * MLA_V_DIM
ROPE_THETA = 10000.0
Q_BLOCK = 128

MIX_DIM = RWKV_DIM + DIL_OUT_DIM + MLA_OUT_DIM
IN_SIZES = (RWKV_IN_DIM, DIL_QKV_DIM, DIL_QKV_DIM, DIL_QKV_DIM, MLA_Q_LORA, MLA_KV_LORA, MLA_ROPE_DIM)
IN_DIM = sum(IN_SIZES)

N_EXPERTS = 32
N_EXPERT_GROUPS = 8
EXPERTS_PER_GROUP = 4
TOP_K = 2
D_EXPERT = 512
MOE_BLOCK = 128

DEEPNORM_ALPHA = (2 * DEPTH) ** 0.25
DEEPNORM_BETA = (8 * DEPTH) ** -0.25
LN_EPS = 1e-5
RMS_EPS = 1e-6
NEG_INF = -1e30

kernel_name = "hybrid_rwkv7_dilated_mla_grouped_moe_deepnorm"


def _split(z, sizes):
    return jnp.split(z, np.cumsum(sizes)[:-1].tolist(), axis=-1)


def _layernorm(x, g, b):
    xf = x.astype(jnp.float32)
    mu = xf.mean(-1, keepdims=True)
    var = jnp.square(xf - mu).mean(-1, keepdims=True)
    return ((xf - mu) * lax.rsqrt(var + LN_EPS) * g + b).astype(x.dtype)


def _rmsnorm(x, g):
    xf = x.astype(jnp.float32)
    return (xf * lax.rsqrt(jnp.mean(xf * xf, -1, keepdims=True) + RMS_EPS) * g).astype(x.dtype)


def _rope(t, pos):
    half = MLA_ROPE_DIM // 2
    inv = ROPE_THETA ** (-jnp.arange(half, dtype=jnp.float32) / half)
    ang = pos.astype(jnp.float32)[:, None] * inv[None, :]
    cos, sin = jnp.cos(ang)[None, :, None, :], jnp.sin(ang)[None, :, None, :]
    t1, t2 = t[..., :half].astype(jnp.float32), t[..., half:].astype(jnp.float32)
    return jnp.concatenate([t1 * cos - t2 * sin, t1 * sin + t2 * cos], axis=-1)


def _rwkv7(z, mu, w0, w_up, a0, a_up, g_up, k_k, k_a, r_k, gn_g, gn_b):
    B, S, _ = z.shape
    H, E = RWKV_HEADS, RWKV_HEAD_DIM
    z_prev = jnp.pad(z[:, :-1], ((0, 0), (1, 0), (0, 0)))
    z = z + (z_prev - z) * mu
    r, k, v, wd, ad, gd = _split(z, RWKV_IN_SIZES)
    w = -jax.nn.softplus(-(w0 + jnp.tanh(wd) @ w_up)) - 0.5
    decay = jnp.exp(-jnp.exp(w.astype(jnp.float32)))
    a = jax.nn.sigmoid(a0 + ad @ a_up)
    g = jax.nn.sigmoid(gd) @ g_up
    heads = lambda t: t.reshape(B, S, H, E).astype(jnp.float32)
    kk = heads(k * k_k)
    kk = kk / jnp.maximum(jnp.sqrt(jnp.sum(kk * kk, -1, keepdims=True)), 1e-12)
    k = k * (1 + (a - 1) * k_a)
    rh, kh, vh, ah, wh = heads(r), heads(k), heads(v), heads(a), heads(decay)

    def step(state, inp):
        r_t, w_t, k_t, v_t, a_t, b_t = inp
        sa = jnp.einsum('bhij,bhj->bhi', state, a_t)
        state = (state * w_t[:, :, None, :] + sa[..., None] * b_t[:, :, None, :]
                 + v_t[..., None] * k_t[:, :, None, :])
        return state, jnp.einsum('bhij,bhj->bhi', state, r_t)

    tm = lambda t: jnp.moveaxis(t, 1, 0)
    s0 = jnp.zeros((B, H, E, E), jnp.float32)
    _, y = lax.scan(step, s0, (tm(rh), tm(wh), tm(kh), tm(vh), tm(-kk), tm(kk * ah)))
    y = jnp.moveaxis(y, 0, 1)
    ym = y.mean(-1, keepdims=True)
    yv = jnp.square(y - ym).mean(-1, keepdims=True)
    y = ((y - ym) * lax.rsqrt(yv + RWKV_GN_EPS)).reshape(B, S, RWKV_DIM) * gn_g + gn_b
    bonus = jnp.sum(rh * kh * r_k, -1, keepdims=True) * vh
    y = y + bonus.reshape(B, S, RWKV_DIM)
    return (y * g).astype(z.dtype)


def _dilated_group(q, k, v, window, dilation, slopes):
    B, S, Hg, E = q.shape
    n_neigh = window // dilation
    L = S // dilation
    nb = -(-L // DIL_BLOCK)
    Lp = nb * DIL_BLOCK

    def sub(t):
        t = t.reshape(B, L, dilation, Hg, E).transpose(0, 2, 1, 3, 4)
        t = jnp.pad(t, ((0, 0), (0, 0), (0, Lp - L), (0, 0), (0, 0)))
        return t.reshape(B, dilation, nb, DIL_BLOCK, Hg, E)

    def band(t):
        prev = jnp.pad(t, ((0, 0), (0, 0), (1, 0), (0, 0), (0, 0), (0, 0)))[:, :, :-1]
        return jnp.concatenate([prev, t], axis=3)

    qb, kw, vw = sub(q), band(sub(k)), band(sub(v))
    s = jnp.einsum('bdnqhe,bdnkhe->bdnhqk', qb, kw) * (E ** -0.5)
    qi = jnp.arange(DIL_BLOCK)
    ki = jnp.arange(2 * DIL_BLOCK)
    rel = qi[:, None] + DIL_BLOCK - ki[None, :]
    key_idx = jnp.arange(nb)[:, None] * DIL_BLOCK - DIL_BLOCK + ki[None, :]
    valid = (rel >= 0)[None] & (rel <= n_neigh)[None] & (key_idx >= 0)[:, None, :]
    dist = (rel * dilation).astype(jnp.float32)
    s = s - slopes[:, None, None] * dist[None]
    s = jnp.where(valid[:, None], s, NEG_INF)
    m = s.max(-1, keepdims=True)
    e = jnp.exp(s - m)
    den = e.sum(-1, keepdims=True)
    o = jnp.einsum('bdnhqk,bdnkhe->bdnqhe', e / den, vw)
    lse = (m + jnp.log(den))[..., 0]

    def unsub(t):
        t = t[:, :, :L]
        return jnp.swapaxes(t, 1, 2).reshape((B, S) + t.shape[3:])

    o = unsub(o.reshape(B, dilation, Lp, Hg, E))
    lse = unsub(jnp.swapaxes(lse, 3, 4).reshape(B, dilation, Lp, Hg))
    return o, lse


def _dilated_attention(zq, zk, zv):
    B, S, _ = zq.shape
    shp = (B, S, DIL_N_GROUPS, DIL_HEADS_PER_GROUP, DIL_HEAD_DIM)
    q = zq.reshape(shp).astype(jnp.float32)
    k = zk.reshape(shp).astype(jnp.float32)
    v = zv.reshape(shp).astype(jnp.float32)
    slopes = jnp.exp2(-ALIBI_MAX_BIAS * jnp.arange(1, DIL_HEADS + 1, dtype=jnp.float32) / DIL_HEADS)
    slopes = slopes.reshape(DIL_N_GROUPS, DIL_HEADS_PER_GROUP)
    outs, lses = [], []
    for gi, (window, dilation) in enumerate(DIL_PATTERNS):
        o, l = _dilated_group(q[:, :, gi], k[:, :, gi], v[:, :, gi], window, dilation, slopes[gi])
        outs.append(o)
        lses.append(l)
    wts = jax.nn.softmax(jnp.stack(lses), axis=0)
    out = jnp.sum(wts[..., None] * jnp.stack(outs), axis=0)
    return out.reshape(B, S, DIL_OUT_DIM).astype(zq.dtype)


def _mla(zq, zkv, zkr, qa_g, w_uq, kva_g, w_ukv):
    B, S, _ = zq.shape
    H, QD = MLA_HEADS, MLA_NOPE_DIM + MLA_ROPE_DIM
    pos = jnp.arange(S)
    q = (_rmsnorm(zq, qa_g) @ w_uq).reshape(B, S, H, QD)
    kv = (_rmsnorm(zkv, kva_g) @ w_ukv).reshape(B, S, H, MLA_NOPE_DIM + MLA_V_DIM)
    k_nope, v = kv[..., :MLA_NOPE_DIM], kv[..., MLA_NOPE_DIM:]
    k_rope = _rope(zkr[:, :, None, :], pos)
    qf = jnp.concatenate([q[..., :MLA_NOPE_DIM].astype(jnp.float32), _rope(q[..., MLA_NOPE_DIM:], pos)], -1)
    kf = jnp.concatenate([k_nope.astype(jnp.float32), jnp.broadcast_to(k_rope, (B, S, H, MLA_ROPE_DIM))], -1)
    vf = v.astype(jnp.float32)
    scale = QD ** -0.5
    nq = S // Q_BLOCK
    qb = jnp.moveaxis(qf.reshape(B, nq, Q_BLOCK, H, QD), 1, 0)

    def block(args):
        q_blk, bi = args
        s = jnp.einsum('bqhe,bkhe->bhqk', q_blk, kf) * scale
        qpos = bi * Q_BLOCK + jnp.arange(Q_BLOCK)
        s = jnp.where(pos[None, :] <= qpos[:, None], s, NEG_INF)
        return jnp.einsum('bhqk,bkhe->bqhe', jax.nn.softmax(s, axis=-1), vf)

    o = lax.map(block, (qb, jnp.arange(nq)))
    return jnp.moveaxis(o, 0, 1).reshape(B, S, MLA_OUT_DIM).astype(zq.dtype)


def _moe(x, router_w, router_b, w_gate, w_up, w_down):
    B, S, D = x.shape
    N = B * S
    xt = x.reshape(N, D)
    scores = jax.nn.sigmoid((xt @ router_w).astype(jnp.float32))
    sel = scores + router_b.astype(jnp.float32)
    grp_score = lax.top_k(sel.reshape(N, N_EXPERT_GROUPS, EXPERTS_PER_GROUP), TOP_K)[0].sum(-1)
    g_best = jnp.argmax(grp_score, axis=-1)
    in_group = (jnp.arange(N_EXPERTS) // EXPERTS_PER_GROUP)[None, :] == g_best[:, None]
    _, idx = lax.top_k(jnp.where(in_group, sel, -jnp.inf), TOP_K)
    gate = jnp.take_along_axis(scores, idx, axis=-1)
    gate = gate / gate.sum(-1, keepdims=True)

    A = N * TOP_K
    e_flat = idx.reshape(A)
    tok = jnp.repeat(jnp.arange(N, dtype=jnp.int32), TOP_K)
    order = jnp.argsort(e_flat)
    e_s, tok_s, gate_s = e_flat[order], tok[order], gate.reshape(A)[order]
    counts = jnp.zeros((N_EXPERTS,), jnp.int32).at[e_flat].add(1)
    padded = (counts + MOE_BLOCK - 1) // MOE_BLOCK * MOE_BLOCK
    pad_end = jnp.cumsum(padded)
    pad_start = pad_end - padded
    start = jnp.cumsum(counts) - counts
    dest = pad_start[e_s] + jnp.arange(A, dtype=jnp.int32) - start[e_s]
    nb = (A + N_EXPERTS * (MOE_BLOCK - 1) + MOE_BLOCK - 1) // MOE_BLOCK
    P = nb * MOE_BLOCK
    buf_tok = jnp.full((P,), N, jnp.int32).at[dest].set(tok_s)
    xb = jnp.concatenate([xt, jnp.zeros((1, D), xt.dtype)], axis=0)[buf_tok].reshape(nb, MOE_BLOCK, D)
    blk_e = jnp.minimum(jnp.searchsorted(pad_end, jnp.arange(nb, dtype=jnp.int32) * MOE_BLOCK, side='right'),
                        N_EXPERTS - 1)

    def expert_block(args):
        xblk, e = args
        h = jax.nn.silu(xblk @ w_gate[e]) * (xblk @ w_up[e])
        return h @ w_down[e]

    yb = lax.map(expert_block, (xb, blk_e)).reshape(P, D)
    y = jax.ops.segment_sum(yb[dest] * gate_s[:, None].astype(yb.dtype), tok_s, num_segments=N)
    return y.reshape(B, S, D).astype(x.dtype)


def setup_inputs(seed: int = 0) -> dict:
    key = jax.random.key(seed)
    ks = iter(jax.random.split(key, 40))
    L, D = DEPTH, D_MODEL

    def nrm(shape, scale):
        return jax.random.normal(next(ks), shape, jnp.float32) * scale

    def uni(shape, lo, hi):
        return jax.random.uniform(next(ks), shape, jnp.float32, lo, hi)

    return {
        "x": nrm((BATCH, SEQ, D), 1.0),
        "p": nrm((DEPTH, BATCH, SEQ, PLE_DIM), 1.0),
        "w_in": nrm((L, D, IN_DIM), D ** -0.5),
        "rwkv_mu": uni((L, RWKV_IN_DIM), 0.0, 1.0),
        "rwkv_w0": uni((L, RWKV_DIM), -6.0, 1.0),
        "rwkv_w_up": nrm((L, RWKV_DECAY_LORA, RWKV_DIM), 0.1 * RWKV_DECAY_LORA ** -0.5),
        "rwkv_a0": nrm((L, RWKV_DIM), 0.1),
        "rwkv_a_up": nrm((L, RWKV_AAA_LORA, RWKV_DIM), 0.5 * RWKV_AAA_LORA ** -0.5),
        "rwkv_g_up": nrm((L, RWKV_GATE_LORA, RWKV_DIM), RWKV_GATE_LORA ** -0.5),
        "rwkv_k_k": 0.85 + nrm((L, RWKV_DIM), 0.05),
        "rwkv_k_a": 1.0 + nrm((L, RWKV_DIM), 0.05),
        "rwkv_r_k": nrm((L, RWKV_HEADS, RWKV_HEAD_DIM), 0.1),
        "rwkv_gn_g": 1.0 + nrm((L, RWKV_DIM), 0.05),
        "rwkv_gn_b": nrm((L, RWKV_DIM), 0.02),
        "mla_qa_g": 1.0 + nrm((L, MLA_Q_LORA), 0.05),
        "mla_w_uq": nrm((L, MLA_Q_LORA, MLA_HEADS * (MLA_NOPE_DIM + MLA_ROPE_DIM)), MLA_Q_LORA ** -0.5),
        "mla_kva_g": 1.0 + nrm((L, MLA_KV_LORA), 0.05),
        "mla_w_ukv": nrm((L, MLA_KV_LORA, MLA_HEADS * (MLA_NOPE_DIM + MLA_V_DIM)), MLA_KV_LORA ** -0.5),
        "w_out": nrm((L, MIX_DIM, D), DEEPNORM_BETA * MIX_DIM ** -0.5),
        "ln1_g": 1.0 + nrm((L, D), 0.05),
        "ln1_b": nrm((L, D), 0.02),
        "router_w": nrm((D, N_EXPERTS), D ** -0.5),
        "router_b": nrm((N_EXPERTS,), 0.01),
        "moe_w_gate": nrm((L, N_EXPERTS, D, D_EXPERT), D ** -0.5),
        "moe_w_up": nrm((L, N_EXPERTS, D, D_EXPERT), D ** -0.5),
        "moe_w_down": nrm((L, N_EXPERTS, D_EXPERT, D), DEEPNORM_BETA * D_EXPERT ** -0.5),
        "ln2_g": 1.0 + nrm((L, D), 0.05),
        "ln2_b": nrm((L, D), 0.02),
        "ple_w_proj": nrm((L, PLE_DIM, D), PLE_DIM ** -0.5),
        "ple_w_gate": nrm((L, D, D), D ** -0.5),
    }


def reference(x, p, w_in, rwkv_mu, rwkv_w0, rwkv_w_up, rwkv_a0, rwkv_a_up, rwkv_g_up,
              rwkv_k_k, rwkv_k_a, rwkv_r_k, rwkv_gn_g, rwkv_gn_b,
              mla_qa_g, mla_w_uq, mla_kva_g, mla_w_ukv, w_out, ln1_g, ln1_b,
              router_w, router_b, moe_w_gate, moe_w_up, moe_w_down, ln2_g, ln2_b,
              ple_w_proj, ple_w_gate):
    for i in range(DEPTH):
        z = x @ w_in[i]
        z_rwkv, z_dq, z_dk, z_dv, z_qa, z_kva, z_kr = _split(z, IN_SIZES)
        y_a = _rwkv7(z_rwkv, rwkv_mu[i], rwkv_w0[i], rwkv_w_up[i], rwkv_a0[i], rwkv_a_up[i],
                     rwkv_g_up[i], rwkv_k_k[i], rwkv_k_a[i], rwkv_r_k[i], rwkv_gn_g[i], rwkv_gn_b[i])
        y_b = _dilated_attention(z_dq, z_dk, z_dv)
        y_c = _mla(z_qa, z_kva, z_kr, mla_qa_g[i], mla_w_uq[i], mla_kva_g[i], mla_w_ukv[i])
        mix = jnp.concatenate([y_a, y_b, y_c], axis=-1) @ w_out[i]
        x = _layernorm(DEEPNORM_ALPHA * x + mix, ln1_g[i], ln1_b[i])
        ffn = _moe(x, router_w, router_b, moe_w_gate[i], moe_w_up[i], moe_w_down[i])
        x = _layernorm(DEEPNORM_ALPHA * x + ffn, ln2_g[i], ln2_b[i])
        x = x + jax.nn.sigmoid(x @ ple_w_gate[i]) * (p[i] @ ple_w_proj[i])
    return x
```

```cpp
#include <hip/hip_runtime.h>
#include <cstdio>
#include <cstdint>

#ifndef MK_PER_PHASE
#define MK_PER_PHASE 1
#endif

#define DI __device__ __forceinline__
#define LAS __attribute__((address_space(3)))
#define GAS __attribute__((address_space(1)))
typedef unsigned short bf16_t;
typedef short bf16x8 __attribute__((ext_vector_type(8)));
typedef float f32x2 __attribute__((ext_vector_type(2)));
typedef float f32x4 __attribute__((ext_vector_type(4)));
typedef float f32x16 __attribute__((ext_vector_type(16)));
typedef unsigned u32x2 __attribute__((ext_vector_type(2)));
typedef unsigned u32x4 __attribute__((ext_vector_type(4)));
typedef __bf16 hbf2 __attribute__((ext_vector_type(2)));

DI unsigned pack2(float lo, float hi) { return __builtin_bit_cast(unsigned, __builtin_convertvector((f32x2){lo, hi}, hbf2)); }
DI float bf2f(bf16_t b) { return __uint_as_float(((unsigned)b) << 16); }
DI float bflo(unsigned w) { return __uint_as_float(w << 16); }
DI float bfhi(unsigned w) { return __uint_as_float(w & 0xffff0000u); }
DI bf16_t f2bf(float f) { return (bf16_t)(pack2(f, 0.f) & 0xffffu); }
DI float wave_sum(float v) { for (int o = 32; o >= 1; o >>= 1) v += __shfl_xor(v, o); return v; }
DI float sigmoidf_(float x) { return 1.0f / (1.0f + __expf(-x)); }

constexpr int T = 8192, SEQ = 4096, D = 2048, NL = 4, PLE = 256;
constexpr int ZLD = 8192;
constexpr int ZC_DQ = 2560, ZC_DK = 4096, ZC_DV = 5632, ZC_QA = 7168, ZC_KVA = 7680, ZC_KR = 7936;
constexpr int NEXP = 32, DEXP = 512, HB_ROWS = 24576;
constexpr float ALPHA = 1.681792830507429f;
constexpr float LOG2E = 1.4426950408889634f;

constexpr size_t CTL_BYTES = 65536;
constexpr size_t WS_WIN = CTL_BYTES;                              constexpr size_t SZ_WIN = (size_t)NL * 8192 * 2048 * 2;
constexpr size_t WS_WOUT = WS_WIN + SZ_WIN;                       constexpr size_t SZ_WOUT = (size_t)NL * 2048 * 2048 * 2;
constexpr size_t WS_WPG = WS_WOUT + SZ_WOUT;                      constexpr size_t SZ_WPG = SZ_WOUT;
constexpr size_t WS_WPP = WS_WPG + SZ_WPG;                        constexpr size_t SZ_WPP = (size_t)NL * 2048 * 256 * 2;
constexpr size_t WS_WGU = WS_WPP + SZ_WPP;                        constexpr size_t SZ_WGU = (size_t)NL * 32 * 1024 * 2048 * 2;
constexpr size_t WS_WDN = WS_WGU + SZ_WGU;                        constexpr size_t SZ_WDN = (size_t)NL * 32 * 2048 * 512 * 2;
constexpr size_t WS_WUQ = WS_WDN + SZ_WDN;                        constexpr size_t SZ_WUQ = (size_t)NL * 1280 * 512 * 2;
constexpr size_t WS_WUKV = WS_WUQ + SZ_WUQ;                       constexpr size_t SZ_WUKV = (size_t)NL * 1536 * 256 * 2;
constexpr size_t WS_ROPE = WS_WUKV + SZ_WUKV;                     constexpr size_t SZ_ROPE = (size_t)4096 * 32 * 8;
constexpr size_t WS_PBF = WS_ROPE + SZ_ROPE;                      constexpr size_t SZ_PBF = (size_t)NL * T * 256 * 2;
constexpr size_t WS_XCUR = WS_PBF + SZ_PBF;                       constexpr size_t SZ_XF = (size_t)T * D * 4;
constexpr size_t WS_XBF = WS_XCUR + SZ_XF;                        constexpr size_t SZ_XB = (size_t)T * D * 2;
constexpr size_t WS_Z = WS_XBF + SZ_XB;                           constexpr size_t SZ_Z = (size_t)T * ZLD * 2;
constexpr size_t SZ_RW1 = (size_t)T * 768 * 4;
constexpr size_t WS_RW = WS_Z + SZ_Z;
constexpr size_t WS_RK = WS_RW + 7 * SZ_RW1;                      constexpr size_t SZ_RK = (size_t)T * 16 * 4;
constexpr size_t WS_QN = WS_RK + SZ_RK;                           constexpr size_t SZ_QN = (size_t)T * 512 * 2;
constexpr size_t WS_KVN = WS_QN + SZ_QN;                          constexpr size_t SZ_KVN = (size_t)T * 256 * 2;
constexpr size_t WS_KROPE = WS_KVN + SZ_KVN;                      constexpr size_t SZ_KROPE = (size_t)T * 64 * 2;
constexpr size_t WS_VTD = WS_KROPE + SZ_KROPE;                    constexpr size_t SZ_VTD = (size_t)2 * 12 * 128 * 4096 * 2;
constexpr size_t WS_QB = WS_VTD + SZ_VTD;                         constexpr size_t SZ_QB = (size_t)T * 1280 * 2;
constexpr size_t WS_KC = WS_QB + SZ_QB;                           constexpr size_t SZ_KC = (size_t)T * 768 * 2;
constexpr size_t WS_VT = WS_KC + SZ_KC;                           constexpr size_t SZ_VT = (size_t)768 * 8192 * 2;
constexpr size_t WS_OP = WS_VT + SZ_VT;                           constexpr size_t SZ_OP = (size_t)3 * T * 512 * 2;
constexpr size_t WS_LSE = WS_OP + SZ_OP;                          constexpr size_t SZ_LSE = (size_t)3 * T * 4 * 4;
constexpr size_t WS_MIX = WS_LSE + SZ_LSE;                        constexpr size_t SZ_MIX = SZ_XB;
constexpr size_t WS_TMP = WS_MIX + SZ_MIX;
constexpr size_t WS_X1 = WS_TMP + SZ_XF;
constexpr size_t WS_X1BF = WS_X1 + SZ_XF;
constexpr size_t WS_PP = WS_X1BF + SZ_XB;
constexpr size_t WS_TOKL = WS_PP + SZ_XB;                         constexpr size_t SZ_TOKL = (size_t)32 * 8192 * 4;
constexpr size_t WS_GATE = WS_TOKL + SZ_TOKL;                     constexpr size_t SZ_GATE = (size_t)T * 2 * 4;
constexpr size_t WS_HB = WS_GATE + SZ_GATE;                       constexpr size_t SZ_HB = (size_t)HB_ROWS * 512 * 2;
constexpr size_t WS_YBT = WS_HB + SZ_HB;                          constexpr size_t SZ_YBT = (size_t)T * 2 * 2048 * 2;
constexpr size_t WS_END = WS_YBT + SZ_YBT;
constexpr int CW_MOECNT = 4096;
constexpr int CW_QUEUE = 8192;

constexpr int LDS_STAGE = 131072;
constexpr int LDS_CTL = 131072;
constexpr int LDS_UTAB = LDS_CTL + 64;
constexpr int LDS_MOE = LDS_UTAB + 1024;
constexpr int LDS_INTAB = LDS_MOE + 1536;
constexpr int LDS_ROWL = 131072 + 4096;
constexpr int LDS_BYTES = 131072 + 8192;

#define XB_TMO      128
#define XB_XCNT(j)  (256  + 64 * (j))
#define XB_XSUB(j)  (1280 + 64 * (j))
#define XB_XGEN(j)  (2304 + 64 * (j))
#define XB_TOP      3328
#define XB_TOPGEN   3392
#define XCD_BAR_WORDS 3456
#define XB_SPIN_CAP (1u << 22)

__device__ __forceinline__ unsigned xb_ld(unsigned* p)              { return __hip_atomic_load(p, __ATOMIC_RELAXED, __HIP_MEMORY_SCOPE_AGENT); }
__device__ __forceinline__ unsigned xb_add(unsigned* p, unsigned v) { return __hip_atomic_fetch_add(p, v, __ATOMIC_RELAXED, __HIP_MEMORY_SCOPE_AGENT); }
__device__ __forceinline__ unsigned xb_xcc_id() { return (unsigned)__builtin_amdgcn_s_getreg((3 << 11) | 20) & 0xFu; }
#define XB_SPIN(cond, bar) do { unsigned _sp = 0; while (cond) { __builtin_amdgcn_s_sleep(1); \
    if ((++_sp & 255u) == 0u) { if (xb_ld(&(bar)[XB_TMO])) break; if (_sp > XB_SPIN_CAP) { atomicAdd(&(bar)[XB_TMO], 1u); break; } } } } while (0)

struct XcdBarrier { unsigned* bar; unsigned x; volatile LAS unsigned* st; };

__device__ __forceinline__ XcdBarrier xcd_barrier_post(unsigned* bar, volatile LAS unsigned* st, bool leader) {
    XcdBarrier b; b.bar = bar; b.x = xb_xcc_id(); b.st = st;
    if (leader) (void)xb_add(&bar[XB_XCNT(b.x)], 1u);
    return b;
}
__device__ __forceinline__ void xcd_barrier_complete(unsigned* bar, unsigned x, unsigned& nloc, unsigned& nx) {
    const unsigned G = gridDim.x * gridDim.y * gridDim.z;
    unsigned sum, cnt, mine, sp = 0u;
    for (;;) {
        sum = 0u; cnt = 0u; mine = 0u;
#pragma unroll
        for (unsigned j = 0; j < 16; ++j) { const unsigned c = xb_ld(&bar[XB_XCNT(j)]); sum += c; cnt += (c > 0u) ? 1u : 0u; mine = (j == x) ? c : mine; }
        if (sum == G) break;
        __builtin_amdgcn_s_sleep(1);
        if ((++sp & 255u) == 0u) { if (xb_ld(&bar[XB_TMO])) break; if (sp > XB_SPIN_CAP) { atomicAdd(&bar[XB_TMO], 1u); break; } }
    }
    nloc = mine > 0u ? mine : 1u; nx = cnt > 0u ? cnt : 1u;
}
__device__ __forceinline__ void xcd_barrier(const XcdBarrier& b, bool leader) {
    asm volatile("s_waitcnt vmcnt(0)" ::: "memory");
    __syncthreads();
    if (leader) {
        unsigned* bar = b.bar;
        __builtin_amdgcn_s_waitcnt(0);
        unsigned nloc = b.st[0], nx = b.st[1];
        if (nloc == 0u) { xcd_barrier_complete(bar, b.x, nloc, nx); b.st[0] = nloc; b.st[1] = nx; }
        const unsigned old = xb_add(&bar[XB_XSUB(b.x)], 1u);
        const unsigned gen = old / nloc;
        if (old + 1u == (gen + 1u) * nloc) {
            __builtin_amdgcn_fence(__ATOMIC_RELEASE, "agent");
            asm volatile("s_waitcnt vmcnt(0)" ::: "memory");
            const unsigned og = xb_add(&bar[XB_TOP], 1u);
            const unsigned tg = og / nx;
            if (og + 1u == (tg + 1u) * nx) xb_add(&bar[XB_TOPGEN], 1u);
            else XB_SPIN(xb_ld(&bar[XB_TOPGEN]) == tg, bar);
            __builtin_amdgcn_fence(__ATOMIC_ACQUIRE, "agent");
            xb_add(&bar[XB_XGEN(b.x)], 1u);
            asm volatile("s_waitcnt vmcnt(0)" ::: "memory");
        } else {
            XB_SPIN(xb_ld(&bar[XB_XGEN(b.x)]) == gen, bar);
            __builtin_amdgcn_fence(__ATOMIC_ACQUIRE, "agent");
            asm volatile("s_waitcnt vmcnt(0)" ::: "memory");
        }
    }
    __syncthreads();
}

namespace pg8 {
constexpr int BM = 256, BK = 64, HALF = 128, HTB = HALF * BK * 2, STAGE_BYTES = 8 * HTB, NXCD = 8, WGM = 8;
DI int lds_byte(int r, int c) { const int st = (r >> 4) * 2 + (c >> 5), rr = r & 15, cc = c & 31, ob = rr * 64 + cc * 2; return st * 1024 + (ob ^ (((ob >> 9) & 1) << 5)); }
DI void stage_rc(int b, int& R, int& C) { const int st = b / 1024, sb = b % 1024, swz = sb ^ (((sb >> 9) & 1) << 5); R = (st >> 1) * 16 + swz / 64; C = (st & 1) * 32 + (swz % 64) / 2; }
DI int perm32(int rho) { const int n = rho >> 4, i = rho & 15; return 8 * (i >> 2) + 4 * n + (i & 3); }

struct Unit { GAS const char* a; GAS const char* b; GAS char* out; int K, ldc, row0, col0, aux0, aux1; };
constexpr int UD = 12;
DI void unit_put(LAS int* tab, int i, const void* a, const void* b, void* o, int K, int ldc, int row0, int col0, int aux0, int aux1) {
    LAS int* p = tab + i * UD; const unsigned long long ua = (unsigned long long)a, ub = (unsigned long long)b, uo = (unsigned long long)o;
    p[0] = (int)(unsigned)ua; p[1] = (int)(unsigned)(ua >> 32); p[2] = (int)(unsigned)ub; p[3] = (int)(unsigned)(ub >> 32); p[4] = (int)(unsigned)uo; p[5] = (int)(unsigned)(uo >> 32);
    p[6] = K; p[7] = ldc; p[8] = row0; p[9] = col0; p[10] = aux0; p[11] = aux1;
}
DI void unit_get(const LAS int* tab, int i, Unit& u) {
    const LAS int* p = tab + i * UD; int v[UD];
#pragma unroll
    for (int j = 0; j < UD; ++j) v[j] = __builtin_amdgcn_readfirstlane(p[j]);
    u.a = (GAS const char*)(((unsigned long long)(unsigned)v[1] << 32) | (unsigned)v[0]);
    u.b = (GAS const char*)(((unsigned long long)(unsigned)v[3] << 32) | (unsigned)v[2]);
    u.out = (GAS char*)(((unsigned long long)(unsigned)v[5] << 32) | (unsigned)v[4]);
    u.K = v[6]; u.ldc = v[7]; u.row0 = v[8]; u.col0 = v[9]; u.aux0 = v[10]; u.aux1 = v[11];
}
DI void build_dense(LAS int* tab, int& n, int& Lbase, const void* A, const void* Bt, void* out, int esz, int M, int N, int K, int ldc, int G, int c) {
    const int nM = M / BM, nN = N / BM, nwg = nM * nN;
    int L = c; if (L < Lbase) L += ((Lbase - L + G - 1) / G) * G;
    for (; L < Lbase + nwg; L += G) {
        int wgid = L - Lbase; { const int q = nwg / NXCD, r = nwg % NXCD, xcd = wgid % NXCD, off = wgid / NXCD; wgid = (xcd < r ? xcd * (q + 1) : r * (q + 1) + (xcd - r) * q) + off; }
        const int nig = WGM * nN, gid = wgid / nig, fm = gid * WGM, gsz = (nM - fm) < WGM ? (nM - fm) : WGM;
        const int pm = fm + ((wgid % nig) % gsz), pn = (wgid % nig) / gsz;
        unit_put(tab, n, (const char*)A + (size_t)pm * BM * K * 2, (const char*)Bt + (size_t)pn * BM * K * 2, out, K, ldc, pm * BM, pn * BM, 0, BM); ++n;
    }
    Lbase += nwg;
}

template <class Epi, bool GATHER>
DI void gemm_phase(LAS unsigned char* lds, const int tid, const LAS int* utab, const int nunits, const LAS int* rowl, const Epi& E) {
    const int wid = __builtin_amdgcn_readfirstlane(tid >> 6), lane = tid & 63, wr = wid >> 2, wc = wid & 3, fr = lane & 15, fq = lane >> 4;
    int Rr[2], Cc[2], Rb[2];
#pragma unroll
    for (int i = 0; i < 2; ++i) { stage_rc(tid * 16 + i * 8192, Rr[i], Cc[i]); Rb[i] = Epi::PERM ? ((Rr[i] & ~31) + perm32(Rr[i] & 31)) : Rr[i]; }
    const size_t kstep = (size_t)(BK * 2);
    const unsigned ldsw = (unsigned)wid * 1024u;
    const int aoff = lds_byte(wr * 64 + fr, fq * 8), boff = lds_byte(wc * 32 + fr, fq * 8);
#define PG8_SA(b, h) (((b) * 2 + (h)) * HTB)
#define PG8_SB(b, h) ((4 + (b) * 2 + (h)) * HTB)
#define PG8_STAGE(bufoff, gbase, voff) do { _Pragma("unroll") for (int _i = 0; _i < 2; ++_i) \
        __builtin_amdgcn_global_load_lds((GAS const unsigned*)((gbase) + (voff)[_i]), (LAS unsigned*)(lds + (bufoff) + ldsw + _i * 8192), 16, 0, 0); } while (0)
#define PG8_LDA(dst, b, h) do { _Pragma("unroll") for (int m = 0; m < 4; ++m) _Pragma("unroll") for (int k = 0; k < 2; ++k) dst[m][k] = *(const LAS bf16x8*)(lds + PG8_SA(b, h) + aoff + m * 2048 + k * 1024); } while (0)
#define PG8_LDB(dst, b, h) do { _Pragma("unroll") for (int n = 0; n < 2; ++n) _Pragma("unroll") for (int k = 0; k < 2; ++k) dst[n][k] = *(const LAS bf16x8*)(lds + PG8_SB(b, h) + boff + n * 2048 + k * 1024); } while (0)
#define PG8_MMA(ai, bj, At, Bt) do { __builtin_amdgcn_s_setprio(1); _Pragma("unroll") for (int m = 0; m < 4; ++m) _Pragma("unroll") for (int n = 0; n < 2; ++n) _Pragma("unroll") for (int k = 0; k < 2; ++k) \
        acc[ai][bj][m][n] = __builtin_amdgcn_mfma_f32_16x16x32_bf16(Bt[n][k], At[m][k], acc[ai][bj][m][n], 0, 0, 0); __builtin_amdgcn_s_setprio(0); } while (0)
#define PG8_WAIT_V(n) asm volatile("s_waitcnt vmcnt(" #n ")" ::: "memory")
#define PG8_WAIT_L(n) asm volatile("s_waitcnt lgkmcnt(" #n ")" ::: "memory")
#define PG8_BAR __builtin_amdgcn_s_barrier()
#define PG8_SCHED __builtin_amdgcn_sched_barrier(0)
#define PG8_VOFF_D(va, vb, K_) do { _Pragma("unroll") for (int _i = 0; _i < 2; ++_i) { va[0][_i] = (unsigned)(Rr[_i] * (K_) + Cc[_i]) * 2u; va[1][_i] = va[0][_i]; vb[_i] = (unsigned)(Rb[_i] * (K_) + Cc[_i]) * 2u; } } while (0)
#define PG8_VOFF_G(va, K_, ui_) do { _Pragma("unroll") for (int _i = 0; _i < 2; ++_i) { _Pragma("unroll") for (int _h = 0; _h < 2; ++_h) { \
        const int _r = rowl[(ui_) * BM + _h * HALF + Rr[_i]]; va[_h][_i] = (unsigned)(_r * (K_) + Cc[_i]) * 2u; } } } while (0)
    if (nunits <= 0) return;
    Unit cur, nxt; int ui = 0;
    unit_get(utab, 0, cur);
    f32x4 acc[2][2][4][2];
#pragma unroll
    for (int a = 0; a < 2; ++a)
#pragma unroll
        for (int b = 0; b < 2; ++b)
#pragma unroll
            for (int m = 0; m < 4; ++m)
#pragma unroll
                for (int n = 0; n < 2; ++n) acc[a][b][m][n] = (f32x4){0.f, 0.f, 0.f, 0.f};
    bf16x8 At[4][2], B0[2][2], B1[2][2];
    unsigned vc[2][2], vbc[2], vn[2][2];
    PG8_VOFF_D(vc, vbc, cur.K);
    if (GATHER) PG8_VOFF_G(vc, cur.K, 0);
    GAS const char* cA = cur.a; GAS const char* cB = cur.b;
    size_t hsc = (size_t)HALF * cur.K * 2;
    size_t hsa = GATHER ? (size_t)0 : hsc;
    PG8_STAGE(PG8_SB(0, 0), cB, vbc); PG8_STAGE(PG8_SA(0, 0), cA, vc[0]); PG8_STAGE(PG8_SB(0, 1), cB + hsc, vbc); PG8_STAGE(PG8_SA(0, 1), cA + hsa, vc[1]);
    if (wr == 1) PG8_BAR;
    PG8_WAIT_V(4); PG8_BAR;
    PG8_STAGE(PG8_SB(1, 0), cB + kstep, vbc); PG8_STAGE(PG8_SA(1, 0), cA + kstep, vc[0]); PG8_STAGE(PG8_SB(1, 1), cB + hsc + kstep, vbc);
    PG8_WAIT_V(6); PG8_BAR;
    for (;;) {
        const bool has_next = (ui + 1 < nunits);
        if (has_next) { unit_get(utab, ui + 1, nxt); if (GATHER) PG8_VOFF_G(vn, nxt.K, ui + 1); }
        else { nxt = cur;
            if (GATHER) {
#pragma unroll
                for (int i = 0; i < 2; ++i) { vn[0][i] = vc[0][i]; vn[1][i] = vc[1][i]; } } }
        GAS const char* nA = nxt.a; GAS const char* nB = nxt.b;
        const int nt = cur.K / BK;
        for (int t = 0; t < nt; t += 2) {
            const bool last = (t == nt - 2);
            GAS const char* a1 = cA + (size_t)(t + 1) * kstep;
            GAS const char* a2 = last ? nA : cA + (size_t)(t + 2) * kstep; GAS const char* b2 = last ? nB : cB + (size_t)(t + 2) * kstep;
            GAS const char* a3 = a2 + kstep; GAS const char* b3 = b2 + kstep;
            PG8_LDB(B0, 0, 0); PG8_SCHED; PG8_LDA(At, 0, 0); PG8_STAGE(PG8_SA(1, 1), a1 + hsa, vc[1]);
            if (last) {
                if (GATHER) {
#pragma unroll
                    for (int i = 0; i < 2; ++i) { vc[0][i] = vn[0][i]; vc[1][i] = vn[1][i]; } }
                if (nxt.K != cur.K) {
                    if (!GATHER) PG8_VOFF_D(vc, vbc, nxt.K);
                    else {
#pragma unroll
                        for (int i = 0; i < 2; ++i) vbc[i] = (unsigned)(Rb[i] * nxt.K + Cc[i]) * 2u; }
                    hsc = (size_t)HALF * nxt.K * 2; hsa = GATHER ? (size_t)0 : hsc; } }
            PG8_WAIT_L(8); PG8_BAR; PG8_WAIT_L(0); PG8_MMA(0, 0, At, B0); PG8_BAR; PG8_SCHED;
            PG8_LDB(B1, 0, 1); PG8_STAGE(PG8_SB(0, 0), b2, vbc);
            PG8_BAR; PG8_WAIT_L(0); PG8_MMA(0, 1, At, B1); PG8_BAR;
            PG8_LDA(At, 0, 1); PG8_STAGE(PG8_SA(0, 0), a2, vc[0]);
            PG8_BAR; PG8_WAIT_L(0); PG8_MMA(1, 0, At, B0); PG8_BAR; PG8_SCHED;
            PG8_STAGE(PG8_SB(0, 1), b2 + hsc, vbc);
            PG8_WAIT_V(6); PG8_BAR; PG8_MMA(1, 1, At, B1); PG8_BAR;
            PG8_LDB(B0, 1, 0); PG8_SCHED; PG8_LDA(At, 1, 0); PG8_STAGE(PG8_SA(0, 1), a2 + hsa, vc[1]);
            PG8_WAIT_L(8); PG8_BAR; PG8_WAIT_L(0); PG8_MMA(0, 0, At, B0); PG8_BAR; PG8_SCHED;
            PG8_LDB(B1, 1, 1); PG8_STAGE(PG8_SB(1, 0), b3, vbc);
            PG8_BAR; PG8_WAIT_L(0); PG8_MMA(0, 1, At, B1); PG8_BAR;
            PG8_LDA(At, 1, 1); PG8_STAGE(PG8_SA(1, 0), a3, vc[0]);
            PG8_BAR; PG8_WAIT_L(0); PG8_MMA(1, 0, At, B0); PG8_BAR; PG8_SCHED;
            PG8_STAGE(PG8_SB(1, 1), b3 + hsc, vbc);
            PG8_WAIT_V(6); PG8_BAR; PG8_MMA(1, 1, At, B1); PG8_BAR;
        }
        E(acc, cur, ui, wr, wc, fr, fq);
        if (!has_next) break;
#pragma unroll
        for (int a = 0; a < 2; ++a)
#pragma unroll
            for (int b = 0; b < 2; ++b)
#pragma unroll
                for (int m = 0; m < 4; ++m)
#pragma unroll
                    for (int n = 0; n < 2; ++n) acc[a][b][m][n] = (f32x4){0.f, 0.f, 0.f, 0.f};
        cur = nxt; cA = nA; cB = nB; ++ui;
    }
    PG8_WAIT_V(0);
    if (wr == 0) PG8_BAR;
    PG8_BAR;
#undef PG8_SA
#undef PG8_SB
#undef PG8_STAGE
#undef PG8_LDA
#undef PG8_LDB
#undef PG8_MMA
#undef PG8_WAIT_V
#undef PG8_WAIT_L
#undef PG8_BAR
#undef PG8_SCHED
#undef PG8_VOFF_D
#undef PG8_VOFF_G
}

struct EpiBf16 {
    static constexpr bool PERM = true;
    DI void operator()(const f32x4 (&acc)[2][2][4][2], const Unit& u, int, int wr, int wc, int fr, int fq) const {
        const int row0 = u.row0 + wr * 64 + fr, col0 = u.col0 + wc * 32 + 8 * fq; GAS bf16_t* O = (GAS bf16_t*)u.out; const int ldc = u.ldc;
#pragma unroll
        for (int ai = 0; ai < 2; ++ai)
#pragma unroll
            for (int m = 0; m < 4; ++m) { GAS bf16_t* rowp = O + (size_t)(row0 + ai * HALF + m * 16) * ldc + col0;
#pragma unroll
                for (int bj = 0; bj < 2; ++bj) { const f32x4 v0 = acc[ai][bj][m][0], v1 = acc[ai][bj][m][1];
                    u32x4 w; w.x = pack2(v0[0], v0[1]); w.y = pack2(v0[2], v0[3]); w.z = pack2(v1[0], v1[1]); w.w = pack2(v1[2], v1[3]);
                    *(GAS u32x4*)(rowp + bj * HALF) = w; } }
    }
};
struct EpiF32 {
    static constexpr bool PERM = false;
    DI void operator()(const f32x4 (&acc)[2][2][4][2], const Unit& u, int, int wr, int wc, int fr, int fq) const {
        const int row0 = u.row0 + wr * 64 + fr, col0 = u.col0 + wc * 32 + 4 * fq; GAS float* C = (GAS float*)u.out; const int ldc = u.ldc;
#pragma unroll
        for (int ai = 0; ai < 2; ++ai)
#pragma unroll
            for (int m = 0; m < 4; ++m) { GAS float* rowp = C + (size_t)(row0 + ai * HALF + m * 16) * ldc + col0;
#pragma unroll
                for (int bj = 0; bj < 2; ++bj)
#pragma unroll
                    for (int n = 0; n < 2; ++n) *(GAS f32x4*)(rowp + bj * HALF + n * 16) = acc[ai][bj][m][n]; }
    }
};
struct EpiGU {
    static constexpr bool PERM = true;
    DI void operator()(const f32x4 (&acc)[2][2][4][2], const Unit& u, int, int wr, int wc, int fr, int fq) const {
        const int row0 = u.row0 + wr * 64 + fr, col0 = (u.col0 >> 1) + wc * 32 + 8 * fq; GAS bf16_t* H = (GAS bf16_t*)u.out;
#pragma unroll
        for (int ai = 0; ai < 2; ++ai)
#pragma unroll
            for (int m = 0; m < 4; ++m) { GAS bf16_t* rowp = H + (size_t)(row0 + ai * HALF + m * 16) * DEXP + col0;
                float o[8];
#pragma unroll
                for (int n = 0; n < 2; ++n)
#pragma unroll
                    for (int j = 0; j < 4; ++j) { const float g = acc[ai][0][m][n][j], up = acc[ai][1][m][n][j]; o[n * 4 + j] = g / (1.0f + __expf(-g)) * up; }
                u32x4 w; w.x = pack2(o[0], o[1]); w.y = pack2(o[2], o[3]); w.z = pack2(o[4], o[5]); w.w = pack2(o[6], o[7]);
                *(GAS u32x4*)rowp = w; }
    }
};
struct EpiScatter {
    static constexpr bool PERM = true;
    const LAS int* rowl;
    DI void operator()(const f32x4 (&acc)[2][2][4][2], const Unit& u, int ui, int wr, int wc, int fr, int fq) const {
        const int col0 = u.col0 + wc * 32 + 8 * fq; GAS bf16_t* Y = (GAS bf16_t*)u.out;
#pragma unroll
        for (int ai = 0; ai < 2; ++ai)
#pragma unroll
            for (int m = 0; m < 4; ++m) { const int t2 = rowl[ui * BM + ai * HALF + wr * 64 + m * 16 + fr];
                if (t2 >= 0) { GAS bf16_t* rowp = Y + (size_t)t2 * D + col0;
#pragma unroll
                    for (int bj = 0; bj < 2; ++bj) { const f32x4 v0 = acc[ai][bj][m][0], v1 = acc[ai][bj][m][1];
                        u32x4 w; w.x = pack2(v0[0], v0[1]); w.y = pack2(v0[2], v0[3]); w.z = pack2(v1[0], v1[1]); w.w = pack2(v1[2], v1[3]);
                        *(GAS u32x4*)(rowp + bj * HALF) = w; } }
                asm volatile("" ::: "memory"); }
    }
};
struct EpiPle {
    static constexpr bool PERM = false;
    const float* x2; const bf16_t* pp; bf16_t* xb;
    DI void operator()(const f32x4 (&acc)[2][2][4][2], const Unit& u, int, int wr, int wc, int fr, int fq) const {
        const int row0 = u.row0 + wr * 64 + fr, col0 = u.col0 + wc * 32 + 4 * fq; GAS float* out = (GAS float*)u.out;
#pragma unroll
        for (int ai = 0; ai < 2; ++ai)
#pragma unroll
            for (int m = 0; m < 4; ++m) { const size_t ro = (size_t)(row0 + ai * HALF + m * 16) * D + col0;
#pragma unroll
                for (int bj = 0; bj < 2; ++bj)
#pragma unroll
                    for (int n = 0; n < 2; ++n) { const size_t o = ro + bj * HALF + n * 16;
                        const f32x4 xv = *(const f32x4*)(x2 + o); const u32x2 pw = *(const u32x2*)(pp + o); const f32x4 a = acc[ai][bj][m][n];
                        f32x4 r; r[0] = xv[0] + bflo(pw.x) / (1.0f + __expf(-a[0])); r[1] = xv[1] + bfhi(pw.x) / (1.0f + __expf(-a[1]));
                        r[2] = xv[2] + bflo(pw.y) / (1.0f + __expf(-a[2])); r[3] = xv[3] + bfhi(pw.y) / (1.0f + __expf(-a[3]));
                        *(GAS f32x4*)(out + o) = r;
                        if (xb) { u32x2 w; w.x = pack2(r[0], r[1]); w.y = pack2(r[2], r[3]); *(u32x2*)(xb + o) = w; } }
                asm volatile("" ::: "memory"); }
    }
};
}

struct Params { const float* in[30]; float* out; unsigned char* ws; int ph_lo, ph_hi; };
struct Frame {
    LAS unsigned char* lds; int tid, lane, wave, G, wg;
    GAS unsigned char* ws; unsigned* ctl;
};
#define WSP(T_, off) ((T_*)(GAS T_*)(F.ws + (off)))
#define INP(i_) ((const float*)(GAS const float*)rfl64(((const LAS unsigned long long*)(F.lds + LDS_INTAB))[i_]))
DI unsigned long long rfl64(unsigned long long v) {
    return ((unsigned long long)(unsigned)__builtin_amdgcn_readfirstlane((int)(unsigned)(v >> 32)) << 32) | (unsigned)__builtin_amdgcn_readfirstlane((int)(unsigned)v);
}
DI int my_tid(int wave) { return (wave << 6) | (int)__builtin_amdgcn_mbcnt_hi(~0u, __builtin_amdgcn_mbcnt_lo(~0u, 0u)); }
DI Frame make_frame(LAS unsigned char* lds, GAS unsigned char* ws, int wave) {
    Frame F;
    int wv = __builtin_amdgcn_readfirstlane(wave); asm volatile("" : "+s"(wv));
    int tid = my_tid(wv); asm volatile("" : "+v"(tid));
    unsigned l32 = (unsigned)__builtin_amdgcn_readfirstlane((int)(unsigned)(size_t)lds); asm volatile("" : "+s"(l32));
    unsigned long long w64 = rfl64((unsigned long long)ws); asm volatile("" : "+s"(w64));
    F.lds = (LAS unsigned char*)l32; F.tid = tid; F.lane = tid & 63; F.wave = wv;
    F.G = gridDim.x; F.wg = blockIdx.x;
    F.ws = (GAS unsigned char*)w64;
    F.ctl = (unsigned*)(GAS unsigned*)F.ws;
    return F;
}
#define PHASE_FN __device__ __forceinline__ void
#define GEMM_FN __device__ __forceinline__ void
#define PHASE_ARGS LAS unsigned char* lds_, GAS unsigned char* ws_, int wave_
#define PHASE_FRAME const Frame F = make_frame(lds_, ws_, wave_)

template <int MODE> DI int rowmap(int n, int which) {
    if (MODE == 0) return n;
    if (MODE == 1) return (n >> 7) * 256 + which * 128 + (n & 127);
    const int h = n >> 8, c = n & 255; return c < 128 ? h * 128 + c : 768 + h * 128 + (c - 128);
}
template <int MODE>
DI void convert_t(const Frame F, const float* src, int K, int N, bf16_t* dst, int which, int nmat, size_t src_ms, size_t dst_ms) {
    LAS float* tile = (LAS float*)F.lds;
    const int nkt = K / 64, nnt = (N + 255) / 256, per = nkt * nnt, total = per * nmat;
    const int tid = F.tid;
    f32x4 reg[8];
    int ti = F.wg;
#define CONV_ISSUE(t_) do { const int t__ = (t_); const int mat_ = t__ / per, rem_ = t__ - mat_ * per, kt_ = rem_ / nnt, ntl_ = rem_ - kt_ * nnt; \
        const float* s_ = src + (size_t)mat_ * src_ms + (size_t)(kt_ * 64) * N + ntl_ * 256; const int n4_ = tid & 63, n_ = ntl_ * 256 + n4_ * 4; \
        _Pragma("unroll") for (int i_ = 0; i_ < 8; ++i_) { const int kr_ = (tid >> 6) + 8 * i_; reg[i_] = (n_ < N) ? *(const f32x4*)(s_ + (size_t)kr_ * N + n4_ * 4) : (f32x4){0.f, 0.f, 0.f, 0.f}; } } while (0)
    if (ti < total) CONV_ISSUE(ti);
    for (; ti < total; ti += F.G) {
#pragma unroll
        for (int i = 0; i < 8; ++i) { const int kr = (tid >> 6) + 8 * i; *(LAS f32x4*)(tile + kr * 260 + (tid & 63) * 4) = reg[i]; }
        __syncthreads();
        const int mat = ti / per, rem = ti - mat * per, kt = rem / nnt, nt_ = rem - kt * nnt;
        if (ti + F.G < total) CONV_ISSUE(ti + F.G);
        bf16_t* d = dst + (size_t)mat * dst_ms + kt * 64;
#pragma unroll
        for (int i = 0; i < 4; ++i) {
            const int nl = (tid >> 3) + 64 * i, kg = tid & 7, n = nt_ * 256 + nl;
            if (n < N) {
                float v[8];
#pragma unroll
                for (int j = 0; j < 8; ++j) v[j] = tile[(kg * 8 + j) * 260 + nl];
                u32x4 w; w.x = pack2(v[0], v[1]); w.y = pack2(v[2], v[3]); w.z = pack2(v[4], v[5]); w.w = pack2(v[6], v[7]);
                *(u32x4*)(d + (size_t)rowmap<MODE>(n, which) * K + kg * 8) = w;
            }
        }
        __syncthreads();
    }
}
DI void zero_rows(const Frame F, bf16_t* dst, size_t nelem) {
    for (size_t i = ((size_t)F.wg * 512 + F.tid) * 8; i < nelem; i += (size_t)F.G * 512 * 8) *(u32x4*)(dst + i) = (u32x4){0u, 0u, 0u, 0u};
}
DI void cvt_plain(const Frame F, const float* src, bf16_t* dst, size_t nelem) {
    for (size_t i = ((size_t)F.wg * 512 + F.tid) * 4; i < nelem; i += (size_t)F.G * 512 * 4) {
        const f32x4 v = *(const f32x4*)(src + i); u32x2 w; w.x = pack2(v[0], v[1]); w.y = pack2(v[2], v[3]); *(u32x2*)(dst + i) = w; }
}
DI void p_prologue(const Frame F) {
    convert_t<0>(F, INP(2), 2048, 8000, WSP(bf16_t, WS_WIN), 0, NL, (size_t)2048 * 8000, (size_t)8192 * 2048);
    for (int l = 0; l < NL; ++l) zero_rows(F, WSP(bf16_t, WS_WIN) + (size_t)l * 8192 * 2048 + (size_t)8000 * 2048, (size_t)192 * 2048);
    convert_t<0>(F, INP(18), 2048, 2048, WSP(bf16_t, WS_WOUT), 0, NL, (size_t)2048 * 2048, (size_t)2048 * 2048);
    convert_t<0>(F, INP(29), 2048, 2048, WSP(bf16_t, WS_WPG), 0, NL, (size_t)2048 * 2048, (size_t)2048 * 2048);
    convert_t<0>(F, INP(28), 256, 2048, WSP(bf16_t, WS_WPP), 0, NL, (size_t)256 * 2048, (size_t)2048 * 256);
    convert_t<1>(F, INP(23), 2048, 512, WSP(bf16_t, WS_WGU), 0, NL * 32, (size_t)2048 * 512, (size_t)1024 * 2048);
    convert_t<1>(F, INP(24), 2048, 512, WSP(bf16_t, WS_WGU), 1, NL * 32, (size_t)2048 * 512, (size_t)1024 * 2048);
    convert_t<0>(F, INP(25), 512, 2048, WSP(bf16_t, WS_WDN), 0, NL * 32, (size_t)512 * 2048, (size_t)2048 * 512);
    convert_t<0>(F, INP(15), 512, 1152, WSP(bf16_t, WS_WUQ), 0, NL, (size_t)512 * 1152, (size_t)1280 * 512);
    for (int l = 0; l < NL; ++l) zero_rows(F, WSP(bf16_t, WS_WUQ) + (size_t)l * 1280 * 512 + (size_t)1152 * 512, (size_t)128 * 512);
    convert_t<2>(F, INP(17), 256, 1536, WSP(bf16_t, WS_WUKV), 0, NL, (size_t)256 * 1536, (size_t)1536 * 256);
    cvt_plain(F, INP(0), WSP(bf16_t, WS_XBF), (size_t)T * D);
    cvt_plain(F, INP(1), WSP(bf16_t, WS_PBF), (size_t)NL * T * PLE);
    for (int i = F.wg * 512 + F.tid; i < 4096 * 32; i += F.G * 512) {
        const int pos = i >> 5, k = i & 31; const double ang = (double)pos * pow(10000.0, -(double)k / 32.0);
        WSP(f32x2, WS_ROPE)[i] = (f32x2){(float)cos(ang), (float)sin(ang)}; }
}

DI float zsh(const bf16_t* z, int t, int c, float mu) {
    const float a = bf2f(z[(size_t)t * ZLD + c]);
    const float p = ((t & (SEQ - 1)) == 0) ? 0.f : bf2f(z[(size_t)(t - 1) * ZLD + c]);
    return a + (p - a) * mu;
}
DI void p_rwkv_prep(const Frame F, int l) {
    const bf16_t* z = WSP(bf16_t, WS_Z);
    const float* mu = INP(3) + (size_t)l * 2560; const float* w0 = INP(4) + (size_t)l * 768;
    const float* w_up = INP(5) + (size_t)l * 64 * 768; const float* a0 = INP(6) + (size_t)l * 768; const float* a_up = INP(7) + (size_t)l * 64 * 768;
    const float* g_up = INP(8) + (size_t)l * 128 * 768; const float* k_k = INP(9) + (size_t)l * 768; const float* k_a = INP(10) + (size_t)l * 768;
    const float* r_k = INP(11) + (size_t)l * 768;
    float* R = WSP(float, WS_RW); float* DEC = R + (size_t)T * 768; float* K2 = DEC + (size_t)T * 768; float* V = K2 + (size_t)T * 768;
    float* AA = V + (size_t)T * 768; float* BB = AA + (size_t)T * 768; float* GG = BB + (size_t)T * 768; float* RK = WSP(float, WS_RK);
    LAS float* lw = (LAS float*)F.lds;
    LAS float* la = lw + 16 * 64;
    LAS float* lg = la + 16 * 64;
    const int tid = F.tid;
    for (int tile = F.wg; tile < T / 16; tile += F.G) {
        const int t0 = tile * 16;
        __syncthreads();
        for (int i = tid; i < 16 * 256; i += 512) { const int tk = i >> 8, c = i & 255; const float v = zsh(z, t0 + tk, 2304 + c, mu[2304 + c]);
            if (c < 64) lw[tk * 64 + c] = tanhf(v); else if (c < 128) la[tk * 64 + (c - 64)] = v; else lg[tk * 128 + (c - 128)] = sigmoidf_(v); }
        __syncthreads();
        for (int p = 0; p < 4; ++p) {
            const int c = (p >> 1) * 512 + tid, tb = (p & 1) * 8;
            if (c < 768) {
                float aw[8], aa[8], ag[8];
#pragma unroll
                for (int i = 0; i < 8; ++i) { aw[i] = 0.f; aa[i] = 0.f; ag[i] = 0.f; }
#pragma unroll 2
                for (int k = 0; k < 64; k += 4) {
                    float wu[4], au[4], g0[4], g1[4];
#pragma unroll
                    for (int j = 0; j < 4; ++j) { wu[j] = w_up[(size_t)(k + j) * 768 + c]; au[j] = a_up[(size_t)(k + j) * 768 + c]; g0[j] = g_up[(size_t)(k + j) * 768 + c]; g1[j] = g_up[(size_t)(64 + k + j) * 768 + c]; }
#pragma unroll
                    for (int tk = 0; tk < 8; ++tk) {
                        const f32x4 xw = *(const LAS f32x4*)(lw + (tb + tk) * 64 + k), xa = *(const LAS f32x4*)(la + (tb + tk) * 64 + k), x0 = *(const LAS f32x4*)(lg + (tb + tk) * 128 + k), x1 = *(const LAS f32x4*)(lg + (tb + tk) * 128 + 64 + k);
#pragma unroll
                        for (int j = 0; j < 4; ++j) { aw[tk] += xw[j] * wu[j]; aa[tk] += xa[j] * au[j]; ag[tk] += x0[j] * g0[j] + x1[j] * g1[j]; }
                    }
                }
                const float mur = mu[c], muk = mu[768 + c], muv = mu[1536 + c], w0c = w0[c], a0c = a0[c], kkc = k_k[c], kac = k_a[c], rkc = r_k[c];
                const int h = c >> 6;
#pragma unroll
                for (int tk = 0; tk < 8; ++tk) {
                    const int t = t0 + tb + tk;
                    const float zr = zsh(z, t, c, mur), zk = zsh(z, t, 768 + c, muk), zv = zsh(z, t, 1536 + c, muv);
                    const float xw = -(w0c + aw[tk]);
                    const float sp = (xw > 15.f) ? xw : log1pf(__expf(xw));
                    const float w = -sp - 0.5f;
                    const float dec = __expf(-__expf(w));
                    const float a = sigmoidf_(a0c + aa[tk]);
                    const float kkv = zk * kkc;
                    const float nrm = sqrtf(wave_sum(kkv * kkv));
                    const float kkh = kkv / fmaxf(nrm, 1e-12f);
                    const float k2 = zk * (1.0f + (a - 1.0f) * kac);
                    const float rks = wave_sum(zr * k2 * rkc);
                    const size_t o = (size_t)t * 768 + c;
                    R[o] = zr; DEC[o] = dec; K2[o] = k2; V[o] = zv; AA[o] = -kkh; BB[o] = kkh * a; GG[o] = ag[tk];
                    if ((tid & 63) == 0) RK[(size_t)t * 16 + h] = rks;
                }
            }
        }
    }
}

DI void p_mla_prep(const Frame F, int l) {
    const bf16_t* z = WSP(bf16_t, WS_Z);
    const float* qa_g = INP(14) + (size_t)l * 512; const float* kva_g = INP(16) + (size_t)l * 256;
    bf16_t* qn = WSP(bf16_t, WS_QN); bf16_t* kvn = WSP(bf16_t, WS_KVN); bf16_t* kr = WSP(bf16_t, WS_KROPE);
    const f32x2* rope = WSP(f32x2, WS_ROPE);
    const int lane = F.lane;
    for (int t = F.wg * 8 + F.wave; t < T; t += F.G * 8) {
        const bf16_t* zr = z + (size_t)t * ZLD;
        { const u32x4 w = *(const u32x4*)(zr + ZC_QA + lane * 8); float v[8] = {bflo(w.x), bfhi(w.x), bflo(w.y), bfhi(w.y), bflo(w.z), bfhi(w.z), bflo(w.w), bfhi(w.w)};
          float ss = 0.f;
#pragma unroll
          for (int j = 0; j < 8; ++j) ss += v[j] * v[j];
          ss = wave_sum(ss); const float rs = rsqrtf(ss * (1.0f / 512.0f) + 1e-6f);
          const f32x4 g0 = *(const f32x4*)(qa_g + lane * 8), g1 = *(const f32x4*)(qa_g + lane * 8 + 4);
          u32x4 o; o.x = pack2(v[0] * rs * g0[0], v[1] * rs * g0[1]); o.y = pack2(v[2] * rs * g0[2], v[3] * rs * g0[3]); o.z = pack2(v[4] * rs * g1[0], v[5] * rs * g1[1]); o.w = pack2(v[6] * rs * g1[2], v[7] * rs * g1[3]);
          *(u32x4*)(qn + (size_t)t * 512 + lane * 8) = o; }
        { const u32x2 w = *(const u32x2*)(zr + ZC_KVA + lane * 4); float v[4] = {bflo(w.x), bfhi(w.x), bflo(w.y), bfhi(w.y)};
          float ss = v[0] * v[0] + v[1] * v[1] + v[2] * v[2] + v[3] * v[3];
          ss = wave_sum(ss); const float rs = rsqrtf(ss * (1.0f / 256.0f) + 1e-6f);
          const f32x4 g0 = *(const f32x4*)(kva_g + lane * 4);
          u32x2 o; o.x = pack2(v[0] * rs * g0[0], v[1] * rs * g0[1]); o.y = pack2(v[2] * rs * g0[2], v[3] * rs * g0[3]);
          *(u32x2*)(kvn + (size_t)t * 256 + lane * 4) = o; }
        { const int i = lane & 31; const float t1 = bf2f(zr[ZC_KR + i]), t2 = bf2f(zr[ZC_KR + 32 + i]); const f32x2 cs = rope[(t & (SEQ - 1)) * 32 + i];
          const float o = (lane < 32) ? (t1 * cs.x - t2 * cs.y) : (t1 * cs.y + t2 * cs.x);
          kr[(size_t)t * 64 + lane] = f2bf(o); }
    }
}

DI void p_vtd_prep(const Frame F) {
    const bf16_t* z = WSP(bf16_t, WS_Z); bf16_t* vtd = WSP(bf16_t, WS_VTD);
    LAS bf16_t* buf = (LAS bf16_t*)(F.lds + F.wave * 8704);
    const int lane = F.lane;
    for (int tile = F.wg * 8 + F.wave; tile < 2 * 12 * 128; tile += F.G * 8) {
        const int pt = tile & 127, hd = (tile >> 7) % 12, b = tile / (128 * 12);
        const int g = hd >> 2, d = 1 << (2 * g), Ls = SEQ / d;
        const int pos0 = pt * 32, r = pos0 / Ls, j0 = pos0 - r * Ls;
#pragma unroll
        for (int i = 0; i < 8; ++i) { const int p = lane + 64 * i, row = p >> 4, seg = p & 15;
            const size_t tok = (size_t)b * SEQ + (size_t)(j0 + row) * d + r;
            const u32x4 w = *(const u32x4*)(z + tok * ZLD + ZC_DV + hd * 128 + seg * 8);
            *(LAS u32x4*)(buf + row * 136 + seg * 8) = w; }
        __builtin_amdgcn_s_waitcnt(0);
#pragma unroll
        for (int i = 0; i < 8; ++i) { const int p = lane + 64 * i, dv = p >> 2, seg = p & 3;
            unsigned short v[8];
#pragma unroll
            for (int j = 0; j < 8; ++j) v[j] = buf[(seg * 8 + j) * 136 + dv];
            u32x4 w; w.x = v[0] | ((unsigned)v[1] << 16); w.y = v[2] | ((unsigned)v[3] << 16); w.z = v[4] | ((unsigned)v[5] << 16); w.w = v[6] | ((unsigned)v[7] << 16);
            *(u32x4*)(vtd + ((size_t)(b * 12 + hd) * 128 + dv) * SEQ + pos0 + seg * 8) = w; }
        __builtin_amdgcn_s_waitcnt(0);
    }
}

DI int swap23(int i) { return (i & ~12) | ((i & 4) << 1) | ((i & 8) >> 1); }
DI int crow(int reg, int h) { return (reg & 3) + 8 * (reg >> 2) + 4 * h; }
#define MFMA32(a, b, c) __builtin_amdgcn_mfma_f32_32x32x16_bf16((a), (b), (c), 0, 0, 0)
DI bf16x8 packp(const f32x16& p, int s) {
    u32x4 w; w.x = pack2(p[8 * s], p[8 * s + 1]); w.y = pack2(p[8 * s + 2], p[8 * s + 3]); w.z = pack2(p[8 * s + 4], p[8 * s + 5]); w.w = pack2(p[8 * s + 6], p[8 * s + 7]);
    return __builtin_bit_cast(bf16x8, w);
}

DI void dil_item(const Frame F, int item) {
    const bf16_t* z = WSP(bf16_t, WS_Z); const bf16_t* vtd = WSP(bf16_t, WS_VTD);
    bf16_t* op = WSP(bf16_t, WS_OP); float* lse = WSP(float, WS_LSE);
    const int lane = F.lane, c = lane & 31, hh = lane >> 5;
    const int bgh = item >> 7, rem = item & 127, b = bgh / 12, hd = bgh % 12, g = hd >> 2, hs = hd & 3;
    const int d = 1 << (2 * g), Ls = SEQ / d, ntile = Ls / 32, r = rem / ntile, jt = rem % ntile;
    const float slope2 = exp2f(-8.0f * (float)(hd + 1) / 12.0f) * LOG2E * (float)d;
    const float sc = 0.08838834764831845f * LOG2E;
    const int jq = jt * 32 + c;
    const size_t tq = (size_t)b * SEQ + (size_t)jq * d + r;
    bf16x8 qf[8];
#pragma unroll
    for (int ks = 0; ks < 8; ++ks) qf[ks] = *(const bf16x8*)(z + tq * ZLD + ZC_DQ + hd * 128 + 16 * ks + 8 * hh);
    f32x16 O[4];
#pragma unroll
    for (int i = 0; i < 4; ++i)
#pragma unroll
        for (int j = 0; j < 16; ++j) O[i][j] = 0.f;
    float m = -1e30f, lsum = 0.f;
    const int kt0 = jt - 4 < 0 ? 0 : jt - 4;
    for (int kt = kt0; kt <= jt; ++kt) {
        const int jk = kt * 32 + swap23(c);
        const size_t tk = (size_t)b * SEQ + (size_t)jk * d + r;
        bf16x8 kf[8], vf[4][2];
#pragma unroll
        for (int ks = 0; ks < 8; ++ks) kf[ks] = *(const bf16x8*)(z + tk * ZLD + ZC_DK + hd * 128 + 16 * ks + 8 * hh);
#pragma unroll
        for (int dvt = 0; dvt < 4; ++dvt)
#pragma unroll
            for (int s = 0; s < 2; ++s) vf[dvt][s] = *(const bf16x8*)(vtd + ((size_t)(b * 12 + hd) * 128 + dvt * 32 + c) * SEQ + r * Ls + kt * 32 + 16 * s + 8 * hh);
        f32x16 S;
#pragma unroll
        for (int j = 0; j < 16; ++j) S[j] = 0.f;
#pragma unroll
        for (int ks = 0; ks < 8; ++ks) S = MFMA32(kf[ks], qf[ks], S);
        float mx = -1e30f;
#pragma unroll
        for (int i = 0; i < 16; ++i) { const int rel = jq - (kt * 32 + swap23(crow(i, hh)));
            float s = S[i] * sc - slope2 * (float)rel; s = (rel >= 0 && rel <= 128) ? s : -1e30f; S[i] = s; mx = fmaxf(mx, s); }
        mx = fmaxf(mx, __shfl_xor(mx, 32));
        const float mn = fmaxf(m, mx), al = __builtin_amdgcn_exp2f(m - mn); m = mn;
        float ps = 0.f;
#pragma unroll
        for (int i = 0; i < 16; ++i) { const float p = __builtin_amdgcn_exp2f(S[i] - mn); S[i] = p; ps += p; }
        lsum = lsum * al + ps;
#pragma unroll
        for (int i = 0; i < 4; ++i)
#pragma unroll
            for (int j = 0; j < 16; ++j) O[i][j] *= al;
        const bf16x8 p0 = packp(S, 0), p1 = packp(S, 1);
#pragma unroll
        for (int dvt = 0; dvt < 4; ++dvt) { O[dvt] = MFMA32(vf[dvt][0], p0, O[dvt]); O[dvt] = MFMA32(vf[dvt][1], p1, O[dvt]); }
    }
    const float lt = lsum + __shfl_xor(lsum, 32), inv = 1.0f / lt;
    bf16_t* orow = op + ((size_t)g * T + tq) * 512 + hs * 128;
#pragma unroll
    for (int dvt = 0; dvt < 4; ++dvt)
#pragma unroll
        for (int g4 = 0; g4 < 4; ++g4) { u32x2 w; w.x = pack2(O[dvt][4 * g4] * inv, O[dvt][4 * g4 + 1] * inv); w.y = pack2(O[dvt][4 * g4 + 2] * inv, O[dvt][4 * g4 + 3] * inv);
            *(u32x2*)(orow + dvt * 32 + 8 * g4 + 4 * hh) = w; }
    if (hh == 0) lse[((size_t)g * T + tq) * 4 + hs] = m + __builtin_amdgcn_logf(lt);
}

DI void mla_item(const Frame F, int item) {
    const bf16_t* qb = WSP(bf16_t, WS_QB); const bf16_t* kc = WSP(bf16_t, WS_KC); const bf16_t* krp = WSP(bf16_t, WS_KROPE); const bf16_t* vt = WSP(bf16_t, WS_VT);
    const f32x2* rope = WSP(f32x2, WS_ROPE); bf16_t* mix = WSP(bf16_t, WS_MIX);
    const int lane = F.lane, c = lane & 31, hh = lane >> 5;
    const int qt = 127 - item / 12, bh = item % 12, b = bh / 6, h = bh % 6;
    const int q0 = qt * 32;
    const size_t tq = (size_t)b * SEQ + q0 + c;
    const float sc = 0.07216878364870322f * LOG2E;
    bf16x8 qf[12];
#pragma unroll
    for (int ks = 0; ks < 12; ++ks) qf[ks] = *(const bf16x8*)(qb + tq * 1280 + h * 192 + 16 * ks + 8 * hh);
#pragma unroll
    for (int kk = 0; kk < 2; ++kk) {
        const u32x4 w1 = __builtin_bit_cast(u32x4, qf[8 + kk]), w2 = __builtin_bit_cast(u32x4, qf[10 + kk]);
        const unsigned a1[4] = {w1.x, w1.y, w1.z, w1.w}, a2[4] = {w2.x, w2.y, w2.z, w2.w};
        unsigned o1[4], o2[4];
#pragma unroll
        for (int jj = 0; jj < 4; ++jj) {
            const int i0 = 16 * kk + 8 * hh + 2 * jj;
            const f32x2 cs0 = rope[(q0 + c) * 32 + i0], cs1 = rope[(q0 + c) * 32 + i0 + 1];
            const float t1a = bflo(a1[jj]), t1b = bfhi(a1[jj]), t2a = bflo(a2[jj]), t2b = bfhi(a2[jj]);
            o1[jj] = pack2(t1a * cs0.x - t2a * cs0.y, t1b * cs1.x - t2b * cs1.y);
            o2[jj] = pack2(t1a * cs0.y + t2a * cs0.x, t1b * cs1.y + t2b * cs1.x);
        }
        qf[8 + kk] = __builtin_bit_cast(bf16x8, (u32x4){o1[0], o1[1], o1[2], o1[3]});
        qf[10 + kk] = __builtin_bit_cast(bf16x8, (u32x4){o2[0], o2[1], o2[2], o2[3]});
    }
    f32x16 O[4];
#pragma unroll
    for (int i = 0; i < 4; ++i)
#pragma unroll
        for (int j = 0; j < 16; ++j) O[i][j] = 0.f;
    float m = -1e30f, lsum = 0.f;
    for (int kt = 0; kt <= qt; ++kt) {
        const size_t tk = (size_t)b * SEQ + kt * 32 + swap23(c);
        bf16x8 kf[12], vf[4][2];
#pragma unroll
        for (int ks = 0; ks < 8; ++ks) kf[ks] = *(const bf16x8*)(kc + tk * 768 + h * 128 + 16 * ks + 8 * hh);
#pragma unroll
        for (int ks = 0; ks < 4; ++ks) kf[8 + ks] = *(const bf16x8*)(krp + tk * 64 + 16 * ks + 8 * hh);
#pragma unroll
        for (int dvt = 0; dvt < 4; ++dvt)
#pragma unroll
            for (int s = 0; s < 2; ++s) vf[dvt][s] = *(const bf16x8*)(vt + (size_t)(h * 128 + dvt * 32 + c) * T + (size_t)b * SEQ + kt * 32 + 16 * s + 8 * hh);
        f32x16 S;
#pragma unroll
        for (int j = 0; j < 16; ++j) S[j] = 0.f;
#pragma unroll
        for (int ks = 0; ks < 12; ++ks) S = MFMA32(kf[ks], qf[ks], S);
        float mx = -1e30f;
        const bool diag = (kt == qt);
#pragma unroll
        for (int i = 0; i < 16; ++i) { float s = S[i] * sc; if (diag && swap23(crow(i, hh)) > c) s = -1e30f; S[i] = s; mx = fmaxf(mx, s); }
        mx = fmaxf(mx, __shfl_xor(mx, 32));
        const float mn = fmaxf(m, mx), al = __builtin_amdgcn_exp2f(m - mn); m = mn;
        float ps = 0.f;
#pragma unroll
        for (int i = 0; i < 16; ++i) { const float p = __builtin_amdgcn_exp2f(S[i] - mn); S[i] = p; ps += p; }
        lsum = lsum * al + ps;
#pragma unroll
        for (int i = 0; i < 4; ++i)
#pragma unroll
            for (int j = 0; j < 16; ++j) O[i][j] *= al;
        const bf16x8 p0 = packp(S, 0), p1 = packp(S, 1);
#pragma unroll
        for (int dvt = 0; dvt < 4; ++dvt) { O[dvt] = MFMA32(vf[dvt][0], p0, O[dvt]); O[dvt] = MFMA32(vf[dvt][1], p1, O[dvt]); }
    }
    const float lt = lsum + __shfl_xor(lsum, 32), inv = 1.0f / lt;
    bf16_t* orow = mix + tq * D + 1280 + h * 128;
#pragma unroll
    for (int dvt = 0; dvt < 4; ++dvt)
#pragma unroll
        for (int g4 = 0; g4 < 4; ++g4) { u32x2 w; w.x = pack2(O[dvt][4 * g4] * inv, O[dvt][4 * g4 + 1] * inv); w.y = pack2(O[dvt][4 * g4 + 2] * inv, O[dvt][4 * g4 + 3] * inv);
            *(u32x2*)(orow + dvt * 32 + 8 * g4 + 4 * hh) = w; }
}

DI void dilc_item(const Frame F, int item) {
    const bf16_t* op = WSP(bf16_t, WS_OP); const float* lse = WSP(float, WS_LSE); bf16_t* mix = WSP(bf16_t, WS_MIX);
    for (int i = 0; i < 16; ++i) {
        const int task = i * 64 + F.lane, tl = task >> 6, rem = task & 63, hs = rem >> 4, oc = rem & 15;
        const size_t t = (size_t)item * 16 + tl;
        const float l0 = lse[((size_t)0 * T + t) * 4 + hs], l1 = lse[((size_t)1 * T + t) * 4 + hs], l2 = lse[((size_t)2 * T + t) * 4 + hs];
        const float mx = fmaxf(l0, fmaxf(l1, l2));
        float w0 = __builtin_amdgcn_exp2f(l0 - mx), w1 = __builtin_amdgcn_exp2f(l1 - mx), w2 = __builtin_amdgcn_exp2f(l2 - mx);
        const float inv = 1.0f / (w0 + w1 + w2); w0 *= inv; w1 *= inv; w2 *= inv;
        const u32x4 a = *(const u32x4*)(op + ((size_t)0 * T + t) * 512 + hs * 128 + oc * 8), bq = *(const u32x4*)(op + ((size_t)1 * T + t) * 512 + hs * 128 + oc * 8), cq = *(const u32x4*)(op + ((size_t)2 * T + t) * 512 + hs * 128 + oc * 8);
        const unsigned aw[4] = {a.x, a.y, a.z, a.w}, bw[4] = {bq.x, bq.y, bq.z, bq.w}, cw[4] = {cq.x, cq.y, cq.z, cq.w}; unsigned o[4];
#pragma unroll
        for (int j = 0; j < 4; ++j) o[j] = pack2(w0 * bflo(aw[j]) + w1 * bflo(bw[j]) + w2 * bflo(cw[j]), w0 * bfhi(aw[j]) + w1 * bfhi(bw[j]) + w2 * bfhi(cw[j]));
        *(u32x4*)(mix + t * D + 768 + hs * 128 + oc * 8) = (u32x4){o[0], o[1], o[2], o[3]};
    }
}

DI float dppf(float x, int ctrl_sel) {
    const int v = __float_as_int(x); int r;
    if (ctrl_sel == 0) r = __builtin_amdgcn_mov_dpp(v, 0xB1, 0xF, 0xF, true);
    else if (ctrl_sel == 1) r = __builtin_amdgcn_mov_dpp(v, 0x4E, 0xF, 0xF, true);
    else r = __builtin_amdgcn_mov_dpp(v, 0x141, 0xF, 0xF, true);
    return __int_as_float(r);
}
DI float reduce8(float x) { x += dppf(x, 0); x += dppf(x, 1); x += dppf(x, 2); return x; }
constexpr int RTS = 32;
DI void p_rwkv_scan(const Frame F, int l, int bh) {
    const float* R = WSP(float, WS_RW); const float* DEC = R + (size_t)T * 768; const float* K2 = DEC + (size_t)T * 768; const float* V = K2 + (size_t)T * 768;
    const float* AA = V + (size_t)T * 768; const float* BB = AA + (size_t)T * 768; const float* GG = BB + (size_t)T * 768; const float* RK = WSP(float, WS_RK);
    const float* gn_g = INP(12) + (size_t)l * 768; const float* gn_b = INP(13) + (size_t)l * 768;
    bf16_t* mix = WSP(bf16_t, WS_MIX);
    const int b = bh / 12, h = bh % 12, tid = F.tid, i = tid >> 3, jg = tid & 7;
    LAS float* sb = (LAS float*)F.lds;
    LAS float* yb = sb + 2 * 6 * RTS * 64;
    f32x4 reg[6];
    const int st_step = tid >> 4, st_c4 = (tid & 15) * 4;
#define SCAN_ISSUE(chunk_) do { const size_t tok_ = (size_t)b * SEQ + (size_t)(chunk_) * RTS + st_step; \
        reg[0] = *(const f32x4*)(R + tok_ * 768 + h * 64 + st_c4); reg[1] = *(const f32x4*)(DEC + tok_ * 768 + h * 64 + st_c4); reg[2] = *(const f32x4*)(K2 + tok_ * 768 + h * 64 + st_c4); \
        reg[3] = *(const f32x4*)(V + tok_ * 768 + h * 64 + st_c4); reg[4] = *(const f32x4*)(AA + tok_ * 768 + h * 64 + st_c4); reg[5] = *(const f32x4*)(BB + tok_ * 768 + h * 64 + st_c4); } while (0)
    float s[8];
#pragma unroll
    for (int j = 0; j < 8; ++j) s[j] = 0.f;
    SCAN_ISSUE(0);
    __syncthreads();
#pragma unroll
    for (int a = 0; a < 6; ++a) *(LAS f32x4*)(sb + (0 * 6 + a) * RTS * 64 + st_step * 64 + st_c4) = reg[a];
    __syncthreads();
    const int nchunk = SEQ / RTS;
    for (int ch = 0; ch < nchunk; ++ch) {
        const int cb = ch & 1;
        if (ch + 1 < nchunk) SCAN_ISSUE(ch + 1);
        const LAS float* pr = sb + (cb * 6 + 0) * RTS * 64 + jg * 8; const LAS float* pw = sb + (cb * 6 + 1) * RTS * 64 + jg * 8;
        const LAS float* pk = sb + (cb * 6 + 2) * RTS * 64 + jg * 8; const LAS float* pv = sb + (cb * 6 + 3) * RTS * 64 + i;
        const LAS float* pa = sb + (cb * 6 + 4) * RTS * 64 + jg * 8; const LAS float* pb = sb + (cb * 6 + 5) * RTS * 64 + jg * 8;
#pragma unroll 4
        for (int st = 0; st < RTS; ++st) {
            const f32x4 a0 = *(const LAS f32x4*)(pa + st * 64), a1 = *(const LAS f32x4*)(pa + st * 64 + 4);
            const f32x4 w0 = *(const LAS f32x4*)(pw + st * 64), w1 = *(const LAS f32x4*)(pw + st * 64 + 4);
            const f32x4 b0 = *(const LAS f32x4*)(pb + st * 64), b1 = *(const LAS f32x4*)(pb + st * 64 + 4);
            const f32x4 k0 = *(const LAS f32x4*)(pk + st * 64), k1 = *(const LAS f32x4*)(pk + st * 64 + 4);
            const f32x4 r0 = *(const LAS f32x4*)(pr + st * 64), r1 = *(const LAS f32x4*)(pr + st * 64 + 4);
            const float vv = pv[st * 64];
            float sa = (s[0] * a0[0] + s[1] * a0[1]) + (s[2] * a0[2] + s[3] * a0[3]) + (s[4] * a1[0] + s[5] * a1[1]) + (s[6] * a1[2] + s[7] * a1[3]);
            sa = reduce8(sa);
#pragma unroll
            for (int j = 0; j < 4; ++j) { s[j] = s[j] * w0[j] + (sa * b0[j] + vv * k0[j]); s[4 + j] = s[4 + j] * w1[j] + (sa * b1[j] + vv * k1[j]); }
            float y = (s[0] * r0[0] + s[1] * r0[1]) + (s[2] * r0[2] + s[3] * r0[3]) + (s[4] * r1[0] + s[5] * r1[1]) + (s[6] * r1[2] + s[7] * r1[3]);
            y = reduce8(y);
            if (jg == 0) yb[st * 64 + i] = y;
        }
        __syncthreads();
#pragma unroll
        for (int q = 0; q < RTS / 8; ++q) {
            const int st = F.wave * (RTS / 8) + q, lane = F.lane;
            const size_t tok = (size_t)b * SEQ + (size_t)ch * RTS + st;
            const float y = yb[st * 64 + lane];
            const float mean = wave_sum(y) * (1.0f / 64.0f); const float dlt = y - mean; const float var = wave_sum(dlt * dlt) * (1.0f / 64.0f);
            const int cidx = h * 64 + lane;
            float o = dlt * rsqrtf(var + 64e-5f) * gn_g[cidx] + gn_b[cidx];
            o += RK[tok * 16 + h] * sb[(cb * 6 + 3) * RTS * 64 + st * 64 + lane];
            o *= GG[tok * 768 + cidx];
            mix[tok * D + cidx] = f2bf(o);
        }
        if (ch + 1 < nchunk) {
#pragma unroll
            for (int a = 0; a < 6; ++a) *(LAS f32x4*)(sb + ((cb ^ 1) * 6 + a) * RTS * 64 + st_step * 64 + st_c4) = reg[a];
        }
        __syncthreads();
    }
}

DI void p_ln1_route(const Frame F, int l, const float* xin) {
    const float* tmp = WSP(float, WS_TMP); float* x1 = WSP(float, WS_X1); bf16_t* x1b = WSP(bf16_t, WS_X1BF);
    const float* g = INP(19) + (size_t)l * D; const float* bta = INP(20) + (size_t)l * D;
    const float* rw = INP(21); const float* rb = INP(22);
    unsigned* cnt = F.ctl + CW_MOECNT + l * 32; int* tokl = WSP(int, WS_TOKL); float* gate = WSP(float, WS_GATE);
    const int lane = F.lane;
    LAS float* xl = (LAS float*)F.lds + F.wave * 4096;
    for (int pr = F.wg * 8 + F.wave; pr < T / 2; pr += F.G * 8) {
#pragma unroll
        for (int u = 0; u < 2; ++u) {
            const size_t t = (size_t)pr * 2 + u;
            float xv[32]; float sm = 0.f;
#pragma unroll
            for (int i = 0; i < 8; ++i) { const f32x4 a = *(const f32x4*)(xin + t * D + 256 * i + 4 * lane), m = *(const f32x4*)(tmp + t * D + 256 * i + 4 * lane);
#pragma unroll
                for (int j = 0; j < 4; ++j) { const float v = ALPHA * a[j] + m[j]; xv[4 * i + j] = v; sm += v; } }
            const float mean = wave_sum(sm) * (1.0f / 2048.0f);
            float sq = 0.f;
#pragma unroll
            for (int i = 0; i < 32; ++i) { const float dl = xv[i] - mean; sq += dl * dl; }
            const float rstd = rsqrtf(wave_sum(sq) * (1.0f / 2048.0f) + 1e-5f);
#pragma unroll
            for (int i = 0; i < 8; ++i) { const f32x4 gg = *(const f32x4*)(g + 256 * i + 4 * lane), bb = *(const f32x4*)(bta + 256 * i + 4 * lane); f32x4 o;
#pragma unroll
                for (int j = 0; j < 4; ++j) o[j] = (xv[4 * i + j] - mean) * rstd * gg[j] + bb[j];
                *(f32x4*)(x1 + t * D + 256 * i + 4 * lane) = o;
                *(LAS f32x4*)(xl + u * 2048 + 256 * i + 4 * lane) = o;
                u32x2 w; w.x = pack2(o[0], o[1]); w.y = pack2(o[2], o[3]); *(u32x2*)(x1b + t * D + 256 * i + 4 * lane) = w; }
        }
        __builtin_amdgcn_s_waitcnt(0xc07f);
        const int e = lane & 31;
        const LAS float* xr = xl + (lane >> 5) * 2048;
        const float* wcol = rw + e;
        float a0 = 0.f, a1 = 0.f, a2 = 0.f, a3 = 0.f;
#pragma unroll 4
        for (int k = 0; k < 2048; k += 4) {
            const f32x4 xq = *(const LAS f32x4*)(xr + k);
            a0 += xq[0] * wcol[(size_t)(k + 0) * 32]; a1 += xq[1] * wcol[(size_t)(k + 1) * 32]; a2 += xq[2] * wcol[(size_t)(k + 2) * 32]; a3 += xq[3] * wcol[(size_t)(k + 3) * 32];
        }
        const float logit = (a0 + a1) + (a2 + a3);
        const float score = 1.0f / (1.0f + expf(-logit)), sel = score + rb[e];
        const int gb = lane & ~3;
        const float s0 = __shfl(sel, gb), s1 = __shfl(sel, gb + 1), s2 = __shfl(sel, gb + 2), s3 = __shfl(sel, gb + 3);
        const float ha = fmaxf(s0, s1), hb = fminf(s0, s1), hc = fmaxf(s2, s3), hd = fminf(s2, s3);
        float gv = fmaxf(ha, hc) + fmaxf(fminf(ha, hc), fmaxf(hb, hd)); int gi = e >> 2;
#pragma unroll
        for (int msk = 4; msk <= 16; msk <<= 1) { const float ov = __shfl_xor(gv, msk); const int oi = __shfl_xor(gi, msk); if (ov > gv || (ov == gv && oi < gi)) { gv = ov; gi = oi; } }
        const int base = (lane & 32) + 4 * gi;
        float a[4], sc4[4];
#pragma unroll
        for (int k = 0; k < 4; ++k) { a[k] = __shfl(sel, base + k); sc4[k] = __shfl(score, base + k); }
        int i1 = 0; float v1 = a[0];
#pragma unroll
        for (int k = 1; k < 4; ++k) if (a[k] > v1) { v1 = a[k]; i1 = k; }
        int i2 = -1; float v2 = -3.0e38f;
#pragma unroll
        for (int k = 0; k < 4; ++k) if (k != i1 && a[k] > v2) { v2 = a[k]; i2 = k; }
        float g1 = 0.f, g2 = 0.f;
#pragma unroll
        for (int k = 0; k < 4; ++k) { if (k == i1) g1 = sc4[k]; if (k == i2) g2 = sc4[k]; }
        if (e == 0) {
            const int t = pr * 2 + (lane >> 5); const int e1 = 4 * gi + i1, e2 = 4 * gi + i2; const float dn = g1 + g2;
            const unsigned r1 = atomicAdd(cnt + e1, 1u); tokl[e1 * 8192 + r1] = 2 * t;
            const unsigned r2 = atomicAdd(cnt + e2, 1u); tokl[e2 * 8192 + r2] = 2 * t + 1;
            gate[2 * t] = g1 / dn; gate[2 * t + 1] = g2 / dn;
        }
    }
}

DI void p_ln2(const Frame F, int l) {
    const float* x1 = WSP(float, WS_X1); const bf16_t* ybt = WSP(bf16_t, WS_YBT); const float* gate = WSP(float, WS_GATE);
    float* x2 = WSP(float, WS_TMP); bf16_t* x2b = WSP(bf16_t, WS_X1BF);
    const float* g = INP(26) + (size_t)l * D; const float* bta = INP(27) + (size_t)l * D;
    const int lane = F.lane;
    for (int t = F.wg * 8 + F.wave; t < T; t += F.G * 8) {
        const float g0 = gate[2 * t], g1 = gate[2 * t + 1];
        float xv[32]; float sm = 0.f;
#pragma unroll
        for (int i = 0; i < 8; ++i) { const size_t o = 256 * i + 4 * lane; const f32x4 a = *(const f32x4*)(x1 + (size_t)t * D + o);
            const u32x2 y0 = *(const u32x2*)(ybt + (size_t)(2 * t) * D + o), y1 = *(const u32x2*)(ybt + (size_t)(2 * t + 1) * D + o);
            xv[4 * i] = ALPHA * a[0] + (g0 * bflo(y0.x) + g1 * bflo(y1.x)); xv[4 * i + 1] = ALPHA * a[1] + (g0 * bfhi(y0.x) + g1 * bfhi(y1.x));
            xv[4 * i + 2] = ALPHA * a[2] + (g0 * bflo(y0.y) + g1 * bflo(y1.y)); xv[4 * i + 3] = ALPHA * a[3] + (g0 * bfhi(y0.y) + g1 * bfhi(y1.y));
            sm += (xv[4 * i] + xv[4 * i + 1]) + (xv[4 * i + 2] + xv[4 * i + 3]); }
        const float mean = wave_sum(sm) * (1.0f / 2048.0f);
        float sq = 0.f;
#pragma unroll
        for (int i = 0; i < 32; ++i) { const float dl = xv[i] - mean; sq += dl * dl; }
        const float rstd = rsqrtf(wave_sum(sq) * (1.0f / 2048.0f) + 1e-5f);
#pragma unroll
        for (int i = 0; i < 8; ++i) { const size_t o = 256 * i + 4 * lane; const f32x4 gg = *(const f32x4*)(g + o), bb = *(const f32x4*)(bta + o); f32x4 r;
#pragma unroll
            for (int j = 0; j < 4; ++j) r[j] = (xv[4 * i + j] - mean) * rstd * gg[j] + bb[j];
            *(f32x4*)(x2 + (size_t)t * D + o) = r; u32x2 w; w.x = pack2(r[0], r[1]); w.y = pack2(r[2], r[3]); *(u32x2*)(x2b + (size_t)t * D + o) = w; }
    }
}

DI int finish_units(const Frame F, int n) {
    LAS int* cw = (LAS int*)(F.lds + LDS_CTL);
    if (F.tid == 0) cw[4] = n;
    __syncthreads();
    return __builtin_amdgcn_readfirstlane(cw[4]);
}
DI int moe_units_body(const Frame F, int l, bool gemm1) {
    LAS int* mt = (LAS int*)(F.lds + LDS_MOE); LAS int* utab = (LAS int*)(F.lds + LDS_UTAB); LAS int* rowl = (LAS int*)(F.lds + LDS_ROWL);
    const int* tokl = WSP(int, WS_TOKL);
    int n = 0;
    if (F.tid == 0) {
        int hb = 0, nrb = 0;
        for (int e = 0; e < 32; ++e) { int c = (int)__hip_atomic_load(F.ctl + CW_MOECNT + l * 32 + e, __ATOMIC_RELAXED, __HIP_MEMORY_SCOPE_AGENT); if (c > 8192) c = 8192;
            mt[e] = c; mt[32 + e] = hb; const int nb = (c + 255) >> 8;
            for (int j = 0; j < nb && nrb < 128; ++j) { mt[64 + nrb] = e; mt[192 + nrb] = j; ++nrb; }
            hb += nb * 256; }
        const int npn = gemm1 ? 4 : 8;
        for (int L = F.wg; L < nrb * npn && n < 4; L += F.G) {
            const int rb = L / npn, pn = L - rb * npn, e = mt[64 + rb], j = mt[192 + rb], cnt = mt[e], row0 = mt[32 + e] + j * 256;
            const int valid = (cnt - j * 256) < 256 ? (cnt - j * 256) : 256;
            if (gemm1) pg8::unit_put(utab, n, WSP(bf16_t, WS_X1BF), WSP(bf16_t, WS_WGU) + ((size_t)(l * 32 + e) * 1024 + (size_t)pn * 256) * 2048, WSP(bf16_t, WS_HB), 2048, DEXP, row0, pn * 256, e * 8192 + j * 256, valid);
            else pg8::unit_put(utab, n, WSP(bf16_t, WS_HB) + (size_t)row0 * DEXP, WSP(bf16_t, WS_WDN) + ((size_t)(l * 32 + e) * 2048 + (size_t)pn * 256) * 512, WSP(bf16_t, WS_YBT), 512, D, row0, pn * 256, e * 8192 + j * 256, valid);
            ++n;
        }
    }
    n = finish_units(F, n);
    for (int x = F.tid; x < n * 256; x += 512) { const int ui = x >> 8, r = x & 255, a0 = utab[ui * pg8::UD + 10], a1 = utab[ui * pg8::UD + 11];
        const int v = (r < a1) ? tokl[a0 + r] : -1; rowl[x] = gemm1 ? (v < 0 ? 0 : (v >> 1)) : v; }
    __syncthreads();
    return n;
}

__device__ __noinline__ int moe_units(LAS unsigned char* lds_, GAS unsigned char* ws_, int wave_, int l, int gemm1) { const Frame F = make_frame(lds_, ws_, wave_); return moe_units_body(F, l, gemm1 != 0); }
PHASE_FN ph_prologue(PHASE_ARGS) { PHASE_FRAME; p_prologue(F); }
GEMM_FN ph_gemm_in(PHASE_ARGS, int l) {
    PHASE_FRAME; LAS int* utab = (LAS int*)(F.lds + LDS_UTAB);
    int n = 0;
    if (F.tid == 0) { int Lb = 0;
        pg8::build_dense(utab, n, Lb, WSP(bf16_t, WS_XBF), WSP(bf16_t, WS_WIN) + (size_t)l * 8192 * 2048, WSP(bf16_t, WS_Z), 2, T, 8192, 2048, ZLD, F.G, F.wg);
        pg8::build_dense(utab, n, Lb, WSP(bf16_t, WS_PBF) + (size_t)l * T * PLE, WSP(bf16_t, WS_WPP) + (size_t)l * 2048 * 256, WSP(bf16_t, WS_PP), 2, T, 2048, 256, D, F.G, F.wg); }
    n = finish_units(F, n);
    pg8::EpiBf16 E; pg8::gemm_phase<pg8::EpiBf16, false>(F.lds, F.tid, utab, n, nullptr, E);
}
PHASE_FN ph_rwkv_prep(PHASE_ARGS, int l) { PHASE_FRAME; p_rwkv_prep(F, l); }
PHASE_FN ph_mla_prep(PHASE_ARGS, int l) { PHASE_FRAME; p_mla_prep(F, l); p_vtd_prep(F); }
GEMM_FN ph_gemm_mla(PHASE_ARGS, int l) {
    PHASE_FRAME; LAS int* utab = (LAS int*)(F.lds + LDS_UTAB);
    int n = 0;
    if (F.tid == 0) { int Lb = 0;
        pg8::build_dense(utab, n, Lb, WSP(bf16_t, WS_QN), WSP(bf16_t, WS_WUQ) + (size_t)l * 1280 * 512, WSP(bf16_t, WS_QB), 2, T, 1280, 512, 1280, F.G, F.wg);
        pg8::build_dense(utab, n, Lb, WSP(bf16_t, WS_KVN), WSP(bf16_t, WS_WUKV) + (size_t)l * 1536 * 256, WSP(bf16_t, WS_KC), 2, T, 768, 256, 768, F.G, F.wg);
        pg8::build_dense(utab, n, Lb, WSP(bf16_t, WS_WUKV) + (size_t)l * 1536 * 256 + (size_t)768 * 256, WSP(bf16_t, WS_KVN), WSP(bf16_t, WS_VT), 2, 768, T, 256, T, F.G, F.wg); }
    n = finish_units(F, n);
    pg8::EpiBf16 E; pg8::gemm_phase<pg8::EpiBf16, false>(F.lds, F.tid, utab, n, nullptr, E);
}
PHASE_FN ph_dil(PHASE_ARGS) { PHASE_FRAME; for (int it = F.wg * 8 + F.wave; it < 2 * 12 * 128; it += F.G * 8) dil_item(F, it); }
PHASE_FN ph_scan(PHASE_ARGS, int l) { PHASE_FRAME; p_rwkv_scan(F, l, F.wg); }
PHASE_FN ph_attn_queue(PHASE_ARGS, int l) {
    PHASE_FRAME;
    unsigned* q = F.ctl + CW_QUEUE + l * 64;
    for (;;) {
        int it = 0; if (F.lane == 0) it = (int)atomicAdd(q, 1u);
        it = __builtin_amdgcn_readfirstlane(it);
        if (it >= 1536 + 512) break;
        if (it < 1536) mla_item(F, it); else dilc_item(F, it - 1536);
    }
}
GEMM_FN ph_gemm_out(PHASE_ARGS, int l) {
    PHASE_FRAME; LAS int* utab = (LAS int*)(F.lds + LDS_UTAB);
    int n = 0;
    if (F.tid == 0) { int Lb = 0; pg8::build_dense(utab, n, Lb, WSP(bf16_t, WS_MIX), WSP(bf16_t, WS_WOUT) + (size_t)l * 2048 * 2048, WSP(float, WS_TMP), 4, T, 2048, 2048, D, F.G, F.wg); }
    n = finish_units(F, n);
    pg8::EpiF32 E; pg8::gemm_phase<pg8::EpiF32, false>(F.lds, F.tid, utab, n, nullptr, E);
}
PHASE_FN ph_ln1(PHASE_ARGS, int l) { PHASE_FRAME; p_ln1_route(F, l, (l == 0) ? INP(0) : (const float*)WSP(float, WS_XCUR)); }
GEMM_FN ph_moe1(PHASE_ARGS, int l) {
    PHASE_FRAME; const int n = __builtin_amdgcn_readfirstlane(moe_units(lds_, ws_, wave_, l, 1));
    pg8::EpiGU E; pg8::gemm_phase<pg8::EpiGU, true>(F.lds, F.tid, (const LAS int*)(F.lds + LDS_UTAB), n, (const LAS int*)(F.lds + LDS_ROWL), E);
}
GEMM_FN ph_moe2(PHASE_ARGS, int l) {
    PHASE_FRAME; const int n = __builtin_amdgcn_readfirstlane(moe_units(lds_, ws_, wave_, l, 0));
    pg8::EpiScatter E{(const LAS int*)(F.lds + LDS_ROWL)}; pg8::gemm_phase<pg8::EpiScatter, false>(F.lds, F.tid, (const LAS int*)(F.lds + LDS_UTAB), n, (const LAS int*)(F.lds + LDS_ROWL), E);
}
PHASE_FN ph_ln2(PHASE_ARGS, int l) { PHASE_FRAME; p_ln2(F, l); }
GEMM_FN ph_ple(PHASE_ARGS, int l, float* out_) {
    PHASE_FRAME; LAS int* utab = (LAS int*)(F.lds + LDS_UTAB);
    const bool lastl = (l == NL - 1);
    float* outp = (float*)(GAS float*)rfl64((unsigned long long)out_);
    int n = 0;
    if (F.tid == 0) { int Lb = 0; pg8::build_dense(utab, n, Lb, WSP(bf16_t, WS_X1BF), WSP(bf16_t, WS_WPG) + (size_t)l * 2048 * 2048, lastl ? (void*)outp : (void*)WSP(float, WS_XCUR), 4, T, 2048, 2048, D, F.G, F.wg); }
    n = finish_units(F, n);
    pg8::EpiPle E{WSP(float, WS_TMP), WSP(bf16_t, WS_PP), lastl ? (bf16_t*)nullptr : WSP(bf16_t, WS_XBF)};
    pg8::gemm_phase<pg8::EpiPle, false>(F.lds, F.tid, utab, n, nullptr, E);
}

constexpr int NPH = 10;
#ifndef PH_MASK
#define PH_MASK 0x7ff
#endif
__global__ void __launch_bounds__(512, 2) mk_fwd(Params P) {
    extern __shared__ __attribute__((aligned(16))) unsigned char lds_raw[];
    unsigned ldsb = (unsigned)(size_t)(LAS unsigned char*)lds_raw; asm volatile("" : "+s"(ldsb));
    LAS unsigned char* lds = (LAS unsigned char*)ldsb;
    GAS unsigned char* ws = (GAS unsigned char*)P.ws;
    const int wave_s = __builtin_amdgcn_readfirstlane((int)(threadIdx.x >> 6));
    if (threadIdx.x < 16) ((LAS unsigned*)(lds + LDS_CTL))[threadIdx.x] = 0u;
    if (threadIdx.x == 0) {
#pragma unroll
        for (int i = 0; i < 30; ++i) ((LAS unsigned long long*)(lds + LDS_INTAB))[i] = (unsigned long long)P.in[i]; }
    __syncthreads();
#if MK_PER_PHASE
#define GRID_BAR() do { } while (0)
#else
    XcdBarrier bar = xcd_barrier_post((unsigned*)P.ws, (volatile LAS unsigned*)(lds + LDS_CTL), threadIdx.x == 0);
#define GRID_BAR() xcd_barrier(bar, my_tid(wave_s) == 0)
#endif
    const int lo = P.ph_lo, hi = P.ph_hi;
#define IN(k) (lo <= (k) && (k) < hi)
#define ON(j) (((PH_MASK) >> (j)) & 1)
#define SEAM(k) do { __syncthreads(); if (IN(k) && IN((k) + 1)) GRID_BAR(); } while (0)

    if (ON(0) && IN(0)) ph_prologue(lds, ws, wave_s);
    SEAM(0);
    for (int l = 0; l < NL; ++l) {
        const int p0 = 1 + l * NPH;
        if (ON(1) && IN(p0 + 0)) ph_gemm_in(lds, ws, wave_s, l);
        SEAM(p0 + 0);
        if (ON(2) && IN(p0 + 1)) { ph_rwkv_prep(lds, ws, wave_s, l); __syncthreads(); ph_mla_prep(lds, ws, wave_s, l); }
        SEAM(p0 + 1);
        if (ON(3) && IN(p0 + 2)) { ph_gemm_mla(lds, ws, wave_s, l); ph_dil(lds, ws, wave_s); }
        SEAM(p0 + 2);
        if (ON(4) && IN(p0 + 3)) { if (blockIdx.x < 24) ph_scan(lds, ws, wave_s, l); ph_attn_queue(lds, ws, wave_s, l); }
        SEAM(p0 + 3);
        if (ON(5) && IN(p0 + 4)) ph_gemm_out(lds, ws, wave_s, l);
        SEAM(p0 + 4);
        if (ON(6) && IN(p0 + 5)) ph_ln1(lds, ws, wave_s, l);
        SEAM(p0 + 5);
        if (ON(7) && IN(p0 + 6)) ph_moe1(lds, ws, wave_s, l);
        SEAM(p0 + 6);
        if (ON(8) && IN(p0 + 7)) ph_moe2(lds, ws, wave_s, l);
        SEAM(p0 + 7);
        if (ON(9) && IN(p0 + 8)) ph_ln2(lds, ws, wave_s, l);
        SEAM(p0 + 8);
        if (ON(10) && IN(p0 + 9)) ph_ple(lds, ws, wave_s, l, P.out);
        SEAM(p0 + 9);
    }
}

extern "C" void kernel_launch(void* const* d_in, const int* in_sizes, int n_in, void* d_out, int out_size, void* d_ws, size_t ws_size, hipStream_t stream) {
    static int grid = 0;
    if (grid == 0) {
        if (n_in != 30 || ws_size < WS_END) { fprintf(stderr, "kernel_launch: need 30 inputs and %zu bytes of workspace (got %d, %zu)\n", (size_t)WS_END, n_in, ws_size); grid = -1; return; }
        int dev = 0, cus = 0, per_cu = 0;
        if (hipGetDevice(&dev) != hipSuccess || hipDeviceGetAttribute(&cus, hipDeviceAttributeMultiprocessorCount, dev) != hipSuccess) { grid = -1; return; }
        if (hipFuncSetAttribute((const void*)mk_fwd, hipFuncAttributeMaxDynamicSharedMemorySize, LDS_BYTES) != hipSuccess) { fprintf(stderr, "kernel_launch: hipFuncSetAttribute failed\n"); grid = -1; return; }
        if (hipOccupancyMaxActiveBlocksPerMultiprocessor(&per_cu, (const void*)mk_fwd, 512, LDS_BYTES) != hipSuccess || per_cu < 1) { fprintf(stderr, "kernel_launch: occupancy query says %d\n", per_cu); }
        (void)hipGetLastError();
        grid = cus;
    }
    if (grid < 0) return;
    (void)hipMemsetAsync(d_ws, 0, CTL_BYTES, stream);
    Params p{};
    for (int i = 0; i < 30; ++i) p.in[i] = (const float*)d_in[i];
    p.out = (float*)d_out; p.ws = (unsigned char*)d_ws;
    const int nph = 1 + NL * NPH;
#if MK_PER_PHASE
    for (int k = 0; k < nph; ++k) { p.ph_lo = k; p.ph_hi = k + 1; hipLaunchKernelGGL(mk_fwd, dim3(grid), dim3(512), LDS_BYTES, stream, p); }
#else
    p.ph_lo = 0; p.ph_hi = nph;
    hipLaunchKernelGGL(mk_fwd, dim3(grid), dim3(512), LDS_BYTES, stream, p);
#endif
}
```

```cpp
#include <hip/hip_runtime.h>
#include <cstdio>
#include <cstdint>

#ifndef MK_PER_PHASE
#define MK_PER_PHASE 0
#endif

#define DI __device__ __forceinline__
#define LAS __attribute__((address_space(3)))
#define GAS __attribute__((address_space(1)))
typedef unsigned short bf16_t;
typedef short bf16x8 __attribute__((ext_vector_type(8)));
typedef float f32x2 __attribute__((ext_vector_type(2)));
typedef float f32x4 __attribute__((ext_vector_type(4)));
typedef float f32x16 __attribute__((ext_vector_type(16)));
typedef unsigned u32x2 __attribute__((ext_vector_type(2)));
typedef unsigned u32x4 __attribute__((ext_vector_type(4)));
typedef __bf16 hbf2 __attribute__((ext_vector_type(2)));

DI unsigned pack2(float lo, float hi) { return __builtin_bit_cast(unsigned, __builtin_convertvector((f32x2){lo, hi}, hbf2)); }
DI float bf2f(bf16_t b) { return __uint_as_float(((unsigned)b) << 16); }
DI float bflo(unsigned w) { return __uint_as_float(w << 16); }
DI float bfhi(unsigned w) { return __uint_as_float(w & 0xffff0000u); }
DI bf16_t f2bf(float f) { return (bf16_t)(pack2(f, 0.f) & 0xffffu); }
DI float wave_sum(float v) { for (int o = 32; o >= 1; o >>= 1) v += __shfl_xor(v, o); return v; }
DI float sigmoidf_(float x) { return 1.0f / (1.0f + __expf(-x)); }

constexpr int T = 8192, SEQ = 4096, D = 2048, NL = 4, PLE = 256;
constexpr int ZLD = 8192;
constexpr int ZC_DQ = 2560, ZC_DK = 4096, ZC_DV = 5632, ZC_QA = 7168, ZC_KVA = 7680, ZC_KR = 7936;
constexpr int NEXP = 32, DEXP = 512, HB_ROWS = 24576;
constexpr float ALPHA = 1.681792830507429f;
constexpr float LOG2E = 1.4426950408889634f;

constexpr size_t CTL_BYTES = 65536;
constexpr size_t WS_WIN = CTL_BYTES;                              constexpr size_t SZ_WIN = (size_t)NL * 8192 * 2048 * 2;
constexpr size_t WS_WOUT = WS_WIN + SZ_WIN;                       constexpr size_t SZ_WOUT = (size_t)NL * 2048 * 2048 * 2;
constexpr size_t WS_WPG = WS_WOUT + SZ_WOUT;                      constexpr size_t SZ_WPG = SZ_WOUT;
constexpr size_t WS_WPP = WS_WPG + SZ_WPG;                        constexpr size_t SZ_WPP = (size_t)NL * 2048 * 256 * 2;
constexpr size_t WS_WGU = WS_WPP + SZ_WPP;                        constexpr size_t SZ_WGU = (size_t)NL * 32 * 1024 * 2048 * 2;
constexpr size_t WS_WDN = WS_WGU + SZ_WGU;                        constexpr size_t SZ_WDN = (size_t)NL * 32 * 2048 * 512 * 2;
constexpr size_t WS_WUQ = WS_WDN + SZ_WDN;                        constexpr size_t SZ_WUQ = (size_t)NL * 1280 * 512 * 2;
constexpr size_t WS_WUKV = WS_WUQ + SZ_WUQ;                       constexpr size_t SZ_WUKV = (size_t)NL * 1536 * 256 * 2;
constexpr size_t WS_ROPE = WS_WUKV + SZ_WUKV;                     constexpr size_t SZ_ROPE = (size_t)4096 * 32 * 8;
constexpr size_t WS_PBF = WS_ROPE + SZ_ROPE;                      constexpr size_t SZ_PBF = (size_t)NL * T * 256 * 2;
constexpr size_t WS_XCUR = WS_PBF + SZ_PBF;                       constexpr size_t SZ_XF = (size_t)T * D * 4;
constexpr size_t WS_XBF = WS_XCUR + SZ_XF;                        constexpr size_t SZ_XB = (size_t)T * D * 2;
constexpr size_t WS_Z = WS_XBF + SZ_XB;                           constexpr size_t SZ_Z = (size_t)T * ZLD * 2;
constexpr size_t SZ_RW1 = (size_t)T * 768 * 4;
constexpr size_t WS_RW = WS_Z + SZ_Z;
constexpr size_t WS_RK = WS_RW + 7 * SZ_RW1;                      constexpr size_t SZ_RK = (size_t)T * 16 * 4;
constexpr size_t WS_QN = WS_RK + SZ_RK;                           constexpr size_t SZ_QN = (size_t)T * 512 * 2;
constexpr size_t WS_KVN = WS_QN + SZ_QN;                          constexpr size_t SZ_KVN = (size_t)T * 256 * 2;
constexpr size_t WS_KROPE = WS_KVN + SZ_KVN;                      constexpr size_t SZ_KROPE = (size_t)T * 64 * 2;
constexpr size_t WS_VTD = WS_KROPE + SZ_KROPE;                    constexpr size_t SZ_VTD = (size_t)2 * 12 * 128 * 4096 * 2;
constexpr size_t WS_QB = WS_VTD + SZ_VTD;                         constexpr size_t SZ_QB = (size_t)T * 1280 * 2;
constexpr size_t WS_KC = WS_QB + SZ_QB;                           constexpr size_t SZ_KC = (size_t)T * 768 * 2;
constexpr size_t WS_VT = WS_KC + SZ_KC;                           constexpr size_t SZ_VT = (size_t)768 * 8192 * 2;
constexpr size_t WS_OP = WS_VT + SZ_VT;                           constexpr size_t SZ_OP = (size_t)3 * T * 512 * 2;
constexpr size_t WS_LSE = WS_OP + SZ_OP;                          constexpr size_t SZ_LSE = (size_t)3 * T * 4 * 4;
constexpr size_t WS_MIX = WS_LSE + SZ_LSE;                        constexpr size_t SZ_MIX = SZ_XB;
constexpr size_t WS_TMP = WS_MIX + SZ_MIX;
constexpr size_t WS_X1 = WS_TMP + SZ_XF;
constexpr size_t WS_X1BF = WS_X1 + SZ_XF;
constexpr size_t WS_PP = WS_X1BF + SZ_XB;
constexpr size_t WS_TOKL = WS_PP + SZ_XB;                         constexpr size_t SZ_TOKL = (size_t)32 * 8192 * 4;
constexpr size_t WS_GATE = WS_TOKL + SZ_TOKL;                     constexpr size_t SZ_GATE = (size_t)T * 2 * 4;
constexpr size_t WS_HB = WS_GATE + SZ_GATE;                       constexpr size_t SZ_HB = (size_t)HB_ROWS * 512 * 2;
constexpr size_t WS_YBT = WS_HB + SZ_HB;                          constexpr size_t SZ_YBT = (size_t)T * 2 * 2048 * 2;
constexpr size_t WS_END = WS_YBT + SZ_YBT;
constexpr int CW_MOECNT = 4096;
constexpr int CW_QUEUE = 8192;

constexpr int LDS_STAGE = 131072;
constexpr int LDS_CTL = 131072;
constexpr int LDS_UTAB = LDS_CTL + 64;
constexpr int LDS_MOE = LDS_UTAB + 1024;
constexpr int LDS_INTAB = LDS_MOE + 1536;
constexpr int LDS_ROWL = 131072 + 4096;
constexpr int LDS_BYTES = 131072 + 8192;

#define XB_TMO      128
#define XB_XCNT(j)  (256  + 64 * (j))
#define XB_XSUB(j)  (1280 + 64 * (j))
#define XB_XGEN(j)  (2304 + 64 * (j))
#define XB_TOP      3328
#define XB_TOPGEN   3392
#define XCD_BAR_WORDS 3456
#define XB_SPIN_CAP (1u << 22)

__device__ __forceinline__ unsigned xb_ld(unsigned* p)              { return __hip_atomic_load(p, __ATOMIC_RELAXED, __HIP_MEMORY_SCOPE_AGENT); }
__device__ __forceinline__ unsigned xb_add(unsigned* p, unsigned v) { return __hip_atomic_fetch_add(p, v, __ATOMIC_RELAXED, __HIP_MEMORY_SCOPE_AGENT); }
__device__ __forceinline__ unsigned xb_xcc_id() { return (unsigned)__builtin_amdgcn_s_getreg((3 << 11) | 20) & 0xFu; }
#define XB_SPIN(cond, bar) do { unsigned _sp = 0; while (cond) { __builtin_amdgcn_s_sleep(1); \
    if ((++_sp & 255u) == 0u) { if (xb_ld(&(bar)[XB_TMO])) break; if (_sp > XB_SPIN_CAP) { atomicAdd(&(bar)[XB_TMO], 1u); break; } } } } while (0)

struct XcdBarrier { unsigned* bar; unsigned x; volatile LAS unsigned* st; };

__device__ __forceinline__ XcdBarrier xcd_barrier_post(unsigned* bar, volatile LAS unsigned* st, bool leader) {
    XcdBarrier b; b.bar = bar; b.x = xb_xcc_id(); b.st = st;
    if (leader) (void)xb_add(&bar[XB_XCNT(b.x)], 1u);
    return b;
}
__device__ __forceinline__ void xcd_barrier_complete(unsigned* bar, unsigned x, unsigned& nloc, unsigned& nx) {
    const unsigned G = gridDim.x * gridDim.y * gridDim.z;
    unsigned sum, cnt, mine, sp = 0u;
    for (;;) {
        sum = 0u; cnt = 0u; mine = 0u;
#pragma unroll
        for (unsigned j = 0; j < 16; ++j) { const unsigned c = xb_ld(&bar[XB_XCNT(j)]); sum += c; cnt += (c > 0u) ? 1u : 0u; mine = (j == x) ? c : mine; }
        if (sum == G) break;
        __builtin_amdgcn_s_sleep(1);
        if ((++sp & 255u) == 0u) { if (xb_ld(&bar[XB_TMO])) break; if (sp > XB_SPIN_CAP) { atomicAdd(&bar[XB_TMO], 1u); break; } }
    }
    nloc = mine > 0u ? mine : 1u; nx = cnt > 0u ? cnt : 1u;
}
__device__ __forceinline__ void xcd_barrier(const XcdBarrier& b, bool leader) {
    asm volatile("s_waitcnt vmcnt(0)" ::: "memory");
    __syncthreads();
    if (leader) {
        unsigned* bar = b.bar;
        __builtin_amdgcn_s_waitcnt(0);
        unsigned nloc = b.st[0], nx = b.st[1];
        if (nloc == 0u) { xcd_barrier_complete(bar, b.x, nloc, nx); b.st[0] = nloc; b.st[1] = nx; }
        const unsigned old = xb_add(&bar[XB_XSUB(b.x)], 1u);
        const unsigned gen = old / nloc;
        if (old + 1u == (gen + 1u) * nloc) {
            __builtin_amdgcn_fence(__ATOMIC_RELEASE, "agent");
            asm volatile("s_waitcnt vmcnt(0)" ::: "memory");
            const unsigned og = xb_add(&bar[XB_TOP], 1u);
            const unsigned tg = og / nx;
            if (og + 1u == (tg + 1u) * nx) xb_add(&bar[XB_TOPGEN], 1u);
            else XB_SPIN(xb_ld(&bar[XB_TOPGEN]) == tg, bar);
            __builtin_amdgcn_fence(__ATOMIC_ACQUIRE, "agent");
            xb_add(&bar[XB_XGEN(b.x)], 1u);
            asm volatile("s_waitcnt vmcnt(0)" ::: "memory");
        } else {
            XB_SPIN(xb_ld(&bar[XB_XGEN(b.x)]) == gen, bar);
            __builtin_amdgcn_fence(__ATOMIC_ACQUIRE, "agent");
            asm volatile("s_waitcnt vmcnt(0)" ::: "memory");
        }
    }
    __syncthreads();
}

namespace pg8 {
constexpr int BM = 256, BK = 64, HALF = 128, HTB = HALF * BK * 2, STAGE_BYTES = 8 * HTB, NXCD = 8, WGM = 8;
DI int lds_byte(int r, int c) { const int st = (r >> 4) * 2 + (c >> 5), rr = r & 15, cc = c & 31, ob = rr * 64 + cc * 2; return st * 1024 + (ob ^ (((ob >> 9) & 1) << 5)); }
DI void stage_rc(int b, int& R, int& C) { const int st = b / 1024, sb = b % 1024, swz = sb ^ (((sb >> 9) & 1) << 5); R = (st >> 1) * 16 + swz / 64; C = (st & 1) * 32 + (swz % 64) / 2; }
DI int perm32(int rho) { const int n = rho >> 4, i = rho & 15; return 8 * (i >> 2) + 4 * n + (i & 3); }

struct Unit { GAS const char* a; GAS const char* b; GAS char* out; int K, ldc, row0, col0, aux0, aux1; };
constexpr int UD = 12;
DI void unit_put(LAS int* tab, int i, const void* a, const void* b, void* o, int K, int ldc, int row0, int col0, int aux0, int aux1) {
    LAS int* p = tab + i * UD; const unsigned long long ua = (unsigned long long)a, ub = (unsigned long long)b, uo = (unsigned long long)o;
    p[0] = (int)(unsigned)ua; p[1] = (int)(unsigned)(ua >> 32); p[2] = (int)(unsigned)ub; p[3] = (int)(unsigned)(ub >> 32); p[4] = (int)(unsigned)uo; p[5] = (int)(unsigned)(uo >> 32);
    p[6] = K; p[7] = ldc; p[8] = row0; p[9] = col0; p[10] = aux0; p[11] = aux1;
}
DI void unit_get(const LAS int* tab, int i, Unit& u) {
    const LAS int* p = tab + i * UD; int v[UD];
#pragma unroll
    for (int j = 0; j < UD; ++j) v[j] = __builtin_amdgcn_readfirstlane(p[j]);
    u.a = (GAS const char*)(((unsigned long long)(unsigned)v[1] << 32) | (unsigned)v[0]);
    u.b = (GAS const char*)(((unsigned long long)(unsigned)v[3] << 32) | (unsigned)v[2]);
    u.out = (GAS char*)(((unsigned long long)(unsigned)v[5] << 32) | (unsigned)v[4]);
    u.K = v[6]; u.ldc = v[7]; u.row0 = v[8]; u.col0 = v[9]; u.aux0 = v[10]; u.aux1 = v[11];
}
DI void build_dense(LAS int* tab, int& n, int& Lbase, const void* A, const void* Bt, void* out, int esz, int M, int N, int K, int ldc, int G, int c) {
    const int nM = M / BM, nN = N / BM, nwg = nM * nN;
    int L = c; if (L < Lbase) L += ((Lbase - L + G - 1) / G) * G;
    for (; L < Lbase + nwg; L += G) {
        int wgid = L - Lbase; { const int q = nwg / NXCD, r = nwg % NXCD, xcd = wgid % NXCD, off = wgid / NXCD; wgid = (xcd < r ? xcd * (q + 1) : r * (q + 1) + (xcd - r) * q) + off; }
        const int nig = WGM * nN, gid = wgid / nig, fm = gid * WGM, gsz = (nM - fm) < WGM ? (nM - fm) : WGM;
        const int pm = fm + ((wgid % nig) % gsz), pn = (wgid % nig) / gsz;
        unit_put(tab, n, (const char*)A + (size_t)pm * BM * K * 2, (const char*)Bt + (size_t)pn * BM * K * 2, out, K, ldc, pm * BM, pn * BM, 0, BM); ++n;
    }
    Lbase += nwg;
}

template <class Epi, bool GATHER>
DI void gemm_phase(LAS unsigned char* lds, const int tid, const LAS int* utab, const int nunits, const LAS int* rowl, const Epi& E) {
    const int wid = __builtin_amdgcn_readfirstlane(tid >> 6), lane = tid & 63, wr = wid >> 2, wc = wid & 3, fr = lane & 15, fq = lane >> 4;
    const size_t kstep = (size_t)(BK * 2);
    const unsigned ldsw = (unsigned)wid * 1024u;
    const int aoff = lds_byte(wr * 64 + fr, fq * 8), boff = lds_byte(wc * 32 + fr, fq * 8);
#define PG8_SA(b, h) (((b) * 2 + (h)) * HTB)
#define PG8_SB(b, h) ((4 + (b) * 2 + (h)) * HTB)
#define PG8_STAGE(bufoff, gbase, voff) do { _Pragma("unroll") for (int _i = 0; _i < 2; ++_i) \
        __builtin_amdgcn_global_load_lds((GAS const unsigned*)((gbase) + (voff)[_i]), (LAS unsigned*)(lds + (bufoff) + ldsw + _i * 8192), 16, 0, 0); } while (0)
#define PG8_LDA(dst, b, h) do { _Pragma("unroll") for (int m = 0; m < 4; ++m) _Pragma("unroll") for (int k = 0; k < 2; ++k) dst[m][k] = *(const LAS bf16x8*)(lds + PG8_SA(b, h) + aoff + m * 2048 + k * 1024); } while (0)
#define PG8_LDB(dst, b, h) do { _Pragma("unroll") for (int n = 0; n < 2; ++n) _Pragma("unroll") for (int k = 0; k < 2; ++k) dst[n][k] = *(const LAS bf16x8*)(lds + PG8_SB(b, h) + boff + n * 2048 + k * 1024); } while (0)
#define PG8_MMA(ai, bj, At, Bt) do { __builtin_amdgcn_s_setprio(1); _Pragma("unroll") for (int m = 0; m < 4; ++m) _Pragma("unroll") for (int n = 0; n < 2; ++n) _Pragma("unroll") for (int k = 0; k < 2; ++k) \
        acc[ai][bj][m][n] = __builtin_amdgcn_mfma_f32_16x16x32_bf16(Bt[n][k], At[m][k], acc[ai][bj][m][n], 0, 0, 0); __builtin_amdgcn_s_setprio(0); } while (0)
#define PG8_WAIT_V(n) asm volatile("s_waitcnt vmcnt(" #n ")" ::: "memory")
#define PG8_WAIT_L(n) asm volatile("s_waitcnt lgkmcnt(" #n ")" ::: "memory")
#define PG8_BAR __builtin_amdgcn_s_barrier()
#define PG8_SCHED __builtin_amdgcn_sched_barrier(0)
#define PG8_RC(R_, C_, Rb_, i_) int R_, C_; { int t_ = tid; asm volatile("" : "+v"(t_)); stage_rc(t_ * 16 + (i_) * 8192, R_, C_); } const int Rb_ = Epi::PERM ? ((R_ & ~31) + perm32(R_ & 31)) : R_
#define PG8_VOFF_D(va, vb, K_) do { _Pragma("unroll") for (int _i = 0; _i < 2; ++_i) { PG8_RC(_R, _C, _Rb, _i); va[0][_i] = (unsigned)(_R * (K_) + _C) * 2u; va[1][_i] = va[0][_i]; vb[_i] = (unsigned)(_Rb * (K_) + _C) * 2u; } } while (0)
#define PG8_VOFF_G(va, K_, ui_) do { _Pragma("unroll") for (int _i = 0; _i < 2; ++_i) { PG8_RC(_R, _C, _Rb, _i); (void)_Rb; _Pragma("unroll") for (int _h = 0; _h < 2; ++_h) { \
        const int _r = rowl[(ui_) * BM + _h * HALF + _R]; va[_h][_i] = (unsigned)(_r * (K_) + _C) * 2u; } } } while (0)
    if (nunits <= 0) return;
    Unit cur, nxt; int ui = 0;
    unit_get(utab, 0, cur);
    f32x4 acc[2][2][4][2];
#pragma unroll
    for (int a = 0; a < 2; ++a)
#pragma unroll
        for (int b = 0; b < 2; ++b)
#pragma unroll
            for (int m = 0; m < 4; ++m)
#pragma unroll
                for (int n = 0; n < 2; ++n) acc[a][b][m][n] = (f32x4){0.f, 0.f, 0.f, 0.f};
    bf16x8 At[4][2], B0[2][2], B1[2][2];
    unsigned vc[2][2], vbc[2], vn[2][2];
    PG8_VOFF_D(vc, vbc, cur.K);
    if (GATHER) PG8_VOFF_G(vc, cur.K, 0);
    GAS const char* cA = cur.a; GAS const char* cB = cur.b;
    size_t hsc = (size_t)HALF * cur.K * 2;
    size_t hsa = GATHER ? (size_t)0 : hsc;
    PG8_STAGE(PG8_SB(0, 0), cB, vbc); PG8_STAGE(PG8_SA(0, 0), cA, vc[0]); PG8_STAGE(PG8_SB(0, 1), cB + hsc, vbc); PG8_STAGE(PG8_SA(0, 1), cA + hsa, vc[1]);
    if (wr == 1) PG8_BAR;
    PG8_WAIT_V(4); PG8_BAR;
    PG8_STAGE(PG8_SB(1, 0), cB + kstep, vbc); PG8_STAGE(PG8_SA(1, 0), cA + kstep, vc[0]); PG8_STAGE(PG8_SB(1, 1), cB + hsc + kstep, vbc);
    PG8_WAIT_V(6); PG8_BAR;
    for (;;) {
        const bool has_next = (ui + 1 < nunits);
        if (has_next) { unit_get(utab, ui + 1, nxt); if (GATHER) PG8_VOFF_G(vn, nxt.K, ui + 1); }
        else { nxt = cur;
            if (GATHER) {
#pragma unroll
                for (int i = 0; i < 2; ++i) { vn[0][i] = vc[0][i]; vn[1][i] = vc[1][i]; } } }
        GAS const char* nA = nxt.a; GAS const char* nB = nxt.b;
        const int nt = cur.K / BK;
        for (int t = 0; t < nt; t += 2) {
            const bool last = (t == nt - 2);
            GAS const char* a1 = cA + (size_t)(t + 1) * kstep;
            GAS const char* a2 = last ? nA : cA + (size_t)(t + 2) * kstep; GAS const char* b2 = last ? nB : cB + (size_t)(t + 2) * kstep;
            GAS const char* a3 = a2 + kstep; GAS const char* b3 = b2 + kstep;
            PG8_LDB(B0, 0, 0); PG8_SCHED; PG8_LDA(At, 0, 0); PG8_STAGE(PG8_SA(1, 1), a1 + hsa, vc[1]);
            if (last) {
                if (GATHER) {
#pragma unroll
                    for (int i = 0; i < 2; ++i) { vc[0][i] = vn[0][i]; vc[1][i] = vn[1][i]; } }
                if (nxt.K != cur.K) {
                    if (!GATHER) PG8_VOFF_D(vc, vbc, nxt.K);
                    else {
#pragma unroll
                        for (int i = 0; i < 2; ++i) { PG8_RC(R_, C_, Rb_, i); (void)R_; vbc[i] = (unsigned)(Rb_ * nxt.K + C_) * 2u; } }
                    hsc = (size_t)HALF * nxt.K * 2; hsa = GATHER ? (size_t)0 : hsc; } }
            PG8_WAIT_L(8); PG8_BAR; PG8_WAIT_L(0); PG8_MMA(0, 0, At, B0); PG8_BAR; PG8_SCHED;
            PG8_LDB(B1, 0, 1); PG8_STAGE(PG8_SB(0, 0), b2, vbc);
            PG8_BAR; PG8_WAIT_L(0); PG8_MMA(0, 1, At, B1); PG8_BAR;
            PG8_LDA(At, 0, 1); PG8_STAGE(PG8_SA(0, 0), a2, vc[0]);
            PG8_BAR; PG8_WAIT_L(0); PG8_MMA(1, 0, At, B0); PG8_BAR; PG8_SCHED;
            PG8_STAGE(PG8_SB(0, 1), b2 + hsc, vbc);
            PG8_WAIT_V(6); PG8_BAR; PG8_MMA(1, 1, At, B1); PG8_BAR;
            PG8_LDB(B0, 1, 0); PG8_SCHED; PG8_LDA(At, 1, 0); PG8_STAGE(PG8_SA(0, 1), a2 + hsa, vc[1]);
            PG8_WAIT_L(8); PG8_BAR; PG8_WAIT_L(0); PG8_MMA(0, 0, At, B0); PG8_BAR; PG8_SCHED;
            PG8_LDB(B1, 1, 1); PG8_STAGE(PG8_SB(1, 0), b3, vbc);
            PG8_BAR; PG8_WAIT_L(0); PG8_MMA(0, 1, At, B1); PG8_BAR;
            PG8_LDA(At, 1, 1); PG8_STAGE(PG8_SA(1, 0), a3, vc[0]);
            PG8_BAR; PG8_WAIT_L(0); PG8_MMA(1, 0, At, B0); PG8_BAR; PG8_SCHED;
            PG8_STAGE(PG8_SB(1, 1), b3 + hsc, vbc);
            PG8_WAIT_V(6); PG8_BAR; PG8_MMA(1, 1, At, B1); PG8_BAR;
        }
        E(acc, cur, ui, wr, wc, fr, fq);
        if (!has_next) break;
#pragma unroll
        for (int a = 0; a < 2; ++a)
#pragma unroll
            for (int b = 0; b < 2; ++b)
#pragma unroll
                for (int m = 0; m < 4; ++m)
#pragma unroll
                    for (int n = 0; n < 2; ++n) acc[a][b][m][n] = (f32x4){0.f, 0.f, 0.f, 0.f};
        cur = nxt; cA = nA; cB = nB; ++ui;
    }
    PG8_WAIT_V(0);
    if (wr == 0) PG8_BAR;
    PG8_BAR;
#undef PG8_SA
#undef PG8_SB
#undef PG8_STAGE
#undef PG8_LDA
#undef PG8_LDB
#undef PG8_MMA
#undef PG8_WAIT_V
#undef PG8_WAIT_L
#undef PG8_BAR
#undef PG8_SCHED
#undef PG8_VOFF_D
#undef PG8_RC
#undef PG8_VOFF_G
}

struct EpiBf16 {
    static constexpr bool PERM = true;
    DI void operator()(const f32x4 (&acc)[2][2][4][2], const Unit& u, int, int wr, int wc, int fr, int fq) const {
        const int row0 = u.row0 + wr * 64 + fr, col0 = u.col0 + wc * 32 + 8 * fq; GAS bf16_t* O = (GAS bf16_t*)u.out; const int ldc = u.ldc;
#pragma unroll
        for (int ai = 0; ai < 2; ++ai)
#pragma unroll
            for (int m = 0; m < 4; ++m) { GAS bf16_t* rowp = O + (size_t)(row0 + ai * HALF + m * 16) * ldc + col0;
#pragma unroll
                for (int bj = 0; bj < 2; ++bj) { const f32x4 v0 = acc[ai][bj][m][0], v1 = acc[ai][bj][m][1];
                    u32x4 w; w.x = pack2(v0[0], v0[1]); w.y = pack2(v0[2], v0[3]); w.z = pack2(v1[0], v1[1]); w.w = pack2(v1[2], v1[3]);
                    *(GAS u32x4*)(rowp + bj * HALF) = w; } }
    }
};
struct EpiF32 {
    static constexpr bool PERM = false;
    DI void operator()(const f32x4 (&acc)[2][2][4][2], const Unit& u, int, int wr, int wc, int fr, int fq) const {
        const int row0 = u.row0 + wr * 64 + fr, col0 = u.col0 + wc * 32 + 4 * fq; GAS float* C = (GAS float*)u.out; const int ldc = u.ldc;
#pragma unroll
        for (int ai = 0; ai < 2; ++ai)
#pragma unroll
            for (int m = 0; m < 4; ++m) { GAS float* rowp = C + (size_t)(row0 + ai * HALF + m * 16) * ldc + col0;
#pragma unroll
                for (int bj = 0; bj < 2; ++bj)
#pragma unroll
                    for (int n = 0; n < 2; ++n) *(GAS f32x4*)(rowp + bj * HALF + n * 16) = acc[ai][bj][m][n]; }
    }
};
struct EpiGU {
    static constexpr bool PERM = true;
    DI void operator()(const f32x4 (&acc)[2][2][4][2], const Unit& u, int, int wr, int wc, int fr, int fq) const {
        const int row0 = u.row0 + wr * 64 + fr, col0 = (u.col0 >> 1) + wc * 32 + 8 * fq; GAS bf16_t* H = (GAS bf16_t*)u.out;
#pragma unroll
        for (int ai = 0; ai < 2; ++ai)
#pragma unroll
            for (int m = 0; m < 4; ++m) { GAS bf16_t* rowp = H + (size_t)(row0 + ai * HALF + m * 16) * DEXP + col0;
                float o[8];
#pragma unroll
                for (int n = 0; n < 2; ++n)
#pragma unroll
                    for (int j = 0; j < 4; ++j) { const float g = acc[ai][0][m][n][j], up = acc[ai][1][m][n][j]; o[n * 4 + j] = g / (1.0f + __expf(-g)) * up; }
                u32x4 w; w.x = pack2(o[0], o[1]); w.y = pack2(o[2], o[3]); w.z = pack2(o[4], o[5]); w.w = pack2(o[6], o[7]);
                *(GAS u32x4*)rowp = w; }
    }
};
struct EpiScatter {
    static constexpr bool PERM = true;
    const LAS int* rowl;
    DI void operator()(const f32x4 (&acc)[2][2][4][2], const Unit& u, int ui, int wr, int wc, int fr, int fq) const {
        const int col0 = u.col0 + wc * 32 + 8 * fq; GAS bf16_t* Y = (GAS bf16_t*)u.out;
#pragma unroll
        for (int ai = 0; ai < 2; ++ai)
#pragma unroll
            for (int m = 0; m < 4; ++m) { const int t2 = rowl[ui * BM + ai * HALF + wr * 64 + m * 16 + fr];
                if (t2 >= 0) { GAS bf16_t* rowp = Y + (size_t)t2 * D + col0;
#pragma unroll
                    for (int bj = 0; bj < 2; ++bj) { const f32x4 v0 = acc[ai][bj][m][0], v1 = acc[ai][bj][m][1];
                        u32x4 w; w.x = pack2(v0[0], v0[1]); w.y = pack2(v0[2], v0[3]); w.z = pack2(v1[0], v1[1]); w.w = pack2(v1[2], v1[3]);
                        *(GAS u32x4*)(rowp + bj * HALF) = w; } }
                asm volatile("" ::: "memory"); }
    }
};
struct EpiPle {
    static constexpr bool PERM = false;
    const float* x2; const bf16_t* pp; bf16_t* xb;
    DI void operator()(const f32x4 (&acc)[2][2][4][2], const Unit& u, int, int wr, int wc, int fr, int fq) const {
        const int row0 = u.row0 + wr * 64 + fr, col0 = u.col0 + wc * 32 + 4 * fq; GAS float* out = (GAS float*)u.out;
#pragma unroll
        for (int ai = 0; ai < 2; ++ai)
#pragma unroll
            for (int m = 0; m < 4; ++m) { const size_t ro = (size_t)(row0 + ai * HALF + m * 16) * D + col0;
#pragma unroll
                for (int bj = 0; bj < 2; ++bj)
#pragma unroll
                    for (int n = 0; n < 2; ++n) { const size_t o = ro + bj * HALF + n * 16;
                        const f32x4 xv = *(const f32x4*)(x2 + o); const u32x2 pw = *(const u32x2*)(pp + o); const f32x4 a = acc[ai][bj][m][n];
                        f32x4 r; r[0] = xv[0] + bflo(pw.x) / (1.0f + __expf(-a[0])); r[1] = xv[1] + bfhi(pw.x) / (1.0f + __expf(-a[1]));
                        r[2] = xv[2] + bflo(pw.y) / (1.0f + __expf(-a[2])); r[3] = xv[3] + bfhi(pw.y) / (1.0f + __expf(-a[3]));
                        *(GAS f32x4*)(out + o) = r;
                        if (xb) { u32x2 w; w.x = pack2(r[0], r[1]); w.y = pack2(r[2], r[3]); *(u32x2*)(xb + o) = w; } }
                asm volatile("" ::: "memory"); }
    }
};
}

struct Params { const float* in[30]; float* out; unsigned char* ws; int ph_lo, ph_hi; };
struct Frame {
    LAS unsigned char* lds; int tid, lane, wave, G, wg;
    GAS unsigned char* ws; unsigned* ctl;
};
#define WSP(T_, off) ((T_*)(GAS T_*)(F.ws + (off)))
#define INP(i_) ((const float*)(GAS const float*)rfl64(((const LAS unsigned long long*)(F.lds + LDS_INTAB))[i_]))
DI unsigned long long rfl64(unsigned long long v) {
    return ((unsigned long long)(unsigned)__builtin_amdgcn_readfirstlane((int)(unsigned)(v >> 32)) << 32) | (unsigned)__builtin_amdgcn_readfirstlane((int)(unsigned)v);
}
DI int my_tid(int wave) { return (wave << 6) | (int)__builtin_amdgcn_mbcnt_hi(~0u, __builtin_amdgcn_mbcnt_lo(~0u, 0u)); }
DI Frame make_frame(LAS unsigned char* lds, GAS unsigned char* ws, int wave) {
    Frame F;
    int wv = __builtin_amdgcn_readfirstlane(wave); asm volatile("" : "+s"(wv));
    int tid = my_tid(wv); asm volatile("" : "+v"(tid));
    unsigned l32 = (unsigned)__builtin_amdgcn_readfirstlane((int)(unsigned)(size_t)lds); asm volatile("" : "+s"(l32));
    unsigned long long w64 = rfl64((unsigned long long)ws); asm volatile("" : "+s"(w64));
    F.lds = (LAS unsigned char*)l32; F.tid = tid; F.lane = tid & 63; F.wave = wv;
    F.G = gridDim.x; F.wg = blockIdx.x;
    F.ws = (GAS unsigned char*)w64;
    F.ctl = (unsigned*)(GAS unsigned*)F.ws;
    return F;
}
#define PHASE_FN __device__ __forceinline__ void
#define GEMM_FN __device__ __forceinline__ void
#define PHASE_ARGS LAS unsigned char* lds_, GAS unsigned char* ws_, int wave_
#define PHASE_FRAME const Frame F = make_frame(lds_, ws_, wave_)

template <int MODE> DI int rowmap(int n, int which) {
    if (MODE == 0) return n;
    if (MODE == 1) return (n >> 7) * 256 + which * 128 + (n & 127);
    const int h = n >> 8, c = n & 255; return c < 128 ? h * 128 + c : 768 + h * 128 + (c - 128);
}
template <int MODE>
DI void convert_t(const Frame F, const float* src, int K, int N, bf16_t* dst, int which, int nmat, size_t src_ms, size_t dst_ms) {
    LAS float* tile = (LAS float*)F.lds;
    const int nkt = K / 64, nnt = (N + 255) / 256, per = nkt * nnt, total = per * nmat;
    const int tid = F.tid;
    f32x4 reg[8];
    int ti = F.wg;
#define CONV_ISSUE(t_) do { const int t__ = (t_); const int mat_ = t__ / per, rem_ = t__ - mat_ * per, kt_ = rem_ / nnt, ntl_ = rem_ - kt_ * nnt; \
        const float* s_ = src + (size_t)mat_ * src_ms + (size_t)(kt_ * 64) * N + ntl_ * 256; const int n4_ = tid & 63, n_ = ntl_ * 256 + n4_ * 4; \
        _Pragma("unroll") for (int i_ = 0; i_ < 8; ++i_) { const int kr_ = (tid >> 6) + 8 * i_; reg[i_] = (n_ < N) ? *(const f32x4*)(s_ + (size_t)kr_ * N + n4_ * 4) : (f32x4){0.f, 0.f, 0.f, 0.f}; } } while (0)
    if (ti < total) CONV_ISSUE(ti);
    for (; ti < total; ti += F.G) {
#pragma unroll
        for (int i = 0; i < 8; ++i) { const int kr = (tid >> 6) + 8 * i; *(LAS f32x4*)(tile + kr * 260 + (tid & 63) * 4) = reg[i]; }
        __syncthreads();
        const int mat = ti / per, rem = ti - mat * per, kt = rem / nnt, nt_ = rem - kt * nnt;
        if (ti + F.G < total) CONV_ISSUE(ti + F.G);
        bf16_t* d = dst + (size_t)mat * dst_ms + kt * 64;
#pragma unroll
        for (int i = 0; i < 4; ++i) {
            const int nl = (tid >> 3) + 64 * i, kg = tid & 7, n = nt_ * 256 + nl;
            if (n < N) {
                float v[8];
#pragma unroll
                for (int j = 0; j < 8; ++j) v[j] = tile[(kg * 8 + j) * 260 + nl];
                u32x4 w; w.x = pack2(v[0], v[1]); w.y = pack2(v[2], v[3]); w.z = pack2(v[4], v[5]); w.w = pack2(v[6], v[7]);
                *(u32x4*)(d + (size_t)rowmap<MODE>(n, which) * K + kg * 8) = w;
            }
        }
        __syncthreads();
    }
}
DI void zero_rows(const Frame F, bf16_t* dst, size_t nelem) {
    for (size_t i = ((size_t)F.wg * 512 + F.tid) * 8; i < nelem; i += (size_t)F.G * 512 * 8) *(u32x4*)(dst + i) = (u32x4){0u, 0u, 0u, 0u};
}
DI void cvt_plain(const Frame F, const float* src, bf16_t* dst, size_t nelem) {
    for (size_t i = ((size_t)F.wg * 512 + F.tid) * 4; i < nelem; i += (size_t)F.G * 512 * 4) {
        const f32x4 v = *(const f32x4*)(src + i); u32x2 w; w.x = pack2(v[0], v[1]); w.y = pack2(v[2], v[3]); *(u32x2*)(dst + i) = w; }
}
DI void p_prologue(const Frame F) {
    convert_t<0>(F, INP(2), 2048, 8000, WSP(bf16_t, WS_WIN), 0, NL, (size_t)2048 * 8000, (size_t)8192 * 2048);
    for (int l = 0; l < NL; ++l) zero_rows(F, WSP(bf16_t, WS_WIN) + (size_t)l * 8192 * 2048 + (size_t)8000 * 2048, (size_t)192 * 2048);
    convert_t<0>(F, INP(18), 2048, 2048, WSP(bf16_t, WS_WOUT), 0, NL, (size_t)2048 * 2048, (size_t)2048 * 2048);
    convert_t<0>(F, INP(29), 2048, 2048, WSP(bf16_t, WS_WPG), 0, NL, (size_t)2048 * 2048, (size_t)2048 * 2048);
    convert_t<0>(F, INP(28), 256, 2048, WSP(bf16_t, WS_WPP), 0, NL, (size_t)256 * 2048, (size_t)2048 * 256);
    convert_t<1>(F, INP(23), 2048, 512, WSP(bf16_t, WS_WGU), 0, NL * 32, (size_t)2048 * 512, (size_t)1024 * 2048);
    convert_t<1>(F, INP(24), 2048, 512, WSP(bf16_t, WS_WGU), 1, NL * 32, (size_t)2048 * 512, (size_t)1024 * 2048);
    convert_t<0>(F, INP(25), 512, 2048, WSP(bf16_t, WS_WDN), 0, NL * 32, (size_t)512 * 2048, (size_t)2048 * 512);
    convert_t<0>(F, INP(15), 512, 1152, WSP(bf16_t, WS_WUQ), 0, NL, (size_t)512 * 1152, (size_t)1280 * 512);
    for (int l = 0; l < NL; ++l) zero_rows(F, WSP(bf16_t, WS_WUQ) + (size_t)l * 1280 * 512 + (size_t)1152 * 512, (size_t)128 * 512);
    convert_t<2>(F, INP(17), 256, 1536, WSP(bf16_t, WS_WUKV), 0, NL, (size_t)256 * 1536, (size_t)1536 * 256);
    cvt_plain(F, INP(0), WSP(bf16_t, WS_XBF), (size_t)T * D);
    cvt_plain(F, INP(1), WSP(bf16_t, WS_PBF), (size_t)NL * T * PLE);
    for (int i = F.wg * 512 + F.tid; i < 4096 * 32; i += F.G * 512) {
        const int pos = i >> 5, k = i & 31; const double ang = (double)pos * pow(10000.0, -(double)k / 32.0);
        WSP(f32x2, WS_ROPE)[i] = (f32x2){(float)cos(ang), (float)sin(ang)}; }
}

DI float zsh(const bf16_t* z, int t, int c, float mu) {
    const float a = bf2f(z[(size_t)t * ZLD + c]);
    const float p = ((t & (SEQ - 1)) == 0) ? 0.f : bf2f(z[(size_t)(t - 1) * ZLD + c]);
    return a + (p - a) * mu;
}
DI void p_rwkv_prep(const Frame F, int l) {
    const bf16_t* z = WSP(bf16_t, WS_Z);
    const float* mu = INP(3) + (size_t)l * 2560; const float* w0 = INP(4) + (size_t)l * 768;
    const float* w_up = INP(5) + (size_t)l * 64 * 768; const float* a0 = INP(6) + (size_t)l * 768; const float* a_up = INP(7) + (size_t)l * 64 * 768;
    const float* g_up = INP(8) + (size_t)l * 128 * 768; const float* k_k = INP(9) + (size_t)l * 768; const float* k_a = INP(10) + (size_t)l * 768;
    const float* r_k = INP(11) + (size_t)l * 768;
    float* R = WSP(float, WS_RW); float* DEC = R + (size_t)T * 768; float* K2 = DEC + (size_t)T * 768; float* V = K2 + (size_t)T * 768;
    float* AA = V + (size_t)T * 768; float* BB = AA + (size_t)T * 768; float* GG = BB + (size_t)T * 768; float* RK = WSP(float, WS_RK);
    LAS float* lw = (LAS float*)F.lds;
    LAS float* la = lw + 16 * 64;
    LAS float* lg = la + 16 * 64;
    const int tid = F.tid;
    for (int tile = F.wg; tile < T / 16; tile += F.G) {
        const int t0 = tile * 16;
        __syncthreads();
        for (int i = tid; i < 16 * 256; i += 512) { const int tk = i >> 8, c = i & 255; const float v = zsh(z, t0 + tk, 2304 + c, mu[2304 + c]);
            if (c < 64) lw[tk * 64 + c] = tanhf(v); else if (c < 128) la[tk * 64 + (c - 64)] = v; else lg[tk * 128 + (c - 128)] = sigmoidf_(v); }
        __syncthreads();
        for (int p = 0; p < 4; ++p) {
            const int c = (p >> 1) * 512 + tid, tb = (p & 1) * 8;
            if (c < 768) {
                float aw[8], aa[8], ag[8];
#pragma unroll
                for (int i = 0; i < 8; ++i) { aw[i] = 0.f; aa[i] = 0.f; ag[i] = 0.f; }
#pragma unroll 2
                for (int k = 0; k < 64; k += 4) {
                    float wu[4], au[4], g0[4], g1[4];
#pragma unroll
                    for (int j = 0; j < 4; ++j) { wu[j] = w_up[(size_t)(k + j) * 768 + c]; au[j] = a_up[(size_t)(k + j) * 768 + c]; g0[j] = g_up[(size_t)(k + j) * 768 + c]; g1[j] = g_up[(size_t)(64 + k + j) * 768 + c]; }
#pragma unroll
                    for (int tk = 0; tk < 8; ++tk) {
                        const f32x4 xw = *(const LAS f32x4*)(lw + (tb + tk) * 64 + k), xa = *(const LAS f32x4*)(la + (tb + tk) * 64 + k), x0 = *(const LAS f32x4*)(lg + (tb + tk) * 128 + k), x1 = *(const LAS f32x4*)(lg + (tb + tk) * 128 + 64 + k);
#pragma unroll
                        for (int j = 0; j < 4; ++j) { aw[tk] += xw[j] * wu[j]; aa[tk] += xa[j] * au[j]; ag[tk] += x0[j] * g0[j] + x1[j] * g1[j]; }
                    }
                }
                const float mur = mu[c], muk = mu[768 + c], muv = mu[1536 + c], w0c = w0[c], a0c = a0[c], kkc = k_k[c], kac = k_a[c], rkc = r_k[c];
                const int h = c >> 6;
#pragma unroll
                for (int tk = 0; tk < 8; ++tk) {
                    const int t = t0 + tb + tk;
                    const float zr = zsh(z, t, c, mur), zk = zsh(z, t, 768 + c, muk), zv = zsh(z, t, 1536 + c, muv);
                    const float xw = -(w0c + aw[tk]);
                    const float sp = (xw > 15.f) ? xw : log1pf(__expf(xw));
                    const float w = -sp - 0.5f;
                    const float dec = __expf(-__expf(w));
                    const float a = sigmoidf_(a0c + aa[tk]);
                    const float kkv = zk * kkc;
                    const float nrm = sqrtf(wave_sum(kkv * kkv));
                    const float kkh = kkv / fmaxf(nrm, 1e-12f);
                    const float k2 = zk * (1.0f + (a - 1.0f) * kac);
                    const float rks = wave_sum(zr * k2 * rkc);
                    const size_t o = (size_t)t * 768 + c;
                    R[o] = zr; DEC[o] = dec; K2[o] = k2; V[o] = zv; AA[o] = -kkh; BB[o] = kkh * a; GG[o] = ag[tk];
                    if ((tid & 63) == 0) RK[(size_t)t * 16 + h] = rks;
                }
            }
        }
    }
}

DI void p_mla_prep(const Frame F, int l) {
    const bf16_t* z = WSP(bf16_t, WS_Z);
    const float* qa_g = INP(14) + (size_t)l * 512; const float* kva_g = INP(16) + (size_t)l * 256;
    bf16_t* qn = WSP(bf16_t, WS_QN); bf16_t* kvn = WSP(bf16_t, WS_KVN); bf16_t* kr = WSP(bf16_t, WS_KROPE);
    const f32x2* rope = WSP(f32x2, WS_ROPE);
    const int lane = F.lane;
    for (int t = F.wg * 8 + F.wave; t < T; t += F.G * 8) {
        const bf16_t* zr = z + (size_t)t * ZLD;
        { const u32x4 w = *(const u32x4*)(zr + ZC_QA + lane * 8); float v[8] = {bflo(w.x), bfhi(w.x), bflo(w.y), bfhi(w.y), bflo(w.z), bfhi(w.z), bflo(w.w), bfhi(w.w)};
          float ss = 0.f;
#pragma unroll
          for (int j = 0; j < 8; ++j) ss += v[j] * v[j];
          ss = wave_sum(ss); const float rs = rsqrtf(ss * (1.0f / 512.0f) + 1e-6f);
          const f32x4 g0 = *(const f32x4*)(qa_g + lane * 8), g1 = *(const f32x4*)(qa_g + lane * 8 + 4);
          u32x4 o; o.x = pack2(v[0] * rs * g0[0], v[1] * rs * g0[1]); o.y = pack2(v[2] * rs * g0[2], v[3] * rs * g0[3]); o.z = pack2(v[4] * rs * g1[0], v[5] * rs * g1[1]); o.w = pack2(v[6] * rs * g1[2], v[7] * rs * g1[3]);
          *(u32x4*)(qn + (size_t)t * 512 + lane * 8) = o; }
        { const u32x2 w = *(const u32x2*)(zr + ZC_KVA + lane * 4); float v[4] = {bflo(w.x), bfhi(w.x), bflo(w.y), bfhi(w.y)};
          float ss = v[0] * v[0] + v[1] * v[1] + v[2] * v[2] + v[3] * v[3];
          ss = wave_sum(ss); const float rs = rsqrtf(ss * (1.0f / 256.0f) + 1e-6f);
          const f32x4 g0 = *(const f32x4*)(kva_g + lane * 4);
          u32x2 o; o.x = pack2(v[0] * rs * g0[0], v[1] * rs * g0[1]); o.y = pack2(v[2] * rs * g0[2], v[3] * rs * g0[3]);
          *(u32x2*)(kvn + (size_t)t * 256 + lane * 4) = o; }
        { const int i = lane & 31; const float t1 = bf2f(zr[ZC_KR + i]), t2 = bf2f(zr[ZC_KR + 32 + i]); const f32x2 cs = rope[(t & (SEQ - 1)) * 32 + i];
          const float o = (lane < 32) ? (t1 * cs.x - t2 * cs.y) : (t1 * cs.y + t2 * cs.x);
          kr[(size_t)t * 64 + lane] = f2bf(o); }
    }
}

DI void p_vtd_prep(const Frame F) {
    const bf16_t* z = WSP(bf16_t, WS_Z); bf16_t* vtd = WSP(bf16_t, WS_VTD);
    LAS bf16_t* buf = (LAS bf16_t*)(F.lds + F.wave * 8704);
    const int lane = F.lane;
    for (int tile = F.wg * 8 + F.wave; tile < 2 * 12 * 128; tile += F.G * 8) {
        const int pt = tile & 127, hd = (tile >> 7) % 12, b = tile / (128 * 12);
        const int g = hd >> 2, d = 1 << (2 * g), Ls = SEQ / d;
        const int pos0 = pt * 32, r = pos0 / Ls, j0 = pos0 - r * Ls;
#pragma unroll
        for (int i = 0; i < 8; ++i) { const int p = lane + 64 * i, row = p >> 4, seg = p & 15;
            const size_t tok = (size_t)b * SEQ + (size_t)(j0 + row) * d + r;
            const u32x4 w = *(const u32x4*)(z + tok * ZLD + ZC_DV + hd * 128 + seg * 8);
            *(LAS u32x4*)(buf + row * 136 + seg * 8) = w; }
        __builtin_amdgcn_s_waitcnt(0);
#pragma unroll
        for (int i = 0; i < 8; ++i) { const int p = lane + 64 * i, dv = p >> 2, seg = p & 3;
            unsigned short v[8];
#pragma unroll
            for (int j = 0; j < 8; ++j) v[j] = buf[(seg * 8 + j) * 136 + dv];
            u32x4 w; w.x = v[0] | ((unsigned)v[1] << 16); w.y = v[2] | ((unsigned)v[3] << 16); w.z = v[4] | ((unsigned)v[5] << 16); w.w = v[6] | ((unsigned)v[7] << 16);
            *(u32x4*)(vtd + ((size_t)(b * 12 + hd) * 128 + dv) * SEQ + pos0 + seg * 8) = w; }
        __builtin_amdgcn_s_waitcnt(0);
    }
}

DI int swap23(int i) { return (i & ~12) | ((i & 4) << 1) | ((i & 8) >> 1); }
DI int crow(int reg, int h) { return (reg & 3) + 8 * (reg >> 2) + 4 * h; }
#define MFMA32(a, b, c) __builtin_amdgcn_mfma_f32_32x32x16_bf16((a), (b), (c), 0, 0, 0)
DI bf16x8 packp(const f32x16& p, int s) {
    u32x4 w; w.x = pack2(p[8 * s], p[8 * s + 1]); w.y = pack2(p[8 * s + 2], p[8 * s + 3]); w.z = pack2(p[8 * s + 4], p[8 * s + 5]); w.w = pack2(p[8 * s + 6], p[8 * s + 7]);
    return __builtin_bit_cast(bf16x8, w);
}

DI void dil_item(const Frame F, int item) {
    const bf16_t* z = WSP(bf16_t, WS_Z); const bf16_t* vtd = WSP(bf16_t, WS_VTD);
    bf16_t* op = WSP(bf16_t, WS_OP); float* lse = WSP(float, WS_LSE);
    const int lane = F.lane, c = lane & 31, hh = lane >> 5;
    const int bgh = item >> 7, rem = item & 127, b = bgh / 12, hd = bgh % 12, g = hd >> 2, hs = hd & 3;
    const int d = 1 << (2 * g), Ls = SEQ / d, ntile = Ls / 32, r = rem / ntile, jt = rem % ntile;
    const float slope2 = exp2f(-8.0f * (float)(hd + 1) / 12.0f) * LOG2E * (float)d;
    const float sc = 0.08838834764831845f * LOG2E;
    const int jq = jt * 32 + c;
    const size_t tq = (size_t)b * SEQ + (size_t)jq * d + r;
    bf16x8 qf[8];
#pragma unroll
    for (int ks = 0; ks < 8; ++ks) qf[ks] = *(const bf16x8*)(z + tq * ZLD + ZC_DQ + hd * 128 + 16 * ks + 8 * hh);
    f32x16 O[4];
#pragma unroll
    for (int i = 0; i < 4; ++i)
#pragma unroll
        for (int j = 0; j < 16; ++j) O[i][j] = 0.f;
    float m = -1e30f, lsum = 0.f;
    const int kt0 = jt - 4 < 0 ? 0 : jt - 4;
    for (int kt = kt0; kt <= jt; ++kt) {
        const int jk = kt * 32 + swap23(c);
        const size_t tk = (size_t)b * SEQ + (size_t)jk * d + r;
        bf16x8 kf[8], vf[4][2];
#pragma unroll
        for (int ks = 0; ks < 8; ++ks) kf[ks] = *(const bf16x8*)(z + tk * ZLD + ZC_DK + hd * 128 + 16 * ks + 8 * hh);
#pragma unroll
        for (int dvt = 0; dvt < 4; ++dvt)
#pragma unroll
            for (int s = 0; s < 2; ++s) vf[dvt][s] = *(const bf16x8*)(vtd + ((size_t)(b * 12 + hd) * 128 + dvt * 32 + c) * SEQ + r * Ls + kt * 32 + 16 * s + 8 * hh);
        f32x16 S;
#pragma unroll
        for (int j = 0; j < 16; ++j) S[j] = 0.f;
#pragma unroll
        for (int ks = 0; ks < 8; ++ks) S = MFMA32(kf[ks], qf[ks], S);
        float mx = -1e30f;
#pragma unroll
        for (int i = 0; i < 16; ++i) { const int rel = jq - (kt * 32 + swap23(crow(i, hh)));
            float s = S[i] * sc - slope2 * (float)rel; s = (rel >= 0 && rel <= 128) ? s : -1e30f; S[i] = s; mx = fmaxf(mx, s); }
        mx = fmaxf(mx, __shfl_xor(mx, 32));
        const float mn = fmaxf(m, mx), al = __builtin_amdgcn_exp2f(m - mn); m = mn;
        float ps = 0.f;
#pragma unroll
        for (int i = 0; i < 16; ++i) { const float p = __builtin_amdgcn_exp2f(S[i] - mn); S[i] = p; ps += p; }
        lsum = lsum * al + ps;
#pragma unroll
        for (int i = 0; i < 4; ++i)
#pragma unroll
            for (int j = 0; j < 16; ++j) O[i][j] *= al;
        const bf16x8 p0 = packp(S, 0), p1 = packp(S, 1);
#pragma unroll
        for (int dvt = 0; dvt < 4; ++dvt) { O[dvt] = MFMA32(vf[dvt][0], p0, O[dvt]); O[dvt] = MFMA32(vf[dvt][1], p1, O[dvt]); }
    }
    const float lt = lsum + __shfl_xor(lsum, 32), inv = 1.0f / lt;
    bf16_t* orow = op + ((size_t)g * T + tq) * 512 + hs * 128;
#pragma unroll
    for (int dvt = 0; dvt < 4; ++dvt)
#pragma unroll
        for (int g4 = 0; g4 < 4; ++g4) { u32x2 w; w.x = pack2(O[dvt][4 * g4] * inv, O[dvt][4 * g4 + 1] * inv); w.y = pack2(O[dvt][4 * g4 + 2] * inv, O[dvt][4 * g4 + 3] * inv);
            *(u32x2*)(orow + dvt * 32 + 8 * g4 + 4 * hh) = w; }
    if (hh == 0) lse[((size_t)g * T + tq) * 4 + hs] = m + __builtin_amdgcn_logf(lt);
}

DI void mla_item(const Frame F, int item) {
    const bf16_t* qb = WSP(bf16_t, WS_QB); const bf16_t* kc = WSP(bf16_t, WS_KC); const bf16_t* krp = WSP(bf16_t, WS_KROPE); const bf16_t* vt = WSP(bf16_t, WS_VT);
    const f32x2* rope = WSP(f32x2, WS_ROPE); bf16_t* mix = WSP(bf16_t, WS_MIX);
    const int lane = F.lane, c = lane & 31, hh = lane >> 5;
    const int qt = 127 - item / 12, bh = item % 12, b = bh / 6, h = bh % 6;
    const int q0 = qt * 32;
    const size_t tq = (size_t)b * SEQ + q0 + c;
    const float sc = 0.07216878364870322f * LOG2E;
    bf16x8 qf[12];
#pragma unroll
    for (int ks = 0; ks < 12; ++ks) qf[ks] = *(const bf16x8*)(qb + tq * 1280 + h * 192 + 16 * ks + 8 * hh);
#pragma unroll
    for (int kk = 0; kk < 2; ++kk) {
        const u32x4 w1 = __builtin_bit_cast(u32x4, qf[8 + kk]), w2 = __builtin_bit_cast(u32x4, qf[10 + kk]);
        const unsigned a1[4] = {w1.x, w1.y, w1.z, w1.w}, a2[4] = {w2.x, w2.y, w2.z, w2.w};
        unsigned o1[4], o2[4];
#pragma unroll
        for (int jj = 0; jj < 4; ++jj) {
            const int i0 = 16 * kk + 8 * hh + 2 * jj;
            const f32x2 cs0 = rope[(q0 + c) * 32 + i0], cs1 = rope[(q0 + c) * 32 + i0 + 1];
            const float t1a = bflo(a1[jj]), t1b = bfhi(a1[jj]), t2a = bflo(a2[jj]), t2b = bfhi(a2[jj]);
            o1[jj] = pack2(t1a * cs0.x - t2a * cs0.y, t1b * cs1.x - t2b * cs1.y);
            o2[jj] = pack2(t1a * cs0.y + t2a * cs0.x, t1b * cs1.y + t2b * cs1.x);
        }
        qf[8 + kk] = __builtin_bit_cast(bf16x8, (u32x4){o1[0], o1[1], o1[2], o1[3]});
        qf[10 + kk] = __builtin_bit_cast(bf16x8, (u32x4){o2[0], o2[1], o2[2], o2[3]});
    }
    f32x16 O[4];
#pragma unroll
    for (int i = 0; i < 4; ++i)
#pragma unroll
        for (int j = 0; j < 16; ++j) O[i][j] = 0.f;
    float m = -1e30f, lsum = 0.f;
    for (int kt = 0; kt <= qt; ++kt) {
        const size_t tk = (size_t)b * SEQ + kt * 32 + swap23(c);
        bf16x8 kf[12], vf[4][2];
#pragma unroll
        for (int ks = 0; ks < 8; ++ks) kf[ks] = *(const bf16x8*)(kc + tk * 768 + h * 128 + 16 * ks + 8 * hh);
#pragma unroll
        for (int ks = 0; ks < 4; ++ks) kf[8 + ks] = *(const bf16x8*)(krp + tk * 64 + 16 * ks + 8 * hh);
#pragma unroll
        for (int dvt = 0; dvt < 4; ++dvt)
#pragma unroll
            for (int s = 0; s < 2; ++s) vf[dvt][s] = *(const bf16x8*)(vt + (size_t)(h * 128 + dvt * 32 + c) * T + (size_t)b * SEQ + kt * 32 + 16 * s + 8 * hh);
        f32x16 S;
#pragma unroll
        for (int j = 0; j < 16; ++j) S[j] = 0.f;
#pragma unroll
        for (int ks = 0; ks < 12; ++ks) S = MFMA32(kf[ks], qf[ks], S);
        float mx = -1e30f;
        const bool diag = (kt == qt);
#pragma unroll
        for (int i = 0; i < 16; ++i) { float s = S[i] * sc; if (diag && swap23(crow(i, hh)) > c) s = -1e30f; S[i] = s; mx = fmaxf(mx, s); }
        mx = fmaxf(mx, __shfl_xor(mx, 32));
        const float mn = fmaxf(m, mx), al = __builtin_amdgcn_exp2f(m - mn); m = mn;
        float ps = 0.f;
#pragma unroll
        for (int i = 0; i < 16; ++i) { const float p = __builtin_amdgcn_exp2f(S[i] - mn); S[i] = p; ps += p; }
        lsum = lsum * al + ps;
#pragma unroll
        for (int i = 0; i < 4; ++i)
#pragma unroll
            for (int j = 0; j < 16; ++j) O[i][j] *= al;
        const bf16x8 p0 = packp(S, 0), p1 = packp(S, 1);
#pragma unroll
        for (int dvt = 0; dvt < 4; ++dvt) { O[dvt] = MFMA32(vf[dvt][0], p0, O[dvt]); O[dvt] = MFMA32(vf[dvt][1], p1, O[dvt]); }
    }
    const float lt = lsum + __shfl_xor(lsum, 32), inv = 1.0f / lt;
    bf16_t* orow = mix + tq * D + 1280 + h * 128;
#pragma unroll
    for (int dvt = 0; dvt < 4; ++dvt)
#pragma unroll
        for (int g4 = 0; g4 < 4; ++g4) { u32x2 w; w.x = pack2(O[dvt][4 * g4] * inv, O[dvt][4 * g4 + 1] * inv); w.y = pack2(O[dvt][4 * g4 + 2] * inv, O[dvt][4 * g4 + 3] * inv);
            *(u32x2*)(orow + dvt * 32 + 8 * g4 + 4 * hh) = w; }
}

DI void dilc_item(const Frame F, int item) {
    const bf16_t* op = WSP(bf16_t, WS_OP); const float* lse = WSP(float, WS_LSE); bf16_t* mix = WSP(bf16_t, WS_MIX);
    for (int i = 0; i < 16; ++i) {
        const int task = i * 64 + F.lane, tl = task >> 6, rem = task & 63, hs = rem >> 4, oc = rem & 15;
        const size_t t = (size_t)item * 16 + tl;
        const float l0 = lse[((size_t)0 * T + t) * 4 + hs], l1 = lse[((size_t)1 * T + t) * 4 + hs], l2 = lse[((size_t)2 * T + t) * 4 + hs];
        const float mx = fmaxf(l0, fmaxf(l1, l2));
        float w0 = __builtin_amdgcn_exp2f(l0 - mx), w1 = __builtin_amdgcn_exp2f(l1 - mx), w2 = __builtin_amdgcn_exp2f(l2 - mx);
        const float inv = 1.0f / (w0 + w1 + w2); w0 *= inv; w1 *= inv; w2 *= inv;
        const u32x4 a = *(const u32x4*)(op + ((size_t)0 * T + t) * 512 + hs * 128 + oc * 8), bq = *(const u32x4*)(op + ((size_t)1 * T + t) * 512 + hs * 128 + oc * 8), cq = *(const u32x4*)(op + ((size_t)2 * T + t) * 512 + hs * 128 + oc * 8);
        const unsigned aw[4] = {a.x, a.y, a.z, a.w}, bw[4] = {bq.x, bq.y, bq.z, bq.w}, cw[4] = {cq.x, cq.y, cq.z, cq.w}; unsigned o[4];
#pragma unroll
        for (int j = 0; j < 4; ++j) o[j] = pack2(w0 * bflo(aw[j]) + w1 * bflo(bw[j]) + w2 * bflo(cw[j]), w0 * bfhi(aw[j]) + w1 * bfhi(bw[j]) + w2 * bfhi(cw[j]));
        *(u32x4*)(mix + t * D + 768 + hs * 128 + oc * 8) = (u32x4){o[0], o[1], o[2], o[3]};
    }
}

DI float dppf(float x, int ctrl_sel) {
    const int v = __float_as_int(x); int r;
    if (ctrl_sel == 0) r = __builtin_amdgcn_mov_dpp(v, 0xB1, 0xF, 0xF, true);
    else if (ctrl_sel == 1) r = __builtin_amdgcn_mov_dpp(v, 0x4E, 0xF, 0xF, true);
    else r = __builtin_amdgcn_mov_dpp(v, 0x141, 0xF, 0xF, true);
    return __int_as_float(r);
}
DI float reduce8(float x) { x += dppf(x, 0); x += dppf(x, 1); x += dppf(x, 2); return x; }
constexpr int RTS = 32;
DI void p_rwkv_scan(const Frame F, int l, int bh) {
    const float* R = WSP(float, WS_RW); const float* DEC = R + (size_t)T * 768; const float* K2 = DEC + (size_t)T * 768; const float* V = K2 + (size_t)T * 768;
    const float* AA = V + (size_t)T * 768; const float* BB = AA + (size_t)T * 768; const float* GG = BB + (size_t)T * 768; const float* RK = WSP(float, WS_RK);
    const float* gn_g = INP(12) + (size_t)l * 768; const float* gn_b = INP(13) + (size_t)l * 768;
    bf16_t* mix = WSP(bf16_t, WS_MIX);
    const int b = bh / 12, h = bh % 12, tid = F.tid, i = tid >> 3, jg = tid & 7;
    LAS float* sb = (LAS float*)F.lds;
    LAS float* yb = sb + 2 * 6 * RTS * 64;
    f32x4 reg[6];
    const int st_step = tid >> 4, st_c4 = (tid & 15) * 4;
#define SCAN_ISSUE(chunk_) do { const size_t tok_ = (size_t)b * SEQ + (size_t)(chunk_) * RTS + st_step; \
        reg[0] = *(const f32x4*)(R + tok_ * 768 + h * 64 + st_c4); reg[1] = *(const f32x4*)(DEC + tok_ * 768 + h * 64 + st_c4); reg[2] = *(const f32x4*)(K2 + tok_ * 768 + h * 64 + st_c4); \
        reg[3] = *(const f32x4*)(V + tok_ * 768 + h * 64 + st_c4); reg[4] = *(const f32x4*)(AA + tok_ * 768 + h * 64 + st_c4); reg[5] = *(const f32x4*)(BB + tok_ * 768 + h * 64 + st_c4); } while (0)
    float s[8];
#pragma unroll
    for (int j = 0; j < 8; ++j) s[j] = 0.f;
    SCAN_ISSUE(0);
    __syncthreads();
#pragma unroll
    for (int a = 0; a < 6; ++a) *(LAS f32x4*)(sb + (0 * 6 + a) * RTS * 64 + st_step * 64 + st_c4) = reg[a];
    __syncthreads();
    const int nchunk = SEQ / RTS;
    for (int ch = 0; ch < nchunk; ++ch) {
        const int cb = ch & 1;
        if (ch + 1 < nchunk) SCAN_ISSUE(ch + 1);
        const LAS float* pr = sb + (cb * 6 + 0) * RTS * 64 + jg * 8; const LAS float* pw = sb + (cb * 6 + 1) * RTS * 64 + jg * 8;
        const LAS float* pk = sb + (cb * 6 + 2) * RTS * 64 + jg * 8; const LAS float* pv = sb + (cb * 6 + 3) * RTS * 64 + i;
        const LAS float* pa = sb + (cb * 6 + 4) * RTS * 64 + jg * 8; const LAS float* pb = sb + (cb * 6 + 5) * RTS * 64 + jg * 8;
#pragma unroll 4
        for (int st = 0; st < RTS; ++st) {
            const f32x4 a0 = *(const LAS f32x4*)(pa + st * 64), a1 = *(const LAS f32x4*)(pa + st * 64 + 4);
            const f32x4 w0 = *(const LAS f32x4*)(pw + st * 64), w1 = *(const LAS f32x4*)(pw + st * 64 + 4);
            const f32x4 b0 = *(const LAS f32x4*)(pb + st * 64), b1 = *(const LAS f32x4*)(pb + st * 64 + 4);
            const f32x4 k0 = *(const LAS f32x4*)(pk + st * 64), k1 = *(const LAS f32x4*)(pk + st * 64 + 4);
            const f32x4 r0 = *(const LAS f32x4*)(pr + st * 64), r1 = *(const LAS f32x4*)(pr + st * 64 + 4);
            const float vv = pv[st * 64];
            float sa = (s[0] * a0[0] + s[1] * a0[1]) + (s[2] * a0[2] + s[3] * a0[3]) + (s[4] * a1[0] + s[5] * a1[1]) + (s[6] * a1[2] + s[7] * a1[3]);
            sa = reduce8(sa);
#pragma unroll
            for (int j = 0; j < 4; ++j) { s[j] = s[j] * w0[j] + (sa * b0[j] + vv * k0[j]); s[4 + j] = s[4 + j] * w1[j] + (sa * b1[j] + vv * k1[j]); }
            float y = (s[0] * r0[0] + s[1] * r0[1]) + (s[2] * r0[2] + s[3] * r0[3]) + (s[4] * r1[0] + s[5] * r1[1]) + (s[6] * r1[2] + s[7] * r1[3]);
            y = reduce8(y);
            if (jg == 0) yb[st * 64 + i] = y;
        }
        __syncthreads();
#pragma unroll
        for (int q = 0; q < RTS / 8; ++q) {
            const int st = F.wave * (RTS / 8) + q, lane = F.lane;
            const size_t tok = (size_t)b * SEQ + (size_t)ch * RTS + st;
            const float y = yb[st * 64 + lane];
            const float mean = wave_sum(y) * (1.0f / 64.0f); const float dlt = y - mean; const float var = wave_sum(dlt * dlt) * (1.0f / 64.0f);
            const int cidx = h * 64 + lane;
            float o = dlt * rsqrtf(var + 64e-5f) * gn_g[cidx] + gn_b[cidx];
            o += RK[tok * 16 + h] * sb[(cb * 6 + 3) * RTS * 64 + st * 64 + lane];
            o *= GG[tok * 768 + cidx];
            mix[tok * D + cidx] = f2bf(o);
        }
        if (ch + 1 < nchunk) {
#pragma unroll
            for (int a = 0; a < 6; ++a) *(LAS f32x4*)(sb + ((cb ^ 1) * 6 + a) * RTS * 64 + st_step * 64 + st_c4) = reg[a];
        }
        __syncthreads();
    }
}

DI void p_ln1_route(const Frame F, int l, const float* xin) {
    const float* tmp = WSP(float, WS_TMP); float* x1 = WSP(float, WS_X1); bf16_t* x1b = WSP(bf16_t, WS_X1BF);
    const float* g = INP(19) + (size_t)l * D; const float* bta = INP(20) + (size_t)l * D;
    const float* rw = INP(21); const float* rb = INP(22);
    unsigned* cnt = F.ctl + CW_MOECNT + l * 32; int* tokl = WSP(int, WS_TOKL); float* gate = WSP(float, WS_GATE);
    const int lane = F.lane;
    LAS float* xl = (LAS float*)F.lds + F.wave * 4096;
    for (int pr = F.wg * 8 + F.wave; pr < T / 2; pr += F.G * 8) {
#pragma unroll
        for (int u = 0; u < 2; ++u) {
            const size_t t = (size_t)pr * 2 + u;
            float xv[32]; float sm = 0.f;
#pragma unroll
            for (int i = 0; i < 8; ++i) { const f32x4 a = *(const f32x4*)(xin + t * D + 256 * i + 4 * lane), m = *(const f32x4*)(tmp + t * D + 256 * i + 4 * lane);
#pragma unroll
                for (int j = 0; j < 4; ++j) { const float v = ALPHA * a[j] + m[j]; xv[4 * i + j] = v; sm += v; } }
            const float mean = wave_sum(sm) * (1.0f / 2048.0f);
            float sq = 0.f;
#pragma unroll
            for (int i = 0; i < 32; ++i) { const float dl = xv[i] - mean; sq += dl * dl; }
            const float rstd = rsqrtf(wave_sum(sq) * (1.0f / 2048.0f) + 1e-5f);
#pragma unroll
            for (int i = 0; i < 8; ++i) { const f32x4 gg = *(const f32x4*)(g + 256 * i + 4 * lane), bb = *(const f32x4*)(bta + 256 * i + 4 * lane); f32x4 o;
#pragma unroll
                for (int j = 0; j < 4; ++j) o[j] = (xv[4 * i + j] - mean) * rstd * gg[j] + bb[j];
                *(f32x4*)(x1 + t * D + 256 * i + 4 * lane) = o;
                *(LAS f32x4*)(xl + u * 2048 + 256 * i + 4 * lane) = o;
                u32x2 w; w.x = pack2(o[0], o[1]); w.y = pack2(o[2], o[3]); *(u32x2*)(x1b + t * D + 256 * i + 4 * lane) = w; }
        }
        __builtin_amdgcn_s_waitcnt(0xc07f);
        const int e = lane & 31;
        const LAS float* xr = xl + (lane >> 5) * 2048;
        const float* wcol = rw + e;
        float a0 = 0.f, a1 = 0.f, a2 = 0.f, a3 = 0.f;
#pragma unroll 4
        for (int k = 0; k < 2048; k += 4) {
            const f32x4 xq = *(const LAS f32x4*)(xr + k);
            a0 += xq[0] * wcol[(size_t)(k + 0) * 32]; a1 += xq[1] * wcol[(size_t)(k + 1) * 32]; a2 += xq[2] * wcol[(size_t)(k + 2) * 32]; a3 += xq[3] * wcol[(size_t)(k + 3) * 32];
        }
        const float logit = (a0 + a1) + (a2 + a3);
        const float score = 1.0f / (1.0f + expf(-logit)), sel = score + rb[e];
        const int gb = lane & ~3;
        const float s0 = __shfl(sel, gb), s1 = __shfl(sel, gb + 1), s2 = __shfl(sel, gb + 2), s3 = __shfl(sel, gb + 3);
        const float ha = fmaxf(s0, s1), hb = fminf(s0, s1), hc = fmaxf(s2, s3), hd = fminf(s2, s3);
        float gv = fmaxf(ha, hc) + fmaxf(fminf(ha, hc), fmaxf(hb, hd)); int gi = e >> 2;
#pragma unroll
        for (int msk = 4; msk <= 16; msk <<= 1) { const float ov = __shfl_xor(gv, msk); const int oi = __shfl_xor(gi, msk); if (ov > gv || (ov == gv && oi < gi)) { gv = ov; gi = oi; } }
        const int base = (lane & 32) + 4 * gi;
        float a[4], sc4[4];
#pragma unroll
        for (int k = 0; k < 4; ++k) { a[k] = __shfl(sel, base + k); sc4[k] = __shfl(score, base + k); }
        int i1 = 0; float v1 = a[0];
#pragma unroll
        for (int k = 1; k < 4; ++k) if (a[k] > v1) { v1 = a[k]; i1 = k; }
        int i2 = -1; float v2 = -3.0e38f;
#pragma unroll
        for (int k = 0; k < 4; ++k) if (k != i1 && a[k] > v2) { v2 = a[k]; i2 = k; }
        float g1 = 0.f, g2 = 0.f;
#pragma unroll
        for (int k = 0; k < 4; ++k) { if (k == i1) g1 = sc4[k]; if (k == i2) g2 = sc4[k]; }
        if (e == 0) {
            const int t = pr * 2 + (lane >> 5); const int e1 = 4 * gi + i1, e2 = 4 * gi + i2; const float dn = g1 + g2;
            const unsigned r1 = atomicAdd(cnt + e1, 1u); tokl[e1 * 8192 + r1] = 2 * t;
            const unsigned r2 = atomicAdd(cnt + e2, 1u); tokl[e2 * 8192 + r2] = 2 * t + 1;
            gate[2 * t] = g1 / dn; gate[2 * t + 1] = g2 / dn;
        }
    }
}

DI void p_ln2(const Frame F, int l) {
    const float* x1 = WSP(float, WS_X1); const bf16_t* ybt = WSP(bf16_t, WS_YBT); const float* gate = WSP(float, WS_GATE);
    float* x2 = WSP(float, WS_TMP); bf16_t* x2b = WSP(bf16_t, WS_X1BF);
    const float* g = INP(26) + (size_t)l * D; const float* bta = INP(27) + (size_t)l * D;
    const int lane = F.lane;
    for (int t = F.wg * 8 + F.wave; t < T; t += F.G * 8) {
        const float g0 = gate[2 * t], g1 = gate[2 * t + 1];
        float xv[32]; float sm = 0.f;
#pragma unroll
        for (int i = 0; i < 8; ++i) { const size_t o = 256 * i + 4 * lane; const f32x4 a = *(const f32x4*)(x1 + (size_t)t * D + o);
            const u32x2 y0 = *(const u32x2*)(ybt + (size_t)(2 * t) * D + o), y1 = *(const u32x2*)(ybt + (size_t)(2 * t + 1) * D + o);
            xv[4 * i] = ALPHA * a[0] + (g0 * bflo(y0.x) + g1 * bflo(y1.x)); xv[4 * i + 1] = ALPHA * a[1] + (g0 * bfhi(y0.x) + g1 * bfhi(y1.x));
            xv[4 * i + 2] = ALPHA * a[2] + (g0 * bflo(y0.y) + g1 * bflo(y1.y)); xv[4 * i + 3] = ALPHA * a[3] + (g0 * bfhi(y0.y) + g1 * bfhi(y1.y));
            sm += (xv[4 * i] + xv[4 * i + 1]) + (xv[4 * i + 2] + xv[4 * i + 3]); }
        const float mean = wave_sum(sm) * (1.0f / 2048.0f);
        float sq = 0.f;
#pragma unroll
        for (int i = 0; i < 32; ++i) { const float dl = xv[i] - mean; sq += dl * dl; }
        const float rstd = rsqrtf(wave_sum(sq) * (1.0f / 2048.0f) + 1e-5f);
#pragma unroll
        for (int i = 0; i < 8; ++i) { const size_t o = 256 * i + 4 * lane; const f32x4 gg = *(const f32x4*)(g + o), bb = *(const f32x4*)(bta + o); f32x4 r;
#pragma unroll
            for (int j = 0; j < 4; ++j) r[j] = (xv[4 * i + j] - mean) * rstd * gg[j] + bb[j];
            *(f32x4*)(x2 + (size_t)t * D + o) = r; u32x2 w; w.x = pack2(r[0], r[1]); w.y = pack2(r[2], r[3]); *(u32x2*)(x2b + (size_t)t * D + o) = w; }
    }
}

DI int finish_units(const Frame F, int n) {
    LAS int* cw = (LAS int*)(F.lds + LDS_CTL);
    if (F.tid == 0) cw[4] = n;
    __syncthreads();
    return __builtin_amdgcn_readfirstlane(cw[4]);
}
DI int moe_units_body(const Frame F, int l, bool gemm1) {
    LAS int* mt = (LAS int*)(F.lds + LDS_MOE); LAS int* utab = (LAS int*)(F.lds + LDS_UTAB); LAS int* rowl = (LAS int*)(F.lds + LDS_ROWL);
    const int* tokl = WSP(int, WS_TOKL);
    int n = 0;
    if (F.tid == 0) {
        int hb = 0, nrb = 0;
        for (int e = 0; e < 32; ++e) { int c = (int)__hip_atomic_load(F.ctl + CW_MOECNT + l * 32 + e, __ATOMIC_RELAXED, __HIP_MEMORY_SCOPE_AGENT); if (c > 8192) c = 8192;
            mt[e] = c; mt[32 + e] = hb; const int nb = (c + 255) >> 8;
            for (int j = 0; j < nb && nrb < 128; ++j) { mt[64 + nrb] = e; mt[192 + nrb] = j; ++nrb; }
            hb += nb * 256; }
        const int npn = gemm1 ? 4 : 8;
        for (int L = F.wg; L < nrb * npn && n < 4; L += F.G) {
            const int rb = L / npn, pn = L - rb * npn, e = mt[64 + rb], j = mt[192 + rb], cnt = mt[e], row0 = mt[32 + e] + j * 256;
            const int valid = (cnt - j * 256) < 256 ? (cnt - j * 256) : 256;
            if (gemm1) pg8::unit_put(utab, n, WSP(bf16_t, WS_X1BF), WSP(bf16_t, WS_WGU) + ((size_t)(l * 32 + e) * 1024 + (size_t)pn * 256) * 2048, WSP(bf16_t, WS_HB), 2048, DEXP, row0, pn * 256, e * 8192 + j * 256, valid);
            else pg8::unit_put(utab, n, WSP(bf16_t, WS_HB) + (size_t)row0 * DEXP, WSP(bf16_t, WS_WDN) + ((size_t)(l * 32 + e) * 2048 + (size_t)pn * 256) * 512, WSP(bf16_t, WS_YBT), 512, D, row0, pn * 256, e * 8192 + j * 256, valid);
            ++n;
        }
    }
    n = finish_units(F, n);
    for (int x = F.tid; x < n * 256; x += 512) { const int ui = x >> 8, r = x & 255, a0 = utab[ui * pg8::UD + 10], a1 = utab[ui * pg8::UD + 11];
        const int v = (r < a1) ? tokl[a0 + r] : -1; rowl[x] = gemm1 ? (v < 0 ? 0 : (v >> 1)) : v; }
    __syncthreads();
    return n;
}

__device__ __noinline__ int moe_units(LAS unsigned char* lds_, GAS unsigned char* ws_, int wave_, int l, int gemm1) { const Frame F = make_frame(lds_, ws_, wave_); return moe_units_body(F, l, gemm1 != 0); }
PHASE_FN ph_prologue(PHASE_ARGS) { PHASE_FRAME; p_prologue(F); }
GEMM_FN ph_gemm_in(PHASE_ARGS, int l) {
    PHASE_FRAME; LAS int* utab = (LAS int*)(F.lds + LDS_UTAB);
    int n = 0;
    if (F.tid == 0) { int Lb = 0;
        pg8::build_dense(utab, n, Lb, WSP(bf16_t, WS_XBF), WSP(bf16_t, WS_WIN) + (size_t)l * 8192 * 2048, WSP(bf16_t, WS_Z), 2, T, 8192, 2048, ZLD, F.G, F.wg);
        pg8::build_dense(utab, n, Lb, WSP(bf16_t, WS_PBF) + (size_t)l * T * PLE, WSP(bf16_t, WS_WPP) + (size_t)l * 2048 * 256, WSP(bf16_t, WS_PP), 2, T, 2048, 256, D, F.G, F.wg); }
    n = finish_units(F, n);
    pg8::EpiBf16 E; pg8::gemm_phase<pg8::EpiBf16, false>(F.lds, F.tid, utab, n, nullptr, E);
}
PHASE_FN ph_rwkv_prep(PHASE_ARGS, int l) { PHASE_FRAME; p_rwkv_prep(F, l); }
PHASE_FN ph_mla_prep(PHASE_ARGS, int l) { PHASE_FRAME; p_mla_prep(F, l); p_vtd_prep(F); }
GEMM_FN ph_gemm_mla(PHASE_ARGS, int l) {
    PHASE_FRAME; LAS int* utab = (LAS int*)(F.lds + LDS_UTAB);
    int n = 0;
    if (F.tid == 0) { int Lb = 0;
        pg8::build_dense(utab, n, Lb, WSP(bf16_t, WS_QN), WSP(bf16_t, WS_WUQ) + (size_t)l * 1280 * 512, WSP(bf16_t, WS_QB), 2, T, 1280, 512, 1280, F.G, F.wg);
        pg8::build_dense(utab, n, Lb, WSP(bf16_t, WS_KVN), WSP(bf16_t, WS_WUKV) + (size_t)l * 1536 * 256, WSP(bf16_t, WS_KC), 2, T, 768, 256, 768, F.G, F.wg);
        pg8::build_dense(utab, n, Lb, WSP(bf16_t, WS_WUKV) + (size_t)l * 1536 * 256 + (size_t)768 * 256, WSP(bf16_t, WS_KVN), WSP(bf16_t, WS_VT), 2, 768, T, 256, T, F.G, F.wg); }
    n = finish_units(F, n);
    pg8::EpiBf16 E; pg8::gemm_phase<pg8::EpiBf16, false>(F.lds, F.tid, utab, n, nullptr, E);
}
PHASE_FN ph_dil(PHASE_ARGS) { PHASE_FRAME; for (int it = F.wg * 8 + F.wave; it < 2 * 12 * 128; it += F.G * 8) dil_item(F, it); }
PHASE_FN ph_scan(PHASE_ARGS, int l) { PHASE_FRAME; p_rwkv_scan(F, l, F.wg); }
PHASE_FN ph_attn_queue(PHASE_ARGS, int l) {
    PHASE_FRAME;
    unsigned* q = F.ctl + CW_QUEUE + l * 64;
    for (;;) {
        int it = 0; if (F.lane == 0) it = (int)atomicAdd(q, 1u);
        it = __builtin_amdgcn_readfirstlane(it);
        if (it >= 1536 + 512) break;
        if (it < 1536) mla_item(F, it); else dilc_item(F, it - 1536);
    }
}
GEMM_FN ph_gemm_out(PHASE_ARGS, int l) {
    PHASE_FRAME; LAS int* utab = (LAS int*)(F.lds + LDS_UTAB);
    int n = 0;
    if (F.tid == 0) { int Lb = 0; pg8::build_dense(utab, n, Lb, WSP(bf16_t, WS_MIX), WSP(bf16_t, WS_WOUT) + (size_t)l * 2048 * 2048, WSP(float, WS_TMP), 4, T, 2048, 2048, D, F.G, F.wg); }
    n = finish_units(F, n);
    pg8::EpiF32 E; pg8::gemm_phase<pg8::EpiF32, false>(F.lds, F.tid, utab, n, nullptr, E);
}
PHASE_FN ph_ln1(PHASE_ARGS, int l) { PHASE_FRAME; p_ln1_route(F, l, (l == 0) ? INP(0) : (const float*)WSP(float, WS_XCUR)); }
GEMM_FN ph_moe1(PHASE_ARGS, int l) {
    PHASE_FRAME; const int n = __builtin_amdgcn_readfirstlane(moe_units(lds_, ws_, wave_, l, 1));
    pg8::EpiGU E; pg8::gemm_phase<pg8::EpiGU, true>(F.lds, F.tid, (const LAS int*)(F.lds + LDS_UTAB), n, (const LAS int*)(F.lds + LDS_ROWL), E);
}
GEMM_FN ph_moe2(PHASE_ARGS, int l) {
    PHASE_FRAME; const int n = __builtin_amdgcn_readfirstlane(moe_units(lds_, ws_, wave_, l, 0));
    pg8::EpiScatter E{(const LAS int*)(F.lds + LDS_ROWL)}; pg8::gemm_phase<pg8::EpiScatter, false>(F.lds, F.tid, (const LAS int*)(F.lds + LDS_UTAB), n, (const LAS int*)(F.lds + LDS_ROWL), E);
}
PHASE_FN ph_ln2(PHASE_ARGS, int l) { PHASE_FRAME; p_ln2(F, l); }
GEMM_FN ph_ple(PHASE_ARGS, int l, float* out_) {
    PHASE_FRAME; LAS int* utab = (LAS int*)(F.lds + LDS_UTAB);
    const bool lastl = (l == NL - 1);
    float* outp = (float*)(GAS float*)rfl64((unsigned long long)out_);
    int n = 0;
    if (F.tid == 0) { int Lb = 0; pg8::build_dense(utab, n, Lb, WSP(bf16_t, WS_X1BF), WSP(bf16_t, WS_WPG) + (size_t)l * 2048 * 2048, lastl ? (void*)outp : (void*)WSP(float, WS_XCUR), 4, T, 2048, 2048, D, F.G, F.wg); }
    n = finish_units(F, n);
    pg8::EpiPle E{WSP(float, WS_TMP), WSP(bf16_t, WS_PP), lastl ? (bf16_t*)nullptr : WSP(bf16_t, WS_XBF)};
    pg8::gemm_phase<pg8::EpiPle, false>(F.lds, F.tid, utab, n, nullptr, E);
}

constexpr int NPH = 10;
#ifndef PH_MASK
#define PH_MASK 0x7ff
#endif
__global__ void __launch_bounds__(512, 2) mk_fwd(Params P) {
    extern __shared__ __attribute__((aligned(16))) unsigned char lds_raw[];
    unsigned ldsb = (unsigned)(size_t)(LAS unsigned char*)lds_raw; asm volatile("" : "+s"(ldsb));
    LAS unsigned char* lds = (LAS unsigned char*)ldsb;
    GAS unsigned char* ws = (GAS unsigned char*)P.ws;
    const int wave_s = __builtin_amdgcn_readfirstlane((int)(threadIdx.x >> 6));
    if (threadIdx.x < 16) ((LAS unsigned*)(lds + LDS_CTL))[threadIdx.x] = 0u;
    if (threadIdx.x == 0) {
#pragma unroll
        for (int i = 0; i < 30; ++i) ((LAS unsigned long long*)(lds + LDS_INTAB))[i] = (unsigned long long)P.in[i]; }
    __syncthreads();
#if MK_PER_PHASE
#define GRID_BAR() do { } while (0)
#else
    XcdBarrier bar = xcd_barrier_post((unsigned*)P.ws, (volatile LAS unsigned*)(lds + LDS_CTL), threadIdx.x == 0);
#define GRID_BAR() xcd_barrier(bar, my_tid(wave_s) == 0)
#endif
    const int lo = P.ph_lo, hi = P.ph_hi;
#define IN(k) (lo <= (k) && (k) < hi)
#define ON(j) (((PH_MASK) >> (j)) & 1)
#define SEAM(k) do { __syncthreads(); if (IN(k) && IN((k) + 1)) GRID_BAR(); } while (0)

    if (ON(0) && IN(0)) ph_prologue(lds, ws, wave_s);
    SEAM(0);
    for (int l = 0; l < NL; ++l) {
        const int p0 = 1 + l * NPH;
        if (ON(1) && IN(p0 + 0)) ph_gemm_in(lds, ws, wave_s, l);
        SEAM(p0 + 0);
        if (ON(2) && IN(p0 + 1)) { ph_rwkv_prep(lds, ws, wave_s, l); __syncthreads(); ph_mla_prep(lds, ws, wave_s, l); }
        SEAM(p0 + 1);
        if (ON(3) && IN(p0 + 2)) { ph_gemm_mla(lds, ws, wave_s, l); ph_dil(lds, ws, wave_s); }
        SEAM(p0 + 2);
        if (ON(4) && IN(p0 + 3)) { if (blockIdx.x < 24) ph_scan(lds, ws, wave_s, l); ph_attn_queue(lds, ws, wave_s, l); }
        SEAM(p0 + 3);
        if (ON(5) && IN(p0 + 4)) ph_gemm_out(lds, ws, wave_s, l);
        SEAM(p0 + 4);
        if (ON(6) && IN(p0 + 5)) ph_ln1(lds, ws, wave_s, l);
        SEAM(p0 + 5);
        if (ON(7) && IN(p0 + 6)) ph_moe1(lds, ws, wave_s, l);
        SEAM(p0 + 6);
        if (ON(8) && IN(p0 + 7)) ph_moe2(lds, ws, wave_s, l);
        SEAM(p0 + 7);
        if (ON(9) && IN(p0 + 8)) ph_ln2(lds, ws, wave_s, l);
        SEAM(p0 + 8);
        if (ON(10) && IN(p0 + 9)) ph_ple(lds, ws, wave_s, l, P.out);
        SEAM(p0 + 9);
    }
}

extern "C" void kernel_launch(void* const* d_in, const int* in_sizes, int n_in, void* d_out, int out_size, void* d_ws, size_t ws_size, hipStream_t stream) {
    static int grid = 0;
    if (grid == 0) {
        if (n_in != 30 || ws_size < WS_END) { fprintf(stderr, "kernel_launch: need 30 inputs and %zu bytes of workspace (got %d, %zu)\n", (size_t)WS_END, n_in, ws_size); grid = -1; return; }
        int dev = 0, cus = 0, per_cu = 0;
        if (hipGetDevice(&dev) != hipSuccess || hipDeviceGetAttribute(&cus, hipDeviceAttributeMultiprocessorCount, dev) != hipSuccess) { grid = -1; return; }
        if (hipFuncSetAttribute((const void*)mk_fwd, hipFuncAttributeMaxDynamicSharedMemorySize, LDS_BYTES) != hipSuccess) { fprintf(stderr, "kernel_launch: hipFuncSetAttribute failed\n"); grid = -1; return; }
        if (hipOccupancyMaxActiveBlocksPerMultiprocessor(&per_cu, (const void*)mk_fwd, 512, LDS_BYTES) != hipSuccess || per_cu < 1) { fprintf(stderr, "kernel_launch: occupancy query says %d\n", per_cu); }
        (void)hipGetLastError();
        grid = cus;
    }
    if (grid < 0) return;
    (void)hipMemsetAsync(d_ws, 0, CTL_BYTES, stream);
    Params p{};
    for (int i = 0; i < 30; ++i) p.in[i] = (const float*)d_in[i];
    p.out = (float*)d_out; p.ws = (unsigned char*)d_ws;
    const int nph = 1 + NL * NPH;
#if MK_PER_PHASE
    for (int k = 0; k < nph; ++k) { p.ph_lo = k; p.ph_hi = k + 1; hipLaunchKernelGGL(mk_fwd, dim3(grid), dim3(512), LDS_BYTES, stream, p); }
#else
    p.ph_lo = 0; p.ph_hi = nph;
    hipLaunchKernelGGL(mk_fwd, dim3(grid), dim3(512), LDS_BYTES, stream, p);
#endif
}
```

```cpp
#include <hip/hip_runtime.h>
#include <cstdio>
#include <cstdint>

#ifndef MK_PER_PHASE
#define MK_PER_PHASE 0
#endif

#define DI __device__ __forceinline__
#define LAS __attribute__((address_space(3)))
#define GAS __attribute__((address_space(1)))
typedef unsigned short bf16_t;
typedef short bf16x8 __attribute__((ext_vector_type(8)));
typedef float f32x2 __attribute__((ext_vector_type(2)));
typedef float f32x4 __attribute__((ext_vector_type(4)));
typedef float f32x16 __attribute__((ext_vector_type(16)));
typedef unsigned u32x2 __attribute__((ext_vector_type(2)));
typedef unsigned u32x4 __attribute__((ext_vector_type(4)));
typedef __bf16 hbf2 __attribute__((ext_vector_type(2)));

DI unsigned pack2(float lo, float hi) { return __builtin_bit_cast(unsigned, __builtin_convertvector((f32x2){lo, hi}, hbf2)); }
DI float bf2f(bf16_t b) { return __uint_as_float(((unsigned)b) << 16); }
DI float bflo(unsigned w) { return __uint_as_float(w << 16); }
DI float bfhi(unsigned w) { return __uint_as_float(w & 0xffff0000u); }
DI bf16_t f2bf(float f) { return (bf16_t)(pack2(f, 0.f) & 0xffffu); }
DI float wave_sum(float v) { for (int o = 32; o >= 1; o >>= 1) v += __shfl_xor(v, o); return v; }
DI float sigmoidf_(float x) { return 1.0f / (1.0f + __expf(-x)); }

constexpr int T = 8192, SEQ = 4096, D = 2048, NL = 4, PLE = 256;
constexpr int ZLD = 8192;
constexpr int ZC_DQ = 2560, ZC_DK = 4096, ZC_DV = 5632, ZC_QA = 7168, ZC_KVA = 7680, ZC_KR = 7936;
constexpr int NEXP = 32, DEXP = 512, HB_ROWS = 24576;
constexpr float ALPHA = 1.681792830507429f;
constexpr float LOG2E = 1.4426950408889634f;

constexpr size_t CTL_BYTES = 65536;
constexpr size_t WS_WIN = CTL_BYTES;                              constexpr size_t SZ_WIN = (size_t)NL * 8192 * 2048 * 2;
constexpr size_t WS_WOUT = WS_WIN + SZ_WIN;                       constexpr size_t SZ_WOUT = (size_t)NL * 2048 * 2048 * 2;
constexpr size_t WS_WPG = WS_WOUT + SZ_WOUT;                      constexpr size_t SZ_WPG = SZ_WOUT;
constexpr size_t WS_WPP = WS_WPG + SZ_WPG;                        constexpr size_t SZ_WPP = (size_t)NL * 2048 * 256 * 2;
constexpr size_t WS_WGU = WS_WPP + SZ_WPP;                        constexpr size_t SZ_WGU = (size_t)NL * 32 * 1024 * 2048 * 2;
constexpr size_t WS_WDN = WS_WGU + SZ_WGU;                        constexpr size_t SZ_WDN = (size_t)NL * 32 * 2048 * 512 * 2;
constexpr size_t WS_WUQ = WS_WDN + SZ_WDN;                        constexpr size_t SZ_WUQ = (size_t)NL * 1280 * 512 * 2;
constexpr size_t WS_WUKV = WS_WUQ + SZ_WUQ;                       constexpr size_t SZ_WUKV = (size_t)NL * 1536 * 256 * 2;
constexpr size_t WS_ROPE = WS_WUKV + SZ_WUKV;                     constexpr size_t SZ_ROPE = (size_t)4096 * 32 * 8;
constexpr size_t WS_PBF = WS_ROPE + SZ_ROPE;                      constexpr size_t SZ_PBF = (size_t)NL * T * 256 * 2;
constexpr size_t WS_XCUR = WS_PBF + SZ_PBF;                       constexpr size_t SZ_XF = (size_t)T * D * 4;
constexpr size_t WS_XBF = WS_XCUR + SZ_XF;                        constexpr size_t SZ_XB = (size_t)T * D * 2;
constexpr size_t WS_Z = WS_XBF + SZ_XB;                           constexpr size_t SZ_Z = (size_t)T * ZLD * 2;
constexpr size_t SZ_RW1 = (size_t)T * 768 * 4;
constexpr size_t WS_RW = WS_Z + SZ_Z;
constexpr size_t WS_RK = WS_RW + 7 * SZ_RW1;                      constexpr size_t SZ_RK = (size_t)T * 16 * 4;
constexpr size_t WS_QN = WS_RK + SZ_RK;                           constexpr size_t SZ_QN = (size_t)T * 512 * 2;
constexpr size_t WS_KVN = WS_QN + SZ_QN;                          constexpr size_t SZ_KVN = (size_t)T * 256 * 2;
constexpr size_t WS_KROPE = WS_KVN + SZ_KVN;                      constexpr size_t SZ_KROPE = (size_t)T * 64 * 2;
constexpr size_t WS_VTD = WS_KROPE + SZ_KROPE;                    constexpr size_t SZ_VTD = (size_t)2 * 12 * 128 * 4096 * 2;
constexpr size_t WS_QB = WS_VTD + SZ_VTD;                         constexpr size_t SZ_QB = (size_t)T * 1280 * 2;
constexpr size_t WS_KC = WS_QB + SZ_QB;                           constexpr size_t SZ_KC = (size_t)T * 768 * 2;
constexpr size_t WS_VT = WS_KC + SZ_KC;                           constexpr size_t SZ_VT = (size_t)768 * 8192 * 2;
constexpr size_t WS_OP = WS_VT + SZ_VT;                           constexpr size_t SZ_OP = (size_t)3 * T * 512 * 2;
constexpr size_t WS_LSE = WS_OP + SZ_OP;                          constexpr size_t SZ_LSE = (size_t)3 * T * 4 * 4;
constexpr size_t WS_MIX = WS_LSE + SZ_LSE;                        constexpr size_t SZ_MIX = SZ_XB;
constexpr size_t WS_TMP = WS_MIX + SZ_MIX;
constexpr size_t WS_X1 = WS_TMP + SZ_XF;
constexpr size_t WS_X1BF = WS_X1 + SZ_XF;
constexpr size_t WS_PP = WS_X1BF + SZ_XB;
constexpr size_t WS_TOKL = WS_PP + SZ_XB;                         constexpr size_t SZ_TOKL = (size_t)32 * 8192 * 4;
constexpr size_t WS_GATE = WS_TOKL + SZ_TOKL;                     constexpr size_t SZ_GATE = (size_t)T * 2 * 4;
constexpr size_t WS_HB = WS_GATE + SZ_GATE;                       constexpr size_t SZ_HB = (size_t)HB_ROWS * 512 * 2;
constexpr size_t WS_YBT = WS_HB + SZ_HB;                          constexpr size_t SZ_YBT = (size_t)T * 2 * 2048 * 2;
constexpr size_t WS_AC = WS_YBT + SZ_YBT;                         constexpr size_t SZ_CH4 = (size_t)1536 * 64 * 64 * 4;
constexpr size_t WS_GC = WS_AC + SZ_CH4;
constexpr size_t WS_Y0 = WS_GC + SZ_CH4;
constexpr size_t WS_QC = WS_Y0 + SZ_CH4;                          constexpr size_t SZ_CH2 = (size_t)1536 * 64 * 64 * 2;
constexpr size_t WS_SST = WS_QC + SZ_CH2;
constexpr size_t WS_END = WS_SST + SZ_CH2;
constexpr int CW_MOECNT = 4096;
constexpr int CW_QUEUE = 8192;

constexpr int LDS_STAGE = 131072;
constexpr int LDS_CTL = 131072;
constexpr int LDS_UTAB = LDS_CTL + 64;
constexpr int LDS_MOE = LDS_UTAB + 1024;
constexpr int LDS_INTAB = LDS_MOE + 1536;
constexpr int LDS_ROWL = 131072 + 4096;
constexpr int LDS_BYTES = 131072 + 8192;

#define XB_TMO      128
#define XB_XCNT(j)  (256  + 64 * (j))
#define XB_XSUB(j)  (1280 + 64 * (j))
#define XB_XGEN(j)  (2304 + 64 * (j))
#define XB_TOP      3328
#define XB_TOPGEN   3392
#define XCD_BAR_WORDS 3456
#define XB_SPIN_CAP (1u << 22)

__device__ __forceinline__ unsigned xb_ld(unsigned* p)              { return __hip_atomic_load(p, __ATOMIC_RELAXED, __HIP_MEMORY_SCOPE_AGENT); }
__device__ __forceinline__ unsigned xb_add(unsigned* p, unsigned v) { return __hip_atomic_fetch_add(p, v, __ATOMIC_RELAXED, __HIP_MEMORY_SCOPE_AGENT); }
__device__ __forceinline__ unsigned xb_xcc_id() { return (unsigned)__builtin_amdgcn_s_getreg((3 << 11) | 20) & 0xFu; }
#define XB_SPIN(cond, bar) do { unsigned _sp = 0; while (cond) { __builtin_amdgcn_s_sleep(1); \
    if ((++_sp & 255u) == 0u) { if (xb_ld(&(bar)[XB_TMO])) break; if (_sp > XB_SPIN_CAP) { atomicAdd(&(bar)[XB_TMO], 1u); break; } } } } while (0)

struct XcdBarrier { unsigned* bar; unsigned x; volatile LAS unsigned* st; };

__device__ __forceinline__ XcdBarrier xcd_barrier_post(unsigned* bar, volatile LAS unsigned* st, bool leader) {
    XcdBarrier b; b.bar = bar; b.x = xb_xcc_id(); b.st = st;
    if (leader) (void)xb_add(&bar[XB_XCNT(b.x)], 1u);
    return b;
}
__device__ __forceinline__ void xcd_barrier_complete(unsigned* bar, unsigned x, unsigned& nloc, unsigned& nx) {
    const unsigned G = gridDim.x * gridDim.y * gridDim.z;
    unsigned sum, cnt, mine, sp = 0u;
    for (;;) {
        sum = 0u; cnt = 0u; mine = 0u;
#pragma unroll
        for (unsigned j = 0; j < 16; ++j) { const unsigned c = xb_ld(&bar[XB_XCNT(j)]); sum += c; cnt += (c > 0u) ? 1u : 0u; mine = (j == x) ? c : mine; }
        if (sum == G) break;
        __builtin_amdgcn_s_sleep(1);
        if ((++sp & 255u) == 0u) { if (xb_ld(&bar[XB_TMO])) break; if (sp > XB_SPIN_CAP) { atomicAdd(&bar[XB_TMO], 1u); break; } }
    }
    nloc = mine > 0u ? mine : 1u; nx = cnt > 0u ? cnt : 1u;
}
__device__ __forceinline__ void xcd_barrier(const XcdBarrier& b, bool leader) {
    asm volatile("s_waitcnt vmcnt(0)" ::: "memory");
    __syncthreads();
    if (leader) {
        unsigned* bar = b.bar;
        __builtin_amdgcn_s_waitcnt(0);
        unsigned nloc = b.st[0], nx = b.st[1];
        if (nloc == 0u) { xcd_barrier_complete(bar, b.x, nloc, nx); b.st[0] = nloc; b.st[1] = nx; }
        const unsigned old = xb_add(&bar[XB_XSUB(b.x)], 1u);
        const unsigned gen = old / nloc;
        if (old + 1u == (gen + 1u) * nloc) {
            __builtin_amdgcn_fence(__ATOMIC_RELEASE, "agent");
            asm volatile("s_waitcnt vmcnt(0)" ::: "memory");
            const unsigned og = xb_add(&bar[XB_TOP], 1u);
            const unsigned tg = og / nx;
            if (og + 1u == (tg + 1u) * nx) xb_add(&bar[XB_TOPGEN], 1u);
            else XB_SPIN(xb_ld(&bar[XB_TOPGEN]) == tg, bar);
            __builtin_amdgcn_fence(__ATOMIC_ACQUIRE, "agent");
            xb_add(&bar[XB_XGEN(b.x)], 1u);
            asm volatile("s_waitcnt vmcnt(0)" ::: "memory");
        } else {
            XB_SPIN(xb_ld(&bar[XB_XGEN(b.x)]) == gen, bar);
            __builtin_amdgcn_fence(__ATOMIC_ACQUIRE, "agent");
            asm volatile("s_waitcnt vmcnt(0)" ::: "memory");
        }
    }
    __syncthreads();
}

namespace pg8 {
constexpr int BM = 256, BK = 64, HALF = 128, HTB = HALF * BK * 2, STAGE_BYTES = 8 * HTB, NXCD = 8, WGM = 8;
DI int lds_byte(int r, int c) { const int st = (r >> 4) * 2 + (c >> 5), rr = r & 15, cc = c & 31, ob = rr * 64 + cc * 2; return st * 1024 + (ob ^ (((ob >> 9) & 1) << 5)); }
DI void stage_rc(int b, int& R, int& C) { const int st = b / 1024, sb = b % 1024, swz = sb ^ (((sb >> 9) & 1) << 5); R = (st >> 1) * 16 + swz / 64; C = (st & 1) * 32 + (swz % 64) / 2; }
DI int perm32(int rho) { const int n = rho >> 4, i = rho & 15; return 8 * (i >> 2) + 4 * n + (i & 3); }

struct Unit { GAS const char* a; GAS const char* b; GAS char* out; int K, ldc, row0, col0, aux0, aux1; };
constexpr int UD = 12;
DI void unit_put(LAS int* tab, int i, const void* a, const void* b, void* o, int K, int ldc, int row0, int col0, int aux0, int aux1) {
    LAS int* p = tab + i * UD; const unsigned long long ua = (unsigned long long)a, ub = (unsigned long long)b, uo = (unsigned long long)o;
    p[0] = (int)(unsigned)ua; p[1] = (int)(unsigned)(ua >> 32); p[2] = (int)(unsigned)ub; p[3] = (int)(unsigned)(ub >> 32); p[4] = (int)(unsigned)uo; p[5] = (int)(unsigned)(uo >> 32);
    p[6] = K; p[7] = ldc; p[8] = row0; p[9] = col0; p[10] = aux0; p[11] = aux1;
}
DI void unit_get(const LAS int* tab, int i, Unit& u) {
    const LAS int* p = tab + i * UD; int v[UD];
#pragma unroll
    for (int j = 0; j < UD; ++j) v[j] = __builtin_amdgcn_readfirstlane(p[j]);
    u.a = (GAS const char*)(((unsigned long long)(unsigned)v[1] << 32) | (unsigned)v[0]);
    u.b = (GAS const char*)(((unsigned long long)(unsigned)v[3] << 32) | (unsigned)v[2]);
    u.out = (GAS char*)(((unsigned long long)(unsigned)v[5] << 32) | (unsigned)v[4]);
    u.K = v[6]; u.ldc = v[7]; u.row0 = v[8]; u.col0 = v[9]; u.aux0 = v[10]; u.aux1 = v[11];
}
DI void build_dense(LAS int* tab, int& n, int& Lbase, const void* A, const void* Bt, void* out, int esz, int M, int N, int K, int ldc, int G, int c) {
    const int nM = M / BM, nN = N / BM, nwg = nM * nN;
    int L = c; if (L < Lbase) L += ((Lbase - L + G - 1) / G) * G;
    for (; L < Lbase + nwg; L += G) {
        int wgid = L - Lbase; { const int q = nwg / NXCD, r = nwg % NXCD, xcd = wgid % NXCD, off = wgid / NXCD; wgid = (xcd < r ? xcd * (q + 1) : r * (q + 1) + (xcd - r) * q) + off; }
        const int nig = WGM * nN, gid = wgid / nig, fm = gid * WGM, gsz = (nM - fm) < WGM ? (nM - fm) : WGM;
        const int pm = fm + ((wgid % nig) % gsz), pn = (wgid % nig) / gsz;
        unit_put(tab, n, (const char*)A + (size_t)pm * BM * K * 2, (const char*)Bt + (size_t)pn * BM * K * 2, out, K, ldc, pm * BM, pn * BM, 0, BM); ++n;
    }
    Lbase += nwg;
}

template <class Epi, bool GATHER>
DI void gemm_phase(LAS unsigned char* lds, const int tid, const LAS int* utab, const int nunits, const LAS int* rowl, const Epi& E) {
    const int wid = __builtin_amdgcn_readfirstlane(tid >> 6), lane = tid & 63, wr = wid >> 2, wc = wid & 3, fr = lane & 15, fq = lane >> 4;
    const size_t kstep = (size_t)(BK * 2);
    const unsigned ldsw = (unsigned)wid * 1024u;
    const int aoff = lds_byte(wr * 64 + fr, fq * 8), boff = lds_byte(wc * 32 + fr, fq * 8);
#define PG8_SA(b, h) (((b) * 2 + (h)) * HTB)
#define PG8_SB(b, h) ((4 + (b) * 2 + (h)) * HTB)
#define PG8_STAGE(bufoff, gbase, voff) do { _Pragma("unroll") for (int _i = 0; _i < 2; ++_i) \
        __builtin_amdgcn_global_load_lds((GAS const unsigned*)((gbase) + (voff)[_i]), (LAS unsigned*)(lds + (bufoff) + ldsw + _i * 8192), 16, 0, 0); } while (0)
#define PG8_LDA(dst, b, h) do { _Pragma("unroll") for (int m = 0; m < 4; ++m) _Pragma("unroll") for (int k = 0; k < 2; ++k) dst[m][k] = *(const LAS bf16x8*)(lds + PG8_SA(b, h) + aoff + m * 2048 + k * 1024); } while (0)
#define PG8_LDB(dst, b, h) do { _Pragma("unroll") for (int n = 0; n < 2; ++n) _Pragma("unroll") for (int k = 0; k < 2; ++k) dst[n][k] = *(const LAS bf16x8*)(lds + PG8_SB(b, h) + boff + n * 2048 + k * 1024); } while (0)
#define PG8_MMA(ai, bj, At, Bt) do { __builtin_amdgcn_s_setprio(1); _Pragma("unroll") for (int m = 0; m < 4; ++m) _Pragma("unroll") for (int n = 0; n < 2; ++n) _Pragma("unroll") for (int k = 0; k < 2; ++k) \
        acc[ai][bj][m][n] = __builtin_amdgcn_mfma_f32_16x16x32_bf16(Bt[n][k], At[m][k], acc[ai][bj][m][n], 0, 0, 0); __builtin_amdgcn_s_setprio(0); } while (0)
#define PG8_WAIT_V(n) asm volatile("s_waitcnt vmcnt(" #n ")" ::: "memory")
#define PG8_WAIT_L(n) asm volatile("s_waitcnt lgkmcnt(" #n ")" ::: "memory")
#define PG8_BAR __builtin_amdgcn_s_barrier()
#define PG8_SCHED __builtin_amdgcn_sched_barrier(0)
#define PG8_RC(R_, C_, Rb_, i_) int R_, C_; { int t_ = tid; asm volatile("" : "+v"(t_)); stage_rc(t_ * 16 + (i_) * 8192, R_, C_); } const int Rb_ = Epi::PERM ? ((R_ & ~31) + perm32(R_ & 31)) : R_
#define PG8_VOFF_D(va, vb, K_) do { _Pragma("unroll") for (int _i = 0; _i < 2; ++_i) { PG8_RC(_R, _C, _Rb, _i); va[0][_i] = (unsigned)(_R * (K_) + _C) * 2u; va[1][_i] = va[0][_i]; vb[_i] = (unsigned)(_Rb * (K_) + _C) * 2u; } } while (0)
#define PG8_VOFF_G(va, K_, ui_) do { _Pragma("unroll") for (int _i = 0; _i < 2; ++_i) { PG8_RC(_R, _C, _Rb, _i); (void)_Rb; _Pragma("unroll") for (int _h = 0; _h < 2; ++_h) { \
        const int _r = rowl[(ui_) * BM + _h * HALF + _R]; va[_h][_i] = (unsigned)(_r * (K_) + _C) * 2u; } } } while (0)
    if (nunits <= 0) return;
    Unit cur, nxt; int ui = 0;
    unit_get(utab, 0, cur);
    f32x4 acc[2][2][4][2];
#pragma unroll
    for (int a = 0; a < 2; ++a)
#pragma unroll
        for (int b = 0; b < 2; ++b)
#pragma unroll
            for (int m = 0; m < 4; ++m)
#pragma unroll
                for (int n = 0; n < 2; ++n) acc[a][b][m][n] = (f32x4){0.f, 0.f, 0.f, 0.f};
    bf16x8 At[4][2], B0[2][2], B1[2][2];
    unsigned vc[2][2], vbc[2], vn[2][2];
    PG8_VOFF_D(vc, vbc, cur.K);
    if (GATHER) PG8_VOFF_G(vc, cur.K, 0);
    GAS const char* cA = cur.a; GAS const char* cB = cur.b;
    size_t hsc = (size_t)HALF * cur.K * 2;
    size_t hsa = GATHER ? (size_t)0 : hsc;
    PG8_STAGE(PG8_SB(0, 0), cB, vbc); PG8_STAGE(PG8_SA(0, 0), cA, vc[0]); PG8_STAGE(PG8_SB(0, 1), cB + hsc, vbc); PG8_STAGE(PG8_SA(0, 1), cA + hsa, vc[1]);
    if (wr == 1) PG8_BAR;
    PG8_WAIT_V(4); PG8_BAR;
    PG8_STAGE(PG8_SB(1, 0), cB + kstep, vbc); PG8_STAGE(PG8_SA(1, 0), cA + kstep, vc[0]); PG8_STAGE(PG8_SB(1, 1), cB + hsc + kstep, vbc);
    PG8_WAIT_V(6); PG8_BAR;
    for (;;) {
        const bool has_next = (ui + 1 < nunits);
        if (has_next) { unit_get(utab, ui + 1, nxt); if (GATHER) PG8_VOFF_G(vn, nxt.K, ui + 1); }
        else { nxt = cur;
            if (GATHER) {
#pragma unroll
                for (int i = 0; i < 2; ++i) { vn[0][i] = vc[0][i]; vn[1][i] = vc[1][i]; } } }
        GAS const char* nA = nxt.a; GAS const char* nB = nxt.b;
        const int nt = cur.K / BK;
        for (int t = 0; t < nt; t += 2) {
            const bool last = (t == nt - 2);
            GAS const char* a1 = cA + (size_t)(t + 1) * kstep;
            GAS const char* a2 = last ? nA : cA + (size_t)(t + 2) * kstep; GAS const char* b2 = last ? nB : cB + (size_t)(t + 2) * kstep;
            GAS const char* a3 = a2 + kstep; GAS const char* b3 = b2 + kstep;
            PG8_LDB(B0, 0, 0); PG8_SCHED; PG8_LDA(At, 0, 0); PG8_STAGE(PG8_SA(1, 1), a1 + hsa, vc[1]);
            if (last) {
                if (GATHER) {
#pragma unroll
                    for (int i = 0; i < 2; ++i) { vc[0][i] = vn[0][i]; vc[1][i] = vn[1][i]; } }
                if (nxt.K != cur.K) {
                    if (!GATHER) PG8_VOFF_D(vc, vbc, nxt.K);
                    else {
#pragma unroll
                        for (int i = 0; i < 2; ++i) { PG8_RC(R_, C_, Rb_, i); (void)R_; vbc[i] = (unsigned)(Rb_ * nxt.K + C_) * 2u; } }
                    hsc = (size_t)HALF * nxt.K * 2; hsa = GATHER ? (size_t)0 : hsc; } }
            PG8_WAIT_L(8); PG8_BAR; PG8_WAIT_L(0); PG8_MMA(0, 0, At, B0); PG8_BAR; PG8_SCHED;
            PG8_LDB(B1, 0, 1); PG8_STAGE(PG8_SB(0, 0), b2, vbc);
            PG8_BAR; PG8_WAIT_L(0); PG8_MMA(0, 1, At, B1); PG8_BAR;
            PG8_LDA(At, 0, 1); PG8_STAGE(PG8_SA(0, 0), a2, vc[0]);
            PG8_BAR; PG8_WAIT_L(0); PG8_MMA(1, 0, At, B0); PG8_BAR; PG8_SCHED;
            PG8_STAGE(PG8_SB(0, 1), b2 + hsc, vbc);
            PG8_WAIT_V(6); PG8_BAR; PG8_MMA(1, 1, At, B1); PG8_BAR;
            PG8_LDB(B0, 1, 0); PG8_SCHED; PG8_LDA(At, 1, 0); PG8_STAGE(PG8_SA(0, 1), a2 + hsa, vc[1]);
            PG8_WAIT_L(8); PG8_BAR; PG8_WAIT_L(0); PG8_MMA(0, 0, At, B0); PG8_BAR; PG8_SCHED;
            PG8_LDB(B1, 1, 1); PG8_STAGE(PG8_SB(1, 0), b3, vbc);
            PG8_BAR; PG8_WAIT_L(0); PG8_MMA(0, 1, At, B1); PG8_BAR;
            PG8_LDA(At, 1, 1); PG8_STAGE(PG8_SA(1, 0), a3, vc[0]);
            PG8_BAR; PG8_WAIT_L(0); PG8_MMA(1, 0, At, B0); PG8_BAR; PG8_SCHED;
            PG8_STAGE(PG8_SB(1, 1), b3 + hsc, vbc);
            PG8_WAIT_V(6); PG8_BAR; PG8_MMA(1, 1, At, B1); PG8_BAR;
        }
        E(acc, cur, ui, wr, wc, fr, fq);
        if (!has_next) break;
#pragma unroll
        for (int a = 0; a < 2; ++a)
#pragma unroll
            for (int b = 0; b < 2; ++b)
#pragma unroll
                for (int m = 0; m < 4; ++m)
#pragma unroll
                    for (int n = 0; n < 2; ++n) acc[a][b][m][n] = (f32x4){0.f, 0.f, 0.f, 0.f};
        cur = nxt; cA = nA; cB = nB; ++ui;
    }
    PG8_WAIT_V(0);
    if (wr == 0) PG8_BAR;
    PG8_BAR;
#undef PG8_SA
#undef PG8_SB
#undef PG8_STAGE
#undef PG8_LDA
#undef PG8_LDB
#undef PG8_MMA
#undef PG8_WAIT_V
#undef PG8_WAIT_L
#undef PG8_BAR
#undef PG8_SCHED
#undef PG8_VOFF_D
#undef PG8_RC
#undef PG8_VOFF_G
}

struct EpiBf16 {
    static constexpr bool PERM = true;
    DI void operator()(const f32x4 (&acc)[2][2][4][2], const Unit& u, int, int wr, int wc, int fr, int fq) const {
        const int row0 = u.row0 + wr * 64 + fr, col0 = u.col0 + wc * 32 + 8 * fq; GAS bf16_t* O = (GAS bf16_t*)u.out; const int ldc = u.ldc;
#pragma unroll
        for (int ai = 0; ai < 2; ++ai)
#pragma unroll
            for (int m = 0; m < 4; ++m) { GAS bf16_t* rowp = O + (size_t)(row0 + ai * HALF + m * 16) * ldc + col0;
#pragma unroll
                for (int bj = 0; bj < 2; ++bj) { const f32x4 v0 = acc[ai][bj][m][0], v1 = acc[ai][bj][m][1];
                    u32x4 w; w.x = pack2(v0[0], v0[1]); w.y = pack2(v0[2], v0[3]); w.z = pack2(v1[0], v1[1]); w.w = pack2(v1[2], v1[3]);
                    *(GAS u32x4*)(rowp + bj * HALF) = w; } }
    }
};
struct EpiF32 {
    static constexpr bool PERM = false;
    DI void operator()(const f32x4 (&acc)[2][2][4][2], const Unit& u, int, int wr, int wc, int fr, int fq) const {
        const int row0 = u.row0 + wr * 64 + fr, col0 = u.col0 + wc * 32 + 4 * fq; GAS float* C = (GAS float*)u.out; const int ldc = u.ldc;
#pragma unroll
        for (int ai = 0; ai < 2; ++ai)
#pragma unroll
            for (int m = 0; m < 4; ++m) { GAS float* rowp = C + (size_t)(row0 + ai * HALF + m * 16) * ldc + col0;
#pragma unroll
                for (int bj = 0; bj < 2; ++bj)
#pragma unroll
                    for (int n = 0; n < 2; ++n) *(GAS f32x4*)(rowp + bj * HALF + n * 16) = acc[ai][bj][m][n]; }
    }
};
struct EpiGU {
    static constexpr bool PERM = true;
    DI void operator()(const f32x4 (&acc)[2][2][4][2], const Unit& u, int, int wr, int wc, int fr, int fq) const {
        const int row0 = u.row0 + wr * 64 + fr, col0 = (u.col0 >> 1) + wc * 32 + 8 * fq; GAS bf16_t* H = (GAS bf16_t*)u.out;
#pragma unroll
        for (int ai = 0; ai < 2; ++ai)
#pragma unroll
            for (int m = 0; m < 4; ++m) { GAS bf16_t* rowp = H + (size_t)(row0 + ai * HALF + m * 16) * DEXP + col0;
                float o[8];
#pragma unroll
                for (int n = 0; n < 2; ++n)
#pragma unroll
                    for (int j = 0; j < 4; ++j) { const float g = acc[ai][0][m][n][j], up = acc[ai][1][m][n][j]; o[n * 4 + j] = g / (1.0f + __expf(-g)) * up; }
                u32x4 w; w.x = pack2(o[0], o[1]); w.y = pack2(o[2], o[3]); w.z = pack2(o[4], o[5]); w.w = pack2(o[6], o[7]);
                *(GAS u32x4*)rowp = w; }
    }
};
struct EpiScatter {
    static constexpr bool PERM = true;
    const LAS int* rowl;
    DI void operator()(const f32x4 (&acc)[2][2][4][2], const Unit& u, int ui, int wr, int wc, int fr, int fq) const {
        const int col0 = u.col0 + wc * 32 + 8 * fq; GAS bf16_t* Y = (GAS bf16_t*)u.out;
#pragma unroll
        for (int ai = 0; ai < 2; ++ai)
#pragma unroll
            for (int m = 0; m < 4; ++m) { const int t2 = rowl[ui * BM + ai * HALF + wr * 64 + m * 16 + fr];
                if (t2 >= 0) { GAS bf16_t* rowp = Y + (size_t)t2 * D + col0;
#pragma unroll
                    for (int bj = 0; bj < 2; ++bj) { const f32x4 v0 = acc[ai][bj][m][0], v1 = acc[ai][bj][m][1];
                        u32x4 w; w.x = pack2(v0[0], v0[1]); w.y = pack2(v0[2], v0[3]); w.z = pack2(v1[0], v1[1]); w.w = pack2(v1[2], v1[3]);
                        *(GAS u32x4*)(rowp + bj * HALF) = w; } }
                asm volatile("" ::: "memory"); }
    }
};
struct EpiPle {
    static constexpr bool PERM = false;
    const float* x2; const bf16_t* pp; bf16_t* xb;
    DI void operator()(const f32x4 (&acc)[2][2][4][2], const Unit& u, int, int wr, int wc, int fr, int fq) const {
        const int row0 = u.row0 + wr * 64 + fr, col0 = u.col0 + wc * 32 + 4 * fq; GAS float* out = (GAS float*)u.out;
#pragma unroll
        for (int ai = 0; ai < 2; ++ai)
#pragma unroll
            for (int m = 0; m < 4; ++m) { const size_t ro = (size_t)(row0 + ai * HALF + m * 16) * D + col0;
#pragma unroll
                for (int bj = 0; bj < 2; ++bj)
#pragma unroll
                    for (int n = 0; n < 2; ++n) { const size_t o = ro + bj * HALF + n * 16;
                        const f32x4 xv = *(const f32x4*)(x2 + o); const u32x2 pw = *(const u32x2*)(pp + o); const f32x4 a = acc[ai][bj][m][n];
                        f32x4 r; r[0] = xv[0] + bflo(pw.x) / (1.0f + __expf(-a[0])); r[1] = xv[1] + bfhi(pw.x) / (1.0f + __expf(-a[1]));
                        r[2] = xv[2] + bflo(pw.y) / (1.0f + __expf(-a[2])); r[3] = xv[3] + bfhi(pw.y) / (1.0f + __expf(-a[3]));
                        *(GAS f32x4*)(out + o) = r;
                        if (xb) { u32x2 w; w.x = pack2(r[0], r[1]); w.y = pack2(r[2], r[3]); *(u32x2*)(xb + o) = w; } }
                asm volatile("" ::: "memory"); }
    }
};
}

struct Params { const float* in[30]; float* out; unsigned char* ws; int ph_lo, ph_hi; };
struct Frame {
    LAS unsigned char* lds; int tid, lane, wave, G, wg;
    GAS unsigned char* ws; unsigned* ctl;
};
#define WSP(T_, off) ((T_*)(GAS T_*)(F.ws + (off)))
#define INP(i_) ((const float*)(GAS const float*)rfl64(((const LAS unsigned long long*)(F.lds + LDS_INTAB))[i_]))
DI unsigned long long rfl64(unsigned long long v) {
    return ((unsigned long long)(unsigned)__builtin_amdgcn_readfirstlane((int)(unsigned)(v >> 32)) << 32) | (unsigned)__builtin_amdgcn_readfirstlane((int)(unsigned)v);
}
DI int my_tid(int wave) { return (wave << 6) | (int)__builtin_amdgcn_mbcnt_hi(~0u, __builtin_amdgcn_mbcnt_lo(~0u, 0u)); }
DI Frame make_frame(LAS unsigned char* lds, GAS unsigned char* ws, int wave) {
    Frame F;
    int wv = __builtin_amdgcn_readfirstlane(wave); asm volatile("" : "+s"(wv));
    int tid = my_tid(wv); asm volatile("" : "+v"(tid));
    unsigned l32 = (unsigned)__builtin_amdgcn_readfirstlane((int)(unsigned)(size_t)lds); asm volatile("" : "+s"(l32));
    unsigned long long w64 = rfl64((unsigned long long)ws); asm volatile("" : "+s"(w64));
    F.lds = (LAS unsigned char*)l32; F.tid = tid; F.lane = tid & 63; F.wave = wv;
    F.G = gridDim.x; F.wg = blockIdx.x;
    F.ws = (GAS unsigned char*)w64;
    F.ctl = (unsigned*)(GAS unsigned*)F.ws;
    return F;
}
#define PHASE_FN __device__ __forceinline__ void
#define GEMM_FN __device__ __forceinline__ void
#define PHASE_ARGS LAS unsigned char* lds_, GAS unsigned char* ws_, int wave_
#define PHASE_FRAME const Frame F = make_frame(lds_, ws_, wave_)

template <int MODE> DI int rowmap(int n, int which) {
    if (MODE == 0) return n;
    if (MODE == 1) return (n >> 7) * 256 + which * 128 + (n & 127);
    const int h = n >> 8, c = n & 255; return c < 128 ? h * 128 + c : 768 + h * 128 + (c - 128);
}
template <int MODE>
DI void convert_t(const Frame F, const float* src, int K, int N, bf16_t* dst, int which, int nmat, size_t src_ms, size_t dst_ms) {
    LAS float* tile = (LAS float*)F.lds;
    const int nkt = K / 64, nnt = (N + 255) / 256, per = nkt * nnt, total = per * nmat;
    const int tid = F.tid;
    f32x4 reg[8];
    int ti = F.wg;
#define CONV_ISSUE(t_) do { const int t__ = (t_); const int mat_ = t__ / per, rem_ = t__ - mat_ * per, kt_ = rem_ / nnt, ntl_ = rem_ - kt_ * nnt; \
        const float* s_ = src + (size_t)mat_ * src_ms + (size_t)(kt_ * 64) * N + ntl_ * 256; const int n4_ = tid & 63, n_ = ntl_ * 256 + n4_ * 4; \
        _Pragma("unroll") for (int i_ = 0; i_ < 8; ++i_) { const int kr_ = (tid >> 6) + 8 * i_; reg[i_] = (n_ < N) ? *(const f32x4*)(s_ + (size_t)kr_ * N + n4_ * 4) : (f32x4){0.f, 0.f, 0.f, 0.f}; } } while (0)
    if (ti < total) CONV_ISSUE(ti);
    for (; ti < total; ti += F.G) {
#pragma unroll
        for (int i = 0; i < 8; ++i) { const int kr = (tid >> 6) + 8 * i; *(LAS f32x4*)(tile + kr * 260 + (tid & 63) * 4) = reg[i]; }
        __syncthreads();
        const int mat = ti / per, rem = ti - mat * per, kt = rem / nnt, nt_ = rem - kt * nnt;
        if (ti + F.G < total) CONV_ISSUE(ti + F.G);
        bf16_t* d = dst + (size_t)mat * dst_ms + kt * 64;
#pragma unroll
        for (int i = 0; i < 4; ++i) {
            const int nl = (tid >> 3) + 64 * i, kg = tid & 7, n = nt_ * 256 + nl;
            if (n < N) {
                float v[8];
#pragma unroll
                for (int j = 0; j < 8; ++j) v[j] = tile[(kg * 8 + j) * 260 + nl];
                u32x4 w; w.x = pack2(v[0], v[1]); w.y = pack2(v[2], v[3]); w.z = pack2(v[4], v[5]); w.w = pack2(v[6], v[7]);
                *(u32x4*)(d + (size_t)rowmap<MODE>(n, which) * K + kg * 8) = w;
            }
        }
        __syncthreads();
    }
}
DI void zero_rows(const Frame F, bf16_t* dst, size_t nelem) {
    for (size_t i = ((size_t)F.wg * 512 + F.tid) * 8; i < nelem; i += (size_t)F.G * 512 * 8) *(u32x4*)(dst + i) = (u32x4){0u, 0u, 0u, 0u};
}
DI void cvt_plain(const Frame F, const float* src, bf16_t* dst, size_t nelem) {
    for (size_t i = ((size_t)F.wg * 512 + F.tid) * 4; i < nelem; i += (size_t)F.G * 512 * 4) {
        const f32x4 v = *(const f32x4*)(src + i); u32x2 w; w.x = pack2(v[0], v[1]); w.y = pack2(v[2], v[3]); *(u32x2*)(dst + i) = w; }
}
DI void p_prologue(const Frame F) {
    convert_t<0>(F, INP(2), 2048, 8000, WSP(bf16_t, WS_WIN), 0, NL, (size_t)2048 * 8000, (size_t)8192 * 2048);
    for (int l = 0; l < NL; ++l) zero_rows(F, WSP(bf16_t, WS_WIN) + (size_t)l * 8192 * 2048 + (size_t)8000 * 2048, (size_t)192 * 2048);
    convert_t<0>(F, INP(18), 2048, 2048, WSP(bf16_t, WS_WOUT), 0, NL, (size_t)2048 * 2048, (size_t)2048 * 2048);
    convert_t<0>(F, INP(29), 2048, 2048, WSP(bf16_t, WS_WPG), 0, NL, (size_t)2048 * 2048, (size_t)2048 * 2048);
    convert_t<0>(F, INP(28), 256, 2048, WSP(bf16_t, WS_WPP), 0, NL, (size_t)256 * 2048, (size_t)2048 * 256);
    convert_t<1>(F, INP(23), 2048, 512, WSP(bf16_t, WS_WGU), 0, NL * 32, (size_t)2048 * 512, (size_t)1024 * 2048);
    convert_t<1>(F, INP(24), 2048, 512, WSP(bf16_t, WS_WGU), 1, NL * 32, (size_t)2048 * 512, (size_t)1024 * 2048);
    convert_t<0>(F, INP(25), 512, 2048, WSP(bf16_t, WS_WDN), 0, NL * 32, (size_t)512 * 2048, (size_t)2048 * 512);
    convert_t<0>(F, INP(15), 512, 1152, WSP(bf16_t, WS_WUQ), 0, NL, (size_t)512 * 1152, (size_t)1280 * 512);
    for (int l = 0; l < NL; ++l) zero_rows(F, WSP(bf16_t, WS_WUQ) + (size_t)l * 1280 * 512 + (size_t)1152 * 512, (size_t)128 * 512);
    convert_t<2>(F, INP(17), 256, 1536, WSP(bf16_t, WS_WUKV), 0, NL, (size_t)256 * 1536, (size_t)1536 * 256);
    cvt_plain(F, INP(0), WSP(bf16_t, WS_XBF), (size_t)T * D);
    cvt_plain(F, INP(1), WSP(bf16_t, WS_PBF), (size_t)NL * T * PLE);
    for (int i = F.wg * 512 + F.tid; i < 4096 * 32; i += F.G * 512) {
        const int pos = i >> 5, k = i & 31; const double ang = (double)pos * pow(10000.0, -(double)k / 32.0);
        WSP(f32x2, WS_ROPE)[i] = (f32x2){(float)cos(ang), (float)sin(ang)}; }
}

DI float zsh(const bf16_t* z, int t, int c, float mu) {
    const float a = bf2f(z[(size_t)t * ZLD + c]);
    const float p = ((t & (SEQ - 1)) == 0) ? 0.f : bf2f(z[(size_t)(t - 1) * ZLD + c]);
    return a + (p - a) * mu;
}
DI void p_rwkv_prep(const Frame F, int l) {
    const bf16_t* z = WSP(bf16_t, WS_Z);
    const float* mu = INP(3) + (size_t)l * 2560; const float* w0 = INP(4) + (size_t)l * 768;
    const float* w_up = INP(5) + (size_t)l * 64 * 768; const float* a0 = INP(6) + (size_t)l * 768; const float* a_up = INP(7) + (size_t)l * 64 * 768;
    const float* g_up = INP(8) + (size_t)l * 128 * 768; const float* k_k = INP(9) + (size_t)l * 768; const float* k_a = INP(10) + (size_t)l * 768;
    const float* r_k = INP(11) + (size_t)l * 768;
    float* R = WSP(float, WS_RW); float* DEC = R + (size_t)T * 768; float* K2 = DEC + (size_t)T * 768; float* V = K2 + (size_t)T * 768;
    float* AA = V + (size_t)T * 768; float* BB = AA + (size_t)T * 768; float* GG = BB + (size_t)T * 768; float* RK = WSP(float, WS_RK);
    LAS float* lw = (LAS float*)F.lds;
    LAS float* la = lw + 16 * 64;
    LAS float* lg = la + 16 * 64;
    const int tid = F.tid;
    for (int tile = F.wg; tile < T / 16; tile += F.G) {
        const int t0 = tile * 16;
        __syncthreads();
        for (int i = tid; i < 16 * 256; i += 512) { const int tk = i >> 8, c = i & 255; const float v = zsh(z, t0 + tk, 2304 + c, mu[2304 + c]);
            if (c < 64) lw[tk * 64 + c] = tanhf(v); else if (c < 128) la[tk * 64 + (c - 64)] = v; else lg[tk * 128 + (c - 128)] = sigmoidf_(v); }
        __syncthreads();
        for (int p = 0; p < 4; ++p) {
            const int c = (p >> 1) * 512 + tid, tb = (p & 1) * 8;
            if (c < 768) {
                float aw[8], aa[8], ag[8];
#pragma unroll
                for (int i = 0; i < 8; ++i) { aw[i] = 0.f; aa[i] = 0.f; ag[i] = 0.f; }
#pragma unroll 2
                for (int k = 0; k < 64; k += 4) {
                    float wu[4], au[4], g0[4], g1[4];
#pragma unroll
                    for (int j = 0; j < 4; ++j) { wu[j] = w_up[(size_t)(k + j) * 768 + c]; au[j] = a_up[(size_t)(k + j) * 768 + c]; g0[j] = g_up[(size_t)(k + j) * 768 + c]; g1[j] = g_up[(size_t)(64 + k + j) * 768 + c]; }
#pragma unroll
                    for (int tk = 0; tk < 8; ++tk) {
                        const f32x4 xw = *(const LAS f32x4*)(lw + (tb + tk) * 64 + k), xa = *(const LAS f32x4*)(la + (tb + tk) * 64 + k), x0 = *(const LAS f32x4*)(lg + (tb + tk) * 128 + k), x1 = *(const LAS f32x4*)(lg + (tb + tk) * 128 + 64 + k);
#pragma unroll
                        for (int j = 0; j < 4; ++j) { aw[tk] += xw[j] * wu[j]; aa[tk] += xa[j] * au[j]; ag[tk] += x0[j] * g0[j] + x1[j] * g1[j]; }
                    }
                }
                const float mur = mu[c], muk = mu[768 + c], muv = mu[1536 + c], w0c = w0[c], a0c = a0[c], kkc = k_k[c], kac = k_a[c], rkc = r_k[c];
                const int h = c >> 6;
#pragma unroll
                for (int tk = 0; tk < 8; ++tk) {
                    const int t = t0 + tb + tk;
                    const float zr = zsh(z, t, c, mur), zk = zsh(z, t, 768 + c, muk), zv = zsh(z, t, 1536 + c, muv);
                    const float xw = -(w0c + aw[tk]);
                    const float sp = (xw > 15.f) ? xw : log1pf(__expf(xw));
                    const float w = -sp - 0.5f;
                    const float dec = -__expf(w);
                    const float a = sigmoidf_(a0c + aa[tk]);
                    const float kkv = zk * kkc;
                    const float nrm = sqrtf(wave_sum(kkv * kkv));
                    const float kkh = kkv / fmaxf(nrm, 1e-12f);
                    const float k2 = zk * (1.0f + (a - 1.0f) * kac);
                    const float rks = wave_sum(zr * k2 * rkc);
                    const size_t o = (size_t)t * 768 + c;
                    R[o] = zr; DEC[o] = dec; K2[o] = k2; V[o] = zv; AA[o] = -kkh; BB[o] = kkh * a; GG[o] = ag[tk];
                    if ((tid & 63) == 0) RK[(size_t)t * 16 + h] = rks;
                }
            }
        }
    }
}

DI void p_mla_prep(const Frame F, int l) {
    const bf16_t* z = WSP(bf16_t, WS_Z);
    const float* qa_g = INP(14) + (size_t)l * 512; const float* kva_g = INP(16) + (size_t)l * 256;
    bf16_t* qn = WSP(bf16_t, WS_QN); bf16_t* kvn = WSP(bf16_t, WS_KVN); bf16_t* kr = WSP(bf16_t, WS_KROPE);
    const f32x2* rope = WSP(f32x2, WS_ROPE);
    const int lane = F.lane;
    for (int t = F.wg * 8 + F.wave; t < T; t += F.G * 8) {
        const bf16_t* zr = z + (size_t)t * ZLD;
        { const u32x4 w = *(const u32x4*)(zr + ZC_QA + lane * 8); float v[8] = {bflo(w.x), bfhi(w.x), bflo(w.y), bfhi(w.y), bflo(w.z), bfhi(w.z), bflo(w.w), bfhi(w.w)};
          float ss = 0.f;
#pragma unroll
          for (int j = 0; j < 8; ++j) ss += v[j] * v[j];
          ss = wave_sum(ss); const float rs = rsqrtf(ss * (1.0f / 512.0f) + 1e-6f);
          const f32x4 g0 = *(const f32x4*)(qa_g + lane * 8), g1 = *(const f32x4*)(qa_g + lane * 8 + 4);
          u32x4 o; o.x = pack2(v[0] * rs * g0[0], v[1] * rs * g0[1]); o.y = pack2(v[2] * rs * g0[2], v[3] * rs * g0[3]); o.z = pack2(v[4] * rs * g1[0], v[5] * rs * g1[1]); o.w = pack2(v[6] * rs * g1[2], v[7] * rs * g1[3]);
          *(u32x4*)(qn + (size_t)t * 512 + lane * 8) = o; }
        { const u32x2 w = *(const u32x2*)(zr + ZC_KVA + lane * 4); float v[4] = {bflo(w.x), bfhi(w.x), bflo(w.y), bfhi(w.y)};
          float ss = v[0] * v[0] + v[1] * v[1] + v[2] * v[2] + v[3] * v[3];
          ss = wave_sum(ss); const float rs = rsqrtf(ss * (1.0f / 256.0f) + 1e-6f);
          const f32x4 g0 = *(const f32x4*)(kva_g + lane * 4);
          u32x2 o; o.x = pack2(v[0] * rs * g0[0], v[1] * rs * g0[1]); o.y = pack2(v[2] * rs * g0[2], v[3] * rs * g0[3]);
          *(u32x2*)(kvn + (size_t)t * 256 + lane * 4) = o; }
        { const int i = lane & 31; const float t1 = bf2f(zr[ZC_KR + i]), t2 = bf2f(zr[ZC_KR + 32 + i]); const f32x2 cs = rope[(t & (SEQ - 1)) * 32 + i];
          const float o = (lane < 32) ? (t1 * cs.x - t2 * cs.y) : (t1 * cs.y + t2 * cs.x);
          kr[(size_t)t * 64 + lane] = f2bf(o); }
    }
}

DI void p_vtd_prep(const Frame F) {
    const bf16_t* z = WSP(bf16_t, WS_Z); bf16_t* vtd = WSP(bf16_t, WS_VTD);
    LAS bf16_t* buf = (LAS bf16_t*)(F.lds + F.wave * 8704);
    const int lane = F.lane;
    for (int tile = F.wg * 8 + F.wave; tile < 2 * 12 * 128; tile += F.G * 8) {
        const int pt = tile & 127, hd = (tile >> 7) % 12, b = tile / (128 * 12);
        const int g = hd >> 2, d = 1 << (2 * g), Ls = SEQ / d;
        const int pos0 = pt * 32, r = pos0 / Ls, j0 = pos0 - r * Ls;
#pragma unroll
        for (int i = 0; i < 8; ++i) { const int p = lane + 64 * i, row = p >> 4, seg = p & 15;
            const size_t tok = (size_t)b * SEQ + (size_t)(j0 + row) * d + r;
            const u32x4 w = *(const u32x4*)(z + tok * ZLD + ZC_DV + hd * 128 + seg * 8);
            *(LAS u32x4*)(buf + row * 136 + seg * 8) = w; }
        __builtin_amdgcn_s_waitcnt(0);
#pragma unroll
        for (int i = 0; i < 8; ++i) { const int p = lane + 64 * i, dv = p >> 2, seg = p & 3;
            unsigned short v[8];
#pragma unroll
            for (int j = 0; j < 8; ++j) v[j] = buf[(seg * 8 + j) * 136 + dv];
            u32x4 w; w.x = v[0] | ((unsigned)v[1] << 16); w.y = v[2] | ((unsigned)v[3] << 16); w.z = v[4] | ((unsigned)v[5] << 16); w.w = v[6] | ((unsigned)v[7] << 16);
            *(u32x4*)(vtd + ((size_t)(b * 12 + hd) * 128 + dv) * SEQ + pos0 + seg * 8) = w; }
        __builtin_amdgcn_s_waitcnt(0);
    }
}

DI int swap23(int i) { return (i & ~12) | ((i & 4) << 1) | ((i & 8) >> 1); }
DI int crow(int reg, int h) { return (reg & 3) + 8 * (reg >> 2) + 4 * h; }
#define MFMA32(a, b, c) __builtin_amdgcn_mfma_f32_32x32x16_bf16((a), (b), (c), 0, 0, 0)
DI bf16x8 packp(const f32x16& p, int s) {
    u32x4 w; w.x = pack2(p[8 * s], p[8 * s + 1]); w.y = pack2(p[8 * s + 2], p[8 * s + 3]); w.z = pack2(p[8 * s + 4], p[8 * s + 5]); w.w = pack2(p[8 * s + 6], p[8 * s + 7]);
    return __builtin_bit_cast(bf16x8, w);
}

DI void dil_item(const Frame F, int item) {
    const bf16_t* z = WSP(bf16_t, WS_Z); const bf16_t* vtd = WSP(bf16_t, WS_VTD);
    bf16_t* op = WSP(bf16_t, WS_OP); float* lse = WSP(float, WS_LSE);
    const int lane = F.lane, c = lane & 31, hh = lane >> 5;
    const int bgh = item >> 7, rem = item & 127, b = bgh / 12, hd = bgh % 12, g = hd >> 2, hs = hd & 3;
    const int d = 1 << (2 * g), Ls = SEQ / d, ntile = Ls / 32, r = rem / ntile, jt = rem % ntile;
    const float slope2 = exp2f(-8.0f * (float)(hd + 1) / 12.0f) * LOG2E * (float)d;
    const float sc = 0.08838834764831845f * LOG2E;
    const int jq = jt * 32 + c;
    const size_t tq = (size_t)b * SEQ + (size_t)jq * d + r;
    bf16x8 qf[8];
#pragma unroll
    for (int ks = 0; ks < 8; ++ks) qf[ks] = *(const bf16x8*)(z + tq * ZLD + ZC_DQ + hd * 128 + 16 * ks + 8 * hh);
    f32x16 O[4];
#pragma unroll
    for (int i = 0; i < 4; ++i)
#pragma unroll
        for (int j = 0; j < 16; ++j) O[i][j] = 0.f;
    float m = -1e30f, lsum = 0.f;
    const int kt0 = jt - 4 < 0 ? 0 : jt - 4;
    for (int kt = kt0; kt <= jt; ++kt) {
        const int jk = kt * 32 + swap23(c);
        const size_t tk = (size_t)b * SEQ + (size_t)jk * d + r;
        bf16x8 kf[8], vf[4][2];
#pragma unroll
        for (int ks = 0; ks < 8; ++ks) kf[ks] = *(const bf16x8*)(z + tk * ZLD + ZC_DK + hd * 128 + 16 * ks + 8 * hh);
#pragma unroll
        for (int dvt = 0; dvt < 4; ++dvt)
#pragma unroll
            for (int s = 0; s < 2; ++s) vf[dvt][s] = *(const bf16x8*)(vtd + ((size_t)(b * 12 + hd) * 128 + dvt * 32 + c) * SEQ + r * Ls + kt * 32 + 16 * s + 8 * hh);
        f32x16 S;
#pragma unroll
        for (int j = 0; j < 16; ++j) S[j] = 0.f;
#pragma unroll
        for (int ks = 0; ks < 8; ++ks) S = MFMA32(kf[ks], qf[ks], S);
        float mx = -1e30f;
#pragma unroll
        for (int i = 0; i < 16; ++i) { const int rel = jq - (kt * 32 + swap23(crow(i, hh)));
            float s = S[i] * sc - slope2 * (float)rel; s = (rel >= 0 && rel <= 128) ? s : -1e30f; S[i] = s; mx = fmaxf(mx, s); }
        mx = fmaxf(mx, __shfl_xor(mx, 32));
        const float mn = fmaxf(m, mx), al = __builtin_amdgcn_exp2f(m - mn); m = mn;
        float ps = 0.f;
#pragma unroll
        for (int i = 0; i < 16; ++i) { const float p = __builtin_amdgcn_exp2f(S[i] - mn); S[i] = p; ps += p; }
        lsum = lsum * al + ps;
#pragma unroll
        for (int i = 0; i < 4; ++i)
#pragma unroll
            for (int j = 0; j < 16; ++j) O[i][j] *= al;
        const bf16x8 p0 = packp(S, 0), p1 = packp(S, 1);
#pragma unroll
        for (int dvt = 0; dvt < 4; ++dvt) { O[dvt] = MFMA32(vf[dvt][0], p0, O[dvt]); O[dvt] = MFMA32(vf[dvt][1], p1, O[dvt]); }
    }
    const float lt = lsum + __shfl_xor(lsum, 32), inv = 1.0f / lt;
    bf16_t* orow = op + ((size_t)g * T + tq) * 512 + hs * 128;
#pragma unroll
    for (int dvt = 0; dvt < 4; ++dvt)
#pragma unroll
        for (int g4 = 0; g4 < 4; ++g4) { u32x2 w; w.x = pack2(O[dvt][4 * g4] * inv, O[dvt][4 * g4 + 1] * inv); w.y = pack2(O[dvt][4 * g4 + 2] * inv, O[dvt][4 * g4 + 3] * inv);
            *(u32x2*)(orow + dvt * 32 + 8 * g4 + 4 * hh) = w; }
    if (hh == 0) lse[((size_t)g * T + tq) * 4 + hs] = m + __builtin_amdgcn_logf(lt);
}

DI void mla_item(const Frame F, int item) {
    const bf16_t* qb = WSP(bf16_t, WS_QB); const bf16_t* kc = WSP(bf16_t, WS_KC); const bf16_t* krp = WSP(bf16_t, WS_KROPE); const bf16_t* vt = WSP(bf16_t, WS_VT);
    const f32x2* rope = WSP(f32x2, WS_ROPE); bf16_t* mix = WSP(bf16_t, WS_MIX);
    const int lane = F.lane, c = lane & 31, hh = lane >> 5;
    const int qt = 127 - item / 12, bh = item % 12, b = bh / 6, h = bh % 6;
    const int q0 = qt * 32;
    const size_t tq = (size_t)b * SEQ + q0 + c;
    const float sc = 0.07216878364870322f * LOG2E;
    bf16x8 qf[12];
#pragma unroll
    for (int ks = 0; ks < 12; ++ks) qf[ks] = *(const bf16x8*)(qb + tq * 1280 + h * 192 + 16 * ks + 8 * hh);
#pragma unroll
    for (int kk = 0; kk < 2; ++kk) {
        const u32x4 w1 = __builtin_bit_cast(u32x4, qf[8 + kk]), w2 = __builtin_bit_cast(u32x4, qf[10 + kk]);
        const unsigned a1[4] = {w1.x, w1.y, w1.z, w1.w}, a2[4] = {w2.x, w2.y, w2.z, w2.w};
        unsigned o1[4], o2[4];
#pragma unroll
        for (int jj = 0; jj < 4; ++jj) {
            const int i0 = 16 * kk + 8 * hh + 2 * jj;
            const f32x2 cs0 = rope[(q0 + c) * 32 + i0], cs1 = rope[(q0 + c) * 32 + i0 + 1];
            const float t1a = bflo(a1[jj]), t1b = bfhi(a1[jj]), t2a = bflo(a2[jj]), t2b = bfhi(a2[jj]);
            o1[jj] = pack2(t1a * cs0.x - t2a * cs0.y, t1b * cs1.x - t2b * cs1.y);
            o2[jj] = pack2(t1a * cs0.y + t2a * cs0.x, t1b * cs1.y + t2b * cs1.x);
        }
        qf[8 + kk] = __builtin_bit_cast(bf16x8, (u32x4){o1[0], o1[1], o1[2], o1[3]});
        qf[10 + kk] = __builtin_bit_cast(bf16x8, (u32x4){o2[0], o2[1], o2[2], o2[3]});
    }
    f32x16 O[4];
#pragma unroll
    for (int i = 0; i < 4; ++i)
#pragma unroll
        for (int j = 0; j < 16; ++j) O[i][j] = 0.f;
    float m = -1e30f, lsum = 0.f;
    for (int kt = 0; kt <= qt; ++kt) {
        const size_t tk = (size_t)b * SEQ + kt * 32 + swap23(c);
        bf16x8 kf[12], vf[4][2];
#pragma unroll
        for (int ks = 0; ks < 8; ++ks) kf[ks] = *(const bf16x8*)(kc + tk * 768 + h * 128 + 16 * ks + 8 * hh);
#pragma unroll
        for (int ks = 0; ks < 4; ++ks) kf[8 + ks] = *(const bf16x8*)(krp + tk * 64 + 16 * ks + 8 * hh);
#pragma unroll
        for (int dvt = 0; dvt < 4; ++dvt)
#pragma unroll
            for (int s = 0; s < 2; ++s) vf[dvt][s] = *(const bf16x8*)(vt + (size_t)(h * 128 + dvt * 32 + c) * T + (size_t)b * SEQ + kt * 32 + 16 * s + 8 * hh);
        f32x16 S;
#pragma unroll
        for (int j = 0; j < 16; ++j) S[j] = 0.f;
#pragma unroll
        for (int ks = 0; ks < 12; ++ks) S = MFMA32(kf[ks], qf[ks], S);
        float mx = -1e30f;
        const bool diag = (kt == qt);
#pragma unroll
        for (int i = 0; i < 16; ++i) { float s = S[i] * sc; if (diag && swap23(crow(i, hh)) > c) s = -1e30f; S[i] = s; mx = fmaxf(mx, s); }
        mx = fmaxf(mx, __shfl_xor(mx, 32));
        const float mn = fmaxf(m, mx), al = __builtin_amdgcn_exp2f(m - mn); m = mn;
        float ps = 0.f;
#pragma unroll
        for (int i = 0; i < 16; ++i) { const float p = __builtin_amdgcn_exp2f(S[i] - mn); S[i] = p; ps += p; }
        lsum = lsum * al + ps;
#pragma unroll
        for (int i = 0; i < 4; ++i)
#pragma unroll
            for (int j = 0; j < 16; ++j) O[i][j] *= al;
        const bf16x8 p0 = packp(S, 0), p1 = packp(S, 1);
#pragma unroll
        for (int dvt = 0; dvt < 4; ++dvt) { O[dvt] = MFMA32(vf[dvt][0], p0, O[dvt]); O[dvt] = MFMA32(vf[dvt][1], p1, O[dvt]); }
    }
    const float lt = lsum + __shfl_xor(lsum, 32), inv = 1.0f / lt;
    bf16_t* orow = mix + tq * D + 1280 + h * 128;
#pragma unroll
    for (int dvt = 0; dvt < 4; ++dvt)
#pragma unroll
        for (int g4 = 0; g4 < 4; ++g4) { u32x2 w; w.x = pack2(O[dvt][4 * g4] * inv, O[dvt][4 * g4 + 1] * inv); w.y = pack2(O[dvt][4 * g4 + 2] * inv, O[dvt][4 * g4 + 3] * inv);
            *(u32x2*)(orow + dvt * 32 + 8 * g4 + 4 * hh) = w; }
}

DI void dilc_item(const Frame F, int item) {
    const bf16_t* op = WSP(bf16_t, WS_OP); const float* lse = WSP(float, WS_LSE); bf16_t* mix = WSP(bf16_t, WS_MIX);
    for (int i = 0; i < 16; ++i) {
        const int task = i * 64 + F.lane, tl = task >> 6, rem = task & 63, hs = rem >> 4, oc = rem & 15;
        const size_t t = (size_t)item * 16 + tl;
        const float l0 = lse[((size_t)0 * T + t) * 4 + hs], l1 = lse[((size_t)1 * T + t) * 4 + hs], l2 = lse[((size_t)2 * T + t) * 4 + hs];
        const float mx = fmaxf(l0, fmaxf(l1, l2));
        float w0 = __builtin_amdgcn_exp2f(l0 - mx), w1 = __builtin_amdgcn_exp2f(l1 - mx), w2 = __builtin_amdgcn_exp2f(l2 - mx);
        const float inv = 1.0f / (w0 + w1 + w2); w0 *= inv; w1 *= inv; w2 *= inv;
        const u32x4 a = *(const u32x4*)(op + ((size_t)0 * T + t) * 512 + hs * 128 + oc * 8), bq = *(const u32x4*)(op + ((size_t)1 * T + t) * 512 + hs * 128 + oc * 8), cq = *(const u32x4*)(op + ((size_t)2 * T + t) * 512 + hs * 128 + oc * 8);
        const unsigned aw[4] = {a.x, a.y, a.z, a.w}, bw[4] = {bq.x, bq.y, bq.z, bq.w}, cw[4] = {cq.x, cq.y, cq.z, cq.w}; unsigned o[4];
#pragma unroll
        for (int j = 0; j < 4; ++j) o[j] = pack2(w0 * bflo(aw[j]) + w1 * bflo(bw[j]) + w2 * bflo(cw[j]), w0 * bfhi(aw[j]) + w1 * bfhi(bw[j]) + w2 * bfhi(cw[j]));
        *(u32x4*)(mix + t * D + 768 + hs * 128 + oc * 8) = (u32x4){o[0], o[1], o[2], o[3]};
    }
}

DI float dppf(float x, int ctrl_sel) {
    const int v = __float_as_int(x); int r;
    if (ctrl_sel == 0) r = __builtin_amdgcn_mov_dpp(v, 0xB1, 0xF, 0xF, true);
    else if (ctrl_sel == 1) r = __builtin_amdgcn_mov_dpp(v, 0x4E, 0xF, 0xF, true);
    else r = __builtin_amdgcn_mov_dpp(v, 0x141, 0xF, 0xF, true);
    return __int_as_float(r);
}
DI float reduce8(float x) { x += dppf(x, 0); x += dppf(x, 1); x += dppf(x, 2); return x; }
constexpr int RTS = 32;
DI void p_rwkv_scan(const Frame F, int l, int bh) {
    const float* R = WSP(float, WS_RW); const float* DEC = R + (size_t)T * 768; const float* K2 = DEC + (size_t)T * 768; const float* V = K2 + (size_t)T * 768;
    const float* AA = V + (size_t)T * 768; const float* BB = AA + (size_t)T * 768; const float* GG = BB + (size_t)T * 768; const float* RK = WSP(float, WS_RK);
    const float* gn_g = INP(12) + (size_t)l * 768; const float* gn_b = INP(13) + (size_t)l * 768;
    bf16_t* mix = WSP(bf16_t, WS_MIX);
    const int b = bh / 12, h = bh % 12, tid = F.tid, i = tid >> 3, jg = tid & 7;
    LAS float* sb = (LAS float*)F.lds;
    LAS float* yb = sb + 2 * 6 * RTS * 64;
    f32x4 reg[6];
    const int st_step = tid >> 4, st_c4 = (tid & 15) * 4;
#define SCAN_ISSUE(chunk_) do { const size_t tok_ = (size_t)b * SEQ + (size_t)(chunk_) * RTS + st_step; \
        reg[0] = *(const f32x4*)(R + tok_ * 768 + h * 64 + st_c4); reg[1] = *(const f32x4*)(DEC + tok_ * 768 + h * 64 + st_c4); reg[2] = *(const f32x4*)(K2 + tok_ * 768 + h * 64 + st_c4); \
        reg[3] = *(const f32x4*)(V + tok_ * 768 + h * 64 + st_c4); reg[4] = *(const f32x4*)(AA + tok_ * 768 + h * 64 + st_c4); reg[5] = *(const f32x4*)(BB + tok_ * 768 + h * 64 + st_c4); } while (0)
    float s[8];
#pragma unroll
    for (int j = 0; j < 8; ++j) s[j] = 0.f;
    SCAN_ISSUE(0);
    __syncthreads();
#pragma unroll
    for (int a = 0; a < 6; ++a) *(LAS f32x4*)(sb + (0 * 6 + a) * RTS * 64 + st_step * 64 + st_c4) = reg[a];
    __syncthreads();
    const int nchunk = SEQ / RTS;
    for (int ch = 0; ch < nchunk; ++ch) {
        const int cb = ch & 1;
        if (ch + 1 < nchunk) SCAN_ISSUE(ch + 1);
        const LAS float* pr = sb + (cb * 6 + 0) * RTS * 64 + jg * 8; const LAS float* pw = sb + (cb * 6 + 1) * RTS * 64 + jg * 8;
        const LAS float* pk = sb + (cb * 6 + 2) * RTS * 64 + jg * 8; const LAS float* pv = sb + (cb * 6 + 3) * RTS * 64 + i;
        const LAS float* pa = sb + (cb * 6 + 4) * RTS * 64 + jg * 8; const LAS float* pb = sb + (cb * 6 + 5) * RTS * 64 + jg * 8;
#pragma unroll 4
        for (int st = 0; st < RTS; ++st) {
            const f32x4 a0 = *(const LAS f32x4*)(pa + st * 64), a1 = *(const LAS f32x4*)(pa + st * 64 + 4);
            const f32x4 w0 = *(const LAS f32x4*)(pw + st * 64), w1 = *(const LAS f32x4*)(pw + st * 64 + 4);
            const f32x4 b0 = *(const LAS f32x4*)(pb + st * 64), b1 = *(const LAS f32x4*)(pb + st * 64 + 4);
            const f32x4 k0 = *(const LAS f32x4*)(pk + st * 64), k1 = *(const LAS f32x4*)(pk + st * 64 + 4);
            const f32x4 r0 = *(const LAS f32x4*)(pr + st * 64), r1 = *(const LAS f32x4*)(pr + st * 64 + 4);
            const float vv = pv[st * 64];
            float sa = (s[0] * a0[0] + s[1] * a0[1]) + (s[2] * a0[2] + s[3] * a0[3]) + (s[4] * a1[0] + s[5] * a1[1]) + (s[6] * a1[2] + s[7] * a1[3]);
            sa = reduce8(sa);
#pragma unroll
            for (int j = 0; j < 4; ++j) { s[j] = s[j] * w0[j] + (sa * b0[j] + vv * k0[j]); s[4 + j] = s[4 + j] * w1[j] + (sa * b1[j] + vv * k1[j]); }
            float y = (s[0] * r0[0] + s[1] * r0[1]) + (s[2] * r0[2] + s[3] * r0[3]) + (s[4] * r1[0] + s[5] * r1[1]) + (s[6] * r1[2] + s[7] * r1[3]);
            y = reduce8(y);
            if (jg == 0) yb[st * 64 + i] = y;
        }
        __syncthreads();
#pragma unroll
        for (int q = 0; q < RTS / 8; ++q) {
            const int st = F.wave * (RTS / 8) + q, lane = F.lane;
            const size_t tok = (size_t)b * SEQ + (size_t)ch * RTS + st;
            const float y = yb[st * 64 + lane];
            const float mean = wave_sum(y) * (1.0f / 64.0f); const float dlt = y - mean; const float var = wave_sum(dlt * dlt) * (1.0f / 64.0f);
            const int cidx = h * 64 + lane;
            float o = dlt * rsqrtf(var + 64e-5f) * gn_g[cidx] + gn_b[cidx];
            o += RK[tok * 16 + h] * sb[(cb * 6 + 3) * RTS * 64 + st * 64 + lane];
            o *= GG[tok * 768 + cidx];
            mix[tok * D + cidx] = f2bf(o);
        }
        if (ch + 1 < nchunk) {
#pragma unroll
            for (int a = 0; a < 6; ++a) *(LAS f32x4*)(sb + ((cb ^ 1) * 6 + a) * RTS * 64 + st_step * 64 + st_c4) = reg[a];
        }
        __syncthreads();
    }
}

constexpr int MP = 72;
constexpr int MBUF = 64 * MP * 2;
DI bf16x8 ldfrag(const LAS bf16_t* M, int rb, int ks, int lane) { return *(const LAS bf16x8*)(M + (rb * 16 + (lane & 15)) * MP + ks * 32 + 8 * (lane >> 4)); }
DI f32x4 mm_tile(const LAS bf16_t* X, const LAS bf16_t* Y, int rb, int cb, int lane, f32x4 acc) {
#pragma unroll
    for (int ks = 0; ks < 2; ++ks) acc = __builtin_amdgcn_mfma_f32_16x16x32_bf16(ldfrag(X, rb, ks, lane), ldfrag(Y, cb, ks, lane), acc, 0, 0, 0);
    return acc;
}
DI void st_T(LAS bf16_t* M, int rb, int cb, int lane, f32x4 v) {
    u32x2 w; w.x = pack2(v[0], v[1]); w.y = pack2(v[2], v[3]);
    *(LAS u32x2*)(M + (cb * 16 + (lane & 15)) * MP + rb * 16 + 4 * (lane >> 4)) = w;
}
DI void st_N(LAS bf16_t* M, int rb, int cb, int lane, f32x4 v) {
#pragma unroll
    for (int q = 0; q < 4; ++q) M[(rb * 16 + 4 * (lane >> 4) + q) * MP + cb * 16 + (lane & 15)] = f2bf(v[q]);
}
DI void p_rwkv_pass1(const Frame F, int l) {
    const float* R = WSP(float, WS_RW); const float* LW = R + (size_t)T * 768; const float* K2 = LW + (size_t)T * 768; const float* V = K2 + (size_t)T * 768;
    const float* AA = V + (size_t)T * 768; const float* BB = AA + (size_t)T * 768;
    float* ACg = WSP(float, WS_AC); float* GCg = WSP(float, WS_GC); float* Y0g = WSP(float, WS_Y0); bf16_t* QCg = WSP(bf16_t, WS_QC);
    LAS bf16_t* b0 = (LAS bf16_t*)F.lds;
    LAS bf16_t* b1 = (LAS bf16_t*)(F.lds + 1 * MBUF);
    LAS bf16_t* b2 = (LAS bf16_t*)(F.lds + 2 * MBUF);
    LAS bf16_t* b3 = (LAS bf16_t*)(F.lds + 3 * MBUF);
    LAS bf16_t* b4 = (LAS bf16_t*)(F.lds + 4 * MBUF);
    LAS bf16_t* b5 = (LAS bf16_t*)(F.lds + 5 * MBUF);
    LAS bf16_t* b6 = (LAS bf16_t*)(F.lds + 6 * MBUF);
    LAS bf16_t* b7 = (LAS bf16_t*)(F.lds + 7 * MBUF);
    LAS bf16_t* b8 = (LAS bf16_t*)(F.lds + 8 * MBUF);
    LAS bf16_t* b9 = (LAS bf16_t*)(F.lds + 9 * MBUF);
    LAS bf16_t* b10 = (LAS bf16_t*)(F.lds + 10 * MBUF);
    LAS bf16_t* b11 = (LAS bf16_t*)(F.lds + 11 * MBUF);
    LAS float* part = (LAS float*)(F.lds + 12 * MBUF);
    const int tid = F.tid, lane = F.lane, wave = F.wave, rb = wave >> 1, cb0 = 2 * (wave & 1);
    const int j = tid & 63, tg = tid >> 6;
    const f32x4 z4 = (f32x4){0.f, 0.f, 0.f, 0.f};
    for (int ch = F.wg; ch < 1536; ch += F.G) {
        const int bh = ch >> 6, c = ch & 63, b = bh / 12, h = bh % 12;
        const size_t g0 = ((size_t)b * SEQ + (size_t)c * 64 + tg * 8) * 768 + h * 64 + j;
        float lw[8], lam[8];
#pragma unroll
        for (int q = 0; q < 8; ++q) lw[q] = LW[g0 + (size_t)q * 768];
        lam[0] = lw[0];
#pragma unroll
        for (int q = 1; q < 8; ++q) lam[q] = lam[q - 1] + lw[q];
        __syncthreads();
        part[tg * 64 + j] = lam[7];
        __syncthreads();
        float off = 0.f, tot = 0.f;
#pragma unroll
        for (int q = 0; q < 8; ++q) { const float p = part[q * 64 + j]; off += (q < tg) ? p : 0.f; tot += p; }
        if (tg == 0) part[512 + j] = __expf(tot);
        {
            float va[8], vb[8], vk[8], vr[8], vv[8];
#pragma unroll
            for (int q = 0; q < 8; ++q) { const float L_ = off + lam[q], ep = __expf(L_), en = __expf(-L_), epv = __expf(L_ - lw[q]);
                va[q] = AA[g0 + (size_t)q * 768] * epv; vb[q] = BB[g0 + (size_t)q * 768] * en; vk[q] = K2[g0 + (size_t)q * 768] * en; vr[q] = R[g0 + (size_t)q * 768] * ep; vv[q] = V[g0 + (size_t)q * 768]; }
#pragma unroll
            for (int q = 0; q < 8; ++q) { const int t = tg * 8 + q; b0[t * MP + j] = f2bf(va[q]); b1[t * MP + j] = f2bf(vb[q]); b2[t * MP + j] = f2bf(vk[q]); b3[t * MP + j] = f2bf(vr[q]); }
            u32x4 w;
            w.x = pack2(va[0], va[1]); w.y = pack2(va[2], va[3]); w.z = pack2(va[4], va[5]); w.w = pack2(va[6], va[7]); *(LAS u32x4*)(b4 + j * MP + tg * 8) = w;
            w.x = pack2(vb[0], vb[1]); w.y = pack2(vb[2], vb[3]); w.z = pack2(vb[4], vb[5]); w.w = pack2(vb[6], vb[7]); *(LAS u32x4*)(b5 + j * MP + tg * 8) = w;
            w.x = pack2(vk[0], vk[1]); w.y = pack2(vk[2], vk[3]); w.z = pack2(vk[4], vk[5]); w.w = pack2(vk[6], vk[7]); *(LAS u32x4*)(b6 + j * MP + tg * 8) = w;
            w.x = pack2(vv[0], vv[1]); w.y = pack2(vv[2], vv[3]); w.z = pack2(vv[4], vv[5]); w.w = pack2(vv[6], vv[7]); *(LAS u32x4*)(b7 + j * MP + tg * 8) = w;
        }
        __syncthreads();
        f32x4 Tt[2], lak[2], mrb[2], mrk[2];
#pragma unroll
        for (int q = 0; q < 2; ++q) { const int cb = cb0 + q;
            Tt[q] = mm_tile(b0, b1, rb, cb, lane, z4); lak[q] = mm_tile(b0, b2, rb, cb, lane, z4); mrb[q] = mm_tile(b3, b1, rb, cb, lane, z4); mrk[q] = mm_tile(b3, b2, rb, cb, lane, z4);
#pragma unroll
            for (int e = 0; e < 4; ++e) { const int tr = rb * 16 + 4 * (lane >> 4) + e, sc = cb * 16 + (lane & 15);
                if (!(tr > sc)) { Tt[q][e] = 0.f; lak[q][e] = 0.f; }
                if (!(tr >= sc)) { mrb[q][e] = 0.f; mrk[q][e] = 0.f; } } }
        __syncthreads();
#pragma unroll
        for (int q = 0; q < 2; ++q) { const int cb = cb0 + q;
            st_N(b0, rb, cb, lane, Tt[q]); st_T(b1, rb, cb, lane, Tt[q]);
            st_N(b8, rb, cb, lane, lak[q]); st_N(b9, rb, cb, lane, mrb[q]); st_N(b10, rb, cb, lane, mrk[q]);
#pragma unroll
            for (int e = 0; e < 4; ++e) { const int tr = rb * 16 + 4 * (lane >> 4) + e, sc = cb * 16 + (lane & 15); if (tr == sc) Tt[q][e] += 1.0f; }
            st_N(b2, rb, cb, lane, Tt[q]); }
        __syncthreads();
#pragma unroll 1
        for (int it = 0; it < 5; ++it) {
            f32x4 p2[2];
#pragma unroll
            for (int q = 0; q < 2; ++q) p2[q] = mm_tile(b0, b1, rb, cb0 + q, lane, z4);
            __syncthreads();
#pragma unroll
            for (int q = 0; q < 2; ++q) { st_N(b0, rb, cb0 + q, lane, p2[q]); st_T(b1, rb, cb0 + q, lane, p2[q]); }
            __syncthreads();
#pragma unroll
            for (int q = 0; q < 2; ++q) Tt[q] = mm_tile(b2, b1, rb, cb0 + q, lane, Tt[q]);
            __syncthreads();
#pragma unroll
            for (int q = 0; q < 2; ++q) st_N(b2, rb, cb0 + q, lane, Tt[q]);
            __syncthreads();
        }
#pragma unroll
        for (int q = 0; q < 2; ++q) { const int cb = cb0 + q;
            st_T(b11, rb, cb, lane, mm_tile(b2, b4, rb, cb, lane, z4));
            st_T(b0, rb, cb, lane, mm_tile(b8, b7, rb, cb, lane, z4)); }
        __syncthreads();
#pragma unroll
        for (int q = 0; q < 2; ++q) st_T(b8, rb, cb0 + q, lane, mm_tile(b2, b0, rb, cb0 + q, lane, z4));
        __syncthreads();
        const size_t cho = (size_t)ch * 4096;
#pragma unroll
        for (int q = 0; q < 2; ++q) { const int cb = cb0 + q; const int col = cb * 16 + (lane & 15), row0 = rb * 16 + 4 * (lane >> 4);
            f32x4 ac = mm_tile(b5, b11, rb, cb, lane, z4);
            f32x4 gc = mm_tile(b6, b7, rb, cb, lane, mm_tile(b5, b8, rb, cb, lane, z4));
#pragma unroll
            for (int e = 0; e < 4; ++e) { const float gm = part[512 + row0 + e];
                ACg[cho + (size_t)(row0 + e) * 64 + col] = (ac[e] + ((row0 + e) == col ? 1.0f : 0.f)) * gm;
                GCg[cho + (size_t)(row0 + e) * 64 + col] = gc[e] * gm; }
            f32x4 qc = mm_tile(b9, b11, rb, cb, lane, z4);
#pragma unroll
            for (int e = 0; e < 4; ++e) QCg[cho + (size_t)(row0 + e) * 64 + col] = f2bf(qc[e] + bf2f(b3[(row0 + e) * MP + col]));
            const f32x4 y0 = mm_tile(b10, b7, rb, cb, lane, mm_tile(b9, b8, rb, cb, lane, z4));
            *(f32x4*)(Y0g + cho + (size_t)((wave * 2 + q) * 64 + lane) * 4) = y0; }
    }
}
DI void p_rwkv_pass2(const Frame F, int bh) {
    const float* ACg = WSP(float, WS_AC); const float* GCg = WSP(float, WS_GC); bf16_t* SST = WSP(bf16_t, WS_SST);
    LAS float* Sb = (LAS float*)F.lds;
    const int lane = F.lane, wave = F.wave, rb = wave >> 1, cb0 = 2 * (wave & 1), n = lane & 15, kk = lane >> 4;
    f32x4 St[2] = {(f32x4){0.f, 0.f, 0.f, 0.f}, (f32x4){0.f, 0.f, 0.f, 0.f}};
    __syncthreads();
#pragma unroll
    for (int q = 0; q < 2; ++q)
#pragma unroll
        for (int e = 0; e < 4; ++e) Sb[(rb * 16 + 4 * kk + e) * 68 + (cb0 + q) * 16 + n] = 0.f;
    __syncthreads();
    for (int c = 0; c < 64; ++c) {
        const size_t cho = (size_t)(bh * 64 + c) * 4096;
        const LAS float* Sc = Sb + (c & 1) * 64 * 68; LAS float* Sn = Sb + ((c + 1) & 1) * 64 * 68;
#pragma unroll
        for (int q = 0; q < 2; ++q)
#pragma unroll
            for (int e = 0; e < 4; ++e) SST[cho + (size_t)(rb * 16 + 4 * kk + e) * 64 + (cb0 + q) * 16 + n] = f2bf(St[q][e]);
        f32x4 av[4], bv[2][4], gv[2];
#pragma unroll
        for (int m4 = 0; m4 < 4; ++m4) av[m4] = *(const LAS f32x4*)(Sc + (rb * 16 + n) * 68 + 16 * kk + 4 * m4);
#pragma unroll
        for (int q = 0; q < 2; ++q) {
#pragma unroll
            for (int m4 = 0; m4 < 4; ++m4) bv[q][m4] = *(const f32x4*)(ACg + cho + (size_t)((cb0 + q) * 16 + n) * 64 + 16 * kk + 4 * m4);
            gv[q] = *(const f32x4*)(GCg + cho + (size_t)((cb0 + q) * 16 + n) * 64 + rb * 16 + 4 * kk); }
#pragma unroll
        for (int q = 0; q < 2; ++q) { f32x4 acc = gv[q];
#pragma unroll
            for (int m4 = 0; m4 < 4; ++m4)
#pragma unroll
                for (int e = 0; e < 4; ++e) acc = __builtin_amdgcn_mfma_f32_16x16x4f32(av[m4][e], bv[q][m4][e], acc, 0, 0, 0);
            St[q] = acc;
#pragma unroll
            for (int e = 0; e < 4; ++e) Sn[(rb * 16 + 4 * kk + e) * 68 + (cb0 + q) * 16 + n] = acc[e]; }
        __syncthreads();
    }
}
DI void p_rwkv_pass3(const Frame F, int l) {
    const float* V = WSP(float, WS_RW) + (size_t)3 * T * 768; const float* GG = WSP(float, WS_RW) + (size_t)6 * T * 768; const float* RK = WSP(float, WS_RK);
    const float* Y0g = WSP(float, WS_Y0); const bf16_t* QCg = WSP(bf16_t, WS_QC); const bf16_t* SST = WSP(bf16_t, WS_SST);
    const float* gn_g = INP(12) + (size_t)l * 768; const float* gn_b = INP(13) + (size_t)l * 768;
    bf16_t* mix = WSP(bf16_t, WS_MIX);
    LAS float* yb = (LAS float*)F.lds;
    const int lane = F.lane, wave = F.wave, rb = wave >> 1, cb0 = 2 * (wave & 1), n = lane & 15, kk = lane >> 4;
    for (int ch = F.wg; ch < 1536; ch += F.G) {
        const int bh = ch >> 6, c = ch & 63, b = bh / 12, h = bh % 12;
        const size_t cho = (size_t)ch * 4096;
        bf16x8 qa[2];
#pragma unroll
        for (int ks = 0; ks < 2; ++ks) qa[ks] = *(const bf16x8*)(QCg + cho + (size_t)(rb * 16 + n) * 64 + ks * 32 + 8 * kk);
        __syncthreads();
#pragma unroll
        for (int q = 0; q < 2; ++q) { const int cb = cb0 + q;
            f32x4 acc = *(const f32x4*)(Y0g + cho + (size_t)((wave * 2 + q) * 64 + lane) * 4);
#pragma unroll
            for (int ks = 0; ks < 2; ++ks) acc = __builtin_amdgcn_mfma_f32_16x16x32_bf16(qa[ks], *(const bf16x8*)(SST + cho + (size_t)(cb * 16 + n) * 64 + ks * 32 + 8 * kk), acc, 0, 0, 0);
#pragma unroll
            for (int e = 0; e < 4; ++e) yb[(rb * 16 + 4 * kk + e) * 68 + cb * 16 + n] = acc[e]; }
        __syncthreads();
#pragma unroll
        for (int q = 0; q < 8; ++q) {
            const int t = wave * 8 + q; const size_t tok = (size_t)b * SEQ + (size_t)c * 64 + t;
            const float y = yb[t * 68 + lane];
            const float mean = wave_sum(y) * (1.0f / 64.0f); const float dlt = y - mean; const float var = wave_sum(dlt * dlt) * (1.0f / 64.0f);
            const int cidx = h * 64 + lane;
            float o = dlt * rsqrtf(var + 64e-5f) * gn_g[cidx] + gn_b[cidx];
            o += RK[tok * 16 + h] * V[tok * 768 + cidx];
            o *= GG[tok * 768 + cidx];
            mix[tok * D + cidx] = f2bf(o);
        }
    }
}

DI void p_ln1_route(const Frame F, int l, const float* xin) {
    const float* tmp = WSP(float, WS_TMP); float* x1 = WSP(float, WS_X1); bf16_t* x1b = WSP(bf16_t, WS_X1BF);
    const float* g = INP(19) + (size_t)l * D; const float* bta = INP(20) + (size_t)l * D;
    const float* rw = INP(21); const float* rb = INP(22);
    unsigned* cnt = F.ctl + CW_MOECNT + l * 32; int* tokl = WSP(int, WS_TOKL); float* gate = WSP(float, WS_GATE);
    const int lane = F.lane;
    LAS float* xl = (LAS float*)F.lds + F.wave * 4096;
    for (int pr = F.wg * 8 + F.wave; pr < T / 2; pr += F.G * 8) {
#pragma unroll
        for (int u = 0; u < 2; ++u) {
            const size_t t = (size_t)pr * 2 + u;
            float xv[32]; float sm = 0.f;
#pragma unroll
            for (int i = 0; i < 8; ++i) { const f32x4 a = *(const f32x4*)(xin + t * D + 256 * i + 4 * lane), m = *(const f32x4*)(tmp + t * D + 256 * i + 4 * lane);
#pragma unroll
                for (int j = 0; j < 4; ++j) { const float v = ALPHA * a[j] + m[j]; xv[4 * i + j] = v; sm += v; } }
            const float mean = wave_sum(sm) * (1.0f / 2048.0f);
            float sq = 0.f;
#pragma unroll
            for (int i = 0; i < 32; ++i) { const float dl = xv[i] - mean; sq += dl * dl; }
            const float rstd = rsqrtf(wave_sum(sq) * (1.0f / 2048.0f) + 1e-5f);
#pragma unroll
            for (int i = 0; i < 8; ++i) { const f32x4 gg = *(const f32x4*)(g + 256 * i + 4 * lane), bb = *(const f32x4*)(bta + 256 * i + 4 * lane); f32x4 o;
#pragma unroll
                for (int j = 0; j < 4; ++j) o[j] = (xv[4 * i + j] - mean) * rstd * gg[j] + bb[j];
                *(f32x4*)(x1 + t * D + 256 * i + 4 * lane) = o;
                *(LAS f32x4*)(xl + u * 2048 + 256 * i + 4 * lane) = o;
                u32x2 w; w.x = pack2(o[0], o[1]); w.y = pack2(o[2], o[3]); *(u32x2*)(x1b + t * D + 256 * i + 4 * lane) = w; }
        }
        __builtin_amdgcn_s_waitcnt(0xc07f);
        const int e = lane & 31;
        const LAS float* xr = xl + (lane >> 5) * 2048;
        const float* wcol = rw + e;
        float a0 = 0.f, a1 = 0.f, a2 = 0.f, a3 = 0.f;
#pragma unroll 4
        for (int k = 0; k < 2048; k += 4) {
            const f32x4 xq = *(const LAS f32x4*)(xr + k);
            a0 += xq[0] * wcol[(size_t)(k + 0) * 32]; a1 += xq[1] * wcol[(size_t)(k + 1) * 32]; a2 += xq[2] * wcol[(size_t)(k + 2) * 32]; a3 += xq[3] * wcol[(size_t)(k + 3) * 32];
        }
        const float logit = (a0 + a1) + (a2 + a3);
        const float score = 1.0f / (1.0f + expf(-logit)), sel = score + rb[e];
        const int gb = lane & ~3;
        const float s0 = __shfl(sel, gb), s1 = __shfl(sel, gb + 1), s2 = __shfl(sel, gb + 2), s3 = __shfl(sel, gb + 3);
        const float ha = fmaxf(s0, s1), hb = fminf(s0, s1), hc = fmaxf(s2, s3), hd = fminf(s2, s3);
        float gv = fmaxf(ha, hc) + fmaxf(fminf(ha, hc), fmaxf(hb, hd)); int gi = e >> 2;
#pragma unroll
        for (int msk = 4; msk <= 16; msk <<= 1) { const float ov = __shfl_xor(gv, msk); const int oi = __shfl_xor(gi, msk); if (ov > gv || (ov == gv && oi < gi)) { gv = ov; gi = oi; } }
        const int base = (lane & 32) + 4 * gi;
        float a[4], sc4[4];
#pragma unroll
        for (int k = 0; k < 4; ++k) { a[k] = __shfl(sel, base + k); sc4[k] = __shfl(score, base + k); }
        int i1 = 0; float v1 = a[0];
#pragma unroll
        for (int k = 1; k < 4; ++k) if (a[k] > v1) { v1 = a[k]; i1 = k; }
        int i2 = -1; float v2 = -3.0e38f;
#pragma unroll
        for (int k = 0; k < 4; ++k) if (k != i1 && a[k] > v2) { v2 = a[k]; i2 = k; }
        float g1 = 0.f, g2 = 0.f;
#pragma unroll
        for (int k = 0; k < 4; ++k) { if (k == i1) g1 = sc4[k]; if (k == i2) g2 = sc4[k]; }
        if (e == 0) {
            const int t = pr * 2 + (lane >> 5); const int e1 = 4 * gi + i1, e2 = 4 * gi + i2; const float dn = g1 + g2;
            const unsigned r1 = atomicAdd(cnt + e1, 1u); tokl[e1 * 8192 + r1] = 2 * t;
            const unsigned r2 = atomicAdd(cnt + e2, 1u); tokl[e2 * 8192 + r2] = 2 * t + 1;
            gate[2 * t] = g1 / dn; gate[2 * t + 1] = g2 / dn;
        }
    }
}

DI void p_ln2(const Frame F, int l) {
    const float* x1 = WSP(float, WS_X1); const bf16_t* ybt = WSP(bf16_t, WS_YBT); const float* gate = WSP(float, WS_GATE);
    float* x2 = WSP(float, WS_TMP); bf16_t* x2b = WSP(bf16_t, WS_X1BF);
    const float* g = INP(26) + (size_t)l * D; const float* bta = INP(27) + (size_t)l * D;
    const int lane = F.lane;
    for (int t = F.wg * 8 + F.wave; t < T; t += F.G * 8) {
        const float g0 = gate[2 * t], g1 = gate[2 * t + 1];
        float xv[32]; float sm = 0.f;
#pragma unroll
        for (int i = 0; i < 8; ++i) { const size_t o = 256 * i + 4 * lane; const f32x4 a = *(const f32x4*)(x1 + (size_t)t * D + o);
            const u32x2 y0 = *(const u32x2*)(ybt + (size_t)(2 * t) * D + o), y1 = *(const u32x2*)(ybt + (size_t)(2 * t + 1) * D + o);
            xv[4 * i] = ALPHA * a[0] + (g0 * bflo(y0.x) + g1 * bflo(y1.x)); xv[4 * i + 1] = ALPHA * a[1] + (g0 * bfhi(y0.x) + g1 * bfhi(y1.x));
            xv[4 * i + 2] = ALPHA * a[2] + (g0 * bflo(y0.y) + g1 * bflo(y1.y)); xv[4 * i + 3] = ALPHA * a[3] + (g0 * bfhi(y0.y) + g1 * bfhi(y1.y));
            sm += (xv[4 * i] + xv[4 * i + 1]) + (xv[4 * i + 2] + xv[4 * i + 3]); }
        const float mean = wave_sum(sm) * (1.0f / 2048.0f);
        float sq = 0.f;
#pragma unroll
        for (int i = 0; i < 32; ++i) { const float dl = xv[i] - mean; sq += dl * dl; }
        const float rstd = rsqrtf(wave_sum(sq) * (1.0f / 2048.0f) + 1e-5f);
#pragma unroll
        for (int i = 0; i < 8; ++i) { const size_t o = 256 * i + 4 * lane; const f32x4 gg = *(const f32x4*)(g + o), bb = *(const f32x4*)(bta + o); f32x4 r;
#pragma unroll
            for (int j = 0; j < 4; ++j) r[j] = (xv[4 * i + j] - mean) * rstd * gg[j] + bb[j];
            *(f32x4*)(x2 + (size_t)t * D + o) = r; u32x2 w; w.x = pack2(r[0], r[1]); w.y = pack2(r[2], r[3]); *(u32x2*)(x2b + (size_t)t * D + o) = w; }
    }
}

DI int finish_units(const Frame F, int n) {
    LAS int* cw = (LAS int*)(F.lds + LDS_CTL);
    if (F.tid == 0) cw[4] = n;
    __syncthreads();
    return __builtin_amdgcn_readfirstlane(cw[4]);
}
DI int moe_units_body(const Frame F, int l, bool gemm1) {
    LAS int* mt = (LAS int*)(F.lds + LDS_MOE); LAS int* utab = (LAS int*)(F.lds + LDS_UTAB); LAS int* rowl = (LAS int*)(F.lds + LDS_ROWL);
    const int* tokl = WSP(int, WS_TOKL);
    int n = 0;
    if (F.tid == 0) {
        int hb = 0, nrb = 0;
        for (int e = 0; e < 32; ++e) { int c = (int)__hip_atomic_load(F.ctl + CW_MOECNT + l * 32 + e, __ATOMIC_RELAXED, __HIP_MEMORY_SCOPE_AGENT); if (c > 8192) c = 8192;
            mt[e] = c; mt[32 + e] = hb; const int nb = (c + 255) >> 8;
            for (int j = 0; j < nb && nrb < 128; ++j) { mt[64 + nrb] = e; mt[192 + nrb] = j; ++nrb; }
            hb += nb * 256; }
        const int npn = gemm1 ? 4 : 8;
        for (int L = F.wg; L < nrb * npn && n < 4; L += F.G) {
            const int rb = L / npn, pn = L - rb * npn, e = mt[64 + rb], j = mt[192 + rb], cnt = mt[e], row0 = mt[32 + e] + j * 256;
            const int valid = (cnt - j * 256) < 256 ? (cnt - j * 256) : 256;
            if (gemm1) pg8::unit_put(utab, n, WSP(bf16_t, WS_X1BF), WSP(bf16_t, WS_WGU) + ((size_t)(l * 32 + e) * 1024 + (size_t)pn * 256) * 2048, WSP(bf16_t, WS_HB), 2048, DEXP, row0, pn * 256, e * 8192 + j * 256, valid);
            else pg8::unit_put(utab, n, WSP(bf16_t, WS_HB) + (size_t)row0 * DEXP, WSP(bf16_t, WS_WDN) + ((size_t)(l * 32 + e) * 2048 + (size_t)pn * 256) * 512, WSP(bf16_t, WS_YBT), 512, D, row0, pn * 256, e * 8192 + j * 256, valid);
            ++n;
        }
    }
    n = finish_units(F, n);
    for (int x = F.tid; x < n * 256; x += 512) { const int ui = x >> 8, r = x & 255, a0 = utab[ui * pg8::UD + 10], a1 = utab[ui * pg8::UD + 11];
        const int v = (r < a1) ? tokl[a0 + r] : -1; rowl[x] = gemm1 ? (v < 0 ? 0 : (v >> 1)) : v; }
    __syncthreads();
    return n;
}

__device__ __noinline__ int moe_units(LAS unsigned char* lds_, GAS unsigned char* ws_, int wave_, int l, int gemm1) { const Frame F = make_frame(lds_, ws_, wave_); return moe_units_body(F, l, gemm1 != 0); }
PHASE_FN ph_prologue(PHASE_ARGS) { PHASE_FRAME; p_prologue(F); }
GEMM_FN ph_gemm_in(PHASE_ARGS, int l) {
    PHASE_FRAME; LAS int* utab = (LAS int*)(F.lds + LDS_UTAB);
    int n = 0;
    if (F.tid == 0) { int Lb = 0;
        pg8::build_dense(utab, n, Lb, WSP(bf16_t, WS_XBF), WSP(bf16_t, WS_WIN) + (size_t)l * 8192 * 2048, WSP(bf16_t, WS_Z), 2, T, 8192, 2048, ZLD, F.G, F.wg);
        pg8::build_dense(utab, n, Lb, WSP(bf16_t, WS_PBF) + (size_t)l * T * PLE, WSP(bf16_t, WS_WPP) + (size_t)l * 2048 * 256, WSP(bf16_t, WS_PP), 2, T, 2048, 256, D, F.G, F.wg); }
    n = finish_units(F, n);
    pg8::EpiBf16 E; pg8::gemm_phase<pg8::EpiBf16, false>(F.lds, F.tid, utab, n, nullptr, E);
}
PHASE_FN ph_rwkv_prep(PHASE_ARGS, int l) { PHASE_FRAME; p_rwkv_prep(F, l); }
PHASE_FN ph_mla_prep(PHASE_ARGS, int l) { PHASE_FRAME; p_mla_prep(F, l); p_vtd_prep(F); }
GEMM_FN ph_gemm_mla(PHASE_ARGS, int l) {
    PHASE_FRAME; LAS int* utab = (LAS int*)(F.lds + LDS_UTAB);
    int n = 0;
    if (F.tid == 0) { int Lb = 0;
        pg8::build_dense(utab, n, Lb, WSP(bf16_t, WS_QN), WSP(bf16_t, WS_WUQ) + (size_t)l * 1280 * 512, WSP(bf16_t, WS_QB), 2, T, 1280, 512, 1280, F.G, F.wg);
        pg8::build_dense(utab, n, Lb, WSP(bf16_t, WS_KVN), WSP(bf16_t, WS_WUKV) + (size_t)l * 1536 * 256, WSP(bf16_t, WS_KC), 2, T, 768, 256, 768, F.G, F.wg);
        pg8::build_dense(utab, n, Lb, WSP(bf16_t, WS_WUKV) + (size_t)l * 1536 * 256 + (size_t)768 * 256, WSP(bf16_t, WS_KVN), WSP(bf16_t, WS_VT), 2, 768, T, 256, T, F.G, F.wg); }
    n = finish_units(F, n);
    pg8::EpiBf16 E; pg8::gemm_phase<pg8::EpiBf16, false>(F.lds, F.tid, utab, n, nullptr, E);
}
PHASE_FN ph_dil(PHASE_ARGS) { PHASE_FRAME; for (int it = F.wg * 8 + F.wave; it < 2 * 12 * 128; it += F.G * 8) dil_item(F, it); }
PHASE_FN ph_scan(PHASE_ARGS, int l) { PHASE_FRAME; p_rwkv_pass2(F, F.wg); }
PHASE_FN ph_rwkv1(PHASE_ARGS, int l) { PHASE_FRAME; p_rwkv_pass1(F, l); }
PHASE_FN ph_rwkv3(PHASE_ARGS, int l) { PHASE_FRAME; p_rwkv_pass3(F, l); }
PHASE_FN ph_attn_queue(PHASE_ARGS, int l, int rep) {
    PHASE_FRAME;
    unsigned* q = F.ctl + CW_QUEUE + l * 64 + rep * 8;
    for (;;) {
        int it = 0; if (F.lane == 0) it = (int)atomicAdd(q, 1u);
        it = __builtin_amdgcn_readfirstlane(it);
        if (it >= 1536 + 512) break;
        if (it < 1536) mla_item(F, it); else dilc_item(F, it - 1536);
    }
}
GEMM_FN ph_gemm_out(PHASE_ARGS, int l) {
    PHASE_FRAME; LAS int* utab = (LAS int*)(F.lds + LDS_UTAB);
    int n = 0;
    if (F.tid == 0) { int Lb = 0; pg8::build_dense(utab, n, Lb, WSP(bf16_t, WS_MIX), WSP(bf16_t, WS_WOUT) + (size_t)l * 2048 * 2048, WSP(float, WS_TMP), 4, T, 2048, 2048, D, F.G, F.wg); }
    n = finish_units(F, n);
    pg8::EpiF32 E; pg8::gemm_phase<pg8::EpiF32, false>(F.lds, F.tid, utab, n, nullptr, E);
}
PHASE_FN ph_ln1(PHASE_ARGS, int l) { PHASE_FRAME; p_ln1_route(F, l, (l == 0) ? INP(0) : (const float*)WSP(float, WS_XCUR)); }
GEMM_FN ph_moe1(PHASE_ARGS, int l) {
    PHASE_FRAME; const int n = __builtin_amdgcn_readfirstlane(moe_units(lds_, ws_, wave_, l, 1));
    pg8::EpiGU E; pg8::gemm_phase<pg8::EpiGU, true>(F.lds, F.tid, (const LAS int*)(F.lds + LDS_UTAB), n, (const LAS int*)(F.lds + LDS_ROWL), E);
}
GEMM_FN ph_moe2(PHASE_ARGS, int l) {
    PHASE_FRAME; const int n = __builtin_amdgcn_readfirstlane(moe_units(lds_, ws_, wave_, l, 0));
    pg8::EpiScatter E{(const LAS int*)(F.lds + LDS_ROWL)}; pg8::gemm_phase<pg8::EpiScatter, false>(F.lds, F.tid, (const LAS int*)(F.lds + LDS_UTAB), n, (const LAS int*)(F.lds + LDS_ROWL), E);
}
PHASE_FN ph_ln2(PHASE_ARGS, int l) { PHASE_FRAME; p_ln2(F, l); }
GEMM_FN ph_ple(PHASE_ARGS, int l, float* out_) {
    PHASE_FRAME; LAS int* utab = (LAS int*)(F.lds + LDS_UTAB);
    const bool lastl = (l == NL - 1);
    float* outp = (float*)(GAS float*)rfl64((unsigned long long)out_);
    int n = 0;
    if (F.tid == 0) { int Lb = 0; pg8::build_dense(utab, n, Lb, WSP(bf16_t, WS_X1BF), WSP(bf16_t, WS_WPG) + (size_t)l * 2048 * 2048, lastl ? (void*)outp : (void*)WSP(float, WS_XCUR), 4, T, 2048, 2048, D, F.G, F.wg); }
    n = finish_units(F, n);
    pg8::EpiPle E{WSP(float, WS_TMP), WSP(bf16_t, WS_PP), lastl ? (bf16_t*)nullptr : WSP(bf16_t, WS_XBF)};
    pg8::gemm_phase<pg8::EpiPle, false>(F.lds, F.tid, utab, n, nullptr, E);
}

constexpr int NPH = 11;
#ifndef PH_MASK
#define PH_MASK 0x7ff
#endif
__global__ void __launch_bounds__(512, 2) mk_fwd(Params P) {
    extern __shared__ __attribute__((aligned(16))) unsigned char lds_raw[];
    unsigned ldsb = (unsigned)(size_t)(LAS unsigned char*)lds_raw; asm volatile("" : "+s"(ldsb));
    LAS unsigned char* lds = (LAS unsigned char*)ldsb;
    GAS unsigned char* ws = (GAS unsigned char*)P.ws;
    const int wave_s = __builtin_amdgcn_readfirstlane((int)(threadIdx.x >> 6));
    if (threadIdx.x < 16) ((LAS unsigned*)(lds + LDS_CTL))[threadIdx.x] = 0u;
    if (threadIdx.x == 0) {
#pragma unroll
        for (int i = 0; i < 30; ++i) ((LAS unsigned long long*)(lds + LDS_INTAB))[i] = (unsigned long long)P.in[i]; }
    __syncthreads();
#if MK_PER_PHASE
#define GRID_BAR() do { } while (0)
#else
    XcdBarrier bar = xcd_barrier_post((unsigned*)P.ws, (volatile LAS unsigned*)(lds + LDS_CTL), threadIdx.x == 0);
#define GRID_BAR() xcd_barrier(bar, my_tid(wave_s) == 0)
#endif
    const int lo = P.ph_lo, hi = P.ph_hi;
#define IN(k) (lo <= (k) && (k) < hi)
#define ON(j) (((PH_MASK) >> (j)) & 1)
#ifndef DUP_MASK
#define DUP_MASK 0
#endif
#define REPS(j) ((((DUP_MASK) >> (j)) & 1) ? 2 : 1)
#define SEAM(k) do { __syncthreads(); if (IN(k) && IN((k) + 1)) GRID_BAR(); } while (0)

    if (ON(0) && IN(0)) for (int rep = 0; rep < REPS(0); ++rep) { ph_prologue(lds, ws, wave_s); __syncthreads(); }
    SEAM(0);
    for (int l = 0; l < NL; ++l) {
        const int p0 = 1 + l * NPH;
        if (ON(1) && IN(p0 + 0)) for (int rep = 0; rep < REPS(1); ++rep) { ph_gemm_in(lds, ws, wave_s, l); __syncthreads(); }
        SEAM(p0 + 0);
        if (ON(2) && IN(p0 + 1)) for (int rep = 0; rep < REPS(2); ++rep) { ph_rwkv_prep(lds, ws, wave_s, l); __syncthreads(); ph_mla_prep(lds, ws, wave_s, l); __syncthreads(); }
        SEAM(p0 + 1);
        if (ON(3) && IN(p0 + 2)) for (int rep = 0; rep < REPS(3); ++rep) { ph_gemm_mla(lds, ws, wave_s, l); ph_dil(lds, ws, wave_s); __syncthreads(); ph_rwkv1(lds, ws, wave_s, l); __syncthreads(); }
        SEAM(p0 + 2);
        if (ON(4) && IN(p0 + 3)) for (int rep = 0; rep < REPS(4); ++rep) { if (blockIdx.x < 24) for (int r2 = 0; r2 < REPS(11); ++r2) ph_scan(lds, ws, wave_s, l); for (int r2 = 0; r2 < REPS(12); ++r2) ph_attn_queue(lds, ws, wave_s, l, rep * 2 + r2); __syncthreads(); }
        SEAM(p0 + 3);
        if (ON(4) && IN(p0 + 4)) for (int rep = 0; rep < REPS(13); ++rep) { ph_rwkv3(lds, ws, wave_s, l); __syncthreads(); }
        SEAM(p0 + 4);
        if (ON(5) && IN(p0 + 5)) for (int rep = 0; rep < REPS(5); ++rep) { ph_gemm_out(lds, ws, wave_s, l); __syncthreads(); }
        SEAM(p0 + 5);
        if (ON(6) && IN(p0 + 6)) ph_ln1(lds, ws, wave_s, l);
        SEAM(p0 + 6);
        if (ON(7) && IN(p0 + 7)) for (int rep = 0; rep < REPS(7); ++rep) { ph_moe1(lds, ws, wave_s, l); __syncthreads(); }
        SEAM(p0 + 7);
        if (ON(8) && IN(p0 + 8)) for (int rep = 0; rep < REPS(8); ++rep) { ph_moe2(lds, ws, wave_s, l); __syncthreads(); }
        SEAM(p0 + 8);
        if (ON(9) && IN(p0 + 9)) for (int rep = 0; rep < REPS(9); ++rep) { ph_ln2(lds, ws, wave_s, l); __syncthreads(); }
        SEAM(p0 + 9);
        if (ON(10) && IN(p0 + 10)) for (int rep = 0; rep < REPS(10); ++rep) { ph_ple(lds, ws, wave_s, l, P.out); __syncthreads(); }
        SEAM(p0 + 10);
    }
}

extern "C" void kernel_launch(void* const* d_in, const int* in_sizes, int n_in, void* d_out, int out_size, void* d_ws, size_t ws_size, hipStream_t stream) {
    static int grid = 0;
    if (grid == 0) {
        if (n_in != 30 || ws_size < WS_END) { fprintf(stderr, "kernel_launch: need 30 inputs and %zu bytes of workspace (got %d, %zu)\n", (size_t)WS_END, n_in, ws_size); grid = -1; return; }
        int dev = 0, cus = 0, per_cu = 0;
        if (hipGetDevice(&dev) != hipSuccess || hipDeviceGetAttribute(&cus, hipDeviceAttributeMultiprocessorCount, dev) != hipSuccess) { grid = -1; return; }
        if (hipFuncSetAttribute((const void*)mk_fwd, hipFuncAttributeMaxDynamicSharedMemorySize, LDS_BYTES) != hipSuccess) { fprintf(stderr, "kernel_launch: hipFuncSetAttribute failed\n"); grid = -1; return; }
        if (hipOccupancyMaxActiveBlocksPerMultiprocessor(&per_cu, (const void*)mk_fwd, 512, LDS_BYTES) != hipSuccess || per_cu < 1) { fprintf(stderr, "kernel_launch: occupancy query says %d\n", per_cu); }
        (void)hipGetLastError();
        grid = cus;
    }
    if (grid < 0) return;
    (void)hipMemsetAsync(d_ws, 0, CTL_BYTES, stream);
    Params p{};
    for (int i = 0; i < 30; ++i) p.in[i] = (const float*)d_in[i];
    p.out = (float*)d_out; p.ws = (unsigned char*)d_ws;
    const int nph = 1 + NL * NPH;
#if MK_PER_PHASE
    for (int k = 0; k < nph; ++k) { p.ph_lo = k; p.ph_hi = k + 1; hipLaunchKernelGGL(mk_fwd, dim3(grid), dim3(512), LDS_BYTES, stream, p); }
#else
    p.ph_lo = 0; p.ph_hi = nph;
    hipLaunchKernelGGL(mk_fwd, dim3(grid), dim3(512), LDS_BYTES, stream, p);
#endif
}
```

```cpp
#include <hip/hip_runtime.h>
#include <cstdio>
#include <cstdint>

#ifndef MK_PER_PHASE
#define MK_PER_PHASE 0
#endif

#define DI __device__ __forceinline__
#define LAS __attribute__((address_space(3)))
#define GAS __attribute__((address_space(1)))
typedef unsigned short bf16_t;
typedef short bf16x8 __attribute__((ext_vector_type(8)));
typedef float f32x2 __attribute__((ext_vector_type(2)));
typedef float f32x4 __attribute__((ext_vector_type(4)));
typedef float f32x16 __attribute__((ext_vector_type(16)));
typedef unsigned u32x2 __attribute__((ext_vector_type(2)));
typedef unsigned u32x4 __attribute__((ext_vector_type(4)));
typedef __bf16 hbf2 __attribute__((ext_vector_type(2)));

DI unsigned pack2(float lo, float hi) { return __builtin_bit_cast(unsigned, __builtin_convertvector((f32x2){lo, hi}, hbf2)); }
DI float bf2f(bf16_t b) { return __uint_as_float(((unsigned)b) << 16); }
DI float bflo(unsigned w) { return __uint_as_float(w << 16); }
DI float bfhi(unsigned w) { return __uint_as_float(w & 0xffff0000u); }
DI bf16_t f2bf(float f) { return (bf16_t)(pack2(f, 0.f) & 0xffffu); }
DI float wave_sum(float v) { for (int o = 32; o >= 1; o >>= 1) v += __shfl_xor(v, o); return v; }
DI float sigmoidf_(float x) { return 1.0f / (1.0f + __expf(-x)); }

constexpr int T = 8192, SEQ = 4096, D = 2048, NL = 4, PLE = 256;
constexpr int ZLD = 8192;
constexpr int ZC_DQ = 2560, ZC_DK = 4096, ZC_DV = 5632, ZC_QA = 7168, ZC_KVA = 7680, ZC_KR = 7936;
constexpr int NEXP = 32, DEXP = 512, HB_ROWS = 24576;
constexpr float ALPHA = 1.681792830507429f;
constexpr float LOG2E = 1.4426950408889634f;

constexpr size_t CTL_BYTES = 65536;
constexpr size_t WS_WIN = CTL_BYTES;                              constexpr size_t SZ_WIN = (size_t)NL * 8192 * 2048 * 2;
constexpr size_t WS_WOUT = WS_WIN + SZ_WIN;                       constexpr size_t SZ_WOUT = (size_t)NL * 2048 * 2048 * 2;
constexpr size_t WS_WPG = WS_WOUT + SZ_WOUT;                      constexpr size_t SZ_WPG = SZ_WOUT;
constexpr size_t WS_WPP = WS_WPG + SZ_WPG;                        constexpr size_t SZ_WPP = (size_t)NL * 2048 * 256 * 2;
constexpr size_t WS_WGU = WS_WPP + SZ_WPP;                        constexpr size_t SZ_WGU = (size_t)NL * 32 * 1024 * 2048 * 2;
constexpr size_t WS_WDN = WS_WGU + SZ_WGU;                        constexpr size_t SZ_WDN = (size_t)NL * 32 * 2048 * 512 * 2;
constexpr size_t WS_WUQ = WS_WDN + SZ_WDN;                        constexpr size_t SZ_WUQ = (size_t)NL * 1280 * 512 * 2;
constexpr size_t WS_WUKV = WS_WUQ + SZ_WUQ;                       constexpr size_t SZ_WUKV = (size_t)NL * 1536 * 256 * 2;
constexpr size_t WS_ROPE = WS_WUKV + SZ_WUKV;                     constexpr size_t SZ_ROPE = (size_t)4096 * 32 * 8;
constexpr size_t WS_PBF = WS_ROPE + SZ_ROPE;                      constexpr size_t SZ_PBF = (size_t)NL * T * 256 * 2;
constexpr size_t WS_XCUR = WS_PBF + SZ_PBF;                       constexpr size_t SZ_XF = (size_t)T * D * 4;
constexpr size_t WS_XBF = WS_XCUR + SZ_XF;                        constexpr size_t SZ_XB = (size_t)T * D * 2;
constexpr size_t WS_Z = WS_XBF + SZ_XB;                           constexpr size_t SZ_Z = (size_t)T * ZLD * 2;
constexpr size_t SZ_RW1 = (size_t)T * 768 * 4;
constexpr size_t WS_RW = WS_Z + SZ_Z;
constexpr size_t WS_RK = WS_RW + 7 * SZ_RW1;                      constexpr size_t SZ_RK = (size_t)T * 16 * 4;
constexpr size_t WS_QN = WS_RK + SZ_RK;                           constexpr size_t SZ_QN = (size_t)T * 512 * 2;
constexpr size_t WS_KVN = WS_QN + SZ_QN;                          constexpr size_t SZ_KVN = (size_t)T * 256 * 2;
constexpr size_t WS_KROPE = WS_KVN + SZ_KVN;                      constexpr size_t SZ_KROPE = (size_t)T * 64 * 2;
constexpr size_t WS_VTD = WS_KROPE + SZ_KROPE;                    constexpr size_t SZ_VTD = (size_t)2 * 12 * 128 * 4096 * 2;
constexpr size_t WS_QB = WS_VTD + SZ_VTD;                         constexpr size_t SZ_QB = (size_t)T * 1280 * 2;
constexpr size_t WS_KC = WS_QB + SZ_QB;                           constexpr size_t SZ_KC = (size_t)T * 768 * 2;
constexpr size_t WS_VT = WS_KC + SZ_KC;                           constexpr size_t SZ_VT = (size_t)768 * 8192 * 2;
constexpr size_t WS_OP = WS_VT + SZ_VT;                           constexpr size_t SZ_OP = (size_t)3 * T * 512 * 2;
constexpr size_t WS_LSE = WS_OP + SZ_OP;                          constexpr size_t SZ_LSE = (size_t)3 * T * 4 * 4;
constexpr size_t WS_MIX = WS_LSE + SZ_LSE;                        constexpr size_t SZ_MIX = SZ_XB;
constexpr size_t WS_TMP = WS_MIX + SZ_MIX;
constexpr size_t WS_X1 = WS_TMP + SZ_XF;
constexpr size_t WS_X1BF = WS_X1 + SZ_XF;
constexpr size_t WS_PP = WS_X1BF + SZ_XB;
constexpr size_t WS_TOKL = WS_PP + SZ_XB;                         constexpr size_t SZ_TOKL = (size_t)32 * 8192 * 4;
constexpr size_t WS_GATE = WS_TOKL + SZ_TOKL;                     constexpr size_t SZ_GATE = (size_t)T * 2 * 4;
constexpr size_t WS_HB = WS_GATE + SZ_GATE;                       constexpr size_t SZ_HB = (size_t)HB_ROWS * 512 * 2;
constexpr size_t WS_YBT = WS_HB + SZ_HB;                          constexpr size_t SZ_YBT = (size_t)T * 2 * 2048 * 2;
constexpr size_t WS_AC = WS_YBT + SZ_YBT;                         constexpr size_t SZ_CH4 = (size_t)1536 * 64 * 64 * 4;
constexpr size_t WS_GC = WS_AC + SZ_CH4;
constexpr size_t WS_Y0 = WS_GC + SZ_CH4;
constexpr size_t WS_QC = WS_Y0 + SZ_CH4;                          constexpr size_t SZ_CH2 = (size_t)1536 * 64 * 64 * 2;
constexpr size_t WS_SST = WS_QC + SZ_CH2;
constexpr size_t WS_OPM = WS_SST + SZ_CH2;                        constexpr size_t SZ_OPM = (size_t)4 * T * 768 * 2;
constexpr size_t WS_LSEM = WS_OPM + SZ_OPM;                       constexpr size_t SZ_LSEM = (size_t)4 * T * 8 * 4;
constexpr size_t WS_END = WS_LSEM + SZ_LSEM;
constexpr int CW_MOECNT = 4096;
constexpr int CW_QUEUE = 8192;

constexpr int LDS_STAGE = 131072;
constexpr int LDS_CTL = 131072;
constexpr int LDS_UTAB = LDS_CTL + 64;
constexpr int LDS_MOE = LDS_UTAB + 1024;
constexpr int LDS_INTAB = LDS_MOE + 1536;
constexpr int LDS_ROWL = 131072 + 4096;
constexpr int LDS_BYTES = 131072 + 8192;

#define XB_TMO      128
#define XB_XCNT(j)  (256  + 64 * (j))
#define XB_XSUB(j)  (1280 + 64 * (j))
#define XB_XGEN(j)  (2304 + 64 * (j))
#define XB_TOP      3328
#define XB_TOPGEN   3392
#define XCD_BAR_WORDS 3456
#define XB_SPIN_CAP (1u << 22)

__device__ __forceinline__ unsigned xb_ld(unsigned* p)              { return __hip_atomic_load(p, __ATOMIC_RELAXED, __HIP_MEMORY_SCOPE_AGENT); }
__device__ __forceinline__ unsigned xb_add(unsigned* p, unsigned v) { return __hip_atomic_fetch_add(p, v, __ATOMIC_RELAXED, __HIP_MEMORY_SCOPE_AGENT); }
__device__ __forceinline__ unsigned xb_xcc_id() { return (unsigned)__builtin_amdgcn_s_getreg((3 << 11) | 20) & 0xFu; }
#define XB_SPIN(cond, bar) do { unsigned _sp = 0; while (cond) { __builtin_amdgcn_s_sleep(1); \
    if ((++_sp & 255u) == 0u) { if (xb_ld(&(bar)[XB_TMO])) break; if (_sp > XB_SPIN_CAP) { atomicAdd(&(bar)[XB_TMO], 1u); break; } } } } while (0)

struct XcdBarrier { unsigned* bar; unsigned x; volatile LAS unsigned* st; };

__device__ __forceinline__ XcdBarrier xcd_barrier_post(unsigned* bar, volatile LAS unsigned* st, bool leader) {
    XcdBarrier b; b.bar = bar; b.x = xb_xcc_id(); b.st = st;
    if (leader) (void)xb_add(&bar[XB_XCNT(b.x)], 1u);
    return b;
}
__device__ __forceinline__ void xcd_barrier_complete(unsigned* bar, unsigned x, unsigned& nloc, unsigned& nx) {
    const unsigned G = gridDim.x * gridDim.y * gridDim.z;
    unsigned sum, cnt, mine, sp = 0u;
    for (;;) {
        sum = 0u; cnt = 0u; mine = 0u;
#pragma unroll
        for (unsigned j = 0; j < 16; ++j) { const unsigned c = xb_ld(&bar[XB_XCNT(j)]); sum += c; cnt += (c > 0u) ? 1u : 0u; mine = (j == x) ? c : mine; }
        if (sum == G) break;
        __builtin_amdgcn_s_sleep(1);
        if ((++sp & 255u) == 0u) { if (xb_ld(&bar[XB_TMO])) break; if (sp > XB_SPIN_CAP) { atomicAdd(&bar[XB_TMO], 1u); break; } }
    }
    nloc = mine > 0u ? mine : 1u; nx = cnt > 0u ? cnt : 1u;
}
__device__ __forceinline__ void xcd_barrier(const XcdBarrier& b, bool leader) {
    asm volatile("s_waitcnt vmcnt(0)" ::: "memory");
    __syncthreads();
    if (leader) {
        unsigned* bar = b.bar;
        __builtin_amdgcn_s_waitcnt(0);
        unsigned nloc = b.st[0], nx = b.st[1];
        if (nloc == 0u) { xcd_barrier_complete(bar, b.x, nloc, nx); b.st[0] = nloc; b.st[1] = nx; }
        const unsigned old = xb_add(&bar[XB_XSUB(b.x)], 1u);
        const unsigned gen = old / nloc;
        if (old + 1u == (gen + 1u) * nloc) {
            __builtin_amdgcn_fence(__ATOMIC_RELEASE, "agent");
            asm volatile("s_waitcnt vmcnt(0)" ::: "memory");
            const unsigned og = xb_add(&bar[XB_TOP], 1u);
            const unsigned tg = og / nx;
            if (og + 1u == (tg + 1u) * nx) xb_add(&bar[XB_TOPGEN], 1u);
            else XB_SPIN(xb_ld(&bar[XB_TOPGEN]) == tg, bar);
            __builtin_amdgcn_fence(__ATOMIC_ACQUIRE, "agent");
            xb_add(&bar[XB_XGEN(b.x)], 1u);
            asm volatile("s_waitcnt vmcnt(0)" ::: "memory");
        } else {
            XB_SPIN(xb_ld(&bar[XB_XGEN(b.x)]) == gen, bar);
            __builtin_amdgcn_fence(__ATOMIC_ACQUIRE, "agent");
            asm volatile("s_waitcnt vmcnt(0)" ::: "memory");
        }
    }
    __syncthreads();
}

namespace pg8 {
constexpr int BM = 256, BK = 64, HALF = 128, HTB = HALF * BK * 2, STAGE_BYTES = 8 * HTB, NXCD = 8, WGM = 8;
DI int lds_byte(int r, int c) { const int st = (r >> 4) * 2 + (c >> 5), rr = r & 15, cc = c & 31, ob = rr * 64 + cc * 2; return st * 1024 + (ob ^ (((ob >> 9) & 1) << 5)); }
DI void stage_rc(int b, int& R, int& C) { const int st = b / 1024, sb = b % 1024, swz = sb ^ (((sb >> 9) & 1) << 5); R = (st >> 1) * 16 + swz / 64; C = (st & 1) * 32 + (swz % 64) / 2; }
DI int perm32(int rho) { const int n = rho >> 4, i = rho & 15; return 8 * (i >> 2) + 4 * n + (i & 3); }

struct Unit { GAS const char* a; GAS const char* b; GAS char* out; int K, ldc, row0, col0, aux0, aux1; };
constexpr int UD = 12;
DI void unit_put(LAS int* tab, int i, const void* a, const void* b, void* o, int K, int ldc, int row0, int col0, int aux0, int aux1) {
    LAS int* p = tab + i * UD; const unsigned long long ua = (unsigned long long)a, ub = (unsigned long long)b, uo = (unsigned long long)o;
    p[0] = (int)(unsigned)ua; p[1] = (int)(unsigned)(ua >> 32); p[2] = (int)(unsigned)ub; p[3] = (int)(unsigned)(ub >> 32); p[4] = (int)(unsigned)uo; p[5] = (int)(unsigned)(uo >> 32);
    p[6] = K; p[7] = ldc; p[8] = row0; p[9] = col0; p[10] = aux0; p[11] = aux1;
}
DI void unit_get(const LAS int* tab, int i, Unit& u) {
    const LAS int* p = tab + i * UD; int v[UD];
#pragma unroll
    for (int j = 0; j < UD; ++j) v[j] = __builtin_amdgcn_readfirstlane(p[j]);
    u.a = (GAS const char*)(((unsigned long long)(unsigned)v[1] << 32) | (unsigned)v[0]);
    u.b = (GAS const char*)(((unsigned long long)(unsigned)v[3] << 32) | (unsigned)v[2]);
    u.out = (GAS char*)(((unsigned long long)(unsigned)v[5] << 32) | (unsigned)v[4]);
    u.K = v[6]; u.ldc = v[7]; u.row0 = v[8]; u.col0 = v[9]; u.aux0 = v[10]; u.aux1 = v[11];
}
DI void build_dense(LAS int* tab, int& n, int& Lbase, const void* A, const void* Bt, void* out, int esz, int M, int N, int K, int ldc, int G, int c) {
    const int nM = M / BM, nN = N / BM, nwg = nM * nN;
    int L = c; if (L < Lbase) L += ((Lbase - L + G - 1) / G) * G;
    for (; L < Lbase + nwg; L += G) {
        int wgid = L - Lbase; { const int q = nwg / NXCD, r = nwg % NXCD, xcd = wgid % NXCD, off = wgid / NXCD; wgid = (xcd < r ? xcd * (q + 1) : r * (q + 1) + (xcd - r) * q) + off; }
        const int nig = WGM * nN, gid = wgid / nig, fm = gid * WGM, gsz = (nM - fm) < WGM ? (nM - fm) : WGM;
        const int pm = fm + ((wgid % nig) % gsz), pn = (wgid % nig) / gsz;
        unit_put(tab, n, (const char*)A + (size_t)pm * BM * K * 2, (const char*)Bt + (size_t)pn * BM * K * 2, out, K, ldc, pm * BM, pn * BM, 0, BM); ++n;
    }
    Lbase += nwg;
}

template <class Epi, bool GATHER>
DI void gemm_phase(LAS unsigned char* lds, const int tid, const LAS int* utab, const int nunits, const LAS int* rowl, const Epi& E) {
    const int wid = __builtin_amdgcn_readfirstlane(tid >> 6), lane = tid & 63, wr = wid >> 2, wc = wid & 3, fr = lane & 15, fq = lane >> 4;
    const size_t kstep = (size_t)(BK * 2);
    const unsigned ldsw = (unsigned)wid * 1024u;
    const int aoff = lds_byte(wr * 64 + fr, fq * 8), boff = lds_byte(wc * 32 + fr, fq * 8);
#define PG8_SA(b, h) (((b) * 2 + (h)) * HTB)
#define PG8_SB(b, h) ((4 + (b) * 2 + (h)) * HTB)
#define PG8_STAGE(bufoff, gbase, voff) do { _Pragma("unroll") for (int _i = 0; _i < 2; ++_i) \
        __builtin_amdgcn_global_load_lds((GAS const unsigned*)((gbase) + (voff)[_i]), (LAS unsigned*)(lds + (bufoff) + ldsw + _i * 8192), 16, 0, 0); } while (0)
#define PG8_LDA(dst, b, h) do { _Pragma("unroll") for (int m = 0; m < 4; ++m) _Pragma("unroll") for (int k = 0; k < 2; ++k) dst[m][k] = *(const LAS bf16x8*)(lds + PG8_SA(b, h) + aoff + m * 2048 + k * 1024); } while (0)
#define PG8_LDB(dst, b, h) do { _Pragma("unroll") for (int n = 0; n < 2; ++n) _Pragma("unroll") for (int k = 0; k < 2; ++k) dst[n][k] = *(const LAS bf16x8*)(lds + PG8_SB(b, h) + boff + n * 2048 + k * 1024); } while (0)
#define PG8_MMA(ai, bj, At, Bt) do { __builtin_amdgcn_s_setprio(1); _Pragma("unroll") for (int m = 0; m < 4; ++m) _Pragma("unroll") for (int n = 0; n < 2; ++n) _Pragma("unroll") for (int k = 0; k < 2; ++k) \
        acc[ai][bj][m][n] = __builtin_amdgcn_mfma_f32_16x16x32_bf16(Bt[n][k], At[m][k], acc[ai][bj][m][n], 0, 0, 0); __builtin_amdgcn_s_setprio(0); } while (0)
#define PG8_WAIT_V(n) asm volatile("s_waitcnt vmcnt(" #n ")" ::: "memory")
#define PG8_WAIT_L(n) asm volatile("s_waitcnt lgkmcnt(" #n ")" ::: "memory")
#define PG8_BAR __builtin_amdgcn_s_barrier()
#define PG8_SCHED __builtin_amdgcn_sched_barrier(0)
#define PG8_RC(R_, C_, Rb_, i_) int R_, C_; { int t_ = tid; asm volatile("" : "+v"(t_)); stage_rc(t_ * 16 + (i_) * 8192, R_, C_); } const int Rb_ = Epi::PERM ? ((R_ & ~31) + perm32(R_ & 31)) : R_
#define PG8_VOFF_D(va, vb, K_) do { _Pragma("unroll") for (int _i = 0; _i < 2; ++_i) { PG8_RC(_R, _C, _Rb, _i); va[0][_i] = (unsigned)(_R * (K_) + _C) * 2u; va[1][_i] = va[0][_i]; vb[_i] = (unsigned)(_Rb * (K_) + _C) * 2u; } } while (0)
#define PG8_VOFF_G(va, K_, ui_) do { _Pragma("unroll") for (int _i = 0; _i < 2; ++_i) { PG8_RC(_R, _C, _Rb, _i); (void)_Rb; _Pragma("unroll") for (int _h = 0; _h < 2; ++_h) { \
        const int _r = rowl[(ui_) * BM + _h * HALF + _R]; va[_h][_i] = (unsigned)(_r * (K_) + _C) * 2u; } } } while (0)
    if (nunits <= 0) return;
    Unit cur, nxt; int ui = 0;
    unit_get(utab, 0, cur);
    f32x4 acc[2][2][4][2];
#pragma unroll
    for (int a = 0; a < 2; ++a)
#pragma unroll
        for (int b = 0; b < 2; ++b)
#pragma unroll
            for (int m = 0; m < 4; ++m)
#pragma unroll
                for (int n = 0; n < 2; ++n) acc[a][b][m][n] = (f32x4){0.f, 0.f, 0.f, 0.f};
    bf16x8 At[4][2], B0[2][2], B1[2][2];
    unsigned vc[2][2], vbc[2], vn[2][2];
    PG8_VOFF_D(vc, vbc, cur.K);
    if (GATHER) PG8_VOFF_G(vc, cur.K, 0);
    GAS const char* cA = cur.a; GAS const char* cB = cur.b;
    size_t hsc = (size_t)HALF * cur.K * 2;
    size_t hsa = GATHER ? (size_t)0 : hsc;
    PG8_STAGE(PG8_SB(0, 0), cB, vbc); PG8_STAGE(PG8_SA(0, 0), cA, vc[0]); PG8_STAGE(PG8_SB(0, 1), cB + hsc, vbc); PG8_STAGE(PG8_SA(0, 1), cA + hsa, vc[1]);
    if (wr == 1) PG8_BAR;
    PG8_WAIT_V(4); PG8_BAR;
    PG8_STAGE(PG8_SB(1, 0), cB + kstep, vbc); PG8_STAGE(PG8_SA(1, 0), cA + kstep, vc[0]); PG8_STAGE(PG8_SB(1, 1), cB + hsc + kstep, vbc);
    PG8_WAIT_V(6); PG8_BAR;
    for (;;) {
        const bool has_next = (ui + 1 < nunits);
        if (has_next) { unit_get(utab, ui + 1, nxt); if (GATHER) PG8_VOFF_G(vn, nxt.K, ui + 1); }
        else { nxt = cur;
            if (GATHER) {
#pragma unroll
                for (int i = 0; i < 2; ++i) { vn[0][i] = vc[0][i]; vn[1][i] = vc[1][i]; } } }
        GAS const char* nA = nxt.a; GAS const char* nB = nxt.b;
        const int nt = cur.K / BK;
        for (int t = 0; t < nt; t += 2) {
            const bool last = (t == nt - 2);
            GAS const char* a1 = cA + (size_t)(t + 1) * kstep;
            GAS const char* a2 = last ? nA : cA + (size_t)(t + 2) * kstep; GAS const char* b2 = last ? nB : cB + (size_t)(t + 2) * kstep;
            GAS const char* a3 = a2 + kstep; GAS const char* b3 = b2 + kstep;
            PG8_LDB(B0, 0, 0); PG8_SCHED; PG8_LDA(At, 0, 0); PG8_STAGE(PG8_SA(1, 1), a1 + hsa, vc[1]);
            if (last) {
                if (GATHER) {
#pragma unroll
                    for (int i = 0; i < 2; ++i) { vc[0][i] = vn[0][i]; vc[1][i] = vn[1][i]; } }
                if (nxt.K != cur.K) {
                    if (!GATHER) PG8_VOFF_D(vc, vbc, nxt.K);
                    else {
#pragma unroll
                        for (int i = 0; i < 2; ++i) { PG8_RC(R_, C_, Rb_, i); (void)R_; vbc[i] = (unsigned)(Rb_ * nxt.K + C_) * 2u; } }
                    hsc = (size_t)HALF * nxt.K * 2; hsa = GATHER ? (size_t)0 : hsc; } }
            PG8_WAIT_L(8); PG8_BAR; PG8_WAIT_L(0); PG8_MMA(0, 0, At, B0); PG8_BAR; PG8_SCHED;
            PG8_LDB(B1, 0, 1); PG8_STAGE(PG8_SB(0, 0), b2, vbc);
            PG8_BAR; PG8_WAIT_L(0); PG8_MMA(0, 1, At, B1); PG8_BAR;
            PG8_LDA(At, 0, 1); PG8_STAGE(PG8_SA(0, 0), a2, vc[0]);
            PG8_BAR; PG8_WAIT_L(0); PG8_MMA(1, 0, At, B0); PG8_BAR; PG8_SCHED;
            PG8_STAGE(PG8_SB(0, 1), b2 + hsc, vbc);
            PG8_WAIT_V(6); PG8_BAR; PG8_MMA(1, 1, At, B1); PG8_BAR;
            PG8_LDB(B0, 1, 0); PG8_SCHED; PG8_LDA(At, 1, 0); PG8_STAGE(PG8_SA(0, 1), a2 + hsa, vc[1]);
            PG8_WAIT_L(8); PG8_BAR; PG8_WAIT_L(0); PG8_MMA(0, 0, At, B0); PG8_BAR; PG8_SCHED;
            PG8_LDB(B1, 1, 1); PG8_STAGE(PG8_SB(1, 0), b3, vbc);
            PG8_BAR; PG8_WAIT_L(0); PG8_MMA(0, 1, At, B1); PG8_BAR;
            PG8_LDA(At, 1, 1); PG8_STAGE(PG8_SA(1, 0), a3, vc[0]);
            PG8_BAR; PG8_WAIT_L(0); PG8_MMA(1, 0, At, B0); PG8_BAR; PG8_SCHED;
            PG8_STAGE(PG8_SB(1, 1), b3 + hsc, vbc);
            PG8_WAIT_V(6); PG8_BAR; PG8_MMA(1, 1, At, B1); PG8_BAR;
        }
        E(acc, cur, ui, wr, wc, fr, fq);
        if (!has_next) break;
#pragma unroll
        for (int a = 0; a < 2; ++a)
#pragma unroll
            for (int b = 0; b < 2; ++b)
#pragma unroll
                for (int m = 0; m < 4; ++m)
#pragma unroll
                    for (int n = 0; n < 2; ++n) acc[a][b][m][n] = (f32x4){0.f, 0.f, 0.f, 0.f};
        cur = nxt; cA = nA; cB = nB; ++ui;
    }
    PG8_WAIT_V(0);
    if (wr == 0) PG8_BAR;
    PG8_BAR;
#undef PG8_SA
#undef PG8_SB
#undef PG8_STAGE
#undef PG8_LDA
#undef PG8_LDB
#undef PG8_MMA
#undef PG8_WAIT_V
#undef PG8_WAIT_L
#undef PG8_BAR
#undef PG8_SCHED
#undef PG8_VOFF_D
#undef PG8_RC
#undef PG8_VOFF_G
}

struct EpiBf16 {
    static constexpr bool PERM = true;
    DI void operator()(const f32x4 (&acc)[2][2][4][2], const Unit& u, int, int wr, int wc, int fr, int fq) const {
        const int row0 = u.row0 + wr * 64 + fr, col0 = u.col0 + wc * 32 + 8 * fq; GAS bf16_t* O = (GAS bf16_t*)u.out; const int ldc = u.ldc;
#pragma unroll
        for (int ai = 0; ai < 2; ++ai)
#pragma unroll
            for (int m = 0; m < 4; ++m) { GAS bf16_t* rowp = O + (size_t)(row0 + ai * HALF + m * 16) * ldc + col0;
#pragma unroll
                for (int bj = 0; bj < 2; ++bj) { const f32x4 v0 = acc[ai][bj][m][0], v1 = acc[ai][bj][m][1];
                    u32x4 w; w.x = pack2(v0[0], v0[1]); w.y = pack2(v0[2], v0[3]); w.z = pack2(v1[0], v1[1]); w.w = pack2(v1[2], v1[3]);
                    *(GAS u32x4*)(rowp + bj * HALF) = w; } }
    }
};
struct EpiF32 {
    static constexpr bool PERM = false;
    DI void operator()(const f32x4 (&acc)[2][2][4][2], const Unit& u, int, int wr, int wc, int fr, int fq) const {
        const int row0 = u.row0 + wr * 64 + fr, col0 = u.col0 + wc * 32 + 4 * fq; GAS float* C = (GAS float*)u.out; const int ldc = u.ldc;
#pragma unroll
        for (int ai = 0; ai < 2; ++ai)
#pragma unroll
            for (int m = 0; m < 4; ++m) { GAS float* rowp = C + (size_t)(row0 + ai * HALF + m * 16) * ldc + col0;
#pragma unroll
                for (int bj = 0; bj < 2; ++bj)
#pragma unroll
                    for (int n = 0; n < 2; ++n) *(GAS f32x4*)(rowp + bj * HALF + n * 16) = acc[ai][bj][m][n]; }
    }
};
struct EpiGU {
    static constexpr bool PERM = true;
    DI void operator()(const f32x4 (&acc)[2][2][4][2], const Unit& u, int, int wr, int wc, int fr, int fq) const {
        const int row0 = u.row0 + wr * 64 + fr, col0 = (u.col0 >> 1) + wc * 32 + 8 * fq; GAS bf16_t* H = (GAS bf16_t*)u.out;
#pragma unroll
        for (int ai = 0; ai < 2; ++ai)
#pragma unroll
            for (int m = 0; m < 4; ++m) { GAS bf16_t* rowp = H + (size_t)(row0 + ai * HALF + m * 16) * DEXP + col0;
                float o[8];
#pragma unroll
                for (int n = 0; n < 2; ++n)
#pragma unroll
                    for (int j = 0; j < 4; ++j) { const float g = acc[ai][0][m][n][j], up = acc[ai][1][m][n][j]; o[n * 4 + j] = g / (1.0f + __expf(-g)) * up; }
                u32x4 w; w.x = pack2(o[0], o[1]); w.y = pack2(o[2], o[3]); w.z = pack2(o[4], o[5]); w.w = pack2(o[6], o[7]);
                *(GAS u32x4*)rowp = w; }
    }
};
struct EpiScatter {
    static constexpr bool PERM = true;
    const LAS int* rowl;
    DI void operator()(const f32x4 (&acc)[2][2][4][2], const Unit& u, int ui, int wr, int wc, int fr, int fq) const {
        const int col0 = u.col0 + wc * 32 + 8 * fq; GAS bf16_t* Y = (GAS bf16_t*)u.out;
#pragma unroll
        for (int ai = 0; ai < 2; ++ai)
#pragma unroll
            for (int m = 0; m < 4; ++m) { const int t2 = rowl[ui * BM + ai * HALF + wr * 64 + m * 16 + fr];
                if (t2 >= 0) { GAS bf16_t* rowp = Y + (size_t)t2 * D + col0;
#pragma unroll
                    for (int bj = 0; bj < 2; ++bj) { const f32x4 v0 = acc[ai][bj][m][0], v1 = acc[ai][bj][m][1];
                        u32x4 w; w.x = pack2(v0[0], v0[1]); w.y = pack2(v0[2], v0[3]); w.z = pack2(v1[0], v1[1]); w.w = pack2(v1[2], v1[3]);
                        *(GAS u32x4*)(rowp + bj * HALF) = w; } }
                asm volatile("" ::: "memory"); }
    }
};
struct EpiPle {
    static constexpr bool PERM = false;
    const float* x2; const bf16_t* pp; bf16_t* xb;
    DI void operator()(const f32x4 (&acc)[2][2][4][2], const Unit& u, int, int wr, int wc, int fr, int fq) const {
        const int row0 = u.row0 + wr * 64 + fr, col0 = u.col0 + wc * 32 + 4 * fq; GAS float* out = (GAS float*)u.out;
#pragma unroll
        for (int ai = 0; ai < 2; ++ai)
#pragma unroll
            for (int m = 0; m < 4; ++m) { const size_t ro = (size_t)(row0 + ai * HALF + m * 16) * D + col0;
#pragma unroll
                for (int bj = 0; bj < 2; ++bj)
#pragma unroll
                    for (int n = 0; n < 2; ++n) { const size_t o = ro + bj * HALF + n * 16;
                        const f32x4 xv = *(const f32x4*)(x2 + o); const u32x2 pw = *(const u32x2*)(pp + o); const f32x4 a = acc[ai][bj][m][n];
                        f32x4 r; r[0] = xv[0] + bflo(pw.x) / (1.0f + __expf(-a[0])); r[1] = xv[1] + bfhi(pw.x) / (1.0f + __expf(-a[1]));
                        r[2] = xv[2] + bflo(pw.y) / (1.0f + __expf(-a[2])); r[3] = xv[3] + bfhi(pw.y) / (1.0f + __expf(-a[3]));
                        *(GAS f32x4*)(out + o) = r;
                        if (xb) { u32x2 w; w.x = pack2(r[0], r[1]); w.y = pack2(r[2], r[3]); *(u32x2*)(xb + o) = w; } }
                asm volatile("" ::: "memory"); }
    }
};
}

struct Params { const float* in[30]; float* out; unsigned char* ws; int ph_lo, ph_hi; };
struct Frame {
    LAS unsigned char* lds; int tid, lane, wave, G, wg;
    GAS unsigned char* ws; unsigned* ctl;
};
#define WSP(T_, off) ((T_*)(GAS T_*)(F.ws + (off)))
#define INP(i_) ((const float*)(GAS const float*)rfl64(((const LAS unsigned long long*)(F.lds + LDS_INTAB))[i_]))
DI unsigned long long rfl64(unsigned long long v) {
    return ((unsigned long long)(unsigned)__builtin_amdgcn_readfirstlane((int)(unsigned)(v >> 32)) << 32) | (unsigned)__builtin_amdgcn_readfirstlane((int)(unsigned)v);
}
DI int my_tid(int wave) { return (wave << 6) | (int)__builtin_amdgcn_mbcnt_hi(~0u, __builtin_amdgcn_mbcnt_lo(~0u, 0u)); }
DI Frame make_frame(LAS unsigned char* lds, GAS unsigned char* ws, int wave) {
    Frame F;
    int wv = __builtin_amdgcn_readfirstlane(wave); asm volatile("" : "+s"(wv));
    int tid = my_tid(wv); asm volatile("" : "+v"(tid));
    unsigned l32 = (unsigned)__builtin_amdgcn_readfirstlane((int)(unsigned)(size_t)lds); asm volatile("" : "+s"(l32));
    unsigned long long w64 = rfl64((unsigned long long)ws); asm volatile("" : "+s"(w64));
    F.lds = (LAS unsigned char*)l32; F.tid = tid; F.lane = tid & 63; F.wave = wv;
    F.G = gridDim.x; F.wg = blockIdx.x;
    F.ws = (GAS unsigned char*)w64;
    F.ctl = (unsigned*)(GAS unsigned*)F.ws;
    return F;
}
#define PHASE_FN __device__ __forceinline__ void
#define GEMM_FN __device__ __forceinline__ void
#define PHASE_ARGS LAS unsigned char* lds_, GAS unsigned char* ws_, int wave_
#define PHASE_FRAME const Frame F = make_frame(lds_, ws_, wave_)

template <int MODE> DI int rowmap(int n, int which) {
    if (MODE == 0) return n;
    if (MODE == 1) return (n >> 7) * 256 + which * 128 + (n & 127);
    const int h = n >> 8, c = n & 255; return c < 128 ? h * 128 + c : 768 + h * 128 + (c - 128);
}
template <int MODE>
DI void convert_t(const Frame F, const float* src, int K, int N, bf16_t* dst, int which, int nmat, size_t src_ms, size_t dst_ms) {
    LAS float* tile = (LAS float*)F.lds;
    const int nkt = K / 64, nnt = (N + 255) / 256, per = nkt * nnt, total = per * nmat;
    const int tid = F.tid;
    f32x4 reg[8];
    int ti = F.wg;
#define CONV_ISSUE(t_) do { const int t__ = (t_); const int mat_ = t__ / per, rem_ = t__ - mat_ * per, kt_ = rem_ / nnt, ntl_ = rem_ - kt_ * nnt; \
        const float* s_ = src + (size_t)mat_ * src_ms + (size_t)(kt_ * 64) * N + ntl_ * 256; const int n4_ = tid & 63, n_ = ntl_ * 256 + n4_ * 4; \
        _Pragma("unroll") for (int i_ = 0; i_ < 8; ++i_) { const int kr_ = (tid >> 6) + 8 * i_; reg[i_] = (n_ < N) ? *(const f32x4*)(s_ + (size_t)kr_ * N + n4_ * 4) : (f32x4){0.f, 0.f, 0.f, 0.f}; } } while (0)
    if (ti < total) CONV_ISSUE(ti);
    for (; ti < total; ti += F.G) {
#pragma unroll
        for (int i = 0; i < 8; ++i) { const int kr = (tid >> 6) + 8 * i; *(LAS f32x4*)(tile + kr * 260 + (tid & 63) * 4) = reg[i]; }
        __syncthreads();
        const int mat = ti / per, rem = ti - mat * per, kt = rem / nnt, nt_ = rem - kt * nnt;
        if (ti + F.G < total) CONV_ISSUE(ti + F.G);
        bf16_t* d = dst + (size_t)mat * dst_ms + kt * 64;
#pragma unroll
        for (int i = 0; i < 4; ++i) {
            const int nl = (tid >> 3) + 64 * i, kg = tid & 7, n = nt_ * 256 + nl;
            if (n < N) {
                float v[8];
#pragma unroll
                for (int j = 0; j < 8; ++j) v[j] = tile[(kg * 8 + j) * 260 + nl];
                u32x4 w; w.x = pack2(v[0], v[1]); w.y = pack2(v[2], v[3]); w.z = pack2(v[4], v[5]); w.w = pack2(v[6], v[7]);
                *(u32x4*)(d + (size_t)rowmap<MODE>(n, which) * K + kg * 8) = w;
            }
        }
        __syncthreads();
    }
}
DI void zero_rows(const Frame F, bf16_t* dst, size_t nelem) {
    for (size_t i = ((size_t)F.wg * 512 + F.tid) * 8; i < nelem; i += (size_t)F.G * 512 * 8) *(u32x4*)(dst + i) = (u32x4){0u, 0u, 0u, 0u};
}
DI void cvt_plain(const Frame F, const float* src, bf16_t* dst, size_t nelem) {
    for (size_t i = ((size_t)F.wg * 512 + F.tid) * 4; i < nelem; i += (size_t)F.G * 512 * 4) {
        const f32x4 v = *(const f32x4*)(src + i); u32x2 w; w.x = pack2(v[0], v[1]); w.y = pack2(v[2], v[3]); *(u32x2*)(dst + i) = w; }
}
DI void p_prologue(const Frame F) {
    convert_t<0>(F, INP(2), 2048, 8000, WSP(bf16_t, WS_WIN), 0, NL, (size_t)2048 * 8000, (size_t)8192 * 2048);
    for (int l = 0; l < NL; ++l) zero_rows(F, WSP(bf16_t, WS_WIN) + (size_t)l * 8192 * 2048 + (size_t)8000 * 2048, (size_t)192 * 2048);
    convert_t<0>(F, INP(18), 2048, 2048, WSP(bf16_t, WS_WOUT), 0, NL, (size_t)2048 * 2048, (size_t)2048 * 2048);
    convert_t<0>(F, INP(29), 2048, 2048, WSP(bf16_t, WS_WPG), 0, NL, (size_t)2048 * 2048, (size_t)2048 * 2048);
    convert_t<0>(F, INP(28), 256, 2048, WSP(bf16_t, WS_WPP), 0, NL, (size_t)256 * 2048, (size_t)2048 * 256);
    convert_t<1>(F, INP(23), 2048, 512, WSP(bf16_t, WS_WGU), 0, NL * 32, (size_t)2048 * 512, (size_t)1024 * 2048);
    convert_t<1>(F, INP(24), 2048, 512, WSP(bf16_t, WS_WGU), 1, NL * 32, (size_t)2048 * 512, (size_t)1024 * 2048);
    convert_t<0>(F, INP(25), 512, 2048, WSP(bf16_t, WS_WDN), 0, NL * 32, (size_t)512 * 2048, (size_t)2048 * 512);
    convert_t<0>(F, INP(15), 512, 1152, WSP(bf16_t, WS_WUQ), 0, NL, (size_t)512 * 1152, (size_t)1280 * 512);
    for (int l = 0; l < NL; ++l) zero_rows(F, WSP(bf16_t, WS_WUQ) + (size_t)l * 1280 * 512 + (size_t)1152 * 512, (size_t)128 * 512);
    convert_t<2>(F, INP(17), 256, 1536, WSP(bf16_t, WS_WUKV), 0, NL, (size_t)256 * 1536, (size_t)1536 * 256);
    cvt_plain(F, INP(0), WSP(bf16_t, WS_XBF), (size_t)T * D);
    cvt_plain(F, INP(1), WSP(bf16_t, WS_PBF), (size_t)NL * T * PLE);
    for (int i = F.wg * 512 + F.tid; i < 4096 * 32; i += F.G * 512) {
        const int pos = i >> 5, k = i & 31; const double ang = (double)pos * pow(10000.0, -(double)k / 32.0);
        WSP(f32x2, WS_ROPE)[i] = (f32x2){(float)cos(ang), (float)sin(ang)}; }
}

DI float zsh(const bf16_t* z, int t, int c, float mu) {
    const float a = bf2f(z[(size_t)t * ZLD + c]);
    const float p = ((t & (SEQ - 1)) == 0) ? 0.f : bf2f(z[(size_t)(t - 1) * ZLD + c]);
    return a + (p - a) * mu;
}
DI void p_rwkv_prep(const Frame F, int l) {
    const bf16_t* z = WSP(bf16_t, WS_Z);
    const float* mu = INP(3) + (size_t)l * 2560; const float* w0 = INP(4) + (size_t)l * 768;
    const float* w_up = INP(5) + (size_t)l * 64 * 768; const float* a0 = INP(6) + (size_t)l * 768; const float* a_up = INP(7) + (size_t)l * 64 * 768;
    const float* g_up = INP(8) + (size_t)l * 128 * 768; const float* k_k = INP(9) + (size_t)l * 768; const float* k_a = INP(10) + (size_t)l * 768;
    const float* r_k = INP(11) + (size_t)l * 768;
    float* R = WSP(float, WS_RW); float* DEC = R + (size_t)T * 768; float* K2 = DEC + (size_t)T * 768; float* V = K2 + (size_t)T * 768;
    float* AA = V + (size_t)T * 768; float* BB = AA + (size_t)T * 768; float* GG = BB + (size_t)T * 768; float* RK = WSP(float, WS_RK);
    LAS float* lw = (LAS float*)F.lds;
    LAS float* la = lw + 16 * 64;
    LAS float* lg = la + 16 * 64;
    const int tid = F.tid;
    for (int tile = F.wg; tile < T / 16; tile += F.G) {
        const int t0 = tile * 16;
        __syncthreads();
        for (int i = tid; i < 16 * 256; i += 512) { const int tk = i >> 8, c = i & 255; const float v = zsh(z, t0 + tk, 2304 + c, mu[2304 + c]);
            if (c < 64) lw[tk * 64 + c] = tanhf(v); else if (c < 128) la[tk * 64 + (c - 64)] = v; else lg[tk * 128 + (c - 128)] = sigmoidf_(v); }
        __syncthreads();
        for (int p = 0; p < 4; ++p) {
            const int c = (p >> 1) * 512 + tid, tb = (p & 1) * 8;
            if (c < 768) {
                float aw[8], aa[8], ag[8];
#pragma unroll
                for (int i = 0; i < 8; ++i) { aw[i] = 0.f; aa[i] = 0.f; ag[i] = 0.f; }
#pragma unroll 2
                for (int k = 0; k < 64; k += 4) {
                    float wu[4], au[4], g0[4], g1[4];
#pragma unroll
                    for (int j = 0; j < 4; ++j) { wu[j] = w_up[(size_t)(k + j) * 768 + c]; au[j] = a_up[(size_t)(k + j) * 768 + c]; g0[j] = g_up[(size_t)(k + j) * 768 + c]; g1[j] = g_up[(size_t)(64 + k + j) * 768 + c]; }
#pragma unroll
                    for (int tk = 0; tk < 8; ++tk) {
                        const f32x4 xw = *(const LAS f32x4*)(lw + (tb + tk) * 64 + k), xa = *(const LAS f32x4*)(la + (tb + tk) * 64 + k), x0 = *(const LAS f32x4*)(lg + (tb + tk) * 128 + k), x1 = *(const LAS f32x4*)(lg + (tb + tk) * 128 + 64 + k);
#pragma unroll
                        for (int j = 0; j < 4; ++j) { aw[tk] += xw[j] * wu[j]; aa[tk] += xa[j] * au[j]; ag[tk] += x0[j] * g0[j] + x1[j] * g1[j]; }
                    }
                }
                const float mur = mu[c], muk = mu[768 + c], muv = mu[1536 + c], w0c = w0[c], a0c = a0[c], kkc = k_k[c], kac = k_a[c], rkc = r_k[c];
                const int h = c >> 6;
#pragma unroll
                for (int tk = 0; tk < 8; ++tk) {
                    const int t = t0 + tb + tk;
                    const float zr = zsh(z, t, c, mur), zk = zsh(z, t, 768 + c, muk), zv = zsh(z, t, 1536 + c, muv);
                    const float xw = -(w0c + aw[tk]);
                    const float sp = (xw > 15.f) ? xw : log1pf(__expf(xw));
                    const float w = -sp - 0.5f;
                    const float dec = -__expf(w);
                    const float a = sigmoidf_(a0c + aa[tk]);
                    const float kkv = zk * kkc;
                    const float nrm = sqrtf(wave_sum(kkv * kkv));
                    const float kkh = kkv / fmaxf(nrm, 1e-12f);
                    const float k2 = zk * (1.0f + (a - 1.0f) * kac);
                    const float rks = wave_sum(zr * k2 * rkc);
                    const size_t o = (size_t)t * 768 + c;
                    R[o] = zr; DEC[o] = dec; K2[o] = k2; V[o] = zv; AA[o] = -kkh; BB[o] = kkh * a; GG[o] = ag[tk];
                    if ((tid & 63) == 0) RK[(size_t)t * 16 + h] = rks;
                }
            }
        }
    }
}

DI void p_mla_prep(const Frame F, int l) {
    const bf16_t* z = WSP(bf16_t, WS_Z);
    const float* qa_g = INP(14) + (size_t)l * 512; const float* kva_g = INP(16) + (size_t)l * 256;
    bf16_t* qn = WSP(bf16_t, WS_QN); bf16_t* kvn = WSP(bf16_t, WS_KVN); bf16_t* kr = WSP(bf16_t, WS_KROPE);
    const f32x2* rope = WSP(f32x2, WS_ROPE);
    const int lane = F.lane;
    for (int t = F.wg * 8 + F.wave; t < T; t += F.G * 8) {
        const bf16_t* zr = z + (size_t)t * ZLD;
        { const u32x4 w = *(const u32x4*)(zr + ZC_QA + lane * 8); float v[8] = {bflo(w.x), bfhi(w.x), bflo(w.y), bfhi(w.y), bflo(w.z), bfhi(w.z), bflo(w.w), bfhi(w.w)};
          float ss = 0.f;
#pragma unroll
          for (int j = 0; j < 8; ++j) ss += v[j] * v[j];
          ss = wave_sum(ss); const float rs = rsqrtf(ss * (1.0f / 512.0f) + 1e-6f);
          const f32x4 g0 = *(const f32x4*)(qa_g + lane * 8), g1 = *(const f32x4*)(qa_g + lane * 8 + 4);
          u32x4 o; o.x = pack2(v[0] * rs * g0[0], v[1] * rs * g0[1]); o.y = pack2(v[2] * rs * g0[2], v[3] * rs * g0[3]); o.z = pack2(v[4] * rs * g1[0], v[5] * rs * g1[1]); o.w = pack2(v[6] * rs * g1[2], v[7] * rs * g1[3]);
          *(u32x4*)(qn + (size_t)t * 512 + lane * 8) = o; }
        { const u32x2 w = *(const u32x2*)(zr + ZC_KVA + lane * 4); float v[4] = {bflo(w.x), bfhi(w.x), bflo(w.y), bfhi(w.y)};
          float ss = v[0] * v[0] + v[1] * v[1] + v[2] * v[2] + v[3] * v[3];
          ss = wave_sum(ss); const float rs = rsqrtf(ss * (1.0f / 256.0f) + 1e-6f);
          const f32x4 g0 = *(const f32x4*)(kva_g + lane * 4);
          u32x2 o; o.x = pack2(v[0] * rs * g0[0], v[1] * rs * g0[1]); o.y = pack2(v[2] * rs * g0[2], v[3] * rs * g0[3]);
          *(u32x2*)(kvn + (size_t)t * 256 + lane * 4) = o; }
        { const int i = lane & 31; const float t1 = bf2f(zr[ZC_KR + i]), t2 = bf2f(zr[ZC_KR + 32 + i]); const f32x2 cs = rope[(t & (SEQ - 1)) * 32 + i];
          const float o = (lane < 32) ? (t1 * cs.x - t2 * cs.y) : (t1 * cs.y + t2 * cs.x);
          kr[(size_t)t * 64 + lane] = f2bf(o); }
    }
}

DI void p_vtd_prep(const Frame F) {
    const bf16_t* z = WSP(bf16_t, WS_Z); bf16_t* vtd = WSP(bf16_t, WS_VTD);
    LAS bf16_t* buf = (LAS bf16_t*)(F.lds + F.wave * 8704);
    const int lane = F.lane;
    for (int tile = F.wg * 8 + F.wave; tile < 2 * 12 * 128; tile += F.G * 8) {
        const int pt = tile & 127, hd = (tile >> 7) % 12, b = tile / (128 * 12);
        const int g = hd >> 2, d = 1 << (2 * g), Ls = SEQ / d;
        const int pos0 = pt * 32, r = pos0 / Ls, j0 = pos0 - r * Ls;
#pragma unroll
        for (int i = 0; i < 8; ++i) { const int p = lane + 64 * i, row = p >> 4, seg = p & 15;
            const size_t tok = (size_t)b * SEQ + (size_t)(j0 + row) * d + r;
            const u32x4 w = *(const u32x4*)(z + tok * ZLD + ZC_DV + hd * 128 + seg * 8);
            *(LAS u32x4*)(buf + row * 136 + seg * 8) = w; }
        __builtin_amdgcn_s_waitcnt(0);
#pragma unroll
        for (int i = 0; i < 8; ++i) { const int p = lane + 64 * i, dv = p >> 2, seg = p & 3;
            unsigned short v[8];
#pragma unroll
            for (int j = 0; j < 8; ++j) v[j] = buf[(seg * 8 + j) * 136 + dv];
            u32x4 w; w.x = v[0] | ((unsigned)v[1] << 16); w.y = v[2] | ((unsigned)v[3] << 16); w.z = v[4] | ((unsigned)v[5] << 16); w.w = v[6] | ((unsigned)v[7] << 16);
            *(u32x4*)(vtd + ((size_t)(b * 12 + hd) * 128 + dv) * SEQ + pos0 + seg * 8) = w; }
        __builtin_amdgcn_s_waitcnt(0);
    }
}

DI int swap23(int i) { return (i & ~12) | ((i & 4) << 1) | ((i & 8) >> 1); }
DI int crow(int reg, int h) { return (reg & 3) + 8 * (reg >> 2) + 4 * h; }
#define MFMA32(a, b, c) __builtin_amdgcn_mfma_f32_32x32x16_bf16((a), (b), (c), 0, 0, 0)
DI bf16x8 packp(const f32x16& p, int s) {
    u32x4 w; w.x = pack2(p[8 * s], p[8 * s + 1]); w.y = pack2(p[8 * s + 2], p[8 * s + 3]); w.z = pack2(p[8 * s + 4], p[8 * s + 5]); w.w = pack2(p[8 * s + 6], p[8 * s + 7]);
    return __builtin_bit_cast(bf16x8, w);
}

DI void dil_item(const Frame F, int item) {
    const bf16_t* z = WSP(bf16_t, WS_Z); const bf16_t* vtd = WSP(bf16_t, WS_VTD);
    bf16_t* op = WSP(bf16_t, WS_OP); float* lse = WSP(float, WS_LSE);
    const int lane = F.lane, c = lane & 31, hh = lane >> 5;
    const int bgh = item >> 7, rem = item & 127, b = bgh / 12, hd = bgh % 12, g = hd >> 2, hs = hd & 3;
    const int d = 1 << (2 * g), Ls = SEQ / d, ntile = Ls / 32, r = rem / ntile, jt = rem % ntile;
    const float slope2 = exp2f(-8.0f * (float)(hd + 1) / 12.0f) * LOG2E * (float)d;
    const float sc = 0.08838834764831845f * LOG2E;
    const int jq = jt * 32 + c;
    const size_t tq = (size_t)b * SEQ + (size_t)jq * d + r;
    bf16x8 qf[8];
#pragma unroll
    for (int ks = 0; ks < 8; ++ks) qf[ks] = *(const bf16x8*)(z + tq * ZLD + ZC_DQ + hd * 128 + 16 * ks + 8 * hh);
    f32x16 O[4];
#pragma unroll
    for (int i = 0; i < 4; ++i)
#pragma unroll
        for (int j = 0; j < 16; ++j) O[i][j] = 0.f;
    float m = -1e30f, lsum = 0.f;
    const int kt0 = jt - 4 < 0 ? 0 : jt - 4;
    for (int kt = kt0; kt <= jt; ++kt) {
        const int jk = kt * 32 + swap23(c);
        const size_t tk = (size_t)b * SEQ + (size_t)jk * d + r;
        bf16x8 kf[8], vf[4][2];
#pragma unroll
        for (int ks = 0; ks < 8; ++ks) kf[ks] = *(const bf16x8*)(z + tk * ZLD + ZC_DK + hd * 128 + 16 * ks + 8 * hh);
#pragma unroll
        for (int dvt = 0; dvt < 4; ++dvt)
#pragma unroll
            for (int s = 0; s < 2; ++s) vf[dvt][s] = *(const bf16x8*)(vtd + ((size_t)(b * 12 + hd) * 128 + dvt * 32 + c) * SEQ + r * Ls + kt * 32 + 16 * s + 8 * hh);
        f32x16 S;
#pragma unroll
        for (int j = 0; j < 16; ++j) S[j] = 0.f;
#pragma unroll
        for (int ks = 0; ks < 8; ++ks) S = MFMA32(kf[ks], qf[ks], S);
        float mx = -1e30f;
#pragma unroll
        for (int i = 0; i < 16; ++i) { const int rel = jq - (kt * 32 + swap23(crow(i, hh)));
            float s = S[i] * sc - slope2 * (float)rel; s = (rel >= 0 && rel <= 128) ? s : -1e30f; S[i] = s; mx = fmaxf(mx, s); }
        mx = fmaxf(mx, __shfl_xor(mx, 32));
        const float mn = fmaxf(m, mx), al = __builtin_amdgcn_exp2f(m - mn); m = mn;
        float ps = 0.f;
#pragma unroll
        for (int i = 0; i < 16; ++i) { const float p = __builtin_amdgcn_exp2f(S[i] - mn); S[i] = p; ps += p; }
        lsum = lsum * al + ps;
#pragma unroll
        for (int i = 0; i < 4; ++i)
#pragma unroll
            for (int j = 0; j < 16; ++j) O[i][j] *= al;
        const bf16x8 p0 = packp(S, 0), p1 = packp(S, 1);
#pragma unroll
        for (int dvt = 0; dvt < 4; ++dvt) { O[dvt] = MFMA32(vf[dvt][0], p0, O[dvt]); O[dvt] = MFMA32(vf[dvt][1], p1, O[dvt]); }
    }
    const float lt = lsum + __shfl_xor(lsum, 32), inv = 1.0f / lt;
    bf16_t* orow = op + ((size_t)g * T + tq) * 512 + hs * 128;
#pragma unroll
    for (int dvt = 0; dvt < 4; ++dvt)
#pragma unroll
        for (int g4 = 0; g4 < 4; ++g4) { u32x2 w; w.x = pack2(O[dvt][4 * g4] * inv, O[dvt][4 * g4 + 1] * inv); w.y = pack2(O[dvt][4 * g4 + 2] * inv, O[dvt][4 * g4 + 3] * inv);
            *(u32x2*)(orow + dvt * 32 + 8 * g4 + 4 * hh) = w; }
    if (hh == 0) lse[((size_t)g * T + tq) * 4 + hs] = m + __builtin_amdgcn_logf(lt);
}

constexpr int AK_P = 200, AV_P = 40;
constexpr int AST = 32 * AK_P * 2 + 128 * AV_P * 2;
DI void mla_decode(int item, int& bh, int& qb, int& kc, int& nst) {
    if (item < 336) { bh = item / 28; int r = item % 28; qb = 3; for (;;) { const int n = (qb + 1) >> 2; if (r < n) break; r -= n; ++qb; } kc = r; nst = 32; }
    else { const int x = item - 336, cls = x / 48, y = x % 48; bh = y >> 2; const int m = y & 3; qb = 4 * m + (2 - cls); kc = m; nst = (3 - cls) * 8; }
}
DI void mla_wg_item(const Frame F, int item) {
    const bf16_t* qbuf = WSP(bf16_t, WS_QB); const bf16_t* kcb = WSP(bf16_t, WS_KC); const bf16_t* krp = WSP(bf16_t, WS_KROPE); const bf16_t* vt = WSP(bf16_t, WS_VT);
    const f32x2* rope = WSP(f32x2, WS_ROPE); bf16_t* mix = WSP(bf16_t, WS_MIX); bf16_t* opm = WSP(bf16_t, WS_OPM); float* lsem = WSP(float, WS_LSEM);
    const int tid = F.tid, lane = F.lane, wave = F.wave, c = lane & 31, hh = lane >> 5;
    int bh, qb, kc, nst; mla_decode(item, bh, qb, kc, nst);
    const int b = bh / 6, h = bh % 6;
    const int q0 = qb * 256 + wave * 32;
    const size_t tq = (size_t)b * SEQ + q0 + c;
    const float sc = 0.07216878364870322f * LOG2E;
    const int key_base = kc * 1024;
    const int ka_row = tid >> 4, ka_seg = tid & 15;
    const int kb_row = (tid & 255) >> 3, kb_seg = tid & 7;
    const int vb_p = tid - 256, vc_p = tid + 256;
    u32x4 ra, rb_, rc;
#define MLA_ISSUE(s_) do { const int k0_ = key_base + (s_) * 32; const size_t tk0_ = (size_t)b * SEQ + k0_; \
        ra = *(const u32x4*)(kcb + (tk0_ + ka_row) * 768 + h * 128 + ka_seg * 8); \
        if (tid < 256) { rb_ = *(const u32x4*)(krp + (tk0_ + kb_row) * 64 + kb_seg * 8); rc = *(const u32x4*)(vt + (size_t)(h * 128 + (vc_p >> 2)) * T + tk0_ + (vc_p & 3) * 8); } \
        else { rb_ = *(const u32x4*)(vt + (size_t)(h * 128 + (vb_p >> 2)) * T + tk0_ + (vb_p & 3) * 8); } } while (0)
#define MLA_WRITE(s_) do { LAS bf16_t* kb_ = (LAS bf16_t*)(F.lds + ((s_) & 3) * AST); LAS bf16_t* vb_ = kb_ + 32 * AK_P; \
        *(LAS u32x4*)(kb_ + ka_row * AK_P + ka_seg * 8) = ra; \
        if (tid < 256) { *(LAS u32x4*)(kb_ + kb_row * AK_P + 128 + kb_seg * 8) = rb_; *(LAS u32x4*)(vb_ + (vc_p >> 2) * AV_P + (vc_p & 3) * 8) = rc; } \
        else { *(LAS u32x4*)(vb_ + (vb_p >> 2) * AV_P + (vb_p & 3) * 8) = rb_; } } while (0)
    __syncthreads();
    MLA_ISSUE(0); MLA_WRITE(0);
    if (nst > 1) { MLA_ISSUE(1); MLA_WRITE(1); }
    if (nst > 2) MLA_ISSUE(2);
    bf16x8 qf[12];
#pragma unroll
    for (int ks = 0; ks < 12; ++ks) qf[ks] = *(const bf16x8*)(qbuf + tq * 1280 + h * 192 + 16 * ks + 8 * hh);
#pragma unroll
    for (int kk = 0; kk < 2; ++kk) {
        const u32x4 w1 = __builtin_bit_cast(u32x4, qf[8 + kk]), w2 = __builtin_bit_cast(u32x4, qf[10 + kk]);
        const unsigned a1[4] = {w1.x, w1.y, w1.z, w1.w}, a2[4] = {w2.x, w2.y, w2.z, w2.w};
        unsigned o1[4], o2[4];
#pragma unroll
        for (int jj = 0; jj < 4; ++jj) {
            const int i0 = 16 * kk + 8 * hh + 2 * jj;
            const f32x2 cs0 = rope[(q0 + c) * 32 + i0], cs1 = rope[(q0 + c) * 32 + i0 + 1];
            const float t1a = bflo(a1[jj]), t1b = bfhi(a1[jj]), t2a = bflo(a2[jj]), t2b = bfhi(a2[jj]);
            o1[jj] = pack2(t1a * cs0.x - t2a * cs0.y, t1b * cs1.x - t2b * cs1.y);
            o2[jj] = pack2(t1a * cs0.y + t2a * cs0.x, t1b * cs1.y + t2b * cs1.x);
        }
        qf[8 + kk] = __builtin_bit_cast(bf16x8, (u32x4){o1[0], o1[1], o1[2], o1[3]});
        qf[10 + kk] = __builtin_bit_cast(bf16x8, (u32x4){o2[0], o2[1], o2[2], o2[3]});
    }
    f32x16 O[4];
#pragma unroll
    for (int i = 0; i < 4; ++i)
#pragma unroll
        for (int jx = 0; jx < 16; ++jx) O[i][jx] = 0.f;
    float m = -1e30f, lsum = 0.f;
    __syncthreads();
    for (int s = 0; s < nst; ++s) {
        if (s + 2 < nst) MLA_WRITE(s + 2);
        if (s + 3 < nst) MLA_ISSUE(s + 3);
        const int k0 = key_base + s * 32;
        if (k0 <= q0 + 31) {
            const LAS bf16_t* kb = (const LAS bf16_t*)(F.lds + (s & 3) * AST); const LAS bf16_t* vb = kb + 32 * AK_P;
            f32x16 S;
#pragma unroll
            for (int jx = 0; jx < 16; ++jx) S[jx] = 0.f;
            const int krow = swap23(c);
#pragma unroll
            for (int ks = 0; ks < 12; ++ks) S = MFMA32(*(const LAS bf16x8*)(kb + krow * AK_P + 16 * ks + 8 * hh), qf[ks], S);
            const bool diag = (k0 + 31 > q0);
            float mx = -1e30f;
#pragma unroll
            for (int i = 0; i < 16; ++i) { float sv = S[i] * sc; if (diag && (k0 + swap23(crow(i, hh)) > q0 + c)) sv = -3.0e38f; S[i] = sv; mx = fmaxf(mx, sv); }
            mx = fmaxf(mx, __shfl_xor(mx, 32));
            const float mn = fmaxf(m, mx), al = __builtin_amdgcn_exp2f(m - mn); m = mn;
            float ps = 0.f;
#pragma unroll
            for (int i = 0; i < 16; ++i) { const float p = __builtin_amdgcn_exp2f(S[i] - mn); S[i] = p; ps += p; }
            lsum = lsum * al + ps;
#pragma unroll
            for (int i = 0; i < 4; ++i)
#pragma unroll
                for (int jx = 0; jx < 16; ++jx) O[i][jx] *= al;
            const bf16x8 p0 = packp(S, 0), p1 = packp(S, 1);
#pragma unroll
            for (int dvt = 0; dvt < 4; ++dvt) {
                O[dvt] = MFMA32(*(const LAS bf16x8*)(vb + (dvt * 32 + c) * AV_P + 8 * hh), p0, O[dvt]);
                O[dvt] = MFMA32(*(const LAS bf16x8*)(vb + (dvt * 32 + c) * AV_P + 16 + 8 * hh), p1, O[dvt]); }
        }
        __syncthreads();
    }
#undef MLA_ISSUE
#undef MLA_WRITE
    const float lt = lsum + __shfl_xor(lsum, 32), inv = 1.0f / lt;
    const bool single = (qb < 4);
    bf16_t* orow = single ? (mix + tq * D + 1280 + h * 128) : (opm + ((size_t)kc * T + tq) * 768 + h * 128);
#pragma unroll
    for (int dvt = 0; dvt < 4; ++dvt)
#pragma unroll
        for (int g4 = 0; g4 < 4; ++g4) { u32x2 w; w.x = pack2(O[dvt][4 * g4] * inv, O[dvt][4 * g4 + 1] * inv); w.y = pack2(O[dvt][4 * g4 + 2] * inv, O[dvt][4 * g4 + 3] * inv);
            *(u32x2*)(orow + dvt * 32 + 8 * g4 + 4 * hh) = w; }
    if (!single && hh == 0) lsem[((size_t)kc * T + tq) * 8 + h] = m + __builtin_amdgcn_logf(lt);
}
DI void mla_combine_item(const Frame F, int item) {
    const bf16_t* opm = WSP(bf16_t, WS_OPM); const float* lsem = WSP(float, WS_LSEM); bf16_t* mix = WSP(bf16_t, WS_MIX);
    const int t0 = item * 16, qb = (t0 & (SEQ - 1)) >> 8, np = (qb >> 2) + 1;
    if (np == 1) return;
    for (int i = 0; i < 24; ++i) {
        const int task = i * 64 + F.lane, tl = task / 96, rem = task % 96, h = rem >> 4, oc = rem & 15;
        const size_t t = (size_t)t0 + tl;
        float lv[4], mx = -3.0e38f;
#pragma unroll
        for (int k = 0; k < 4; ++k) { lv[k] = (k < np) ? lsem[((size_t)k * T + t) * 8 + h] : -3.0e38f; mx = fmaxf(mx, lv[k]); }
        float wsum = 0.f, acc[8];
#pragma unroll
        for (int jx = 0; jx < 8; ++jx) acc[jx] = 0.f;
#pragma unroll
        for (int k = 0; k < 4; ++k) if (k < np) {
            const float w = __builtin_amdgcn_exp2f(lv[k] - mx); wsum += w;
            const u32x4 a = *(const u32x4*)(opm + ((size_t)k * T + t) * 768 + h * 128 + oc * 8); const unsigned aw[4] = {a.x, a.y, a.z, a.w};
#pragma unroll
            for (int jx = 0; jx < 4; ++jx) { acc[2 * jx] += w * bflo(aw[jx]); acc[2 * jx + 1] += w * bfhi(aw[jx]); } }
        const float inv = 1.0f / wsum;
        *(u32x4*)(mix + t * D + 1280 + h * 128 + oc * 8) = (u32x4){pack2(acc[0] * inv, acc[1] * inv), pack2(acc[2] * inv, acc[3] * inv), pack2(acc[4] * inv, acc[5] * inv), pack2(acc[6] * inv, acc[7] * inv)};
    }
}

DI void dilc_item(const Frame F, int item) {
    const bf16_t* op = WSP(bf16_t, WS_OP); const float* lse = WSP(float, WS_LSE); bf16_t* mix = WSP(bf16_t, WS_MIX);
    for (int i = 0; i < 16; ++i) {
        const int task = i * 64 + F.lane, tl = task >> 6, rem = task & 63, hs = rem >> 4, oc = rem & 15;
        const size_t t = (size_t)item * 16 + tl;
        const float l0 = lse[((size_t)0 * T + t) * 4 + hs], l1 = lse[((size_t)1 * T + t) * 4 + hs], l2 = lse[((size_t)2 * T + t) * 4 + hs];
        const float mx = fmaxf(l0, fmaxf(l1, l2));
        float w0 = __builtin_amdgcn_exp2f(l0 - mx), w1 = __builtin_amdgcn_exp2f(l1 - mx), w2 = __builtin_amdgcn_exp2f(l2 - mx);
        const float inv = 1.0f / (w0 + w1 + w2); w0 *= inv; w1 *= inv; w2 *= inv;
        const u32x4 a = *(const u32x4*)(op + ((size_t)0 * T + t) * 512 + hs * 128 + oc * 8), bq = *(const u32x4*)(op + ((size_t)1 * T + t) * 512 + hs * 128 + oc * 8), cq = *(const u32x4*)(op + ((size_t)2 * T + t) * 512 + hs * 128 + oc * 8);
        const unsigned aw[4] = {a.x, a.y, a.z, a.w}, bw[4] = {bq.x, bq.y, bq.z, bq.w}, cw[4] = {cq.x, cq.y, cq.z, cq.w}; unsigned o[4];
#pragma unroll
        for (int j = 0; j < 4; ++j) o[j] = pack2(w0 * bflo(aw[j]) + w1 * bflo(bw[j]) + w2 * bflo(cw[j]), w0 * bfhi(aw[j]) + w1 * bfhi(bw[j]) + w2 * bfhi(cw[j]));
        *(u32x4*)(mix + t * D + 768 + hs * 128 + oc * 8) = (u32x4){o[0], o[1], o[2], o[3]};
    }
}

DI float dppf(float x, int ctrl_sel) {
    const int v = __float_as_int(x); int r;
    if (ctrl_sel == 0) r = __builtin_amdgcn_mov_dpp(v, 0xB1, 0xF, 0xF, true);
    else if (ctrl_sel == 1) r = __builtin_amdgcn_mov_dpp(v, 0x4E, 0xF, 0xF, true);
    else r = __builtin_amdgcn_mov_dpp(v, 0x141, 0xF, 0xF, true);
    return __int_as_float(r);
}
DI float reduce8(float x) { x += dppf(x, 0); x += dppf(x, 1); x += dppf(x, 2); return x; }
constexpr int RTS = 32;
DI void p_rwkv_scan(const Frame F, int l, int bh) {
    const float* R = WSP(float, WS_RW); const float* DEC = R + (size_t)T * 768; const float* K2 = DEC + (size_t)T * 768; const float* V = K2 + (size_t)T * 768;
    const float* AA = V + (size_t)T * 768; const float* BB = AA + (size_t)T * 768; const float* GG = BB + (size_t)T * 768; const float* RK = WSP(float, WS_RK);
    const float* gn_g = INP(12) + (size_t)l * 768; const float* gn_b = INP(13) + (size_t)l * 768;
    bf16_t* mix = WSP(bf16_t, WS_MIX);
    const int b = bh / 12, h = bh % 12, tid = F.tid, i = tid >> 3, jg = tid & 7;
    LAS float* sb = (LAS float*)F.lds;
    LAS float* yb = sb + 2 * 6 * RTS * 64;
    f32x4 reg[6];
    const int st_step = tid >> 4, st_c4 = (tid & 15) * 4;
#define SCAN_ISSUE(chunk_) do { const size_t tok_ = (size_t)b * SEQ + (size_t)(chunk_) * RTS + st_step; \
        reg[0] = *(const f32x4*)(R + tok_ * 768 + h * 64 + st_c4); reg[1] = *(const f32x4*)(DEC + tok_ * 768 + h * 64 + st_c4); reg[2] = *(const f32x4*)(K2 + tok_ * 768 + h * 64 + st_c4); \
        reg[3] = *(const f32x4*)(V + tok_ * 768 + h * 64 + st_c4); reg[4] = *(const f32x4*)(AA + tok_ * 768 + h * 64 + st_c4); reg[5] = *(const f32x4*)(BB + tok_ * 768 + h * 64 + st_c4); } while (0)
    float s[8];
#pragma unroll
    for (int j = 0; j < 8; ++j) s[j] = 0.f;
    SCAN_ISSUE(0);
    __syncthreads();
#pragma unroll
    for (int a = 0; a < 6; ++a) *(LAS f32x4*)(sb + (0 * 6 + a) * RTS * 64 + st_step * 64 + st_c4) = reg[a];
    __syncthreads();
    const int nchunk = SEQ / RTS;
    for (int ch = 0; ch < nchunk; ++ch) {
        const int cb = ch & 1;
        if (ch + 1 < nchunk) SCAN_ISSUE(ch + 1);
        const LAS float* pr = sb + (cb * 6 + 0) * RTS * 64 + jg * 8; const LAS float* pw = sb + (cb * 6 + 1) * RTS * 64 + jg * 8;
        const LAS float* pk = sb + (cb * 6 + 2) * RTS * 64 + jg * 8; const LAS float* pv = sb + (cb * 6 + 3) * RTS * 64 + i;
        const LAS float* pa = sb + (cb * 6 + 4) * RTS * 64 + jg * 8; const LAS float* pb = sb + (cb * 6 + 5) * RTS * 64 + jg * 8;
#pragma unroll 4
        for (int st = 0; st < RTS; ++st) {
            const f32x4 a0 = *(const LAS f32x4*)(pa + st * 64), a1 = *(const LAS f32x4*)(pa + st * 64 + 4);
            const f32x4 w0 = *(const LAS f32x4*)(pw + st * 64), w1 = *(const LAS f32x4*)(pw + st * 64 + 4);
            const f32x4 b0 = *(const LAS f32x4*)(pb + st * 64), b1 = *(const LAS f32x4*)(pb + st * 64 + 4);
            const f32x4 k0 = *(const LAS f32x4*)(pk + st * 64), k1 = *(const LAS f32x4*)(pk + st * 64 + 4);
            const f32x4 r0 = *(const LAS f32x4*)(pr + st * 64), r1 = *(const LAS f32x4*)(pr + st * 64 + 4);
            const float vv = pv[st * 64];
            float sa = (s[0] * a0[0] + s[1] * a0[1]) + (s[2] * a0[2] + s[3] * a0[3]) + (s[4] * a1[0] + s[5] * a1[1]) + (s[6] * a1[2] + s[7] * a1[3]);
            sa = reduce8(sa);
#pragma unroll
            for (int j = 0; j < 4; ++j) { s[j] = s[j] * w0[j] + (sa * b0[j] + vv * k0[j]); s[4 + j] = s[4 + j] * w1[j] + (sa * b1[j] + vv * k1[j]); }
            float y = (s[0] * r0[0] + s[1] * r0[1]) + (s[2] * r0[2] + s[3] * r0[3]) + (s[4] * r1[0] + s[5] * r1[1]) + (s[6] * r1[2] + s[7] * r1[3]);
            y = reduce8(y);
            if (jg == 0) yb[st * 64 + i] = y;
        }
        __syncthreads();
#pragma unroll
        for (int q = 0; q < RTS / 8; ++q) {
            const int st = F.wave * (RTS / 8) + q, lane = F.lane;
            const size_t tok = (size_t)b * SEQ + (size_t)ch * RTS + st;
            const float y = yb[st * 64 + lane];
            const float mean = wave_sum(y) * (1.0f / 64.0f); const float dlt = y - mean; const float var = wave_sum(dlt * dlt) * (1.0f / 64.0f);
            const int cidx = h * 64 + lane;
            float o = dlt * rsqrtf(var + 64e-5f) * gn_g[cidx] + gn_b[cidx];
            o += RK[tok * 16 + h] * sb[(cb * 6 + 3) * RTS * 64 + st * 64 + lane];
            o *= GG[tok * 768 + cidx];
            mix[tok * D + cidx] = f2bf(o);
        }
        if (ch + 1 < nchunk) {
#pragma unroll
            for (int a = 0; a < 6; ++a) *(LAS f32x4*)(sb + ((cb ^ 1) * 6 + a) * RTS * 64 + st_step * 64 + st_c4) = reg[a];
        }
        __syncthreads();
    }
}

constexpr int MP = 72;
constexpr int MBUF = 64 * MP * 2;
DI bf16x8 ldfrag(const LAS bf16_t* M, int rb, int ks, int lane) { return *(const LAS bf16x8*)(M + (rb * 16 + (lane & 15)) * MP + ks * 32 + 8 * (lane >> 4)); }
DI f32x4 mm_tile(const LAS bf16_t* X, const LAS bf16_t* Y, int rb, int cb, int lane, f32x4 acc) {
#pragma unroll
    for (int ks = 0; ks < 2; ++ks) acc = __builtin_amdgcn_mfma_f32_16x16x32_bf16(ldfrag(X, rb, ks, lane), ldfrag(Y, cb, ks, lane), acc, 0, 0, 0);
    return acc;
}
DI void st_T(LAS bf16_t* M, int rb, int cb, int lane, f32x4 v) {
    u32x2 w; w.x = pack2(v[0], v[1]); w.y = pack2(v[2], v[3]);
    *(LAS u32x2*)(M + (cb * 16 + (lane & 15)) * MP + rb * 16 + 4 * (lane >> 4)) = w;
}
DI void st_N(LAS bf16_t* M, int rb, int cb, int lane, f32x4 v) {
#pragma unroll
    for (int q = 0; q < 4; ++q) M[(rb * 16 + 4 * (lane >> 4) + q) * MP + cb * 16 + (lane & 15)] = f2bf(v[q]);
}
DI void p_rwkv_pass1(const Frame F, int l) {
    const float* R = WSP(float, WS_RW); const float* LW = R + (size_t)T * 768; const float* K2 = LW + (size_t)T * 768; const float* V = K2 + (size_t)T * 768;
    const float* AA = V + (size_t)T * 768; const float* BB = AA + (size_t)T * 768;
    float* ACg = WSP(float, WS_AC); float* GCg = WSP(float, WS_GC); float* Y0g = WSP(float, WS_Y0); bf16_t* QCg = WSP(bf16_t, WS_QC);
    LAS bf16_t* b0 = (LAS bf16_t*)F.lds;
    LAS bf16_t* b1 = (LAS bf16_t*)(F.lds + 1 * MBUF);
    LAS bf16_t* b2 = (LAS bf16_t*)(F.lds + 2 * MBUF);
    LAS bf16_t* b3 = (LAS bf16_t*)(F.lds + 3 * MBUF);
    LAS bf16_t* b4 = (LAS bf16_t*)(F.lds + 4 * MBUF);
    LAS bf16_t* b5 = (LAS bf16_t*)(F.lds + 5 * MBUF);
    LAS bf16_t* b6 = (LAS bf16_t*)(F.lds + 6 * MBUF);
    LAS bf16_t* b7 = (LAS bf16_t*)(F.lds + 7 * MBUF);
    LAS bf16_t* b8 = (LAS bf16_t*)(F.lds + 8 * MBUF);
    LAS bf16_t* b9 = (LAS bf16_t*)(F.lds + 9 * MBUF);
    LAS bf16_t* b10 = (LAS bf16_t*)(F.lds + 10 * MBUF);
    LAS bf16_t* b11 = (LAS bf16_t*)(F.lds + 11 * MBUF);
    LAS float* part = (LAS float*)(F.lds + 12 * MBUF);
    const int tid = F.tid, lane = F.lane, wave = F.wave, rb = wave >> 1, cb0 = 2 * (wave & 1);
    const int j = tid & 63, tg = tid >> 6;
    const f32x4 z4 = (f32x4){0.f, 0.f, 0.f, 0.f};
    for (int ch = F.wg; ch < 1536; ch += F.G) {
        const int bh = ch >> 6, c = ch & 63, b = bh / 12, h = bh % 12;
        const size_t g0 = ((size_t)b * SEQ + (size_t)c * 64 + tg * 8) * 768 + h * 64 + j;
        float lw[8], lam[8];
#pragma unroll
        for (int q = 0; q < 8; ++q) lw[q] = LW[g0 + (size_t)q * 768];
        lam[0] = lw[0];
#pragma unroll
        for (int q = 1; q < 8; ++q) lam[q] = lam[q - 1] + lw[q];
        __syncthreads();
        part[tg * 64 + j] = lam[7];
        __syncthreads();
        float off = 0.f, tot = 0.f;
#pragma unroll
        for (int q = 0; q < 8; ++q) { const float p = part[q * 64 + j]; off += (q < tg) ? p : 0.f; tot += p; }
        if (tg == 0) part[512 + j] = __expf(tot);
        {
            float va[8], vb[8], vk[8], vr[8], vv[8];
#pragma unroll
            for (int q = 0; q < 8; ++q) { const float L_ = off + lam[q], ep = __expf(L_), en = __expf(-L_), epv = __expf(L_ - lw[q]);
                va[q] = AA[g0 + (size_t)q * 768] * epv; vb[q] = BB[g0 + (size_t)q * 768] * en; vk[q] = K2[g0 + (size_t)q * 768] * en; vr[q] = R[g0 + (size_t)q * 768] * ep; vv[q] = V[g0 + (size_t)q * 768]; }
#pragma unroll
            for (int q = 0; q < 8; ++q) { const int t = tg * 8 + q; b0[t * MP + j] = f2bf(va[q]); b1[t * MP + j] = f2bf(vb[q]); b2[t * MP + j] = f2bf(vk[q]); b3[t * MP + j] = f2bf(vr[q]); }
            u32x4 w;
            w.x = pack2(va[0], va[1]); w.y = pack2(va[2], va[3]); w.z = pack2(va[4], va[5]); w.w = pack2(va[6], va[7]); *(LAS u32x4*)(b4 + j * MP + tg * 8) = w;
            w.x = pack2(vb[0], vb[1]); w.y = pack2(vb[2], vb[3]); w.z = pack2(vb[4], vb[5]); w.w = pack2(vb[6], vb[7]); *(LAS u32x4*)(b5 + j * MP + tg * 8) = w;
            w.x = pack2(vk[0], vk[1]); w.y = pack2(vk[2], vk[3]); w.z = pack2(vk[4], vk[5]); w.w = pack2(vk[6], vk[7]); *(LAS u32x4*)(b6 + j * MP + tg * 8) = w;
            w.x = pack2(vv[0], vv[1]); w.y = pack2(vv[2], vv[3]); w.z = pack2(vv[4], vv[5]); w.w = pack2(vv[6], vv[7]); *(LAS u32x4*)(b7 + j * MP + tg * 8) = w;
        }
        __syncthreads();
        f32x4 Tt[2], lak[2], mrb[2], mrk[2];
#pragma unroll
        for (int q = 0; q < 2; ++q) { const int cb = cb0 + q;
            Tt[q] = mm_tile(b0, b1, rb, cb, lane, z4); lak[q] = mm_tile(b0, b2, rb, cb, lane, z4); mrb[q] = mm_tile(b3, b1, rb, cb, lane, z4); mrk[q] = mm_tile(b3, b2, rb, cb, lane, z4);
#pragma unroll
            for (int e = 0; e < 4; ++e) { const int tr = rb * 16 + 4 * (lane >> 4) + e, sc = cb * 16 + (lane & 15);
                if (!(tr > sc)) { Tt[q][e] = 0.f; lak[q][e] = 0.f; }
                if (!(tr >= sc)) { mrb[q][e] = 0.f; mrk[q][e] = 0.f; } } }
        __syncthreads();
#pragma unroll
        for (int q = 0; q < 2; ++q) { const int cb = cb0 + q;
            st_N(b0, rb, cb, lane, Tt[q]); st_T(b1, rb, cb, lane, Tt[q]);
            st_N(b8, rb, cb, lane, lak[q]); st_N(b9, rb, cb, lane, mrb[q]); st_N(b10, rb, cb, lane, mrk[q]);
#pragma unroll
            for (int e = 0; e < 4; ++e) { const int tr = rb * 16 + 4 * (lane >> 4) + e, sc = cb * 16 + (lane & 15); if (tr == sc) Tt[q][e] += 1.0f; }
            st_N(b2, rb, cb, lane, Tt[q]); }
        __syncthreads();
#pragma unroll 1
        for (int it = 0; it < 5; ++it) {
            f32x4 p2[2];
#pragma unroll
            for (int q = 0; q < 2; ++q) p2[q] = mm_tile(b0, b1, rb, cb0 + q, lane, z4);
            __syncthreads();
#pragma unroll
            for (int q = 0; q < 2; ++q) { st_N(b0, rb, cb0 + q, lane, p2[q]); st_T(b1, rb, cb0 + q, lane, p2[q]); }
            __syncthreads();
#pragma unroll
            for (int q = 0; q < 2; ++q) Tt[q] = mm_tile(b2, b1, rb, cb0 + q, lane, Tt[q]);
            __syncthreads();
#pragma unroll
            for (int q = 0; q < 2; ++q) st_N(b2, rb, cb0 + q, lane, Tt[q]);
            __syncthreads();
        }
#pragma unroll
        for (int q = 0; q < 2; ++q) { const int cb = cb0 + q;
            st_T(b11, rb, cb, lane, mm_tile(b2, b4, rb, cb, lane, z4));
            st_T(b0, rb, cb, lane, mm_tile(b8, b7, rb, cb, lane, z4)); }
        __syncthreads();
#pragma unroll
        for (int q = 0; q < 2; ++q) st_T(b8, rb, cb0 + q, lane, mm_tile(b2, b0, rb, cb0 + q, lane, z4));
        __syncthreads();
        const size_t cho = (size_t)ch * 4096;
#pragma unroll
        for (int q = 0; q < 2; ++q) { const int cb = cb0 + q; const int col = cb * 16 + (lane & 15), row0 = rb * 16 + 4 * (lane >> 4);
            f32x4 ac = mm_tile(b5, b11, rb, cb, lane, z4);
            f32x4 gc = mm_tile(b6, b7, rb, cb, lane, mm_tile(b5, b8, rb, cb, lane, z4));
#pragma unroll
            for (int e = 0; e < 4; ++e) { const float gm = part[512 + row0 + e];
                ACg[cho + (size_t)(row0 + e) * 64 + col] = (ac[e] + ((row0 + e) == col ? 1.0f : 0.f)) * gm;
                GCg[cho + (size_t)(row0 + e) * 64 + col] = gc[e] * gm; }
            f32x4 qc = mm_tile(b9, b11, rb, cb, lane, z4);
#pragma unroll
            for (int e = 0; e < 4; ++e) QCg[cho + (size_t)(row0 + e) * 64 + col] = f2bf(qc[e] + bf2f(b3[(row0 + e) * MP + col]));
            const f32x4 y0 = mm_tile(b10, b7, rb, cb, lane, mm_tile(b9, b8, rb, cb, lane, z4));
            *(f32x4*)(Y0g + cho + (size_t)((wave * 2 + q) * 64 + lane) * 4) = y0; }
    }
}
DI void p_rwkv_pass2(const Frame F, int bh) {
    const float* ACg = WSP(float, WS_AC); const float* GCg = WSP(float, WS_GC); bf16_t* SST = WSP(bf16_t, WS_SST);
    LAS float* Sb = (LAS float*)F.lds;
    const int lane = F.lane, wave = F.wave, rb = wave >> 1, cb0 = 2 * (wave & 1), n = lane & 15, kk = lane >> 4;
    f32x4 St[2] = {(f32x4){0.f, 0.f, 0.f, 0.f}, (f32x4){0.f, 0.f, 0.f, 0.f}};
    __syncthreads();
#pragma unroll
    for (int q = 0; q < 2; ++q)
#pragma unroll
        for (int e = 0; e < 4; ++e) Sb[(rb * 16 + 4 * kk + e) * 68 + (cb0 + q) * 16 + n] = 0.f;
    __syncthreads();
    for (int c = 0; c < 64; ++c) {
        const size_t cho = (size_t)(bh * 64 + c) * 4096;
        const LAS float* Sc = Sb + (c & 1) * 64 * 68; LAS float* Sn = Sb + ((c + 1) & 1) * 64 * 68;
#pragma unroll
        for (int q = 0; q < 2; ++q)
#pragma unroll
            for (int e = 0; e < 4; ++e) SST[cho + (size_t)(rb * 16 + 4 * kk + e) * 64 + (cb0 + q) * 16 + n] = f2bf(St[q][e]);
        f32x4 av[4], bv[2][4], gv[2];
#pragma unroll
        for (int m4 = 0; m4 < 4; ++m4) av[m4] = *(const LAS f32x4*)(Sc + (rb * 16 + n) * 68 + 16 * kk + 4 * m4);
#pragma unroll
        for (int q = 0; q < 2; ++q) {
#pragma unroll
            for (int m4 = 0; m4 < 4; ++m4) bv[q][m4] = *(const f32x4*)(ACg + cho + (size_t)((cb0 + q) * 16 + n) * 64 + 16 * kk + 4 * m4);
            gv[q] = *(const f32x4*)(GCg + cho + (size_t)((cb0 + q) * 16 + n) * 64 + rb * 16 + 4 * kk); }
#pragma unroll
        for (int q = 0; q < 2; ++q) { f32x4 acc = gv[q];
#pragma unroll
            for (int m4 = 0; m4 < 4; ++m4)
#pragma unroll
                for (int e = 0; e < 4; ++e) acc = __builtin_amdgcn_mfma_f32_16x16x4f32(av[m4][e], bv[q][m4][e], acc, 0, 0, 0);
            St[q] = acc;
#pragma unroll
            for (int e = 0; e < 4; ++e) Sn[(rb * 16 + 4 * kk + e) * 68 + (cb0 + q) * 16 + n] = acc[e]; }
        __syncthreads();
    }
}
DI void p_rwkv_pass3(const Frame F, int l) {
    const float* V = WSP(float, WS_RW) + (size_t)3 * T * 768; const float* GG = WSP(float, WS_RW) + (size_t)6 * T * 768; const float* RK = WSP(float, WS_RK);
    const float* Y0g = WSP(float, WS_Y0); const bf16_t* QCg = WSP(bf16_t, WS_QC); const bf16_t* SST = WSP(bf16_t, WS_SST);
    const float* gn_g = INP(12) + (size_t)l * 768; const float* gn_b = INP(13) + (size_t)l * 768;
    bf16_t* mix = WSP(bf16_t, WS_MIX);
    LAS float* yb = (LAS float*)F.lds;
    const int lane = F.lane, wave = F.wave, rb = wave >> 1, cb0 = 2 * (wave & 1), n = lane & 15, kk = lane >> 4;
    for (int ch = F.wg; ch < 1536; ch += F.G) {
        const int bh = ch >> 6, c = ch & 63, b = bh / 12, h = bh % 12;
        const size_t cho = (size_t)ch * 4096;
        bf16x8 qa[2];
#pragma unroll
        for (int ks = 0; ks < 2; ++ks) qa[ks] = *(const bf16x8*)(QCg + cho + (size_t)(rb * 16 + n) * 64 + ks * 32 + 8 * kk);
        __syncthreads();
#pragma unroll
        for (int q = 0; q < 2; ++q) { const int cb = cb0 + q;
            f32x4 acc = *(const f32x4*)(Y0g + cho + (size_t)((wave * 2 + q) * 64 + lane) * 4);
#pragma unroll
            for (int ks = 0; ks < 2; ++ks) acc = __builtin_amdgcn_mfma_f32_16x16x32_bf16(qa[ks], *(const bf16x8*)(SST + cho + (size_t)(cb * 16 + n) * 64 + ks * 32 + 8 * kk), acc, 0, 0, 0);
#pragma unroll
            for (int e = 0; e < 4; ++e) yb[(rb * 16 + 4 * kk + e) * 68 + cb * 16 + n] = acc[e]; }
        __syncthreads();
#pragma unroll
        for (int q = 0; q < 8; ++q) {
            const int t = wave * 8 + q; const size_t tok = (size_t)b * SEQ + (size_t)c * 64 + t;
            const float y = yb[t * 68 + lane];
            const float mean = wave_sum(y) * (1.0f / 64.0f); const float dlt = y - mean; const float var = wave_sum(dlt * dlt) * (1.0f / 64.0f);
            const int cidx = h * 64 + lane;
            float o = dlt * rsqrtf(var + 64e-5f) * gn_g[cidx] + gn_b[cidx];
            o += RK[tok * 16 + h] * V[tok * 768 + cidx];
            o *= GG[tok * 768 + cidx];
            mix[tok * D + cidx] = f2bf(o);
        }
    }
}

DI void p_ln1_route(const Frame F, int l, const float* xin) {
    const float* tmp = WSP(float, WS_TMP); float* x1 = WSP(float, WS_X1); bf16_t* x1b = WSP(bf16_t, WS_X1BF);
    const float* g = INP(19) + (size_t)l * D; const float* bta = INP(20) + (size_t)l * D;
    const float* rw = INP(21); const float* rb = INP(22);
    unsigned* cnt = F.ctl + CW_MOECNT + l * 32; int* tokl = WSP(int, WS_TOKL); float* gate = WSP(float, WS_GATE);
    const int lane = F.lane;
    LAS float* xl = (LAS float*)F.lds + F.wave * 4096;
    for (int pr = F.wg * 8 + F.wave; pr < T / 2; pr += F.G * 8) {
#pragma unroll
        for (int u = 0; u < 2; ++u) {
            const size_t t = (size_t)pr * 2 + u;
            float xv[32]; float sm = 0.f;
#pragma unroll
            for (int i = 0; i < 8; ++i) { const f32x4 a = *(const f32x4*)(xin + t * D + 256 * i + 4 * lane), m = *(const f32x4*)(tmp + t * D + 256 * i + 4 * lane);
#pragma unroll
                for (int j = 0; j < 4; ++j) { const float v = ALPHA * a[j] + m[j]; xv[4 * i + j] = v; sm += v; } }
            const float mean = wave_sum(sm) * (1.0f / 2048.0f);
            float sq = 0.f;
#pragma unroll
            for (int i = 0; i < 32; ++i) { const float dl = xv[i] - mean; sq += dl * dl; }
            const float rstd = rsqrtf(wave_sum(sq) * (1.0f / 2048.0f) + 1e-5f);
#pragma unroll
            for (int i = 0; i < 8; ++i) { const f32x4 gg = *(const f32x4*)(g + 256 * i + 4 * lane), bb = *(const f32x4*)(bta + 256 * i + 4 * lane); f32x4 o;
#pragma unroll
                for (int j = 0; j < 4; ++j) o[j] = (xv[4 * i + j] - mean) * rstd * gg[j] + bb[j];
                *(f32x4*)(x1 + t * D + 256 * i + 4 * lane) = o;
                *(LAS f32x4*)(xl + u * 2048 + 256 * i + 4 * lane) = o;
                u32x2 w; w.x = pack2(o[0], o[1]); w.y = pack2(o[2], o[3]); *(u32x2*)(x1b + t * D + 256 * i + 4 * lane) = w; }
        }
        __builtin_amdgcn_s_waitcnt(0xc07f);
        const int e = lane & 31;
        const LAS float* xr = xl + (lane >> 5) * 2048;
        const float* wcol = rw + e;
        float a0 = 0.f, a1 = 0.f, a2 = 0.f, a3 = 0.f;
#pragma unroll 4
        for (int k = 0; k < 2048; k += 4) {
            const f32x4 xq = *(const LAS f32x4*)(xr + k);
            a0 += xq[0] * wcol[(size_t)(k + 0) * 32]; a1 += xq[1] * wcol[(size_t)(k + 1) * 32]; a2 += xq[2] * wcol[(size_t)(k + 2) * 32]; a3 += xq[3] * wcol[(size_t)(k + 3) * 32];
        }
        const float logit = (a0 + a1) + (a2 + a3);
        const float score = 1.0f / (1.0f + expf(-logit)), sel = score + rb[e];
        const int gb = lane & ~3;
        const float s0 = __shfl(sel, gb), s1 = __shfl(sel, gb + 1), s2 = __shfl(sel, gb + 2), s3 = __shfl(sel, gb + 3);
        const float ha = fmaxf(s0, s1), hb = fminf(s0, s1), hc = fmaxf(s2, s3), hd = fminf(s2, s3);
        float gv = fmaxf(ha, hc) + fmaxf(fminf(ha, hc), fmaxf(hb, hd)); int gi = e >> 2;
#pragma unroll
        for (int msk = 4; msk <= 16; msk <<= 1) { const float ov = __shfl_xor(gv, msk); const int oi = __shfl_xor(gi, msk); if (ov > gv || (ov == gv && oi < gi)) { gv = ov; gi = oi; } }
        const int base = (lane & 32) + 4 * gi;
        float a[4], sc4[4];
#pragma unroll
        for (int k = 0; k < 4; ++k) { a[k] = __shfl(sel, base + k); sc4[k] = __shfl(score, base + k); }
        int i1 = 0; float v1 = a[0];
#pragma unroll
        for (int k = 1; k < 4; ++k) if (a[k] > v1) { v1 = a[k]; i1 = k; }
        int i2 = -1; float v2 = -3.0e38f;
#pragma unroll
        for (int k = 0; k < 4; ++k) if (k != i1 && a[k] > v2) { v2 = a[k]; i2 = k; }
        float g1 = 0.f, g2 = 0.f;
#pragma unroll
        for (int k = 0; k < 4; ++k) { if (k == i1) g1 = sc4[k]; if (k == i2) g2 = sc4[k]; }
        if (e == 0) {
            const int t = pr * 2 + (lane >> 5); const int e1 = 4 * gi + i1, e2 = 4 * gi + i2; const float dn = g1 + g2;
            const unsigned r1 = atomicAdd(cnt + e1, 1u); tokl[e1 * 8192 + r1] = 2 * t;
            const unsigned r2 = atomicAdd(cnt + e2, 1u); tokl[e2 * 8192 + r2] = 2 * t + 1;
            gate[2 * t] = g1 / dn; gate[2 * t + 1] = g2 / dn;
        }
    }
}

DI void p_ln2(const Frame F, int l) {
    const float* x1 = WSP(float, WS_X1); const bf16_t* ybt = WSP(bf16_t, WS_YBT); const float* gate = WSP(float, WS_GATE);
    float* x2 = WSP(float, WS_TMP); bf16_t* x2b = WSP(bf16_t, WS_X1BF);
    const float* g = INP(26) + (size_t)l * D; const float* bta = INP(27) + (size_t)l * D;
    const int lane = F.lane;
    for (int t = F.wg * 8 + F.wave; t < T; t += F.G * 8) {
        const float g0 = gate[2 * t], g1 = gate[2 * t + 1];
        float xv[32]; float sm = 0.f;
#pragma unroll
        for (int i = 0; i < 8; ++i) { const size_t o = 256 * i + 4 * lane; const f32x4 a = *(const f32x4*)(x1 + (size_t)t * D + o);
            const u32x2 y0 = *(const u32x2*)(ybt + (size_t)(2 * t) * D + o), y1 = *(const u32x2*)(ybt + (size_t)(2 * t + 1) * D + o);
            xv[4 * i] = ALPHA * a[0] + (g0 * bflo(y0.x) + g1 * bflo(y1.x)); xv[4 * i + 1] = ALPHA * a[1] + (g0 * bfhi(y0.x) + g1 * bfhi(y1.x));
            xv[4 * i + 2] = ALPHA * a[2] + (g0 * bflo(y0.y) + g1 * bflo(y1.y)); xv[4 * i + 3] = ALPHA * a[3] + (g0 * bfhi(y0.y) + g1 * bfhi(y1.y));
            sm += (xv[4 * i] + xv[4 * i + 1]) + (xv[4 * i + 2] + xv[4 * i + 3]); }
        const float mean = wave_sum(sm) * (1.0f / 2048.0f);
        float sq = 0.f;
#pragma unroll
        for (int i = 0; i < 32; ++i) { const float dl = xv[i] - mean; sq += dl * dl; }
        const float rstd = rsqrtf(wave_sum(sq) * (1.0f / 2048.0f) + 1e-5f);
#pragma unroll
        for (int i = 0; i < 8; ++i) { const size_t o = 256 * i + 4 * lane; const f32x4 gg = *(const f32x4*)(g + o), bb = *(const f32x4*)(bta + o); f32x4 r;
#pragma unroll
            for (int j = 0; j < 4; ++j) r[j] = (xv[4 * i + j] - mean) * rstd * gg[j] + bb[j];
            *(f32x4*)(x2 + (size_t)t * D + o) = r; u32x2 w; w.x = pack2(r[0], r[1]); w.y = pack2(r[2], r[3]); *(u32x2*)(x2b + (size_t)t * D + o) = w; }
    }
}

DI int finish_units(const Frame F, int n) {
    LAS int* cw = (LAS int*)(F.lds + LDS_CTL);
    if (F.tid == 0) cw[4] = n;
    __syncthreads();
    return __builtin_amdgcn_readfirstlane(cw[4]);
}
DI int moe_units_body(const Frame F, int l, bool gemm1) {
    LAS int* mt = (LAS int*)(F.lds + LDS_MOE); LAS int* utab = (LAS int*)(F.lds + LDS_UTAB); LAS int* rowl = (LAS int*)(F.lds + LDS_ROWL);
    const int* tokl = WSP(int, WS_TOKL);
    int n = 0;
    if (F.tid == 0) {
        int hb = 0, nrb = 0;
        for (int e = 0; e < 32; ++e) { int c = (int)__hip_atomic_load(F.ctl + CW_MOECNT + l * 32 + e, __ATOMIC_RELAXED, __HIP_MEMORY_SCOPE_AGENT); if (c > 8192) c = 8192;
            mt[e] = c; mt[32 + e] = hb; const int nb = (c + 255) >> 8;
            for (int j = 0; j < nb && nrb < 128; ++j) { mt[64 + nrb] = e; mt[192 + nrb] = j; ++nrb; }
            hb += nb * 256; }
        const int npn = gemm1 ? 4 : 8;
        for (int L = F.wg; L < nrb * npn && n < 4; L += F.G) {
            const int rb = L / npn, pn = L - rb * npn, e = mt[64 + rb], j = mt[192 + rb], cnt = mt[e], row0 = mt[32 + e] + j * 256;
            const int valid = (cnt - j * 256) < 256 ? (cnt - j * 256) : 256;
            if (gemm1) pg8::unit_put(utab, n, WSP(bf16_t, WS_X1BF), WSP(bf16_t, WS_WGU) + ((size_t)(l * 32 + e) * 1024 + (size_t)pn * 256) * 2048, WSP(bf16_t, WS_HB), 2048, DEXP, row0, pn * 256, e * 8192 + j * 256, valid);
            else pg8::unit_put(utab, n, WSP(bf16_t, WS_HB) + (size_t)row0 * DEXP, WSP(bf16_t, WS_WDN) + ((size_t)(l * 32 + e) * 2048 + (size_t)pn * 256) * 512, WSP(bf16_t, WS_YBT), 512, D, row0, pn * 256, e * 8192 + j * 256, valid);
            ++n;
        }
    }
    n = finish_units(F, n);
    for (int x = F.tid; x < n * 256; x += 512) { const int ui = x >> 8, r = x & 255, a0 = utab[ui * pg8::UD + 10], a1 = utab[ui * pg8::UD + 11];
        const int v = (r < a1) ? tokl[a0 + r] : -1; rowl[x] = gemm1 ? (v < 0 ? 0 : (v >> 1)) : v; }
    __syncthreads();
    return n;
}

__device__ __noinline__ int moe_units(LAS unsigned char* lds_, GAS unsigned char* ws_, int wave_, int l, int gemm1) { const Frame F = make_frame(lds_, ws_, wave_); return moe_units_body(F, l, gemm1 != 0); }
PHASE_FN ph_prologue(PHASE_ARGS) { PHASE_FRAME; p_prologue(F); }
GEMM_FN ph_gemm_in(PHASE_ARGS, int l) {
    PHASE_FRAME; LAS int* utab = (LAS int*)(F.lds + LDS_UTAB);
    int n = 0;
    if (F.tid == 0) { int Lb = 0;
        pg8::build_dense(utab, n, Lb, WSP(bf16_t, WS_XBF), WSP(bf16_t, WS_WIN) + (size_t)l * 8192 * 2048, WSP(bf16_t, WS_Z), 2, T, 8192, 2048, ZLD, F.G, F.wg);
        pg8::build_dense(utab, n, Lb, WSP(bf16_t, WS_PBF) + (size_t)l * T * PLE, WSP(bf16_t, WS_WPP) + (size_t)l * 2048 * 256, WSP(bf16_t, WS_PP), 2, T, 2048, 256, D, F.G, F.wg); }
    n = finish_units(F, n);
    pg8::EpiBf16 E; pg8::gemm_phase<pg8::EpiBf16, false>(F.lds, F.tid, utab, n, nullptr, E);
}
PHASE_FN ph_rwkv_prep(PHASE_ARGS, int l) { PHASE_FRAME; p_rwkv_prep(F, l); }
PHASE_FN ph_mla_prep(PHASE_ARGS, int l) { PHASE_FRAME; p_mla_prep(F, l); p_vtd_prep(F); }
GEMM_FN ph_gemm_mla(PHASE_ARGS, int l) {
    PHASE_FRAME; LAS int* utab = (LAS int*)(F.lds + LDS_UTAB);
    int n = 0;
    if (F.tid == 0) { int Lb = 0;
        pg8::build_dense(utab, n, Lb, WSP(bf16_t, WS_QN), WSP(bf16_t, WS_WUQ) + (size_t)l * 1280 * 512, WSP(bf16_t, WS_QB), 2, T, 1280, 512, 1280, F.G, F.wg);
        pg8::build_dense(utab, n, Lb, WSP(bf16_t, WS_KVN), WSP(bf16_t, WS_WUKV) + (size_t)l * 1536 * 256, WSP(bf16_t, WS_KC), 2, T, 768, 256, 768, F.G, F.wg);
        pg8::build_dense(utab, n, Lb, WSP(bf16_t, WS_WUKV) + (size_t)l * 1536 * 256 + (size_t)768 * 256, WSP(bf16_t, WS_KVN), WSP(bf16_t, WS_VT), 2, 768, T, 256, T, F.G, F.wg); }
    n = finish_units(F, n);
    pg8::EpiBf16 E; pg8::gemm_phase<pg8::EpiBf16, false>(F.lds, F.tid, utab, n, nullptr, E);
}
PHASE_FN ph_dil(PHASE_ARGS) { PHASE_FRAME; for (int it = F.wg * 8 + F.wave; it < 2 * 12 * 128; it += F.G * 8) dil_item(F, it); }
PHASE_FN ph_scan(PHASE_ARGS, int l) { PHASE_FRAME; p_rwkv_pass2(F, F.wg); }
PHASE_FN ph_rwkv1(PHASE_ARGS, int l) { PHASE_FRAME; p_rwkv_pass1(F, l); }
PHASE_FN ph_rwkv3(PHASE_ARGS, int l) { PHASE_FRAME; p_rwkv_pass3(F, l); }
PHASE_FN ph_attn_queue(PHASE_ARGS, int l, int rep) {
    PHASE_FRAME;
    unsigned* q = F.ctl + CW_QUEUE + l * 64 + rep * 8;
    LAS int* cw = (LAS int*)(F.lds + LDS_CTL);
    for (;;) {
        __syncthreads();
        if (F.tid == 0) cw[5] = (int)atomicAdd(q, 1u);
        __syncthreads();
        const int it = __builtin_amdgcn_readfirstlane(cw[5]);
        if (it >= 480) break;
        mla_wg_item(F, it);
    }
}
PHASE_FN ph_combine(PHASE_ARGS) {
    PHASE_FRAME;
    for (int it = F.wg * 8 + F.wave; it < 1024; it += F.G * 8) { if (it < 512) dilc_item(F, it); else mla_combine_item(F, it - 512); }
}
GEMM_FN ph_gemm_out(PHASE_ARGS, int l) {
    PHASE_FRAME; LAS int* utab = (LAS int*)(F.lds + LDS_UTAB);
    int n = 0;
    if (F.tid == 0) { int Lb = 0; pg8::build_dense(utab, n, Lb, WSP(bf16_t, WS_MIX), WSP(bf16_t, WS_WOUT) + (size_t)l * 2048 * 2048, WSP(float, WS_TMP), 4, T, 2048, 2048, D, F.G, F.wg); }
    n = finish_units(F, n);
    pg8::EpiF32 E; pg8::gemm_phase<pg8::EpiF32, false>(F.lds, F.tid, utab, n, nullptr, E);
}
PHASE_FN ph_ln1(PHASE_ARGS, int l) { PHASE_FRAME; p_ln1_route(F, l, (l == 0) ? INP(0) : (const float*)WSP(float, WS_XCUR)); }
GEMM_FN ph_moe1(PHASE_ARGS, int l) {
    PHASE_FRAME; const int n = __builtin_amdgcn_readfirstlane(moe_units(F.lds, F.ws, F.wave, l, 1));
    pg8::EpiGU E; pg8::gemm_phase<pg8::EpiGU, true>(F.lds, F.tid, (const LAS int*)(F.lds + LDS_UTAB), n, (const LAS int*)(F.lds + LDS_ROWL), E);
}
GEMM_FN ph_moe2(PHASE_ARGS, int l) {
    PHASE_FRAME; const int n = __builtin_amdgcn_readfirstlane(moe_units(F.lds, F.ws, F.wave, l, 0));
    pg8::EpiScatter E{(const LAS int*)(F.lds + LDS_ROWL)}; pg8::gemm_phase<pg8::EpiScatter, false>(F.lds, F.tid, (const LAS int*)(F.lds + LDS_UTAB), n, (const LAS int*)(F.lds + LDS_ROWL), E);
}
PHASE_FN ph_ln2(PHASE_ARGS, int l) { PHASE_FRAME; p_ln2(F, l); }
GEMM_FN ph_ple(PHASE_ARGS, int l, float* out_) {
    PHASE_FRAME; LAS int* utab = (LAS int*)(F.lds + LDS_UTAB);
    const bool lastl = (l == NL - 1);
    float* outp = (float*)(GAS float*)rfl64((unsigned long long)out_);
    int n = 0;
    if (F.tid == 0) { int Lb = 0; pg8::build_dense(utab, n, Lb, WSP(bf16_t, WS_X1BF), WSP(bf16_t, WS_WPG) + (size_t)l * 2048 * 2048, lastl ? (void*)outp : (void*)WSP(float, WS_XCUR), 4, T, 2048, 2048, D, F.G, F.wg); }
    n = finish_units(F, n);
    pg8::EpiPle E{WSP(float, WS_TMP), WSP(bf16_t, WS_PP), lastl ? (bf16_t*)nullptr : WSP(bf16_t, WS_XBF)};
    pg8::gemm_phase<pg8::EpiPle, false>(F.lds, F.tid, utab, n, nullptr, E);
}

constexpr int NPH = 11;
DI int lz(int l) { asm volatile("" : "+s"(l)); return l; }
typedef __attribute__((address_space(4))) const Params* kparams_t;
DI kparams_t kargs() { unsigned long long a = (unsigned long long)__builtin_amdgcn_kernarg_segment_ptr(); asm volatile("" : "+s"(a)); return (kparams_t)a; }
__global__ void __launch_bounds__(512, 2) mk_fwd(Params P) {
    extern __shared__ __attribute__((aligned(16))) unsigned char lds_raw[];
    const int wave_s = __builtin_amdgcn_readfirstlane((int)(threadIdx.x >> 6));
    {
        LAS unsigned char* lds0 = (LAS unsigned char*)lds_raw;
        if (threadIdx.x < 16) ((LAS unsigned*)(lds0 + LDS_CTL))[threadIdx.x] = 0u;
        if (threadIdx.x == 0) {
#pragma unroll
            for (int i = 0; i < 30; ++i) ((LAS unsigned long long*)(lds0 + LDS_INTAB))[i] = (unsigned long long)P.in[i]; }
        __syncthreads();
#if !MK_PER_PHASE
        (void)xcd_barrier_post((unsigned*)P.ws, (volatile LAS unsigned*)(lds0 + LDS_CTL), threadIdx.x == 0);
#endif
    }
#define KLDS ((LAS unsigned char*)lds_raw)
#define KWS ((GAS unsigned char*)kargs()->ws)
#if MK_PER_PHASE
#define GRID_BAR() do { } while (0)
#else
#define GRID_BAR() do { XcdBarrier bar_; bar_.bar = (unsigned*)kargs()->ws; bar_.x = xb_xcc_id(); bar_.st = (volatile LAS unsigned*)(KLDS + LDS_CTL); xcd_barrier(bar_, my_tid(wave_s) == 0); } while (0)
#endif
#ifndef PH_MASK
#define PH_MASK 0x7ff
#endif
#define IN(k) (kargs()->ph_lo <= (k) && (k) < kargs()->ph_hi)
#define ON(j) (((PH_MASK) >> (j)) & 1)
#ifndef DUP_MASK
#define DUP_MASK 0
#endif
#define REPS(j) ((((DUP_MASK) >> (j)) & 1) ? 2 : 1)
#define SEAM(k) do { __syncthreads(); if (IN(k) && IN((k) + 1)) GRID_BAR(); } while (0)

    if (ON(0) && IN(0)) for (int rep = 0; rep < REPS(0); ++rep) { ph_prologue(KLDS, KWS, wave_s); __syncthreads(); }
    SEAM(0);
    for (int l = 0; l < NL; ++l) {
        const int p0 = 1 + l * NPH;
        if (ON(1) && IN(p0 + 0)) for (int rep = 0; rep < REPS(1); ++rep) { ph_gemm_in(KLDS, KWS, wave_s, lz(l)); __syncthreads(); }
        SEAM(p0 + 0);
        if (ON(2) && IN(p0 + 1)) for (int rep = 0; rep < REPS(2); ++rep) { ph_rwkv_prep(KLDS, KWS, wave_s, lz(l)); __syncthreads(); ph_mla_prep(KLDS, KWS, wave_s, lz(l)); __syncthreads(); }
        SEAM(p0 + 1);
        if (ON(3) && IN(p0 + 2)) for (int rep = 0; rep < REPS(3); ++rep) { ph_gemm_mla(KLDS, KWS, wave_s, lz(l)); ph_dil(KLDS, KWS, wave_s); __syncthreads(); ph_rwkv1(KLDS, KWS, wave_s, lz(l)); __syncthreads(); }
        SEAM(p0 + 2);
        if (ON(4) && IN(p0 + 3)) for (int rep = 0; rep < REPS(4); ++rep) { if (blockIdx.x < 24) for (int r2 = 0; r2 < REPS(11); ++r2) ph_scan(KLDS, KWS, wave_s, lz(l)); for (int r2 = 0; r2 < REPS(12); ++r2) ph_attn_queue(KLDS, KWS, wave_s, lz(l), rep * 2 + r2); __syncthreads(); }
        SEAM(p0 + 3);
        if (ON(4) && IN(p0 + 4)) for (int rep = 0; rep < REPS(13); ++rep) { ph_rwkv3(KLDS, KWS, wave_s, lz(l)); ph_combine(KLDS, KWS, wave_s); __syncthreads(); }
        SEAM(p0 + 4);
        if (ON(5) && IN(p0 + 5)) for (int rep = 0; rep < REPS(5); ++rep) { ph_gemm_out(KLDS, KWS, wave_s, lz(l)); __syncthreads(); }
        SEAM(p0 + 5);
        if (ON(6) && IN(p0 + 6)) ph_ln1(KLDS, KWS, wave_s, lz(l));
        SEAM(p0 + 6);
        if (ON(7) && IN(p0 + 7)) for (int rep = 0; rep < REPS(7); ++rep) { ph_moe1(KLDS, KWS, wave_s, lz(l)); __syncthreads(); }
        SEAM(p0 + 7);
        if (ON(8) && IN(p0 + 8)) for (int rep = 0; rep < REPS(8); ++rep) { ph_moe2(KLDS, KWS, wave_s, lz(l)); __syncthreads(); }
        SEAM(p0 + 8);
        if (ON(9) && IN(p0 + 9)) for (int rep = 0; rep < REPS(9); ++rep) { ph_ln2(KLDS, KWS, wave_s, lz(l)); __syncthreads(); }
        SEAM(p0 + 9);
        if (ON(10) && IN(p0 + 10)) for (int rep = 0; rep < REPS(10); ++rep) { ph_ple(KLDS, KWS, wave_s, lz(l), kargs()->out); __syncthreads(); }
        SEAM(p0 + 10);
    }
#undef KLDS
#undef KWS
}

extern "C" void kernel_launch(void* const* d_in, const int* in_sizes, int n_in, void* d_out, int out_size, void* d_ws, size_t ws_size, hipStream_t stream) {
    static int grid = 0;
    if (grid == 0) {
        if (n_in != 30 || ws_size < WS_END) { fprintf(stderr, "kernel_launch: need 30 inputs and %zu bytes of workspace (got %d, %zu)\n", (size_t)WS_END, n_in, ws_size); grid = -1; return; }
        int dev = 0, cus = 0, per_cu = 0;
        if (hipGetDevice(&dev) != hipSuccess || hipDeviceGetAttribute(&cus, hipDeviceAttributeMultiprocessorCount, dev) != hipSuccess) { grid = -1; return; }
        if (hipFuncSetAttribute((const void*)mk_fwd, hipFuncAttributeMaxDynamicSharedMemorySize, LDS_BYTES) != hipSuccess) { fprintf(stderr, "kernel_launch: hipFuncSetAttribute failed\n"); grid = -1; return; }
        if (hipOccupancyMaxActiveBlocksPerMultiprocessor(&per_cu, (const void*)mk_fwd, 512, LDS_BYTES) != hipSuccess || per_cu < 1) { fprintf(stderr, "kernel_launch: occupancy query says %d\n", per_cu); }
        (void)hipGetLastError();
        grid = cus;
    }
    if (grid < 0) return;
    (void)hipMemsetAsync(d_ws, 0, CTL_BYTES, stream);
    Params p{};
    for (int i = 0; i < 30; ++i) p.in[i] = (const float*)d_in[i];
    p.out = (float*)d_out; p.ws = (unsigned char*)d_ws;
    const int nph = 1 + NL * NPH;
#if MK_PER_PHASE
    for (int k = 0; k < nph; ++k) { p.ph_lo = k; p.ph_hi = k + 1; hipLaunchKernelGGL(mk_fwd, dim3(grid), dim3(512), LDS_BYTES, stream, p); }
#else
    p.ph_lo = 0; p.ph_hi = nph;
    hipLaunchKernelGGL(mk_fwd, dim3(grid), dim3(512), LDS_BYTES, stream, p);
#endif
}
```

```cpp
#include <hip/hip_runtime.h>
#include <cstdio>
#include <cstdint>

#ifndef MK_PER_PHASE
#define MK_PER_PHASE 0
#endif

#define DI __device__ __forceinline__
#define LAS __attribute__((address_space(3)))
#define GAS __attribute__((address_space(1)))
typedef unsigned short bf16_t;
typedef short bf16x8 __attribute__((ext_vector_type(8)));
typedef float f32x2 __attribute__((ext_vector_type(2)));
typedef float f32x4 __attribute__((ext_vector_type(4)));
typedef float f32x16 __attribute__((ext_vector_type(16)));
typedef unsigned u32x2 __attribute__((ext_vector_type(2)));
typedef unsigned u32x4 __attribute__((ext_vector_type(4)));
typedef __bf16 hbf2 __attribute__((ext_vector_type(2)));

DI unsigned pack2(float lo, float hi) { return __builtin_bit_cast(unsigned, __builtin_convertvector((f32x2){lo, hi}, hbf2)); }
DI float bf2f(bf16_t b) { return __uint_as_float(((unsigned)b) << 16); }
DI float bflo(unsigned w) { return __uint_as_float(w << 16); }
DI float bfhi(unsigned w) { return __uint_as_float(w & 0xffff0000u); }
DI bf16_t f2bf(float f) { return (bf16_t)(pack2(f, 0.f) & 0xffffu); }
DI float wave_sum(float v) { for (int o = 32; o >= 1; o >>= 1) v += __shfl_xor(v, o); return v; }
DI float sigmoidf_(float x) { return __builtin_amdgcn_rcpf(1.0f + __expf(-x)); }
DI float tanhf_(float x) { const float e = __expf(2.0f * x); return 1.0f - 2.0f * __builtin_amdgcn_rcpf(e + 1.0f); }
#define MFMA32(a, b, c) __builtin_amdgcn_mfma_f32_32x32x16_bf16((a), (b), (c), 0, 0, 0)

constexpr int T = 8192, SEQ = 4096, D = 2048, NL = 4, PLE = 256;
constexpr int ZLD = 8192;
constexpr int ZC_DQ = 2560, ZC_DK = 4096, ZC_DV = 5632, ZC_QA = 7168, ZC_KVA = 7680, ZC_KR = 7936;
constexpr int NEXP = 32, DEXP = 512, HB_ROWS = 24576;
constexpr float ALPHA = 1.681792830507429f;
constexpr float LOG2E = 1.4426950408889634f;

constexpr size_t CTL_BYTES = 131072;
constexpr size_t WS_WIN = CTL_BYTES;                              constexpr size_t SZ_WIN = (size_t)NL * 8192 * 2048 * 2;
constexpr size_t WS_WOUT = WS_WIN + SZ_WIN;                       constexpr size_t SZ_WOUT = (size_t)NL * 2048 * 2048 * 2;
constexpr size_t WS_WPG = WS_WOUT + SZ_WOUT;                      constexpr size_t SZ_WPG = SZ_WOUT;
constexpr size_t WS_WPP = WS_WPG + SZ_WPG;                        constexpr size_t SZ_WPP = (size_t)NL * 2048 * 256 * 2;
constexpr size_t WS_WGU = WS_WPP + SZ_WPP;                        constexpr size_t SZ_WGU = (size_t)NL * 32 * 1024 * 2048 * 2;
constexpr size_t WS_WDN = WS_WGU + SZ_WGU;                        constexpr size_t SZ_WDN = (size_t)NL * 32 * 2048 * 512 * 2;
constexpr size_t WS_WUQ = WS_WDN + SZ_WDN;                        constexpr size_t SZ_WUQ = (size_t)NL * 1280 * 512 * 2;
constexpr size_t WS_WUKV = WS_WUQ + SZ_WUQ;                       constexpr size_t SZ_WUKV = (size_t)NL * 1536 * 256 * 2;
constexpr size_t WS_ROPE = WS_WUKV + SZ_WUKV;                     constexpr size_t SZ_ROPE = (size_t)4096 * 32 * 8;
constexpr size_t WS_PBF = WS_ROPE + SZ_ROPE;                      constexpr size_t SZ_PBF = (size_t)NL * T * 256 * 2;
constexpr size_t WS_XCUR = WS_PBF + SZ_PBF;                       constexpr size_t SZ_XF = (size_t)T * D * 4;
constexpr size_t WS_XBF = WS_XCUR + SZ_XF;                        constexpr size_t SZ_XB = (size_t)T * D * 2;
constexpr size_t WS_Z = WS_XBF + SZ_XB;                           constexpr size_t SZ_Z = (size_t)T * ZLD * 2;
constexpr size_t SZ_RW1 = (size_t)T * 768 * 4;
constexpr size_t WS_RW = WS_Z + SZ_Z;
constexpr size_t WS_RK = WS_RW + 7 * SZ_RW1;                      constexpr size_t SZ_RK = (size_t)2 * T * 16 * 4;
constexpr size_t WS_QN = WS_RK + SZ_RK;                           constexpr size_t SZ_QN = (size_t)T * 512 * 2;
constexpr size_t WS_KVN = WS_QN + SZ_QN;                          constexpr size_t SZ_KVN = (size_t)T * 256 * 2;
constexpr size_t WS_KROPE = WS_KVN + SZ_KVN;                      constexpr size_t SZ_KROPE = (size_t)T * 64 * 2;
constexpr size_t WS_VTD = WS_KROPE + SZ_KROPE;                    constexpr size_t SZ_VTD = (size_t)2 * 12 * 128 * 4096 * 2;
constexpr size_t WS_QB = WS_VTD + SZ_VTD;                         constexpr size_t SZ_QB = (size_t)T * 1280 * 2;
constexpr size_t WS_KC = WS_QB + SZ_QB;                           constexpr size_t SZ_KC = (size_t)T * 768 * 2;
constexpr size_t WS_VT = WS_KC + SZ_KC;                           constexpr size_t SZ_VT = (size_t)768 * 8192 * 2;
constexpr size_t WS_OP = WS_VT + SZ_VT;                           constexpr size_t SZ_OP = (size_t)3 * T * 512 * 2;
constexpr size_t WS_LSE = WS_OP + SZ_OP;                          constexpr size_t SZ_LSE = (size_t)3 * T * 4 * 4;
constexpr size_t WS_MIX = WS_LSE + SZ_LSE;                        constexpr size_t SZ_MIX = SZ_XB;
constexpr size_t WS_TMP = WS_MIX + SZ_MIX;
constexpr size_t WS_X1 = WS_TMP + SZ_XF;
constexpr size_t WS_X1BF = WS_X1 + SZ_XF;
constexpr size_t WS_PP = WS_X1BF + SZ_XB;
constexpr size_t WS_TOKL = WS_PP + SZ_XB;                         constexpr size_t SZ_TOKL = (size_t)32 * 8192 * 4;
constexpr size_t WS_GATE = WS_TOKL + SZ_TOKL;                     constexpr size_t SZ_GATE = (size_t)T * 2 * 4;
constexpr size_t WS_HB = WS_GATE + SZ_GATE;                       constexpr size_t SZ_HB = (size_t)HB_ROWS * 512 * 2;
constexpr size_t WS_YBT = WS_HB + SZ_HB;                          constexpr size_t SZ_YBT = (size_t)T * 2 * 2048 * 2;
constexpr size_t WS_AC = WS_YBT + SZ_YBT;                         constexpr size_t SZ_CH4 = (size_t)1536 * 64 * 64 * 4;
constexpr size_t WS_GC = WS_AC + SZ_CH4;
constexpr size_t WS_Y0 = WS_GC + SZ_CH4;
constexpr size_t WS_QC = WS_Y0 + SZ_CH4;                          constexpr size_t SZ_CH2 = (size_t)1536 * 64 * 64 * 2;
constexpr size_t WS_SST = WS_QC + SZ_CH2;
constexpr size_t WS_OPM = WS_SST + SZ_CH2;                        constexpr size_t SZ_OPM = (size_t)4 * T * 768 * 2;
constexpr size_t WS_LSEM = WS_OPM + SZ_OPM;                       constexpr size_t SZ_LSEM = (size_t)4 * T * 8 * 4;
constexpr size_t WS_LORA = WS_LSEM + SZ_LSEM;                     constexpr size_t SZ_LORA1 = (size_t)768 * 256 * 2;
constexpr size_t WS_RWT = WS_LORA + NL * SZ_LORA1;                 constexpr size_t SZ_RWT = (size_t)32 * 2048 * 4;
constexpr size_t WS_XL = WS_RWT + SZ_RWT;                         constexpr size_t SZ_XL = (size_t)T * 256 * 2;
constexpr size_t WS_RWG = WS_XL + SZ_XL;                          constexpr size_t SZ_RWG = (size_t)NL * 32 * 2048 * 4;
constexpr size_t WS_RC = WS_RWG + SZ_RWG;                         constexpr size_t SZ_RC = (size_t)NL * 64 * 4;
constexpr size_t WS_END = WS_RC + SZ_RC;
constexpr int CW_QUEUE = 3584;
constexpr int CW_RBCNT = 16384;
constexpr int CW_MOECNT = 4096;

constexpr int LDS_STAGE = 131072;
constexpr int LDS_CTL = 131072;
constexpr int LDS_UTAB = LDS_CTL + 64;
constexpr int LDS_MOE = LDS_UTAB + 1024;
constexpr int LDS_INTAB = LDS_MOE + 1536;
constexpr int LDS_ROWL = 131072 + 4096;
constexpr int LDS_BYTES = 131072 + 4096 + 8192;

#define XB_TMO      128
#define XB_XCNT(j)  (256  + 64 * (j))
#define XB_XSUB(j)  (1280 + 64 * (j))
#define XB_XGEN(j)  (2304 + 64 * (j))
#define XB_TOP      3328
#define XB_TOPGEN   3392
#define XCD_BAR_WORDS 3456
#define XB_SPIN_CAP (1u << 22)

__device__ __forceinline__ unsigned xb_ld(unsigned* p)              { return __hip_atomic_load(p, __ATOMIC_RELAXED, __HIP_MEMORY_SCOPE_AGENT); }
__device__ __forceinline__ unsigned xb_add(unsigned* p, unsigned v) { return __hip_atomic_fetch_add(p, v, __ATOMIC_RELAXED, __HIP_MEMORY_SCOPE_AGENT); }
__device__ __forceinline__ unsigned xb_xcc_id() { return (unsigned)__builtin_amdgcn_s_getreg((3 << 11) | 20) & 0xFu; }
#define XB_SPIN(cond, bar) do { unsigned _sp = 0; while (cond) { __builtin_amdgcn_s_sleep(1); \
    if ((++_sp & 255u) == 0u) { if (xb_ld(&(bar)[XB_TMO])) break; if (_sp > XB_SPIN_CAP) { atomicAdd(&(bar)[XB_TMO], 1u); break; } } } } while (0)

struct XcdBarrier { unsigned* bar; unsigned x; volatile LAS unsigned* st; };

__device__ __forceinline__ XcdBarrier xcd_barrier_post(unsigned* bar, volatile LAS unsigned* st, bool leader) {
    XcdBarrier b; b.bar = bar; b.x = xb_xcc_id(); b.st = st;
    if (leader) (void)xb_add(&bar[XB_XCNT(b.x)], 1u);
    return b;
}
__device__ __forceinline__ void xcd_barrier_complete(unsigned* bar, unsigned x, unsigned& nloc, unsigned& nx) {
    const unsigned G = gridDim.x * gridDim.y * gridDim.z;
    unsigned sum, cnt, mine, sp = 0u;
    for (;;) {
        sum = 0u; cnt = 0u; mine = 0u;
#pragma unroll
        for (unsigned j = 0; j < 16; ++j) { const unsigned c = xb_ld(&bar[XB_XCNT(j)]); sum += c; cnt += (c > 0u) ? 1u : 0u; mine = (j == x) ? c : mine; }
        if (sum == G) break;
        __builtin_amdgcn_s_sleep(1);
        if ((++sp & 255u) == 0u) { if (xb_ld(&bar[XB_TMO])) break; if (sp > XB_SPIN_CAP) { atomicAdd(&bar[XB_TMO], 1u); break; } }
    }
    nloc = mine > 0u ? mine : 1u; nx = cnt > 0u ? cnt : 1u;
}
__device__ __forceinline__ void xcd_barrier(const XcdBarrier& b, bool leader) {
    asm volatile("s_waitcnt vmcnt(0)" ::: "memory");
    __syncthreads();
    if (leader) {
        unsigned* bar = b.bar;
        __builtin_amdgcn_s_waitcnt(0);
        unsigned nloc = b.st[0], nx = b.st[1];
        if (nloc == 0u) { xcd_barrier_complete(bar, b.x, nloc, nx); b.st[0] = nloc; b.st[1] = nx; }
        const unsigned old = xb_add(&bar[XB_XSUB(b.x)], 1u);
        const unsigned gen = old / nloc;
        if (old + 1u == (gen + 1u) * nloc) {
            __builtin_amdgcn_fence(__ATOMIC_RELEASE, "agent");
            asm volatile("s_waitcnt vmcnt(0)" ::: "memory");
            const unsigned og = xb_add(&bar[XB_TOP], 1u);
            const unsigned tg = og / nx;
            if (og + 1u == (tg + 1u) * nx) xb_add(&bar[XB_TOPGEN], 1u);
            else XB_SPIN(xb_ld(&bar[XB_TOPGEN]) == tg, bar);
            __builtin_amdgcn_fence(__ATOMIC_ACQUIRE, "agent");
            xb_add(&bar[XB_XGEN(b.x)], 1u);
            asm volatile("s_waitcnt vmcnt(0)" ::: "memory");
        } else {
            XB_SPIN(xb_ld(&bar[XB_XGEN(b.x)]) == gen, bar);
            __builtin_amdgcn_fence(__ATOMIC_ACQUIRE, "agent");
            asm volatile("s_waitcnt vmcnt(0)" ::: "memory");
        }
    }
    __syncthreads();
}

namespace pg8 {
constexpr int BM = 256, BK = 64, HALF = 128, HTB = HALF * BK * 2, STAGE_BYTES = 8 * HTB, NXCD = 8, WGM = 8;
DI int lds_byte(int r, int c) { const int st = (r >> 4) * 2 + (c >> 5), rr = r & 15, cc = c & 31, ob = rr * 64 + cc * 2; return st * 1024 + (ob ^ (((ob >> 9) & 1) << 5)); }
DI void stage_rc(int b, int& R, int& C) { const int st = b / 1024, sb = b % 1024, swz = sb ^ (((sb >> 9) & 1) << 5); R = (st >> 1) * 16 + swz / 64; C = (st & 1) * 32 + (swz % 64) / 2; }
DI int perm32(int rho) { const int n = rho >> 4, i = rho & 15; return 8 * (i >> 2) + 4 * n + (i & 3); }

struct Unit { GAS const char* a; GAS const char* b; GAS char* out; int K, ldc, row0, col0, aux0, aux1; };
constexpr int UD = 12;
DI void unit_put(LAS int* tab, int i, const void* a, const void* b, void* o, int K, int ldc, int row0, int col0, int aux0, int aux1) {
    LAS int* p = tab + i * UD; const unsigned long long ua = (unsigned long long)a, ub = (unsigned long long)b, uo = (unsigned long long)o;
    p[0] = (int)(unsigned)ua; p[1] = (int)(unsigned)(ua >> 32); p[2] = (int)(unsigned)ub; p[3] = (int)(unsigned)(ub >> 32); p[4] = (int)(unsigned)uo; p[5] = (int)(unsigned)(uo >> 32);
    p[6] = K; p[7] = ldc; p[8] = row0; p[9] = col0; p[10] = aux0; p[11] = aux1;
}
DI void unit_get(const LAS int* tab, int i, Unit& u) {
    const LAS int* p = tab + i * UD; int v[UD];
#pragma unroll
    for (int j = 0; j < UD; ++j) v[j] = __builtin_amdgcn_readfirstlane(p[j]);
    u.a = (GAS const char*)(((unsigned long long)(unsigned)v[1] << 32) | (unsigned)v[0]);
    u.b = (GAS const char*)(((unsigned long long)(unsigned)v[3] << 32) | (unsigned)v[2]);
    u.out = (GAS char*)(((unsigned long long)(unsigned)v[5] << 32) | (unsigned)v[4]);
    u.K = v[6]; u.ldc = v[7]; u.row0 = v[8]; u.col0 = v[9]; u.aux0 = v[10]; u.aux1 = v[11];
}
DI void build_dense(LAS int* tab, int& n, int& Lbase, const void* A, const void* Bt, void* out, int esz, int M, int N, int K, int ldc, int G, int c) {
    const int nM = M / BM, nN = N / BM, nwg = nM * nN;
    int L = c; if (L < Lbase) L += ((Lbase - L + G - 1) / G) * G;
    for (; L < Lbase + nwg; L += G) {
        int wgid = L - Lbase; { const int q = nwg / NXCD, r = nwg % NXCD, xcd = wgid % NXCD, off = wgid / NXCD; wgid = (xcd < r ? xcd * (q + 1) : r * (q + 1) + (xcd - r) * q) + off; }
        const int nig = WGM * nN, gid = wgid / nig, fm = gid * WGM, gsz = (nM - fm) < WGM ? (nM - fm) : WGM;
        const int pm = fm + ((wgid % nig) % gsz), pn = (wgid % nig) / gsz;
        unit_put(tab, n, (const char*)A + (size_t)pm * BM * K * 2, (const char*)Bt + (size_t)pn * BM * K * 2, out, K, ldc, pm * BM, pn * BM, 0, BM); ++n;
    }
    Lbase += nwg;
}

DI void rb_wait(unsigned* rbcnt, int rb, int wid) {
    if (wid == 0) {
        unsigned sp = 0;
        while ((unsigned)__builtin_amdgcn_readfirstlane((int)__hip_atomic_load(rbcnt + rb * 16, __ATOMIC_RELAXED, __HIP_MEMORY_SCOPE_AGENT)) < 32u) { __builtin_amdgcn_s_sleep(2); if (++sp > (1u << 22)) break; }
        __builtin_amdgcn_fence(__ATOMIC_ACQUIRE, "agent");
        asm volatile("s_waitcnt vmcnt(0)" ::: "memory");
    }
    asm volatile("" ::: "memory"); __builtin_amdgcn_s_barrier(); asm volatile("" ::: "memory");
}
template <class Epi, bool GATHER, bool HOOK = false>
DI void gemm_phase(LAS unsigned char* lds, const int tid, const LAS int* utab, const int nunits, const LAS int* rowl, const Epi& E, unsigned* rbcnt = nullptr) {
    const int wid = __builtin_amdgcn_readfirstlane(tid >> 6), lane = tid & 63, wr = wid >> 2, wc = wid & 3, fr = lane & 15, fq = lane >> 4;
    const size_t kstep = (size_t)(BK * 2);
    const unsigned ldsw = (unsigned)wid * 1024u;
    const int aoff = lds_byte(wr * 64 + fr, fq * 8), boff = lds_byte(wc * 32 + fr, fq * 8);
#define PG8_SA(b, h) (((b) * 2 + (h)) * HTB)
#define PG8_SB(b, h) ((4 + (b) * 2 + (h)) * HTB)
#define PG8_STAGE(bufoff, gbase, voff) do { _Pragma("unroll") for (int _i = 0; _i < 2; ++_i) \
        __builtin_amdgcn_global_load_lds((GAS const unsigned*)((gbase) + (voff)[_i]), (LAS unsigned*)(lds + (bufoff) + ldsw + _i * 8192), 16, 0, 0); } while (0)
#define PG8_LDA(dst, b, h) do { _Pragma("unroll") for (int m = 0; m < 4; ++m) _Pragma("unroll") for (int k = 0; k < 2; ++k) dst[m][k] = *(const LAS bf16x8*)(lds + PG8_SA(b, h) + aoff + m * 2048 + k * 1024); } while (0)
#define PG8_LDB(dst, b, h) do { _Pragma("unroll") for (int n = 0; n < 2; ++n) _Pragma("unroll") for (int k = 0; k < 2; ++k) dst[n][k] = *(const LAS bf16x8*)(lds + PG8_SB(b, h) + boff + n * 2048 + k * 1024); } while (0)
#define PG8_MMA(ai, bj, At, Bt) do { __builtin_amdgcn_s_setprio(1); _Pragma("unroll") for (int m = 0; m < 4; ++m) _Pragma("unroll") for (int n = 0; n < 2; ++n) _Pragma("unroll") for (int k = 0; k < 2; ++k) \
        acc[ai][bj][m][n] = __builtin_amdgcn_mfma_f32_16x16x32_bf16(Bt[n][k], At[m][k], acc[ai][bj][m][n], 0, 0, 0); __builtin_amdgcn_s_setprio(0); } while (0)
#define PG8_WAIT_V(n) asm volatile("s_waitcnt vmcnt(" #n ")" ::: "memory")
#define PG8_WAIT_L(n) asm volatile("s_waitcnt lgkmcnt(" #n ")" ::: "memory")
#define PG8_BAR __builtin_amdgcn_s_barrier()
#define PG8_SCHED __builtin_amdgcn_sched_barrier(0)
#define PG8_RC(R_, C_, Rb_, i_) int R_, C_; { int t_ = tid; asm volatile("" : "+v"(t_)); stage_rc(t_ * 16 + (i_) * 8192, R_, C_); } const int Rb_ = Epi::PERM ? ((R_ & ~31) + perm32(R_ & 31)) : R_
#define PG8_VOFF_D(va, vb, K_) do { _Pragma("unroll") for (int _i = 0; _i < 2; ++_i) { PG8_RC(_R, _C, _Rb, _i); va[0][_i] = (unsigned)(_R * (K_) + _C) * 2u; va[1][_i] = va[0][_i]; vb[_i] = (unsigned)(_Rb * (K_) + _C) * 2u; } } while (0)
#define PG8_VOFF_G(va, K_, ui_) do { _Pragma("unroll") for (int _i = 0; _i < 2; ++_i) { PG8_RC(_R, _C, _Rb, _i); (void)_Rb; _Pragma("unroll") for (int _h = 0; _h < 2; ++_h) { \
        const int _r = rowl[(ui_) * BM + _h * HALF + _R]; va[_h][_i] = (unsigned)(_r * (K_) + _C) * 2u; } } } while (0)
    if (nunits <= 0) return;
    Unit cur, nxt; int ui = 0;
    unit_get(utab, 0, cur);
    f32x4 acc[2][2][4][2];
#pragma unroll
    for (int a = 0; a < 2; ++a)
#pragma unroll
        for (int b = 0; b < 2; ++b)
#pragma unroll
            for (int m = 0; m < 4; ++m)
#pragma unroll
                for (int n = 0; n < 2; ++n) acc[a][b][m][n] = (f32x4){0.f, 0.f, 0.f, 0.f};
    bf16x8 At[4][2], B0[2][2], B1[2][2];
    unsigned vc[2][2], vbc[2], vn[2][2];
    if (HOOK) rb_wait(rbcnt, cur.aux1 >> 16, wid);
    PG8_VOFF_D(vc, vbc, cur.K);
    if (GATHER) PG8_VOFF_G(vc, cur.K, 0);
    GAS const char* cA = cur.a; GAS const char* cB = cur.b;
    size_t hsc = (size_t)HALF * cur.K * 2;
    size_t hsa = GATHER ? (size_t)0 : hsc;
    PG8_STAGE(PG8_SB(0, 0), cB, vbc); PG8_STAGE(PG8_SA(0, 0), cA, vc[0]); PG8_STAGE(PG8_SB(0, 1), cB + hsc, vbc); PG8_STAGE(PG8_SA(0, 1), cA + hsa, vc[1]);
    if (wr == 1) PG8_BAR;
    PG8_WAIT_V(4); PG8_BAR;
    PG8_STAGE(PG8_SB(1, 0), cB + kstep, vbc); PG8_STAGE(PG8_SA(1, 0), cA + kstep, vc[0]); PG8_STAGE(PG8_SB(1, 1), cB + hsc + kstep, vbc);
    PG8_WAIT_V(6); PG8_BAR;
    for (;;) {
        const bool has_next = (ui + 1 < nunits);
        if (has_next) { unit_get(utab, ui + 1, nxt); if (GATHER) PG8_VOFF_G(vn, nxt.K, ui + 1); }
        else { nxt = cur;
            if (GATHER) {
#pragma unroll
                for (int i = 0; i < 2; ++i) { vn[0][i] = vc[0][i]; vn[1][i] = vc[1][i]; } } }
        GAS const char* nA = nxt.a; GAS const char* nB = nxt.b;
        const int nt = cur.K / BK;
        for (int t = 0; t < nt; t += 2) {
            const bool last = (t == nt - 2);
            GAS const char* a1 = cA + (size_t)(t + 1) * kstep;
            GAS const char* a2 = last ? nA : cA + (size_t)(t + 2) * kstep; GAS const char* b2 = last ? nB : cB + (size_t)(t + 2) * kstep;
            GAS const char* a3 = a2 + kstep; GAS const char* b3 = b2 + kstep;
            if (HOOK) { if (last && has_next) rb_wait(rbcnt, nxt.aux1 >> 16, wid); }
            PG8_LDB(B0, 0, 0); PG8_SCHED; PG8_LDA(At, 0, 0); PG8_STAGE(PG8_SA(1, 1), a1 + hsa, vc[1]);
            if (last) {
                if (GATHER) {
#pragma unroll
                    for (int i = 0; i < 2; ++i) { vc[0][i] = vn[0][i]; vc[1][i] = vn[1][i]; } }
                if (nxt.K != cur.K) {
                    if (!GATHER) PG8_VOFF_D(vc, vbc, nxt.K);
                    else {
#pragma unroll
                        for (int i = 0; i < 2; ++i) { PG8_RC(R_, C_, Rb_, i); (void)R_; vbc[i] = (unsigned)(Rb_ * nxt.K + C_) * 2u; } }
                    hsc = (size_t)HALF * nxt.K * 2; hsa = GATHER ? (size_t)0 : hsc; } }
            PG8_WAIT_L(8); PG8_BAR; PG8_WAIT_L(0); PG8_MMA(0, 0, At, B0); PG8_BAR; PG8_SCHED;
            PG8_LDB(B1, 0, 1); PG8_STAGE(PG8_SB(0, 0), b2, vbc);
            PG8_BAR; PG8_WAIT_L(0); PG8_MMA(0, 1, At, B1); PG8_BAR;
            PG8_LDA(At, 0, 1); PG8_STAGE(PG8_SA(0, 0), a2, vc[0]);
            PG8_BAR; PG8_WAIT_L(0); PG8_MMA(1, 0, At, B0); PG8_BAR; PG8_SCHED;
            PG8_STAGE(PG8_SB(0, 1), b2 + hsc, vbc);
            PG8_WAIT_V(6); PG8_BAR; PG8_MMA(1, 1, At, B1); PG8_BAR;
            PG8_LDB(B0, 1, 0); PG8_SCHED; PG8_LDA(At, 1, 0); PG8_STAGE(PG8_SA(0, 1), a2 + hsa, vc[1]);
            PG8_WAIT_L(8); PG8_BAR; PG8_WAIT_L(0); PG8_MMA(0, 0, At, B0); PG8_BAR; PG8_SCHED;
            PG8_LDB(B1, 1, 1); PG8_STAGE(PG8_SB(1, 0), b3, vbc);
            PG8_BAR; PG8_WAIT_L(0); PG8_MMA(0, 1, At, B1); PG8_BAR;
            PG8_LDA(At, 1, 1); PG8_STAGE(PG8_SA(1, 0), a3, vc[0]);
            PG8_BAR; PG8_WAIT_L(0); PG8_MMA(1, 0, At, B0); PG8_BAR; PG8_SCHED;
            PG8_STAGE(PG8_SB(1, 1), b3 + hsc, vbc);
            PG8_WAIT_V(6); PG8_BAR; PG8_MMA(1, 1, At, B1); PG8_BAR;
        }
        E(acc, cur, ui, wr, wc, fr, fq);
        E.done(cur, lane);
        if (!has_next) break;
#pragma unroll
        for (int a = 0; a < 2; ++a)
#pragma unroll
            for (int b = 0; b < 2; ++b)
#pragma unroll
                for (int m = 0; m < 4; ++m)
#pragma unroll
                    for (int n = 0; n < 2; ++n) acc[a][b][m][n] = (f32x4){0.f, 0.f, 0.f, 0.f};
        cur = nxt; cA = nA; cB = nB; ++ui;
    }
    PG8_WAIT_V(0);
    if (wr == 0) PG8_BAR;
    PG8_BAR;
#undef PG8_SA
#undef PG8_SB
#undef PG8_STAGE
#undef PG8_LDA
#undef PG8_LDB
#undef PG8_MMA
#undef PG8_WAIT_V
#undef PG8_WAIT_L
#undef PG8_BAR
#undef PG8_SCHED
#undef PG8_VOFF_D
#undef PG8_RC
#undef PG8_VOFF_G
}

struct EpiBf16 {
    static constexpr bool PERM = true;
    DI void done(const Unit&, int) const {}
    DI void operator()(const f32x4 (&acc)[2][2][4][2], const Unit& u, int, int wr, int wc, int fr, int fq) const {
        const int row0 = u.row0 + wr * 64 + fr, col0 = u.col0 + wc * 32 + 8 * fq; GAS bf16_t* O = (GAS bf16_t*)u.out; const int ldc = u.ldc;
#pragma unroll
        for (int ai = 0; ai < 2; ++ai)
#pragma unroll
            for (int m = 0; m < 4; ++m) { GAS bf16_t* rowp = O + (size_t)(row0 + ai * HALF + m * 16) * ldc + col0;
#pragma unroll
                for (int bj = 0; bj < 2; ++bj) { const f32x4 v0 = acc[ai][bj][m][0], v1 = acc[ai][bj][m][1];
                    u32x4 w; w.x = pack2(v0[0], v0[1]); w.y = pack2(v0[2], v0[3]); w.z = pack2(v1[0], v1[1]); w.w = pack2(v1[2], v1[3]);
                    *(GAS u32x4*)(rowp + bj * HALF) = w; } }
    }
};
struct EpiF32 {
    static constexpr bool PERM = false;
    DI void done(const Unit&, int) const {}
    DI void operator()(const f32x4 (&acc)[2][2][4][2], const Unit& u, int, int wr, int wc, int fr, int fq) const {
        const int row0 = u.row0 + wr * 64 + fr, col0 = u.col0 + wc * 32 + 4 * fq; GAS float* C = (GAS float*)u.out; const int ldc = u.ldc;
#pragma unroll
        for (int ai = 0; ai < 2; ++ai)
#pragma unroll
            for (int m = 0; m < 4; ++m) { GAS float* rowp = C + (size_t)(row0 + ai * HALF + m * 16) * ldc + col0;
#pragma unroll
                for (int bj = 0; bj < 2; ++bj)
#pragma unroll
                    for (int n = 0; n < 2; ++n) *(GAS f32x4*)(rowp + bj * HALF + n * 16) = acc[ai][bj][m][n]; }
    }
};
struct EpiGU {
    static constexpr bool PERM = true;
    unsigned* rbcnt;
    DI void operator()(const f32x4 (&acc)[2][2][4][2], const Unit& u, int, int wr, int wc, int fr, int fq) const {
        const int row0 = u.row0 + wr * 64 + fr, col0 = (u.col0 >> 1) + wc * 32 + 8 * fq; GAS bf16_t* H = (GAS bf16_t*)u.out;
#pragma unroll
        for (int ai = 0; ai < 2; ++ai)
#pragma unroll
            for (int m = 0; m < 4; ++m) { GAS bf16_t* rowp = H + (size_t)(row0 + ai * HALF + m * 16) * DEXP + col0;
                float o[8];
#pragma unroll
                for (int n = 0; n < 2; ++n)
#pragma unroll
                    for (int j = 0; j < 4; ++j) { const float g = acc[ai][0][m][n][j], up = acc[ai][1][m][n][j]; o[n * 4 + j] = g / (1.0f + __expf(-g)) * up; }
                const unsigned long long lo = ((unsigned long long)pack2(o[2], o[3]) << 32) | pack2(o[0], o[1]), hi = ((unsigned long long)pack2(o[6], o[7]) << 32) | pack2(o[4], o[5]);
                __hip_atomic_store((GAS unsigned long long*)rowp, lo, __ATOMIC_RELAXED, __HIP_MEMORY_SCOPE_AGENT);
                __hip_atomic_store((GAS unsigned long long*)rowp + 1, hi, __ATOMIC_RELAXED, __HIP_MEMORY_SCOPE_AGENT); }
    }
    DI void done(const Unit& u, int lane) const {
        asm volatile("s_waitcnt vmcnt(0)" ::: "memory");
        if (lane == 0) __hip_atomic_fetch_add(rbcnt + (u.aux1 >> 16) * 16, 1u, __ATOMIC_RELAXED, __HIP_MEMORY_SCOPE_AGENT);
    }
};
struct EpiScatter {
    static constexpr bool PERM = true;
    DI void done(const Unit&, int) const {}
    const LAS int* rowl;
    DI void operator()(const f32x4 (&acc)[2][2][4][2], const Unit& u, int ui, int wr, int wc, int fr, int fq) const {
        const int col0 = u.col0 + wc * 32 + 8 * fq; GAS bf16_t* Y = (GAS bf16_t*)u.out;
#pragma unroll
        for (int ai = 0; ai < 2; ++ai)
#pragma unroll
            for (int m = 0; m < 4; ++m) { const int t2 = rowl[ui * BM + ai * HALF + wr * 64 + m * 16 + fr];
                if (t2 >= 0) { GAS bf16_t* rowp = Y + (size_t)t2 * D + col0;
#pragma unroll
                    for (int bj = 0; bj < 2; ++bj) { const f32x4 v0 = acc[ai][bj][m][0], v1 = acc[ai][bj][m][1];
                        u32x4 w; w.x = pack2(v0[0], v0[1]); w.y = pack2(v0[2], v0[3]); w.z = pack2(v1[0], v1[1]); w.w = pack2(v1[2], v1[3]);
                        *(GAS u32x4*)(rowp + bj * HALF) = w; } }
                asm volatile("" ::: "memory"); }
    }
};
struct EpiPle {
    static constexpr bool PERM = true;
    DI void done(const Unit&, int) const {}
    const bf16_t* x2; const bf16_t* pp; bf16_t* xb; float* outf;
    DI void operator()(const f32x4 (&acc)[2][2][4][2], const Unit& u, int, int wr, int wc, int fr, int fq) const {
        const int row0 = u.row0 + wr * 64 + fr, col0 = u.col0 + wc * 32 + 8 * fq;
#pragma unroll
        for (int ai = 0; ai < 2; ++ai)
#pragma unroll
            for (int m = 0; m < 4; ++m) { const size_t ro = (size_t)(row0 + ai * HALF + m * 16) * D + col0;
#pragma unroll
                for (int bj = 0; bj < 2; ++bj) { const size_t o = ro + bj * HALF;
                    const u32x4 xw = *(const u32x4*)(x2 + o); const u32x4 pw = *(const u32x4*)(pp + o);
                    const unsigned xa[4] = {xw.x, xw.y, xw.z, xw.w}, pa[4] = {pw.x, pw.y, pw.z, pw.w};
                    float r[8];
#pragma unroll
                    for (int n = 0; n < 2; ++n)
#pragma unroll
                        for (int j2 = 0; j2 < 2; ++j2) { const f32x4 a = acc[ai][bj][m][n]; const int w = 2 * n + j2;
                            r[4 * n + 2 * j2] = bflo(xa[w]) + bflo(pa[w]) * __builtin_amdgcn_rcpf(1.0f + __expf(-a[2 * j2]));
                            r[4 * n + 2 * j2 + 1] = bfhi(xa[w]) + bfhi(pa[w]) * __builtin_amdgcn_rcpf(1.0f + __expf(-a[2 * j2 + 1])); }
                    if (outf) { *(f32x4*)(outf + o) = (f32x4){r[0], r[1], r[2], r[3]}; *(f32x4*)(outf + o + 4) = (f32x4){r[4], r[5], r[6], r[7]}; }
                    else *(u32x4*)(xb + o) = (u32x4){pack2(r[0], r[1]), pack2(r[2], r[3]), pack2(r[4], r[5]), pack2(r[6], r[7])}; }
                if (m & 1) asm volatile("" ::: "memory"); }
    }
};
}

struct Params { const float* in[30]; float* out; unsigned char* ws; int ph_lo, ph_hi; };
struct Frame {
    LAS unsigned char* lds; int tid, lane, wave, G, wg;
    GAS unsigned char* ws; unsigned* ctl;
};
#define WSP(T_, off) ((T_*)(GAS T_*)(F.ws + (off)))
#define INP(i_) ((const float*)(GAS const float*)rfl64(((const LAS unsigned long long*)(F.lds + LDS_INTAB))[i_]))
DI unsigned long long rfl64(unsigned long long v) {
    return ((unsigned long long)(unsigned)__builtin_amdgcn_readfirstlane((int)(unsigned)(v >> 32)) << 32) | (unsigned)__builtin_amdgcn_readfirstlane((int)(unsigned)v);
}
DI int my_tid(int wave) { return (wave << 6) | (int)__builtin_amdgcn_mbcnt_hi(~0u, __builtin_amdgcn_mbcnt_lo(~0u, 0u)); }
DI Frame make_frame(LAS unsigned char* lds, GAS unsigned char* ws, int wave) {
    Frame F;
    int wv = __builtin_amdgcn_readfirstlane(wave); asm volatile("" : "+s"(wv));
    int tid = my_tid(wv); asm volatile("" : "+v"(tid));
    unsigned l32 = (unsigned)__builtin_amdgcn_readfirstlane((int)(unsigned)(size_t)lds); asm volatile("" : "+s"(l32));
    unsigned long long w64 = rfl64((unsigned long long)ws); asm volatile("" : "+s"(w64));
    F.lds = (LAS unsigned char*)l32; F.tid = tid; F.lane = tid & 63; F.wave = wv;
    F.G = gridDim.x; F.wg = blockIdx.x;
    F.ws = (GAS unsigned char*)w64;
    F.ctl = (unsigned*)(GAS unsigned*)F.ws;
    return F;
}
#ifndef TSEL
#define TSEL -1
#endif
#define TSL_B(j) unsigned long long tsl_b_##j = 0; if (TSEL == (j)) tsl_b_##j = __builtin_amdgcn_s_memrealtime()
#define TSL_E(j) do { if (TSEL == (j) && F.tid == 0) *(LAS unsigned long long*)(F.lds + LDS_CTL + 32) += __builtin_amdgcn_s_memrealtime() - tsl_b_##j; } while (0)
#define PHASE_FN __device__ __forceinline__ void
#define GEMM_FN __device__ __forceinline__ void
#define PHASE_ARGS LAS unsigned char* lds_, GAS unsigned char* ws_, int wave_
#define PHASE_FRAME const Frame F = make_frame(lds_, ws_, wave_)

template <int MODE> DI int rowmap(int n, int which) {
    if (MODE == 0) return n;
    if (MODE == 1) return (n >> 7) * 256 + which * 128 + (n & 127);
    const int h = n >> 8, c = n & 255; return c < 128 ? h * 128 + c : 768 + h * 128 + (c - 128);
}
template <int MODE>
DI void convert_t(const Frame F, const float* src, int K, int N, bf16_t* dst, int which, int nmat, size_t src_ms, size_t dst_ms, int t_begin = -1, int t_end = 0, int t_step = 0) {
    LAS float* tile = (LAS float*)F.lds;
    const int nkt = K / 64, nnt = (N + 255) / 256, per = nkt * nnt, total = per * nmat;
    const int tid = F.tid;
    f32x4 reg[8];
    int ti = F.wg, tstep = F.G, tend = total;
    if (t_begin >= 0) { ti = t_begin; tstep = t_step; tend = t_end; }
#define CONV_ISSUE(t_) do { const int t__ = (t_); const int mat_ = t__ / per, rem_ = t__ - mat_ * per, kt_ = rem_ / nnt, ntl_ = rem_ - kt_ * nnt; \
        const float* s_ = src + (size_t)mat_ * src_ms + (size_t)(kt_ * 64) * N + ntl_ * 256; const int n4_ = tid & 63, n_ = ntl_ * 256 + n4_ * 4; \
        _Pragma("unroll") for (int i_ = 0; i_ < 8; ++i_) { const int kr_ = (tid >> 6) + 8 * i_; reg[i_] = (n_ < N) ? *(const f32x4*)(s_ + (size_t)kr_ * N + n4_ * 4) : (f32x4){0.f, 0.f, 0.f, 0.f}; } } while (0)
    if (ti < tend) CONV_ISSUE(ti);
    for (; ti < tend; ti += tstep) {
#pragma unroll
        for (int i = 0; i < 8; ++i) { const int kr = (tid >> 6) + 8 * i; *(LAS f32x4*)(tile + kr * 260 + (((tid & 63) * 4 + 8 * (kr >> 3)) & 255)) = reg[i]; }
        __syncthreads();
        const int mat = ti / per, rem = ti - mat * per, kt = rem / nnt, nt_ = rem - kt * nnt;
        if (ti + tstep < tend) CONV_ISSUE(ti + tstep);
        bf16_t* d = dst + (size_t)mat * dst_ms + kt * 64;
#pragma unroll
        for (int i = 0; i < 4; ++i) {
            const int nl = (tid >> 3) + 64 * i, kg = tid & 7, n = nt_ * 256 + nl;
            if (n < N) {
                float v[8];
#pragma unroll
                for (int j = 0; j < 8; ++j) v[j] = tile[(kg * 8 + j) * 260 + ((nl + 8 * kg) & 255)];
                u32x4 w; w.x = pack2(v[0], v[1]); w.y = pack2(v[2], v[3]); w.z = pack2(v[4], v[5]); w.w = pack2(v[6], v[7]);
                *(u32x4*)(d + (size_t)rowmap<MODE>(n, which) * K + kg * 8) = w;
            }
        }
        __syncthreads();
    }
}
template <int MODE>
DI void convert_dma(const Frame F, const float* src, int K, int N, bf16_t* dst, int which, size_t src_ms, size_t dst_ms, int t0, int nt) {
    const int nkt = K / 64, nnt = (N + 255) / 256, per = nkt * nnt;
    const int lane = F.lane, wave = F.wave, rr = lane >> 3, sl = lane & 7, nsub = lane >> 3, kg = lane & 7;
    LAS unsigned char* slot = F.lds + wave * 8192;
#define CD_ISSUE(t_, b_) do { const int t__ = (t_); const int mat_ = t__ / per, rem_ = t__ - mat_ * per, kt_ = rem_ / nnt, ntl_ = rem_ - kt_ * nnt; \
        const int cb_ = (ntl_ * 256 + wave * 32 < N) ? ntl_ * 256 + wave * 32 : 0; \
        const float* s_ = src + (size_t)mat_ * src_ms + (size_t)(kt_ * 64 + rr) * N + cb_; \
        _Pragma("unroll") for (int i_ = 0; i_ < 8; ++i_) __builtin_amdgcn_global_load_lds((GAS const unsigned*)(s_ + (size_t)(i_ * 8) * N + 4 * ((sl - i_) & 7)), (LAS unsigned*)(slot + (b_) * 65536 + i_ * 1024), 16, 0, 0); } while (0)
    CD_ISSUE(t0, 0);
    if (nt > 1) CD_ISSUE(t0 + 1, 1);
#pragma unroll 1
    for (int i = 0; i < nt; ++i) {
        const int b = i & 1, tc = t0 + i;
        if (i + 1 < nt) asm volatile("s_waitcnt vmcnt(8)" ::: "memory"); else asm volatile("s_waitcnt vmcnt(0)" ::: "memory");
        const int mat = tc / per, rem = tc - mat * per, kt = rem / nnt, ntl = rem - kt * nnt;
        bf16_t* d = dst + (size_t)mat * dst_ms + kt * 64 + kg * 8;
        const LAS float* blk = (const LAS float*)(slot + b * 65536 + kg * 1024);
        float v[4][8];
#pragma unroll
        for (int p = 0; p < 4; ++p)
#pragma unroll
            for (int j = 0; j < 8; ++j) v[p][j] = blk[j * 32 + ((p * 8 + nsub + 4 * kg) & 31)];
        asm volatile("s_waitcnt lgkmcnt(0)" ::: "memory");
        if (ntl * 256 + wave * 32 < N) {
#pragma unroll
            for (int p = 0; p < 4; ++p) {
                u32x4 w; w.x = pack2(v[p][0], v[p][1]); w.y = pack2(v[p][2], v[p][3]); w.z = pack2(v[p][4], v[p][5]); w.w = pack2(v[p][6], v[p][7]);
                *(u32x4*)(d + (size_t)rowmap<MODE>(ntl * 256 + wave * 32 + p * 8 + nsub, which) * K) = w;
            }
        }
        if (i + 2 < nt) CD_ISSUE(tc + 2, b);
    }
#undef CD_ISSUE
}
DI void zero_rows(const Frame F, bf16_t* dst, size_t nelem) {
    for (size_t i = ((size_t)F.wg * 512 + F.tid) * 8; i < nelem; i += (size_t)F.G * 512 * 8) *(u32x4*)(dst + i) = (u32x4){0u, 0u, 0u, 0u};
}
DI void cvt_plain(const Frame F, const float* src, bf16_t* dst, size_t nelem) {
    for (size_t i = ((size_t)F.wg * 512 + F.tid) * 4; i < nelem; i += (size_t)F.G * 512 * 4) {
        const f32x4 v = *(const f32x4*)(src + i); u32x2 w; w.x = pack2(v[0], v[1]); w.y = pack2(v[2], v[3]); *(u32x2*)(dst + i) = w; }
}
DI void p_prologue(const Frame F) {
    convert_t<0>(F, INP(2), 2048, 8000, WSP(bf16_t, WS_WIN), 0, 1, (size_t)2048 * 8000, (size_t)8192 * 2048);
    for (int l = 0; l < NL; ++l) zero_rows(F, WSP(bf16_t, WS_WIN) + (size_t)l * 8192 * 2048 + (size_t)8000 * 2048, (size_t)192 * 2048);
    convert_t<0>(F, INP(28), 256, 2048, WSP(bf16_t, WS_WPP), 0, NL, (size_t)256 * 2048, (size_t)2048 * 256);
    convert_t<0>(F, INP(15), 512, 1152, WSP(bf16_t, WS_WUQ), 0, NL, (size_t)512 * 1152, (size_t)1280 * 512);
    for (int l = 0; l < NL; ++l) zero_rows(F, WSP(bf16_t, WS_WUQ) + (size_t)l * 1280 * 512 + (size_t)1152 * 512, (size_t)128 * 512);
    convert_t<2>(F, INP(17), 256, 1536, WSP(bf16_t, WS_WUKV), 0, NL, (size_t)256 * 1536, (size_t)1536 * 256);
    convert_t<0>(F, INP(5), 64, 768, WSP(bf16_t, WS_LORA), 0, NL, (size_t)64 * 768, (size_t)768 * 256);
    convert_t<0>(F, INP(7), 64, 768, WSP(bf16_t, WS_LORA) + (size_t)768 * 64, 0, NL, (size_t)64 * 768, (size_t)768 * 256);
    convert_t<0>(F, INP(8), 128, 768, WSP(bf16_t, WS_LORA) + (size_t)768 * 128, 0, NL, (size_t)128 * 768, (size_t)768 * 256);
    cvt_plain(F, INP(0), WSP(bf16_t, WS_XBF), (size_t)T * D);
    cvt_plain(F, INP(1), WSP(bf16_t, WS_PBF), (size_t)NL * T * PLE);
    for (int i = F.wg * 512 + F.tid; i < 32 * 2048; i += F.G * 512) { const int e = i >> 11, k = i & 2047; WSP(float, WS_RWT)[i] = INP(21)[(size_t)k * 32 + e]; }
    for (int i = F.wg * 512 + F.tid; i < NL * 32 * 2048; i += F.G * 512) { const int k = i & 2047, e = (i >> 11) & 31, l = i >> 16; WSP(float, WS_RWG)[i] = INP(19)[(size_t)l * D + k] * INP(21)[(size_t)k * 32 + e]; }
    for (int p = F.wg * 8 + F.wave; p < NL * 32; p += F.G * 8) { const int l = p >> 5, e = p & 31; float s1 = 0.f, s2 = 0.f;
        for (int k = F.lane; k < 2048; k += 64) { const float w = INP(21)[(size_t)k * 32 + e]; s1 += INP(19)[(size_t)l * D + k] * w; s2 += INP(20)[(size_t)l * D + k] * w; }
        s1 = wave_sum(s1); s2 = wave_sum(s2); if (F.lane == 0) { WSP(float, WS_RC)[l * 64 + e] = s1; WSP(float, WS_RC)[l * 64 + 32 + e] = s2; } }
    for (int i = F.wg * 512 + F.tid; i < 4096 * 32; i += F.G * 512) {
        const int pos = i >> 5, k = i & 31; const double ang = (double)pos * pow(10000.0, -(double)k / 32.0);
        WSP(f32x2, WS_ROPE)[i] = (f32x2){(float)cos(ang), (float)sin(ang)}; }
}

DI void p_rwkv_prep(const Frame F, int l) {
    const bf16_t* z = WSP(bf16_t, WS_Z);
    const float* mu = INP(3) + (size_t)l * 2560; const float* w0 = INP(4) + (size_t)l * 768; const float* a0 = INP(6) + (size_t)l * 768;
    const float* k_k = INP(9) + (size_t)l * 768; const float* k_a = INP(10) + (size_t)l * 768; const float* r_k = INP(11) + (size_t)l * 768;
    const bf16_t* wT = WSP(bf16_t, WS_LORA) + (size_t)l * 768 * 256; const bf16_t* aT = wT + 768 * 64; const bf16_t* gT = wT + 768 * 128;
    float* R = WSP(float, WS_RW); float* LWo = R + (size_t)T * 768; float* K2 = LWo + (size_t)T * 768; float* V = K2 + (size_t)T * 768;
    float* AA = V + (size_t)T * 768; float* BB = AA + (size_t)T * 768; float* GG = BB + (size_t)T * 768; float* RK = WSP(float, WS_RK);
    LAS bf16_t* X = (LAS bf16_t*)F.lds;
    LAS f32x2* part = (LAS f32x2*)(F.lds + 32 * 264 * 2);
    const int tid = F.tid, lane = F.lane, wave = F.wave, c = lane & 31, hh = lane >> 5;
    for (int tile = F.wg; tile < T / 32; tile += F.G) {
        const int t0 = tile * 32;
        __syncthreads();
        {
            const int tk = tid >> 4, cg = tid & 15, t = t0 + tk, c0 = 2304 + 16 * cg;
            const bool first = (t & (SEQ - 1)) == 0;
            unsigned ow[8];
#pragma unroll
            for (int hf = 0; hf < 2; ++hf) {
                const u32x4 za = *(const u32x4*)(z + (size_t)t * ZLD + c0 + 8 * hf);
                const u32x4 zp = first ? (u32x4){0u, 0u, 0u, 0u} : *(const u32x4*)(z + (size_t)(t - 1) * ZLD + c0 + 8 * hf);
                const f32x4 m0 = *(const f32x4*)(mu + c0 + 8 * hf), m1 = *(const f32x4*)(mu + c0 + 8 * hf + 4);
                const unsigned aw[4] = {za.x, za.y, za.z, za.w}, pw[4] = {zp.x, zp.y, zp.z, zp.w}; const float mm[8] = {m0[0], m0[1], m0[2], m0[3], m1[0], m1[1], m1[2], m1[3]};
                float v[8];
#pragma unroll
                for (int j = 0; j < 4; ++j) { const float a_lo = bflo(aw[j]), a_hi = bfhi(aw[j]); v[2 * j] = a_lo + (bflo(pw[j]) - a_lo) * mm[2 * j]; v[2 * j + 1] = a_hi + (bfhi(pw[j]) - a_hi) * mm[2 * j + 1]; }
#pragma unroll
                for (int j = 0; j < 8; ++j) v[j] = (cg < 4) ? tanhf(v[j]) : ((cg < 8) ? v[j] : sigmoidf_(v[j]));
#pragma unroll
                for (int j = 0; j < 4; ++j) ow[4 * hf + j] = pack2(v[2 * j], v[2 * j + 1]);
            }
            *(LAS u32x4*)(X + tk * 264 + 16 * cg) = (u32x4){ow[0], ow[1], ow[2], ow[3]};
            *(LAS u32x4*)(X + tk * 264 + 16 * cg + 8) = (u32x4){ow[4], ow[5], ow[6], ow[7]};
        }
        __syncthreads();
        const int t = t0 + c; const bool first = (t & (SEQ - 1)) == 0;
        const size_t zt = (size_t)t * ZLD, zq = (size_t)(first ? t : t - 1) * ZLD;
#pragma unroll 1
        for (int i = 0; i < 3; ++i) {
            const int g = 3 * wave + i, cb = 32 * g;
            f32x16 accw, acca, accg;
#pragma unroll
            for (int j = 0; j < 16; ++j) { accw[j] = 0.f; acca[j] = 0.f; accg[j] = 0.f; }
#pragma unroll
            for (int ks = 0; ks < 4; ++ks) {
                accw = MFMA32(*(const bf16x8*)(wT + (size_t)(cb + c) * 64 + 16 * ks + 8 * hh), *(const LAS bf16x8*)(X + c * 264 + 16 * ks + 8 * hh), accw);
                acca = MFMA32(*(const bf16x8*)(aT + (size_t)(cb + c) * 64 + 16 * ks + 8 * hh), *(const LAS bf16x8*)(X + c * 264 + 64 + 16 * ks + 8 * hh), acca); }
#pragma unroll
            for (int ks = 0; ks < 8; ++ks)
                accg = MFMA32(*(const bf16x8*)(gT + (size_t)(cb + c) * 128 + 16 * ks + 8 * hh), *(const LAS bf16x8*)(X + c * 264 + 128 + 16 * ks + 8 * hh), accg);
            float ss = 0.f, rs = 0.f;
#pragma unroll
            for (int rg = 0; rg < 4; ++rg) {
                const int ch0 = cb + 8 * rg + 4 * hh;
                const f32x4 w0v = *(const f32x4*)(w0 + ch0), a0v = *(const f32x4*)(a0 + ch0), kkc = *(const f32x4*)(k_k + ch0), kac = *(const f32x4*)(k_a + ch0), rkc = *(const f32x4*)(r_k + ch0);
                const f32x4 mur = *(const f32x4*)(mu + ch0), muk = *(const f32x4*)(mu + 768 + ch0), muv = *(const f32x4*)(mu + 1536 + ch0);
                const u32x2 r_t = *(const u32x2*)(z + zt + ch0), r_p = *(const u32x2*)(z + zq + ch0), k_t = *(const u32x2*)(z + zt + 768 + ch0), k_p = *(const u32x2*)(z + zq + 768 + ch0), v_t = *(const u32x2*)(z + zt + 1536 + ch0), v_p = *(const u32x2*)(z + zq + 1536 + ch0);
                const float rt4[4] = {bflo(r_t.x), bfhi(r_t.x), bflo(r_t.y), bfhi(r_t.y)}, rp4[4] = {bflo(r_p.x), bfhi(r_p.x), bflo(r_p.y), bfhi(r_p.y)};
                const float kt4[4] = {bflo(k_t.x), bfhi(k_t.x), bflo(k_t.y), bfhi(k_t.y)}, kp4[4] = {bflo(k_p.x), bfhi(k_p.x), bflo(k_p.y), bfhi(k_p.y)};
                const float vt4[4] = {bflo(v_t.x), bfhi(v_t.x), bflo(v_t.y), bfhi(v_t.y)}, vp4[4] = {bflo(v_p.x), bfhi(v_p.x), bflo(v_p.y), bfhi(v_p.y)};
                f32x4 oR, oL, oK, oV, oG, oA, oB;
#pragma unroll
                for (int e = 0; e < 4; ++e) {
                    const int rr = 4 * rg + e;
                    const float zr = rt4[e] + ((first ? 0.f : rp4[e]) - rt4[e]) * mur[e], zk = kt4[e] + ((first ? 0.f : kp4[e]) - kt4[e]) * muk[e], zv = vt4[e] + ((first ? 0.f : vp4[e]) - vt4[e]) * muv[e];
                    const float xw = -(w0v[e] + accw[rr]);
                    const float sp = (xw > 15.f) ? xw : log1pf(__expf(xw));
                    const float lw = -__expf(-sp - 0.5f);
                    const float a = sigmoidf_(a0v[e] + acca[rr]);
                    const float kk1 = zk * kkc[e];
                    const float k2 = zk * (1.0f + (a - 1.0f) * kac[e]);
                    ss += kk1 * kk1; rs += zr * k2 * rkc[e];
                    oR[e] = zr; oL[e] = lw; oK[e] = k2; oV[e] = zv; oG[e] = accg[rr]; oA[e] = -kk1; oB[e] = kk1 * a;
                }
                const size_t o = (size_t)t * 768 + ch0;
                *(f32x4*)(R + o) = oR; *(f32x4*)(LWo + o) = oL; *(f32x4*)(K2 + o) = oK; *(f32x4*)(V + o) = oV; *(f32x4*)(GG + o) = oG; *(f32x4*)(AA + o) = oA; *(f32x4*)(BB + o) = oB;
                asm volatile("" ::: "memory");
            }
            ss += __shfl_xor(ss, 32); rs += __shfl_xor(rs, 32);
            if (hh == 0) part[g * 32 + c] = (f32x2){ss, rs};
        }
        __syncthreads();
        if (tid < 384) { const int tk = tid & 31, h = tid >> 5; const f32x2 p0 = part[(2 * h) * 32 + tk], p1 = part[(2 * h + 1) * 32 + tk];
            RK[(size_t)(t0 + tk) * 16 + h] = p0.y + p1.y; RK[(size_t)T * 16 + (size_t)(t0 + tk) * 16 + h] = 1.0f / fmaxf(sqrtf(p0.x + p1.x), 1e-12f); }
    }
}

DI void p_mla_prep(const Frame F, int l) {
    const bf16_t* z = WSP(bf16_t, WS_Z);
    const float* qa_g = INP(14) + (size_t)l * 512; const float* kva_g = INP(16) + (size_t)l * 256;
    bf16_t* qn = WSP(bf16_t, WS_QN); bf16_t* kvn = WSP(bf16_t, WS_KVN); bf16_t* kr = WSP(bf16_t, WS_KROPE);
    const f32x2* rope = WSP(f32x2, WS_ROPE);
    const float* mu = INP(3) + (size_t)l * 2560; bf16_t* xl = WSP(bf16_t, WS_XL);
    const int lane = F.lane;
#pragma unroll 2
    for (int t = F.wg * 8 + F.wave; t < T; t += F.G * 8) {
        const bf16_t* zr = z + (size_t)t * ZLD;
        {
            const bool first = (t & (SEQ - 1)) == 0;
            const u32x2 za = *(const u32x2*)(zr + 2304 + 4 * lane); const u32x2 zp = first ? (u32x2){0u, 0u} : *(const u32x2*)(zr - ZLD + 2304 + 4 * lane);
            const f32x4 m4 = *(const f32x4*)(mu + 2304 + 4 * lane);
            float v[4] = {bflo(za.x), bfhi(za.x), bflo(za.y), bfhi(za.y)}; const float p[4] = {bflo(zp.x), bfhi(zp.x), bflo(zp.y), bfhi(zp.y)};
#pragma unroll
            for (int q = 0; q < 4; ++q) { v[q] = v[q] + (p[q] - v[q]) * m4[q]; v[q] = (lane < 16) ? tanhf_(v[q]) : ((lane < 32) ? v[q] : sigmoidf_(v[q])); }
            u32x2 o; o.x = pack2(v[0], v[1]); o.y = pack2(v[2], v[3]); *(u32x2*)(xl + (size_t)t * 256 + 4 * lane) = o; }
        { const u32x4 w = *(const u32x4*)(zr + ZC_QA + lane * 8); float v[8] = {bflo(w.x), bfhi(w.x), bflo(w.y), bfhi(w.y), bflo(w.z), bfhi(w.z), bflo(w.w), bfhi(w.w)};
          float ss = 0.f;
#pragma unroll
          for (int j = 0; j < 8; ++j) ss += v[j] * v[j];
          ss = wave_sum(ss); const float rs = rsqrtf(ss * (1.0f / 512.0f) + 1e-6f);
          const f32x4 g0 = *(const f32x4*)(qa_g + lane * 8), g1 = *(const f32x4*)(qa_g + lane * 8 + 4);
          u32x4 o; o.x = pack2(v[0] * rs * g0[0], v[1] * rs * g0[1]); o.y = pack2(v[2] * rs * g0[2], v[3] * rs * g0[3]); o.z = pack2(v[4] * rs * g1[0], v[5] * rs * g1[1]); o.w = pack2(v[6] * rs * g1[2], v[7] * rs * g1[3]);
          *(u32x4*)(qn + (size_t)t * 512 + lane * 8) = o; }
        { const u32x2 w = *(const u32x2*)(zr + ZC_KVA + lane * 4); float v[4] = {bflo(w.x), bfhi(w.x), bflo(w.y), bfhi(w.y)};
          float ss = v[0] * v[0] + v[1] * v[1] + v[2] * v[2] + v[3] * v[3];
          ss = wave_sum(ss); const float rs = rsqrtf(ss * (1.0f / 256.0f) + 1e-6f);
          const f32x4 g0 = *(const f32x4*)(kva_g + lane * 4);
          u32x2 o; o.x = pack2(v[0] * rs * g0[0], v[1] * rs * g0[1]); o.y = pack2(v[2] * rs * g0[2], v[3] * rs * g0[3]);
          *(u32x2*)(kvn + (size_t)t * 256 + lane * 4) = o; }
        { const int i = lane & 31; const float t1 = bf2f(zr[ZC_KR + i]), t2 = bf2f(zr[ZC_KR + 32 + i]); const f32x2 cs = rope[(t & (SEQ - 1)) * 32 + i];
          const float o = (lane < 32) ? (t1 * cs.x - t2 * cs.y) : (t1 * cs.y + t2 * cs.x);
          kr[(size_t)t * 64 + lane] = f2bf(o); }
    }
}

DI void p_vtd_prep(const Frame F) {
    const bf16_t* z = WSP(bf16_t, WS_Z); bf16_t* vtd = WSP(bf16_t, WS_VTD);
    LAS bf16_t* buf = (LAS bf16_t*)(F.lds + F.wave * 8704);
    const int lane = F.lane;
    for (int tile = F.wg * 8 + F.wave; tile < 2 * 12 * 128; tile += F.G * 8) {
        const int pt = tile & 127, hd = (tile >> 7) % 12, b = tile / (128 * 12);
        const int g = hd >> 2, d = 1 << (2 * g), Ls = SEQ / d;
        const int pos0 = pt * 32, r = pos0 / Ls, j0 = pos0 - r * Ls;
#pragma unroll
        for (int i = 0; i < 8; ++i) { const int p = lane + 64 * i, row = p >> 4, seg = p & 15;
            const size_t tok = (size_t)b * SEQ + (size_t)(j0 + row) * d + r;
            const u32x4 w = *(const u32x4*)(z + tok * ZLD + ZC_DV + hd * 128 + seg * 8);
            *(LAS u32x4*)(buf + row * 136 + seg * 8) = w; }
        __builtin_amdgcn_s_waitcnt(0);
#pragma unroll
        for (int i = 0; i < 8; ++i) { const int p = lane + 64 * i, dv = p >> 2, seg = p & 3;
            unsigned short v[8];
#pragma unroll
            for (int j = 0; j < 8; ++j) v[j] = buf[(seg * 8 + j) * 136 + dv];
            u32x4 w; w.x = v[0] | ((unsigned)v[1] << 16); w.y = v[2] | ((unsigned)v[3] << 16); w.z = v[4] | ((unsigned)v[5] << 16); w.w = v[6] | ((unsigned)v[7] << 16);
            *(u32x4*)(vtd + ((size_t)(b * 12 + hd) * 128 + dv) * SEQ + pos0 + seg * 8) = w; }
        __builtin_amdgcn_s_waitcnt(0);
    }
}

DI int swap23(int i) { return (i & ~12) | ((i & 4) << 1) | ((i & 8) >> 1); }
DI int crow(int reg, int h) { return (reg & 3) + 8 * (reg >> 2) + 4 * h; }
DI bf16x8 packp(const f32x16& p, int s) {
    u32x4 w; w.x = pack2(p[8 * s], p[8 * s + 1]); w.y = pack2(p[8 * s + 2], p[8 * s + 3]); w.z = pack2(p[8 * s + 4], p[8 * s + 5]); w.w = pack2(p[8 * s + 6], p[8 * s + 7]);
    return __builtin_bit_cast(bf16x8, w);
}

DI void dil_item(const Frame F, int item) {
    const bf16_t* z = WSP(bf16_t, WS_Z); const bf16_t* vtd = WSP(bf16_t, WS_VTD);
    bf16_t* op = WSP(bf16_t, WS_OP); float* lse = WSP(float, WS_LSE);
    const int lane = F.lane, c = lane & 31, hh = lane >> 5;
    const int bgh = item >> 7, rem = item & 127, b = bgh / 12, hd = bgh % 12, g = hd >> 2, hs = hd & 3;
    const int d = 1 << (2 * g), Ls = SEQ / d, ntile = Ls / 32, r = rem / ntile, jt = rem % ntile;
    const float slope2 = exp2f(-8.0f * (float)(hd + 1) / 12.0f) * LOG2E * (float)d;
    const float sc = 0.08838834764831845f * LOG2E;
    const int jq = jt * 32 + c;
    const size_t tq = (size_t)b * SEQ + (size_t)jq * d + r;
    bf16x8 qf[8];
#pragma unroll
    for (int ks = 0; ks < 8; ++ks) qf[ks] = *(const bf16x8*)(z + tq * ZLD + ZC_DQ + hd * 128 + 16 * ks + 8 * hh);
    f32x16 O[4];
#pragma unroll
    for (int i = 0; i < 4; ++i)
#pragma unroll
        for (int j = 0; j < 16; ++j) O[i][j] = 0.f;
    float m = -1e30f, lsum = 0.f;
    const int kt0 = jt - 4 < 0 ? 0 : jt - 4;
    for (int kt = kt0; kt <= jt; ++kt) {
        const int jk = kt * 32 + swap23(c);
        const size_t tk = (size_t)b * SEQ + (size_t)jk * d + r;
        bf16x8 kf[8], vf[4][2];
#pragma unroll
        for (int ks = 0; ks < 8; ++ks) kf[ks] = *(const bf16x8*)(z + tk * ZLD + ZC_DK + hd * 128 + 16 * ks + 8 * hh);
#pragma unroll
        for (int dvt = 0; dvt < 4; ++dvt)
#pragma unroll
            for (int s = 0; s < 2; ++s) vf[dvt][s] = *(const bf16x8*)(vtd + ((size_t)(b * 12 + hd) * 128 + dvt * 32 + c) * SEQ + r * Ls + kt * 32 + 16 * s + 8 * hh);
        f32x16 S;
#pragma unroll
        for (int j = 0; j < 16; ++j) S[j] = 0.f;
#pragma unroll
        for (int ks = 0; ks < 8; ++ks) S = MFMA32(kf[ks], qf[ks], S);
        float mx = -1e30f;
#pragma unroll
        for (int i = 0; i < 16; ++i) { const int rel = jq - (kt * 32 + swap23(crow(i, hh)));
            float s = S[i] * sc - slope2 * (float)rel; s = (rel >= 0 && rel <= 128) ? s : -1e30f; S[i] = s; mx = fmaxf(mx, s); }
        mx = fmaxf(mx, __shfl_xor(mx, 32));
        const float mn = fmaxf(m, mx), al = __builtin_amdgcn_exp2f(m - mn); m = mn;
        float ps = 0.f;
#pragma unroll
        for (int i = 0; i < 16; ++i) { const float p = __builtin_amdgcn_exp2f(S[i] - mn); S[i] = p; ps += p; }
        lsum = lsum * al + ps;
#pragma unroll
        for (int i = 0; i < 4; ++i)
#pragma unroll
            for (int j = 0; j < 16; ++j) O[i][j] *= al;
        const bf16x8 p0 = packp(S, 0), p1 = packp(S, 1);
#pragma unroll
        for (int dvt = 0; dvt < 4; ++dvt) { O[dvt] = MFMA32(vf[dvt][0], p0, O[dvt]); O[dvt] = MFMA32(vf[dvt][1], p1, O[dvt]); }
    }
    const float lt = lsum + __shfl_xor(lsum, 32), inv = 1.0f / lt;
    bf16_t* orow = op + ((size_t)g * T + tq) * 512 + hs * 128;
#pragma unroll
    for (int dvt = 0; dvt < 4; ++dvt)
#pragma unroll
        for (int g4 = 0; g4 < 4; ++g4) { u32x2 w; w.x = pack2(O[dvt][4 * g4] * inv, O[dvt][4 * g4 + 1] * inv); w.y = pack2(O[dvt][4 * g4 + 2] * inv, O[dvt][4 * g4 + 3] * inv);
            *(u32x2*)(orow + dvt * 32 + 8 * g4 + 4 * hh) = w; }
    if (hh == 0) lse[((size_t)g * T + tq) * 4 + hs] = m + __builtin_amdgcn_logf(lt);
}

constexpr int AK_P = 200, AV_P = 40;
constexpr int AST = 32 * AK_P * 2 + 128 * AV_P * 2;
DI void mla_decode(int item, int& bh, int& qb, int& kc, int& nst) {
    if (item < 336) { bh = item / 28; int r = item % 28; qb = 3; for (;;) { const int n = (qb + 1) >> 2; if (r < n) break; r -= n; ++qb; } kc = r; nst = 32; }
    else { const int x = item - 336, cls = x / 48, y = x % 48; bh = y >> 2; const int m = y & 3; qb = 4 * m + (2 - cls); kc = m; nst = (3 - cls) * 8; }
}
DI void mla_wg_item(const Frame F, int item) {
    const bf16_t* qbuf = WSP(bf16_t, WS_QB); const bf16_t* kcb = WSP(bf16_t, WS_KC); const bf16_t* krp = WSP(bf16_t, WS_KROPE); const bf16_t* vt = WSP(bf16_t, WS_VT);
    const f32x2* rope = WSP(f32x2, WS_ROPE); bf16_t* mix = WSP(bf16_t, WS_MIX); bf16_t* opm = WSP(bf16_t, WS_OPM); float* lsem = WSP(float, WS_LSEM);
    const int tid = F.tid, lane = F.lane, wave = F.wave, c = lane & 31, hh = lane >> 5;
    int bh, qb, kc, nst; mla_decode(item, bh, qb, kc, nst);
    const int b = bh / 6, h = bh % 6;
    const int q0 = qb * 256 + wave * 32;
    const size_t tq = (size_t)b * SEQ + q0 + c;
    const float sc = 0.07216878364870322f * LOG2E;
    const int key_base = kc * 1024;
    const int ka_row = tid >> 4, ka_seg = tid & 15;
    const int kb_row = (tid & 255) >> 3, kb_seg = tid & 7;
    const int vb_p = tid - 256, vc_p = tid + 256;
    u32x4 ra0, rb0, rc0, ra1, rb1, rc1;
#define MLA_ISSUE(ra, rb_, rc, s_) do { const int k0_ = key_base + (s_) * 32; const size_t tk0_ = (size_t)b * SEQ + k0_; \
        ra = *(const u32x4*)(kcb + (tk0_ + ka_row) * 768 + h * 128 + ka_seg * 8); \
        if (tid < 256) { rb_ = *(const u32x4*)(krp + (tk0_ + kb_row) * 64 + kb_seg * 8); rc = *(const u32x4*)(vt + (size_t)(h * 128 + (vc_p >> 2)) * T + tk0_ + (vc_p & 3) * 8); } \
        else { rb_ = *(const u32x4*)(vt + (size_t)(h * 128 + (vb_p >> 2)) * T + tk0_ + (vb_p & 3) * 8); } } while (0)
#define MLA_WRITE(ra, rb_, rc, s_) do { LAS bf16_t* kb_ = (LAS bf16_t*)(F.lds + ((s_) & 3) * AST); LAS bf16_t* vb_ = kb_ + 32 * AK_P; \
        *(LAS u32x4*)(kb_ + ka_row * AK_P + ka_seg * 8) = ra; \
        if (tid < 256) { *(LAS u32x4*)(kb_ + kb_row * AK_P + 128 + kb_seg * 8) = rb_; *(LAS u32x4*)(vb_ + (vc_p >> 2) * AV_P + (vc_p & 3) * 8) = rc; } \
        else { *(LAS u32x4*)(vb_ + (vb_p >> 2) * AV_P + (vb_p & 3) * 8) = rb_; } } while (0)
    __syncthreads();
    MLA_ISSUE(ra0, rb0, rc0, 0); MLA_WRITE(ra0, rb0, rc0, 0);
    MLA_ISSUE(ra1, rb1, rc1, 1); MLA_WRITE(ra1, rb1, rc1, 1);
    MLA_ISSUE(ra0, rb0, rc0, 2); MLA_ISSUE(ra1, rb1, rc1, 3);
    bf16x8 qf[12];
#pragma unroll
    for (int ks = 0; ks < 12; ++ks) qf[ks] = *(const bf16x8*)(qbuf + tq * 1280 + h * 192 + 16 * ks + 8 * hh);
#pragma unroll
    for (int kk = 0; kk < 2; ++kk) {
        const u32x4 w1 = __builtin_bit_cast(u32x4, qf[8 + kk]), w2 = __builtin_bit_cast(u32x4, qf[10 + kk]);
        const unsigned a1[4] = {w1.x, w1.y, w1.z, w1.w}, a2[4] = {w2.x, w2.y, w2.z, w2.w};
        unsigned o1[4], o2[4];
#pragma unroll
        for (int jj = 0; jj < 4; ++jj) {
            const int i0 = 16 * kk + 8 * hh + 2 * jj;
            const f32x2 cs0 = rope[(q0 + c) * 32 + i0], cs1 = rope[(q0 + c) * 32 + i0 + 1];
            const float t1a = bflo(a1[jj]), t1b = bfhi(a1[jj]), t2a = bflo(a2[jj]), t2b = bfhi(a2[jj]);
            o1[jj] = pack2(t1a * cs0.x - t2a * cs0.y, t1b * cs1.x - t2b * cs1.y);
            o2[jj] = pack2(t1a * cs0.y + t2a * cs0.x, t1b * cs1.y + t2b * cs1.x);
        }
        qf[8 + kk] = __builtin_bit_cast(bf16x8, (u32x4){o1[0], o1[1], o1[2], o1[3]});
        qf[10 + kk] = __builtin_bit_cast(bf16x8, (u32x4){o2[0], o2[1], o2[2], o2[3]});
    }
    f32x16 O[4];
#pragma unroll
    for (int i = 0; i < 4; ++i)
#pragma unroll
        for (int jx = 0; jx < 16; ++jx) O[i][jx] = 0.f;
    float m = -1e30f, lsum = 0.f;
    __syncthreads();
#define MLA_SB __builtin_amdgcn_sched_barrier(0)
#define MLA_LDK(dst, base_, ks0_) do { _Pragma("unroll") for (int q_ = 0; q_ < 4; ++q_) dst[q_] = *(const LAS bf16x8*)((base_) + krow * AK_P + 16 * ((ks0_) + q_) + 8 * hh); } while (0)
#define MLA_LDV(dst, base_, off_) do { _Pragma("unroll") for (int q_ = 0; q_ < 4; ++q_) dst[q_] = *(const LAS bf16x8*)((base_) + (q_ * 32 + c) * AV_P + (off_) + 8 * hh); } while (0)
#define MLA_COMPUTE(s_) do { const int s = (s_); const int k0 = key_base + s * 32; \
        if (k0 <= q0 + 31) {                                 \
            const LAS bf16_t* kb = (const LAS bf16_t*)(F.lds + (s & 3) * AST); const LAS bf16_t* vb = kb + 32 * AK_P; \
            f32x16 S; bf16x8 fA[4], fB[4]; \
            _Pragma("unroll") for (int jx = 0; jx < 16; ++jx) S[jx] = 0.f; \
            MLA_LDK(fA, kb, 0); MLA_SB; \
            MLA_LDK(fB, kb, 4); _Pragma("unroll") for (int q_ = 0; q_ < 4; ++q_) S = MFMA32(fA[q_], qf[q_], S); MLA_SB; \
            MLA_LDK(fA, kb, 8); _Pragma("unroll") for (int q_ = 0; q_ < 4; ++q_) S = MFMA32(fB[q_], qf[4 + q_], S); MLA_SB; \
            MLA_LDV(fB, vb, 0); _Pragma("unroll") for (int q_ = 0; q_ < 4; ++q_) S = MFMA32(fA[q_], qf[8 + q_], S); MLA_SB; \
            MLA_LDV(fA, vb, 16); \
            const bool diag = (k0 + 31 > q0); \
            float mx = -3.0e38f; \
            if (diag) { _Pragma("unroll") for (int i = 0; i < 16; ++i) if (k0 + swap23(crow(i, hh)) > q0 + c) S[i] = -3.0e38f; } \
            _Pragma("unroll") for (int i = 0; i < 16; ++i) mx = fmaxf(mx, S[i]); \
            mx = fmaxf(mx, __shfl_xor(mx, 32)); \
            const float mc = mx * sc, mn = (mc > m + 8.0f) ? mc : m, al = __builtin_amdgcn_exp2f(m - mn); m = mn;     \
            float ps = 0.f; \
            _Pragma("unroll") for (int i = 0; i < 16; ++i) { const float p = __builtin_amdgcn_exp2f(fmaf(S[i], sc, -mn)); S[i] = p; ps += p; } \
            lsum = lsum * al + ps; \
            if (__any(al != 1.0f)) { \
                _Pragma("unroll") for (int i = 0; i < 4; ++i) _Pragma("unroll") for (int jx = 0; jx < 16; ++jx) O[i][jx] *= al; } \
            const bf16x8 p0 = packp(S, 0), p1 = packp(S, 1); \
            MLA_SB; \
            _Pragma("unroll") for (int dvt = 0; dvt < 4; ++dvt) O[dvt] = MFMA32(fB[dvt], p0, O[dvt]); \
            _Pragma("unroll") for (int dvt = 0; dvt < 4; ++dvt) O[dvt] = MFMA32(fA[dvt], p1, O[dvt]); \
        } } while (0)
    const int krow = swap23(c);
    for (int s2 = 0; s2 < nst; s2 += 2) {
        if (s2 + 2 < nst) { MLA_WRITE(ra0, rb0, rc0, s2 + 2); MLA_WRITE(ra1, rb1, rc1, s2 + 3); }
        if (s2 + 4 < nst) { MLA_ISSUE(ra0, rb0, rc0, s2 + 4); MLA_ISSUE(ra1, rb1, rc1, s2 + 5); }
        MLA_COMPUTE(s2); MLA_COMPUTE(s2 + 1);
        asm volatile("s_waitcnt lgkmcnt(0)\n\ts_barrier" ::: "memory");
    }
#undef MLA_COMPUTE
#undef MLA_LDK
#undef MLA_LDV
#undef MLA_SB
#undef MLA_ISSUE
#undef MLA_WRITE
    const float lt = lsum + __shfl_xor(lsum, 32), inv = 1.0f / lt;
    const bool single = (qb < 4);
    bf16_t* orow = single ? (mix + tq * D + 1280 + h * 128) : (opm + ((size_t)kc * T + tq) * 768 + h * 128);
#pragma unroll
    for (int dvt = 0; dvt < 4; ++dvt)
#pragma unroll
        for (int g4 = 0; g4 < 4; ++g4) { u32x2 w; w.x = pack2(O[dvt][4 * g4] * inv, O[dvt][4 * g4 + 1] * inv); w.y = pack2(O[dvt][4 * g4 + 2] * inv, O[dvt][4 * g4 + 3] * inv);
            *(u32x2*)(orow + dvt * 32 + 8 * g4 + 4 * hh) = w; }
    if (!single && hh == 0) lsem[((size_t)kc * T + tq) * 8 + h] = m + __builtin_amdgcn_logf(lt);
}
DI void mla_combine_item(const Frame F, int item) {
    const bf16_t* opm = WSP(bf16_t, WS_OPM); const float* lsem = WSP(float, WS_LSEM); bf16_t* mix = WSP(bf16_t, WS_MIX);
    const int t0 = item * 4, qb = (t0 & (SEQ - 1)) >> 8, np = (qb >> 2) + 1;
    if (np == 1) return;
#pragma unroll 2
    for (int i = 0; i < 6; ++i) {
        const int task = i * 64 + F.lane, tl = task / 96, rem = task % 96, h = rem >> 4, oc = rem & 15;
        const size_t t = (size_t)t0 + tl;
        float lv[4], mx = -3.0e38f;
#pragma unroll
        for (int k = 0; k < 4; ++k) { lv[k] = (k < np) ? lsem[((size_t)k * T + t) * 8 + h] : -3.0e38f; mx = fmaxf(mx, lv[k]); }
        float wsum = 0.f, acc[8];
#pragma unroll
        for (int jx = 0; jx < 8; ++jx) acc[jx] = 0.f;
#pragma unroll
        for (int k = 0; k < 4; ++k) if (k < np) {
            const float w = __builtin_amdgcn_exp2f(lv[k] - mx); wsum += w;
            const u32x4 a = *(const u32x4*)(opm + ((size_t)k * T + t) * 768 + h * 128 + oc * 8); const unsigned aw[4] = {a.x, a.y, a.z, a.w};
#pragma unroll
            for (int jx = 0; jx < 4; ++jx) { acc[2 * jx] += w * bflo(aw[jx]); acc[2 * jx + 1] += w * bfhi(aw[jx]); } }
        const float inv = 1.0f / wsum;
        *(u32x4*)(mix + t * D + 1280 + h * 128 + oc * 8) = (u32x4){pack2(acc[0] * inv, acc[1] * inv), pack2(acc[2] * inv, acc[3] * inv), pack2(acc[4] * inv, acc[5] * inv), pack2(acc[6] * inv, acc[7] * inv)};
    }
}

DI void dilc_item(const Frame F, int item) {
    const bf16_t* op = WSP(bf16_t, WS_OP); const float* lse = WSP(float, WS_LSE); bf16_t* mix = WSP(bf16_t, WS_MIX);
#pragma unroll
    for (int i = 0; i < 4; ++i) {
        const int task = i * 64 + F.lane, tl = task >> 6, rem = task & 63, hs = rem >> 4, oc = rem & 15;
        const size_t t = (size_t)item * 4 + tl;
        const float l0 = lse[((size_t)0 * T + t) * 4 + hs], l1 = lse[((size_t)1 * T + t) * 4 + hs], l2 = lse[((size_t)2 * T + t) * 4 + hs];
        const float mx = fmaxf(l0, fmaxf(l1, l2));
        float w0 = __builtin_amdgcn_exp2f(l0 - mx), w1 = __builtin_amdgcn_exp2f(l1 - mx), w2 = __builtin_amdgcn_exp2f(l2 - mx);
        const float inv = 1.0f / (w0 + w1 + w2); w0 *= inv; w1 *= inv; w2 *= inv;
        const u32x4 a = *(const u32x4*)(op + ((size_t)0 * T + t) * 512 + hs * 128 + oc * 8), bq = *(const u32x4*)(op + ((size_t)1 * T + t) * 512 + hs * 128 + oc * 8), cq = *(const u32x4*)(op + ((size_t)2 * T + t) * 512 + hs * 128 + oc * 8);
        const unsigned aw[4] = {a.x, a.y, a.z, a.w}, bw[4] = {bq.x, bq.y, bq.z, bq.w}, cw[4] = {cq.x, cq.y, cq.z, cq.w}; unsigned o[4];
#pragma unroll
        for (int j = 0; j < 4; ++j) o[j] = pack2(w0 * bflo(aw[j]) + w1 * bflo(bw[j]) + w2 * bflo(cw[j]), w0 * bfhi(aw[j]) + w1 * bfhi(bw[j]) + w2 * bfhi(cw[j]));
        *(u32x4*)(mix + t * D + 768 + hs * 128 + oc * 8) = (u32x4){o[0], o[1], o[2], o[3]};
    }
}

DI float dppf(float x, int ctrl_sel) {
    const int v = __float_as_int(x); int r;
    if (ctrl_sel == 0) r = __builtin_amdgcn_mov_dpp(v, 0xB1, 0xF, 0xF, true);
    else if (ctrl_sel == 1) r = __builtin_amdgcn_mov_dpp(v, 0x4E, 0xF, 0xF, true);
    else r = __builtin_amdgcn_mov_dpp(v, 0x141, 0xF, 0xF, true);
    return __int_as_float(r);
}
DI float reduce8(float x) { x += dppf(x, 0); x += dppf(x, 1); x += dppf(x, 2); return x; }
constexpr int RTS = 32;
DI void p_rwkv_scan(const Frame F, int l, int bh) {
    const float* R = WSP(float, WS_RW); const float* DEC = R + (size_t)T * 768; const float* K2 = DEC + (size_t)T * 768; const float* V = K2 + (size_t)T * 768;
    const float* AA = V + (size_t)T * 768; const float* BB = AA + (size_t)T * 768; const float* GG = BB + (size_t)T * 768; const float* RK = WSP(float, WS_RK);
    const float* gn_g = INP(12) + (size_t)l * 768; const float* gn_b = INP(13) + (size_t)l * 768;
    bf16_t* mix = WSP(bf16_t, WS_MIX);
    const int b = bh / 12, h = bh % 12, tid = F.tid, i = tid >> 3, jg = tid & 7;
    LAS float* sb = (LAS float*)F.lds;
    LAS float* yb = sb + 2 * 6 * RTS * 64;
    f32x4 reg[6];
    const int st_step = tid >> 4, st_c4 = (tid & 15) * 4;
#define SCAN_ISSUE(chunk_) do { const size_t tok_ = (size_t)b * SEQ + (size_t)(chunk_) * RTS + st_step; \
        reg[0] = *(const f32x4*)(R + tok_ * 768 + h * 64 + st_c4); reg[1] = *(const f32x4*)(DEC + tok_ * 768 + h * 64 + st_c4); reg[2] = *(const f32x4*)(K2 + tok_ * 768 + h * 64 + st_c4); \
        reg[3] = *(const f32x4*)(V + tok_ * 768 + h * 64 + st_c4); reg[4] = *(const f32x4*)(AA + tok_ * 768 + h * 64 + st_c4); reg[5] = *(const f32x4*)(BB + tok_ * 768 + h * 64 + st_c4); } while (0)
    float s[8];
#pragma unroll
    for (int j = 0; j < 8; ++j) s[j] = 0.f;
    SCAN_ISSUE(0);
    __syncthreads();
#pragma unroll
    for (int a = 0; a < 6; ++a) *(LAS f32x4*)(sb + (0 * 6 + a) * RTS * 64 + st_step * 64 + st_c4) = reg[a];
    __syncthreads();
    const int nchunk = SEQ / RTS;
    for (int ch = 0; ch < nchunk; ++ch) {
        const int cb = ch & 1;
        if (ch + 1 < nchunk) SCAN_ISSUE(ch + 1);
        const LAS float* pr = sb + (cb * 6 + 0) * RTS * 64 + jg * 8; const LAS float* pw = sb + (cb * 6 + 1) * RTS * 64 + jg * 8;
        const LAS float* pk = sb + (cb * 6 + 2) * RTS * 64 + jg * 8; const LAS float* pv = sb + (cb * 6 + 3) * RTS * 64 + i;
        const LAS float* pa = sb + (cb * 6 + 4) * RTS * 64 + jg * 8; const LAS float* pb = sb + (cb * 6 + 5) * RTS * 64 + jg * 8;
#pragma unroll 4
        for (int st = 0; st < RTS; ++st) {
            const f32x4 a0 = *(const LAS f32x4*)(pa + st * 64), a1 = *(const LAS f32x4*)(pa + st * 64 + 4);
            const f32x4 w0 = *(const LAS f32x4*)(pw + st * 64), w1 = *(const LAS f32x4*)(pw + st * 64 + 4);
            const f32x4 b0 = *(const LAS f32x4*)(pb + st * 64), b1 = *(const LAS f32x4*)(pb + st * 64 + 4);
            const f32x4 k0 = *(const LAS f32x4*)(pk + st * 64), k1 = *(const LAS f32x4*)(pk + st * 64 + 4);
            const f32x4 r0 = *(const LAS f32x4*)(pr + st * 64), r1 = *(const LAS f32x4*)(pr + st * 64 + 4);
            const float vv = pv[st * 64];
            float sa = (s[0] * a0[0] + s[1] * a0[1]) + (s[2] * a0[2] + s[3] * a0[3]) + (s[4] * a1[0] + s[5] * a1[1]) + (s[6] * a1[2] + s[7] * a1[3]);
            sa = reduce8(sa);
#pragma unroll
            for (int j = 0; j < 4; ++j) { s[j] = s[j] * w0[j] + (sa * b0[j] + vv * k0[j]); s[4 + j] = s[4 + j] * w1[j] + (sa * b1[j] + vv * k1[j]); }
            float y = (s[0] * r0[0] + s[1] * r0[1]) + (s[2] * r0[2] + s[3] * r0[3]) + (s[4] * r1[0] + s[5] * r1[1]) + (s[6] * r1[2] + s[7] * r1[3]);
            y = reduce8(y);
            if (jg == 0) yb[st * 64 + i] = y;
        }
        __syncthreads();
#pragma unroll
        for (int q = 0; q < RTS / 8; ++q) {
            const int st = F.wave * (RTS / 8) + q, lane = F.lane;
            const size_t tok = (size_t)b * SEQ + (size_t)ch * RTS + st;
            const float y = yb[st * 64 + lane];
            const float mean = wave_sum(y) * (1.0f / 64.0f); const float dlt = y - mean; const float var = wave_sum(dlt * dlt) * (1.0f / 64.0f);
            const int cidx = h * 64 + lane;
            float o = dlt * rsqrtf(var + 64e-5f) * gn_g[cidx] + gn_b[cidx];
            o += RK[tok * 16 + h] * sb[(cb * 6 + 3) * RTS * 64 + st * 64 + lane];
            o *= GG[tok * 768 + cidx];
            mix[tok * D + cidx] = f2bf(o);
        }
        if (ch + 1 < nchunk) {
#pragma unroll
            for (int a = 0; a < 6; ++a) *(LAS f32x4*)(sb + ((cb ^ 1) * 6 + a) * RTS * 64 + st_step * 64 + st_c4) = reg[a];
        }
        __syncthreads();
    }
}

constexpr int MP = 72;
constexpr int MBUF = 64 * MP * 2;
DI bf16x8 ldfrag(const LAS bf16_t* M, int rb, int ks, int lane) { return *(const LAS bf16x8*)(M + (rb * 16 + (lane & 15)) * MP + ks * 32 + 8 * (lane >> 4)); }
DI f32x4 mm_tile(const LAS bf16_t* X, const LAS bf16_t* Y, int rb, int cb, int lane, f32x4 acc) {
#pragma unroll
    for (int ks = 0; ks < 2; ++ks) acc = __builtin_amdgcn_mfma_f32_16x16x32_bf16(ldfrag(X, rb, ks, lane), ldfrag(Y, cb, ks, lane), acc, 0, 0, 0);
    return acc;
}
DI void st_T(LAS bf16_t* M, int rb, int cb, int lane, f32x4 v) {
    u32x2 w; w.x = pack2(v[0], v[1]); w.y = pack2(v[2], v[3]);
    *(LAS u32x2*)(M + (cb * 16 + (lane & 15)) * MP + rb * 16 + 4 * (lane >> 4)) = w;
}
DI void st_N(LAS bf16_t* M, int rb, int cb, int lane, f32x4 v) {
#pragma unroll
    for (int q = 0; q < 4; ++q) M[(rb * 16 + 4 * (lane >> 4) + q) * MP + cb * 16 + (lane & 15)] = f2bf(v[q]);
}
DI void p_rwkv_pass1(const Frame F, int l) {
    const bf16_t* z = WSP(bf16_t, WS_Z);
    const float* mu = INP(3) + (size_t)l * 2560; const float* w0 = INP(4) + (size_t)l * 768; const float* a0 = INP(6) + (size_t)l * 768;
    const float* k_k = INP(9) + (size_t)l * 768; const float* k_a = INP(10) + (size_t)l * 768; const float* r_k = INP(11) + (size_t)l * 768;
    const bf16_t* wT = WSP(bf16_t, WS_LORA) + (size_t)l * 768 * 256; const bf16_t* aT = wT + 768 * 64; const bf16_t* gT = wT + 768 * 128;
    bf16_t* Vb = WSP(bf16_t, WS_RW); bf16_t* Gb = Vb + (size_t)T * 768; float* RK = WSP(float, WS_RK);
    float* ACg = WSP(float, WS_AC); float* GCg = WSP(float, WS_GC); float* Y0g = WSP(float, WS_Y0); bf16_t* QCg = WSP(bf16_t, WS_QC);
    LAS bf16_t* b0 = (LAS bf16_t*)F.lds;
    LAS bf16_t* b1 = (LAS bf16_t*)(F.lds + 1 * MBUF);
    LAS bf16_t* b2 = (LAS bf16_t*)(F.lds + 2 * MBUF);
    LAS bf16_t* b3 = (LAS bf16_t*)(F.lds + 3 * MBUF);
    LAS bf16_t* b4 = (LAS bf16_t*)(F.lds + 4 * MBUF);
    LAS bf16_t* b5 = (LAS bf16_t*)(F.lds + 5 * MBUF);
    LAS bf16_t* b6 = (LAS bf16_t*)(F.lds + 6 * MBUF);
    LAS bf16_t* b7 = (LAS bf16_t*)(F.lds + 7 * MBUF);
    LAS bf16_t* b8 = (LAS bf16_t*)(F.lds + 8 * MBUF);
    LAS bf16_t* b9 = (LAS bf16_t*)(F.lds + 9 * MBUF);
    LAS bf16_t* b10 = (LAS bf16_t*)(F.lds + 10 * MBUF);
    LAS bf16_t* b11 = (LAS bf16_t*)(F.lds + 11 * MBUF);
    LAS float* part = (LAS float*)(F.lds + 12 * MBUF);
    LAS bf16_t* XB = b8;
    LAS float* LO = (LAS float*)F.lds;
    const int tid = F.tid, lane = F.lane, wave = F.wave, rb = wave >> 1, cb0 = 2 * (wave & 1);
    const int j = tid & 63, tg = tid >> 6;
    const f32x4 z4 = (f32x4){0.f, 0.f, 0.f, 0.f};
    for (int ch = F.wg; ch < 1536; ch += F.G) {
        const int cidx = ch / 12, h = ch - cidx * 12, b = cidx >> 6, c = cidx & 63, bh = b * 12 + h;
        const int tok0 = b * SEQ + c * 64;
        const int cj = h * 64 + j;
        TSL_B(20);
        float zr_[9], zk_[9], zv_[9];
#pragma unroll
        for (int q = 0; q < 9; ++q) { const int t = tok0 + tg * 8 + q - 1; const bool ok = !(q == 0 && ((t + 1) & (SEQ - 1)) == 0);
            const size_t zo = (size_t)(ok ? t : t + 1) * ZLD + cj;
            zr_[q] = ok ? bf2f(z[zo]) : 0.f; zk_[q] = ok ? bf2f(z[zo + 768]) : 0.f; zv_[q] = ok ? bf2f(z[zo + 1536]) : 0.f; }
        __syncthreads();
        {
            const bf16_t* xl = WSP(bf16_t, WS_XL) + (size_t)tok0 * 256;
#pragma unroll
            for (int i = 0; i < 4; ++i) { const int p = tid + 512 * i, tk = p >> 5, sg = p & 31; *(LAS u32x4*)(XB + tk * 264 + sg * 8) = *(const u32x4*)(xl + (size_t)tk * 256 + sg * 8); }
        }
        __syncthreads();
        {
            const int c32 = lane & 31, hh = lane >> 5, ct = (wave >> 1) & 1, tt = wave & 1;
            const size_t arow = (size_t)(h * 64 + ct * 32 + c32);
            f32x16 acc0, acc1;
#pragma unroll
            for (int q = 0; q < 16; ++q) { acc0[q] = 0.f; acc1[q] = 0.f; }
            if (wave < 4) {
#pragma unroll
                for (int ks = 0; ks < 4; ++ks) {
                    acc0 = MFMA32(*(const bf16x8*)(wT + arow * 64 + 16 * ks + 8 * hh), *(const LAS bf16x8*)(XB + (tt * 32 + c32) * 264 + 16 * ks + 8 * hh), acc0);
                    acc1 = MFMA32(*(const bf16x8*)(aT + arow * 64 + 16 * ks + 8 * hh), *(const LAS bf16x8*)(XB + (tt * 32 + c32) * 264 + 64 + 16 * ks + 8 * hh), acc1); }
            } else {
#pragma unroll
                for (int ks = 0; ks < 8; ++ks)
                    acc0 = MFMA32(*(const bf16x8*)(gT + arow * 128 + 16 * ks + 8 * hh), *(const LAS bf16x8*)(XB + (tt * 32 + c32) * 264 + 128 + 16 * ks + 8 * hh), acc0);
            }
            LAS float* o0 = LO + ((wave < 4) ? 0 : 2) * 64 * 68 + (tt * 32 + c32) * 68 + ct * 32 + 4 * hh;
#pragma unroll
            for (int rg = 0; rg < 4; ++rg) { *(LAS f32x4*)(o0 + 8 * rg) = (f32x4){acc0[4 * rg], acc0[4 * rg + 1], acc0[4 * rg + 2], acc0[4 * rg + 3]};
                if (wave < 4) *(LAS f32x4*)(o0 + 64 * 68 + 8 * rg) = (f32x4){acc1[4 * rg], acc1[4 * rg + 1], acc1[4 * rg + 2], acc1[4 * rg + 3]}; }
        }
        __syncthreads();
        float lw[8], lam[8], va[8], vb[8], vk[8], vr[8], vv[8];
        {
            const float mur = mu[cj], muk = mu[768 + cj], muv = mu[1536 + cj], w0c = w0[cj], a0c = a0[cj], kkc = k_k[cj], kac = k_a[cj], rkc = r_k[cj];
            float lo_w[8], lo_a[8], lo_g[8];
#pragma unroll
            for (int q = 0; q < 8; ++q) { const int tl = tg * 8 + q; lo_w[q] = LO[tl * 68 + j]; lo_a[q] = LO[64 * 68 + tl * 68 + j]; lo_g[q] = LO[2 * 64 * 68 + tl * 68 + j]; }
            __syncthreads();
            float ss[8], rs[8], kk1v[8], av_[8];
#pragma unroll
            for (int q = 0; q < 8; ++q) {
                const float zr = zr_[q + 1] + (zr_[q] - zr_[q + 1]) * mur, zk = zk_[q + 1] + (zk_[q] - zk_[q + 1]) * muk, zv = zv_[q + 1] + (zv_[q] - zv_[q + 1]) * muv;
                const float xw = -(w0c + lo_w[q]);
                const float sp = (xw > 15.f) ? xw : __logf(1.0f + __expf(xw));
                lw[q] = -__expf(-sp - 0.5f);
                const float a = sigmoidf_(a0c + lo_a[q]);
                const float kk1 = zk * kkc;
                const float k2 = zk * (1.0f + (a - 1.0f) * kac);
                ss[q] = kk1 * kk1; rs[q] = zr * k2 * rkc; kk1v[q] = kk1; av_[q] = a;
                vk[q] = k2; vr[q] = zr; vv[q] = zv;
            }
#pragma unroll
            for (int o = 32; o >= 1; o >>= 1) {
#pragma unroll
                for (int q = 0; q < 8; ++q) { ss[q] += __shfl_xor(ss[q], o); rs[q] += __shfl_xor(rs[q], o); } }
#pragma unroll
            for (int q = 0; q < 8; ++q) {
                const size_t t = (size_t)tok0 + tg * 8 + q;
                const float kh = kk1v[q] * __builtin_amdgcn_rsqf(fmaxf(ss[q], 1e-24f));
                va[q] = -kh; vb[q] = kh * av_[q];
                Vb[t * 768 + cj] = f2bf(vv[q]); Gb[t * 768 + cj] = f2bf(lo_g[q]);
                if (j == 0) RK[t * 16 + h] = rs[q];
            }
        }
        lam[0] = lw[0];
#pragma unroll
        for (int q = 1; q < 8; ++q) lam[q] = lam[q - 1] + lw[q];
        part[tg * 64 + j] = lam[7];
        __syncthreads();
        float off = 0.f, tot = 0.f;
#pragma unroll
        for (int q = 0; q < 8; ++q) { const float p = part[q * 64 + j]; off += (q < tg) ? p : 0.f; tot += p; }
        if (tg == 0) part[512 + j] = __expf(tot);
        {
#pragma unroll
            for (int q = 0; q < 8; ++q) { const float L_ = off + lam[q], ep = __expf(L_), en = __expf(-L_), epv = __expf(L_ - lw[q]);
                va[q] *= epv; vb[q] *= en; vk[q] *= en; vr[q] *= ep; }
#pragma unroll
            for (int q = 0; q < 8; ++q) { const int t = tg * 8 + q; b0[t * MP + j] = f2bf(va[q]); b1[t * MP + j] = f2bf(vb[q]); b2[t * MP + j] = f2bf(vk[q]); b3[t * MP + j] = f2bf(vr[q]); }
            u32x4 w;
            w.x = pack2(va[0], va[1]); w.y = pack2(va[2], va[3]); w.z = pack2(va[4], va[5]); w.w = pack2(va[6], va[7]); *(LAS u32x4*)(b4 + j * MP + tg * 8) = w;
            w.x = pack2(vb[0], vb[1]); w.y = pack2(vb[2], vb[3]); w.z = pack2(vb[4], vb[5]); w.w = pack2(vb[6], vb[7]); *(LAS u32x4*)(b5 + j * MP + tg * 8) = w;
            w.x = pack2(vk[0], vk[1]); w.y = pack2(vk[2], vk[3]); w.z = pack2(vk[4], vk[5]); w.w = pack2(vk[6], vk[7]); *(LAS u32x4*)(b6 + j * MP + tg * 8) = w;
            w.x = pack2(vv[0], vv[1]); w.y = pack2(vv[2], vv[3]); w.z = pack2(vv[4], vv[5]); w.w = pack2(vv[6], vv[7]); *(LAS u32x4*)(b7 + j * MP + tg * 8) = w;
        }
        __syncthreads();
        TSL_E(20); TSL_B(21);
        f32x4 Tt[2], lak[2], mrb[2], mrk[2];
#pragma unroll
        for (int q = 0; q < 2; ++q) { const int cb = cb0 + q;
            Tt[q] = mm_tile(b0, b1, rb, cb, lane, z4); lak[q] = mm_tile(b0, b2, rb, cb, lane, z4); mrb[q] = mm_tile(b3, b1, rb, cb, lane, z4); mrk[q] = mm_tile(b3, b2, rb, cb, lane, z4);
#pragma unroll
            for (int e = 0; e < 4; ++e) { const int tr = rb * 16 + 4 * (lane >> 4) + e, sc = cb * 16 + (lane & 15);
                if (!(tr > sc)) { Tt[q][e] = 0.f; lak[q][e] = 0.f; }
                if (!(tr >= sc)) { mrb[q][e] = 0.f; mrk[q][e] = 0.f; } } }
        float rtv[2][4];
#pragma unroll
        for (int q = 0; q < 2; ++q)
#pragma unroll
            for (int e = 0; e < 4; ++e) rtv[q][e] = bf2f(b3[(rb * 16 + 4 * (lane >> 4) + e) * MP + (cb0 + q) * 16 + (lane & 15)]);
        __syncthreads();
        LAS bf16_t* bx = (LAS bf16_t*)(F.lds + 12 * MBUF + 2304);
#pragma unroll
        for (int q = 0; q < 2; ++q) { const int cb = cb0 + q;
            st_N(b0, rb, cb, lane, Tt[q]); st_T(b1, rb, cb, lane, Tt[q]);
            st_N(b8, rb, cb, lane, lak[q]); st_N(b9, rb, cb, lane, mrb[q]); st_N(b10, rb, cb, lane, mrk[q]);
#pragma unroll
            for (int e = 0; e < 4; ++e) { const int tr = rb * 16 + 4 * (lane >> 4) + e, sc = cb * 16 + (lane & 15); if (tr == sc) Tt[q][e] += 1.0f; }
            st_N(b2, rb, cb, lane, Tt[q]); }
        __syncthreads();
        {
            f32x4 p2[2];
#pragma unroll
            for (int q = 0; q < 2; ++q) p2[q] = mm_tile(b0, b1, rb, cb0 + q, lane, z4);
#pragma unroll
            for (int q = 0; q < 2; ++q) { st_N(b3, rb, cb0 + q, lane, p2[q]); st_T(bx, rb, cb0 + q, lane, p2[q]); }
            __syncthreads();
#pragma unroll
            for (int k = 1; k <= 5; ++k) {
                LAS bf16_t* Pn_c = (k & 1) ? b3 : b0; LAS bf16_t* Pt_c = (k & 1) ? bx : b1; LAS bf16_t* Pn_n = (k & 1) ? b0 : b3; LAS bf16_t* Pt_n = (k & 1) ? b1 : bx;
                LAS bf16_t* Tb_c = ((k - 1) & 1) ? b11 : b2; LAS bf16_t* Tb_n = ((k - 1) & 1) ? b2 : b11;
#pragma unroll
                for (int q = 0; q < 2; ++q) { Tt[q] = mm_tile(Tb_c, Pt_c, rb, cb0 + q, lane, Tt[q]); if (k < 5) p2[q] = mm_tile(Pn_c, Pt_c, rb, cb0 + q, lane, z4); }
#pragma unroll
                for (int q = 0; q < 2; ++q) { st_N(Tb_n, rb, cb0 + q, lane, Tt[q]); if (k < 5) { st_N(Pn_n, rb, cb0 + q, lane, p2[q]); st_T(Pt_n, rb, cb0 + q, lane, p2[q]); } }
                __syncthreads();
            }
        }
#pragma unroll
        for (int q = 0; q < 2; ++q) { const int cb = cb0 + q;
            st_T(b0, rb, cb, lane, mm_tile(b11, b4, rb, cb, lane, z4));
            st_T(b1, rb, cb, lane, mm_tile(b8, b7, rb, cb, lane, z4)); }
        __syncthreads();
#pragma unroll
        for (int q = 0; q < 2; ++q) st_T(b8, rb, cb0 + q, lane, mm_tile(b11, b1, rb, cb0 + q, lane, z4));
        __syncthreads();
        TSL_E(21); TSL_B(22);
        const size_t cho = (size_t)(bh * 64 + c) * 4096;
#pragma unroll
        for (int q = 0; q < 2; ++q) { const int cb = cb0 + q; const int col = cb * 16 + (lane & 15), row0 = rb * 16 + 4 * (lane >> 4);
            f32x4 ac = mm_tile(b5, b0, rb, cb, lane, z4);
            f32x4 gc = mm_tile(b6, b7, rb, cb, lane, mm_tile(b5, b8, rb, cb, lane, z4));
#pragma unroll
            for (int e = 0; e < 4; ++e) { const float gm = part[512 + row0 + e];
                ACg[cho + (size_t)(row0 + e) * 64 + col] = (ac[e] + ((row0 + e) == col ? 1.0f : 0.f)) * gm;
                GCg[cho + (size_t)(row0 + e) * 64 + col] = gc[e] * gm; }
            f32x4 qc = mm_tile(b9, b0, rb, cb, lane, z4);
#pragma unroll
            for (int e = 0; e < 4; ++e) QCg[cho + (size_t)(row0 + e) * 64 + col] = f2bf(qc[e] + rtv[q][e]);
            const f32x4 y0 = mm_tile(b10, b7, rb, cb, lane, mm_tile(b9, b8, rb, cb, lane, z4));
            *(f32x4*)(Y0g + cho + (size_t)((wave * 2 + q) * 64 + lane) * 4) = y0; }
        TSL_E(22);
    }
}
DI void p_rwkv_pass2(const Frame F, int unit) {
    const float* ACg = WSP(float, WS_AC); const float* GCg = WSP(float, WS_GC); bf16_t* SST = WSP(bf16_t, WS_SST);
    LAS float* Sb = (LAS float*)F.lds;
    const int bh = unit >> 2, rb = unit & 3;
    const int lane = F.lane, wave = F.wave, cb = wave & 3, n = lane & 15, kk = lane >> 4;
    const bool act = wave < 4;
    f32x4 St = (f32x4){0.f, 0.f, 0.f, 0.f};
    __syncthreads();
    if (act) {
#pragma unroll
        for (int e = 0; e < 4; ++e) Sb[(4 * kk + e) * 68 + cb * 16 + n] = 0.f; }
    __syncthreads();
    f32x4 bvA[4], gvA, bvB[4], gvB, bvC[4], gvC, bvD[4], gvD, bvE[4], gvE, bvF[4], gvF;
#define P2_LOAD(bv, gv, c_) do { const size_t cho_ = (size_t)(bh * 64 + (c_)) * 4096; \
        _Pragma("unroll") for (int m4 = 0; m4 < 4; ++m4) bv[m4] = *(const f32x4*)(ACg + cho_ + (size_t)(cb * 16 + n) * 64 + 16 * kk + 4 * m4); \
        gv = *(const f32x4*)(GCg + cho_ + (size_t)(cb * 16 + n) * 64 + rb * 16 + 4 * kk); } while (0)
#define P2_STEP(bc, gc, bn, gn, c_) do { const int cc_ = (c_); const size_t cho = (size_t)(bh * 64 + cc_) * 4096; \
        const LAS float* Sc = Sb + (cc_ & 1) * 16 * 68; LAS float* Sn = Sb + ((cc_ + 1) & 1) * 16 * 68; \
        if (act) { \
            _Pragma("unroll") for (int e = 0; e < 4; ++e) SST[cho + (size_t)(rb * 16 + 4 * kk + e) * 64 + cb * 16 + n] = f2bf(St[e]); \
            if (cc_ + 5 < 64) P2_LOAD(bn, gn, cc_ + 5); \
            f32x4 av[4]; _Pragma("unroll") for (int m4 = 0; m4 < 4; ++m4) av[m4] = *(const LAS f32x4*)(Sc + n * 68 + 16 * kk + 4 * m4); \
            f32x4 acc0 = gc, acc1 = (f32x4){0.f, 0.f, 0.f, 0.f}; \
            _Pragma("unroll") for (int m4 = 0; m4 < 4; m4 += 2) _Pragma("unroll") for (int e = 0; e < 4; ++e) { \
                acc0 = __builtin_amdgcn_mfma_f32_16x16x4f32(av[m4][e], bc[m4][e], acc0, 0, 0, 0); \
                acc1 = __builtin_amdgcn_mfma_f32_16x16x4f32(av[m4 + 1][e], bc[m4 + 1][e], acc1, 0, 0, 0); } \
            St = acc0 + acc1; \
            _Pragma("unroll") for (int e = 0; e < 4; ++e) Sn[(4 * kk + e) * 68 + cb * 16 + n] = St[e]; } \
        asm volatile("s_waitcnt lgkmcnt(0)\n\ts_barrier" ::: "memory"); } while (0)
    if (act) { P2_LOAD(bvA, gvA, 0); P2_LOAD(bvB, gvB, 1); P2_LOAD(bvC, gvC, 2); P2_LOAD(bvD, gvD, 3); P2_LOAD(bvE, gvE, 4); }
    for (int c = 0; c < 60; c += 6) { P2_STEP(bvA, gvA, bvF, gvF, c); P2_STEP(bvB, gvB, bvA, gvA, c + 1); P2_STEP(bvC, gvC, bvB, gvB, c + 2);
                                       P2_STEP(bvD, gvD, bvC, gvC, c + 3); P2_STEP(bvE, gvE, bvD, gvD, c + 4); P2_STEP(bvF, gvF, bvE, gvE, c + 5); }
    P2_STEP(bvA, gvA, bvF, gvF, 60); P2_STEP(bvB, gvB, bvA, gvA, 61); P2_STEP(bvC, gvC, bvB, gvB, 62); P2_STEP(bvD, gvD, bvC, gvC, 63);
#undef P2_LOAD
#undef P2_STEP
}
DI void p_rwkv_pass3(const Frame F, int l) {
    const bf16_t* Vb = WSP(bf16_t, WS_RW); const bf16_t* Gb = Vb + (size_t)T * 768; const float* RK = WSP(float, WS_RK);
    const float* Y0g = WSP(float, WS_Y0); const bf16_t* QCg = WSP(bf16_t, WS_QC); const bf16_t* SST = WSP(bf16_t, WS_SST);
    const float* gn_g = INP(12) + (size_t)l * 768; const float* gn_b = INP(13) + (size_t)l * 768;
    bf16_t* mix = WSP(bf16_t, WS_MIX);
    LAS float* ybuf = (LAS float*)F.lds;
    const int lane = F.lane, wave = F.wave, rb = wave >> 1, cb0 = 2 * (wave & 1), n = lane & 15, kk = lane >> 4;
    bf16x8 qaA[2], ssA[2][2], qaB[2], ssB[2][2]; f32x4 y0A[2], y0B[2]; float rkA[8], rkB[8]; bf16_t vA[8], gA[8], vB[8], gB[8];
#define P3_LOAD(qa, ss, y0, rk, vv, gg, ch_) do { const int ch__ = (ch_); const size_t cho_ = (size_t)ch__ * 4096; const int bh_ = ch__ >> 6, c_ = ch__ & 63, b_ = bh_ / 12, h_ = bh_ % 12; \
        _Pragma("unroll") for (int ks = 0; ks < 2; ++ks) qa[ks] = *(const bf16x8*)(QCg + cho_ + (size_t)(rb * 16 + n) * 64 + ks * 32 + 8 * kk); \
        _Pragma("unroll") for (int q = 0; q < 2; ++q) { y0[q] = *(const f32x4*)(Y0g + cho_ + (size_t)((wave * 2 + q) * 64 + lane) * 4); \
            _Pragma("unroll") for (int ks = 0; ks < 2; ++ks) ss[q][ks] = *(const bf16x8*)(SST + cho_ + (size_t)((cb0 + q) * 16 + n) * 64 + ks * 32 + 8 * kk); } \
        _Pragma("unroll") for (int q = 0; q < 8; ++q) { const size_t tok_ = (size_t)b_ * SEQ + (size_t)c_ * 64 + wave * 8 + q; \
            rk[q] = RK[tok_ * 16 + h_]; vv[q] = Vb[tok_ * 768 + h_ * 64 + lane]; gg[q] = Gb[tok_ * 768 + h_ * 64 + lane]; } } while (0)
#define P3_BODY(qa, ss, y0, rk, vv, gg, ch_, par_) do { const int ch__ = (ch_); const int bh_ = ch__ >> 6, c_ = ch__ & 63, b_ = bh_ / 12, h_ = bh_ % 12; \
        LAS float* yb = ybuf + (par_) * 64 * 68; \
        _Pragma("unroll") for (int q = 0; q < 2; ++q) { f32x4 acc = y0[q]; \
            _Pragma("unroll") for (int ks = 0; ks < 2; ++ks) acc = __builtin_amdgcn_mfma_f32_16x16x32_bf16(qa[ks], ss[q][ks], acc, 0, 0, 0); \
            _Pragma("unroll") for (int e = 0; e < 4; ++e) yb[(rb * 16 + 4 * kk + e) * 68 + (cb0 + q) * 16 + n] = acc[e]; } \
        __syncthreads(); \
        float yv[8], s1[8], s2[8]; \
        _Pragma("unroll") for (int q = 0; q < 8; ++q) { yv[q] = yb[(wave * 8 + q) * 68 + lane]; s1[q] = yv[q]; s2[q] = yv[q] * yv[q]; } \
        _Pragma("unroll") for (int o = 32; o >= 1; o >>= 1) { _Pragma("unroll") for (int q = 0; q < 8; ++q) { s1[q] += __shfl_xor(s1[q], o); s2[q] += __shfl_xor(s2[q], o); } } \
        const int cidx = h_ * 64 + lane; const float gng = gn_g[cidx], gnb = gn_b[cidx]; \
        _Pragma("unroll") for (int q = 0; q < 8; ++q) { const size_t tok_ = (size_t)b_ * SEQ + (size_t)c_ * 64 + wave * 8 + q; \
            const float mean = s1[q] * (1.0f / 64.0f), var = fmaxf(s2[q] * (1.0f / 64.0f) - mean * mean, 0.f); \
            float o = (yv[q] - mean) * rsqrtf(var + 64e-5f) * gng + gnb; \
            o += rk[q] * bf2f(vv[q]); o *= bf2f(gg[q]); \
            mix[tok_ * D + cidx] = f2bf(o); } } while (0)
    if (F.wg < 1536) P3_LOAD(qaA, ssA, y0A, rkA, vA, gA, F.wg);
    for (int ch = F.wg; ch < 1536; ch += 2 * F.G) {
        if (ch + F.G < 1536) P3_LOAD(qaB, ssB, y0B, rkB, vB, gB, ch + F.G);
        P3_BODY(qaA, ssA, y0A, rkA, vA, gA, ch, 0);
        if (ch + 2 * F.G < 1536) P3_LOAD(qaA, ssA, y0A, rkA, vA, gA, ch + 2 * F.G);
        if (ch + F.G < 1536) P3_BODY(qaB, ssB, y0B, rkB, vB, gB, ch + F.G, 1);
    }
#undef P3_LOAD
#undef P3_BODY
}

DI void p_ln1_route(const Frame F, int l, bool commit) {
    const bf16_t* xin = WSP(bf16_t, WS_XBF); const bf16_t* tmp = WSP(bf16_t, WS_TMP); bf16_t* x1b = WSP(bf16_t, WS_X1BF);
    const float* g = INP(19) + (size_t)l * D; const float* bta = INP(20) + (size_t)l * D;
    const float* rwg = WSP(float, WS_RWG) + (size_t)l * 32 * 2048; const float* rc = WSP(float, WS_RC) + l * 64; const float* rb = INP(22);
    unsigned* cnt = F.ctl + CW_MOECNT + l * 32 * 64; int* tokl = WSP(int, WS_TOKL); float* gate = WSP(float, WS_GATE);
    const int lane = F.lane, wave = F.wave;
    LAS float* red = (LAS float*)F.lds;
    LAS f32x2* stat = (LAS f32x2*)(F.lds + 32768);
    for (int tile = F.wg; tile < T / 32; tile += F.G) {
        const int t0 = tile * 32;
        TSL_B(23);
        {
            const int c = lane & 31, hh = lane >> 5;
            const size_t ao = (size_t)(t0 + c) * D + 256 * wave + 128 * hh; const float* brow = rwg + (size_t)c * D + 256 * wave + 128 * hh;
            f32x16 acc;
#pragma unroll
            for (int i = 0; i < 16; ++i) acc[i] = 0.f;
#pragma unroll 4
            for (int s8 = 0; s8 < 16; ++s8) {
                const u32x4 xa = *(const u32x4*)(xin + ao + 8 * s8), ma = *(const u32x4*)(tmp + ao + 8 * s8); const f32x4 b0 = *(const f32x4*)(brow + 8 * s8), b1 = *(const f32x4*)(brow + 8 * s8 + 4);
                const unsigned xw[4] = {xa.x, xa.y, xa.z, xa.w}, mw[4] = {ma.x, ma.y, ma.z, ma.w}; const float bb[8] = {b0[0], b0[1], b0[2], b0[3], b1[0], b1[1], b1[2], b1[3]};
#pragma unroll
                for (int q = 0; q < 4; ++q) { acc = __builtin_amdgcn_mfma_f32_32x32x2f32(ALPHA * bflo(xw[q]) + bflo(mw[q]), bb[2 * q], acc, 0, 0, 0);
                                              acc = __builtin_amdgcn_mfma_f32_32x32x2f32(ALPHA * bfhi(xw[q]) + bfhi(mw[q]), bb[2 * q + 1], acc, 0, 0, 0); } }
#pragma unroll
            for (int i = 0; i < 16; ++i) red[wave * 1024 + crow(i, hh) * 32 + c] = acc[i];
        }
#pragma unroll 1
        for (int up = 0; up < 4; up += 2) {
            float xv[2][32], sm[2], sq[2];
#pragma unroll
            for (int u = 0; u < 2; ++u) { const size_t t = (size_t)t0 + wave * 4 + up + u; sm[u] = 0.f;
#pragma unroll
                for (int i = 0; i < 8; ++i) { const u32x2 a = *(const u32x2*)(xin + t * D + 256 * i + 4 * lane), m = *(const u32x2*)(tmp + t * D + 256 * i + 4 * lane);
                    xv[u][4 * i] = ALPHA * bflo(a.x) + bflo(m.x); xv[u][4 * i + 1] = ALPHA * bfhi(a.x) + bfhi(m.x); xv[u][4 * i + 2] = ALPHA * bflo(a.y) + bflo(m.y); xv[u][4 * i + 3] = ALPHA * bfhi(a.y) + bfhi(m.y);
                    sm[u] += (xv[u][4 * i] + xv[u][4 * i + 1]) + (xv[u][4 * i + 2] + xv[u][4 * i + 3]); } }
#pragma unroll
            for (int o = 32; o >= 1; o >>= 1) {
#pragma unroll
                for (int u = 0; u < 2; ++u) sm[u] += __shfl_xor(sm[u], o); }
#pragma unroll
            for (int u = 0; u < 2; ++u) { sm[u] *= (1.0f / 2048.0f); sq[u] = 0.f;
#pragma unroll
                for (int i = 0; i < 32; ++i) { const float dl = xv[u][i] - sm[u]; sq[u] += dl * dl; } }
#pragma unroll
            for (int o = 32; o >= 1; o >>= 1) {
#pragma unroll
                for (int u = 0; u < 2; ++u) sq[u] += __shfl_xor(sq[u], o); }
#pragma unroll
            for (int u = 0; u < 2; ++u) { sq[u] = rsqrtf(sq[u] * (1.0f / 2048.0f) + 1e-5f); if (lane == 0) stat[wave * 4 + up + u] = (f32x2){sm[u], sq[u]}; }
#pragma unroll
            for (int i = 0; i < 8; ++i) { const f32x4 gg = *(const f32x4*)(g + 256 * i + 4 * lane), bb = *(const f32x4*)(bta + 256 * i + 4 * lane);
#pragma unroll
                for (int u = 0; u < 2; ++u) { const size_t t = (size_t)t0 + wave * 4 + up + u; f32x4 o;
#pragma unroll
                    for (int j = 0; j < 4; ++j) o[j] = (xv[u][4 * i + j] - sm[u]) * sq[u] * gg[j] + bb[j];
                    u32x2 w; w.x = pack2(o[0], o[1]); w.y = pack2(o[2], o[3]); *(u32x2*)(x1b + t * D + 256 * i + 4 * lane) = w; } }
        }
        __syncthreads();
        TSL_E(23); TSL_B(24);
#pragma unroll 1
        for (int p = 0; p < 2; ++p) {
            const int e = lane & 31, tl = wave * 4 + 2 * p + (lane >> 5);
            float dot = 0.f;
#pragma unroll
            for (int w2 = 0; w2 < 8; ++w2) dot += red[w2 * 1024 + tl * 32 + e];
            const f32x2 st = stat[tl];
            const float logit = st.y * (dot - st.x * rc[e]) + rc[32 + e];
        const float score = 1.0f / (1.0f + expf(-logit)), sel = score + rb[e];
            const int gb = lane & ~3;
            const float s0 = __shfl(sel, gb), s1 = __shfl(sel, gb + 1), s2 = __shfl(sel, gb + 2), s3 = __shfl(sel, gb + 3);
            const float ha = fmaxf(s0, s1), hb = fminf(s0, s1), hc = fmaxf(s2, s3), hd = fminf(s2, s3);
            float gv = fmaxf(ha, hc) + fmaxf(fminf(ha, hc), fmaxf(hb, hd)); int gi = e >> 2;
#pragma unroll
            for (int msk = 4; msk <= 16; msk <<= 1) { const float ov = __shfl_xor(gv, msk); const int oi = __shfl_xor(gi, msk); if (ov > gv || (ov == gv && oi < gi)) { gv = ov; gi = oi; } }
            const int base = (lane & 32) + 4 * gi;
            float a[4], sc4[4];
#pragma unroll
            for (int k = 0; k < 4; ++k) { a[k] = __shfl(sel, base + k); sc4[k] = __shfl(score, base + k); }
            int i1 = 0; float v1 = a[0];
#pragma unroll
            for (int k = 1; k < 4; ++k) if (a[k] > v1) { v1 = a[k]; i1 = k; }
            int i2 = -1; float v2 = -3.0e38f;
#pragma unroll
            for (int k = 0; k < 4; ++k) if (k != i1 && a[k] > v2) { v2 = a[k]; i2 = k; }
            float g1 = 0.f, g2 = 0.f;
#pragma unroll
            for (int k = 0; k < 4; ++k) { if (k == i1) g1 = sc4[k]; if (k == i2) g2 = sc4[k]; }
            if (e == 0 && commit) {
                const int t = t0 + tl; const int e1 = 4 * gi + i1, e2 = 4 * gi + i2; const float dn = g1 + g2;
                const unsigned r1 = atomicAdd(cnt + e1 * 64, 1u); tokl[e1 * 8192 + r1] = 2 * t;
                const unsigned r2 = atomicAdd(cnt + e2 * 64, 1u); tokl[e2 * 8192 + r2] = 2 * t + 1;
                gate[2 * t] = g1 / dn; gate[2 * t + 1] = g2 / dn;
            }
        }
        __syncthreads();
        TSL_E(24);
    }
}

DI void p_ln2(const Frame F, int l) {
    const bf16_t* ybt = WSP(bf16_t, WS_YBT); const float* gate = WSP(float, WS_GATE);
    bf16_t* xb = WSP(bf16_t, WS_X1BF);
    const float* g = INP(26) + (size_t)l * D; const float* bta = INP(27) + (size_t)l * D;
    const int lane = F.lane;
    for (int tb = F.wg * 8 + F.wave; tb < T; tb += F.G * 8 * 2) {
        float xv[2][32], sm[2], sq[2], gg0[2], gg1[2];
#pragma unroll
        for (int k = 0; k < 2; ++k) { const int t = tb + k * F.G * 8; gg0[k] = gate[2 * t]; gg1[k] = gate[2 * t + 1]; sm[k] = 0.f;
#pragma unroll
            for (int i = 0; i < 8; ++i) { const size_t o = 256 * i + 4 * lane; const u32x2 a = *(const u32x2*)(xb + (size_t)t * D + o);
                const u32x2 y0 = *(const u32x2*)(ybt + (size_t)(2 * t) * D + o), y1 = *(const u32x2*)(ybt + (size_t)(2 * t + 1) * D + o);
                xv[k][4 * i] = ALPHA * bflo(a.x) + (gg0[k] * bflo(y0.x) + gg1[k] * bflo(y1.x)); xv[k][4 * i + 1] = ALPHA * bfhi(a.x) + (gg0[k] * bfhi(y0.x) + gg1[k] * bfhi(y1.x));
                xv[k][4 * i + 2] = ALPHA * bflo(a.y) + (gg0[k] * bflo(y0.y) + gg1[k] * bflo(y1.y)); xv[k][4 * i + 3] = ALPHA * bfhi(a.y) + (gg0[k] * bfhi(y0.y) + gg1[k] * bfhi(y1.y));
                sm[k] += (xv[k][4 * i] + xv[k][4 * i + 1]) + (xv[k][4 * i + 2] + xv[k][4 * i + 3]); } }
#pragma unroll
        for (int o = 32; o >= 1; o >>= 1) {
#pragma unroll
            for (int k = 0; k < 2; ++k) sm[k] += __shfl_xor(sm[k], o); }
#pragma unroll
        for (int k = 0; k < 2; ++k) { sm[k] *= (1.0f / 2048.0f); sq[k] = 0.f;
#pragma unroll
            for (int i = 0; i < 32; ++i) { const float dl = xv[k][i] - sm[k]; sq[k] += dl * dl; } }
#pragma unroll
        for (int o = 32; o >= 1; o >>= 1) {
#pragma unroll
            for (int k = 0; k < 2; ++k) sq[k] += __shfl_xor(sq[k], o); }
#pragma unroll
        for (int i = 0; i < 8; ++i) { const size_t o = 256 * i + 4 * lane; const f32x4 gg = *(const f32x4*)(g + o), bb = *(const f32x4*)(bta + o);
#pragma unroll
            for (int k = 0; k < 2; ++k) { const int t = tb + k * F.G * 8; const float rstd = rsqrtf(sq[k] * (1.0f / 2048.0f) + 1e-5f); f32x4 r;
#pragma unroll
                for (int j = 0; j < 4; ++j) r[j] = (xv[k][4 * i + j] - sm[k]) * rstd * gg[j] + bb[j];
                u32x2 w; w.x = pack2(r[0], r[1]); w.y = pack2(r[2], r[3]); *(u32x2*)(xb + (size_t)t * D + o) = w; } }
    }
}

DI int finish_units(const Frame F, int n) {
    LAS int* cw = (LAS int*)(F.lds + LDS_CTL);
    if (F.tid == 0) cw[4] = n;
    __syncthreads();
    return __builtin_amdgcn_readfirstlane(cw[4]);
}
DI int moe_units_body(const Frame F, int l) {
    LAS int* mt = (LAS int*)(F.lds + LDS_MOE); LAS int* utab = (LAS int*)(F.lds + LDS_UTAB); LAS int* rowl = (LAS int*)(F.lds + LDS_ROWL);
    const int* tokl = WSP(int, WS_TOKL);
    int n1 = 0, n2 = 0;
    if (F.tid < 32) { int c = (int)__hip_atomic_load(F.ctl + CW_MOECNT + (l * 32 + F.tid) * 64, __ATOMIC_RELAXED, __HIP_MEMORY_SCOPE_AGENT); mt[F.tid] = c > 8192 ? 8192 : c; }
    __syncthreads();
    if (F.tid == 0) {
        int hb = 0, nrb = 0;
        for (int e = 0; e < 32; ++e) { const int c = mt[e];
            mt[32 + e] = hb; const int nb = (c + 255) >> 8;
            for (int j = 0; j < nb && nrb < 128; ++j) { mt[64 + nrb] = e; mt[192 + nrb] = j; ++nrb; }
            hb += nb * 256; }
        for (int L = F.wg; L < nrb * 4 && n1 < 2; L += F.G) {
            const int rb = L >> 2, pn = L & 3, e = mt[64 + rb], j = mt[192 + rb], cnt = mt[e], row0 = mt[32 + e] + j * 256;
            const int valid = (cnt - j * 256) < 256 ? (cnt - j * 256) : 256;
            pg8::unit_put(utab, n1, WSP(bf16_t, WS_X1BF), WSP(bf16_t, WS_WGU) + ((size_t)(l * 32 + e) * 1024 + (size_t)pn * 256) * 2048, WSP(bf16_t, WS_HB), 2048, DEXP, row0, pn * 256, e * 8192 + j * 256, valid | (rb << 16));
            ++n1; }
        int heavy = nrb * 4 - F.G; if (heavy < 0) heavy = 0; if (heavy > F.G - 1) heavy = F.G - 1;
        const int nl = F.G - heavy;
        if (F.wg >= heavy) for (int u2 = F.wg - heavy; u2 < nrb * 8 && n2 < 6; u2 += nl) {
            const int rb = u2 >> 3, pn = u2 & 7, e = mt[64 + rb], j = mt[192 + rb], cnt = mt[e], row0 = mt[32 + e] + j * 256;
            const int valid = (cnt - j * 256) < 256 ? (cnt - j * 256) : 256;
            pg8::unit_put(utab, n1 + n2, WSP(bf16_t, WS_HB) + (size_t)row0 * DEXP, WSP(bf16_t, WS_WDN) + ((size_t)(l * 32 + e) * 2048 + (size_t)pn * 256) * 512, WSP(bf16_t, WS_YBT), 512, D, row0, pn * 256, e * 8192 + j * 256, valid | (rb << 16));
            ++n2; }
    }
    const int nn = finish_units(F, n1 | (n2 << 8));
    n1 = nn & 255; n2 = nn >> 8;
    for (int x = F.tid; x < (n1 + n2) * 256; x += 512) { const int ui = x >> 8, r = x & 255, a0 = utab[ui * pg8::UD + 10], a1 = utab[ui * pg8::UD + 11] & 0xffff;
        const int v = (r < a1) ? tokl[a0 + r] : -1; rowl[x] = (ui < n1) ? (v < 0 ? 0 : (v >> 1)) : v; }
    __syncthreads();
    return nn;
}

__device__ __noinline__ int moe_units(LAS unsigned char* lds_, GAS unsigned char* ws_, int wave_, int l) { const Frame F = make_frame(lds_, ws_, wave_); return moe_units_body(F, l); }
PHASE_FN ph_prologue(PHASE_ARGS) { PHASE_FRAME; p_prologue(F); }
GEMM_FN ph_gemm_in(PHASE_ARGS, int l) {
    PHASE_FRAME; LAS int* utab = (LAS int*)(F.lds + LDS_UTAB);
    int n = 0;
    if (F.tid == 0) { int Lb = 0;
        pg8::build_dense(utab, n, Lb, WSP(bf16_t, WS_XBF), WSP(bf16_t, WS_WIN) + (size_t)l * 8192 * 2048, WSP(bf16_t, WS_Z), 2, T, 8192, 2048, ZLD, F.G, F.wg);
        pg8::build_dense(utab, n, Lb, WSP(bf16_t, WS_PBF) + (size_t)l * T * PLE, WSP(bf16_t, WS_WPP) + (size_t)l * 2048 * 256, WSP(bf16_t, WS_PP), 2, T, 2048, 256, D, F.G, F.wg); }
    n = finish_units(F, n);
    pg8::EpiBf16 E; pg8::gemm_phase<pg8::EpiBf16, false>(F.lds, F.tid, utab, n, nullptr, E);
}
PHASE_FN ph_rwkv_prep(PHASE_ARGS, int l) { PHASE_FRAME; p_rwkv_prep(F, l); }
PHASE_FN ph_mla_prep(PHASE_ARGS, int l) { PHASE_FRAME; p_mla_prep(F, l); p_vtd_prep(F); }
GEMM_FN ph_gemm_mla(PHASE_ARGS, int l) {
    PHASE_FRAME; LAS int* utab = (LAS int*)(F.lds + LDS_UTAB);
    int n = 0;
    if (F.tid == 0) { int Lb = 0;
        pg8::build_dense(utab, n, Lb, WSP(bf16_t, WS_QN), WSP(bf16_t, WS_WUQ) + (size_t)l * 1280 * 512, WSP(bf16_t, WS_QB), 2, T, 1280, 512, 1280, F.G, F.wg);
        pg8::build_dense(utab, n, Lb, WSP(bf16_t, WS_KVN), WSP(bf16_t, WS_WUKV) + (size_t)l * 1536 * 256, WSP(bf16_t, WS_KC), 2, T, 768, 256, 768, F.G, F.wg);
        Lb += 160;
        pg8::build_dense(utab, n, Lb, WSP(bf16_t, WS_WUKV) + (size_t)l * 1536 * 256 + (size_t)768 * 256, WSP(bf16_t, WS_KVN), WSP(bf16_t, WS_VT), 2, 768, T, 256, T, F.G, F.wg); }
    n = finish_units(F, n);
    pg8::EpiBf16 E; pg8::gemm_phase<pg8::EpiBf16, false>(F.lds, F.tid, utab, n, nullptr, E);
}
PHASE_FN ph_dil(PHASE_ARGS) { PHASE_FRAME; for (int it = F.wg * 8 + F.wave; it < 2 * 12 * 128; it += F.G * 8) dil_item(F, it); }
PHASE_FN ph_scan(PHASE_ARGS, int l) { PHASE_FRAME; p_rwkv_pass2(F, F.wg); }
PHASE_FN ph_rwkv1(PHASE_ARGS, int l) { PHASE_FRAME; p_rwkv_pass1(F, l); }
PHASE_FN ph_rwkv3(PHASE_ARGS, int l) { PHASE_FRAME; p_rwkv_pass3(F, l); }
DI void conv_item_body(const Frame F, int l, int j) {
    if (j < 768) {
        const int set = j >> 8, t0 = (j & 255) * 8;
        if (set == 0)      convert_dma<1>(F, INP(23) + (size_t)l * 32 * 2048 * 512, 2048, 512, WSP(bf16_t, WS_WGU) + (size_t)l * 32 * 1024 * 2048, 0, (size_t)2048 * 512, (size_t)1024 * 2048, t0, 8);
        else if (set == 1) convert_dma<1>(F, INP(24) + (size_t)l * 32 * 2048 * 512, 2048, 512, WSP(bf16_t, WS_WGU) + (size_t)l * 32 * 1024 * 2048, 1, (size_t)2048 * 512, (size_t)1024 * 2048, t0, 8);
        else               convert_dma<0>(F, INP(25) + (size_t)l * 32 * 512 * 2048, 512, 2048, WSP(bf16_t, WS_WDN) + (size_t)l * 32 * 2048 * 512, 0, (size_t)512 * 2048, (size_t)2048 * 512, t0, 8);
    } else if (j < 800) {
        convert_dma<0>(F, INP(18) + (size_t)l * 2048 * 2048, 2048, 2048, WSP(bf16_t, WS_WOUT) + (size_t)l * 2048 * 2048, 0, (size_t)2048 * 2048, (size_t)2048 * 2048, (j - 768) * 8, 8);
    } else if (j < 832) {
        convert_dma<0>(F, INP(29) + (size_t)l * 2048 * 2048, 2048, 2048, WSP(bf16_t, WS_WPG) + (size_t)l * 2048 * 2048, 0, (size_t)2048 * 2048, (size_t)2048 * 2048, (j - 800) * 8, 8);
    } else if (l + 1 < NL) {
        convert_dma<0>(F, INP(2) + (size_t)(l + 1) * 2048 * 8000, 2048, 8000, WSP(bf16_t, WS_WIN) + (size_t)(l + 1) * 8192 * 2048, 0, (size_t)2048 * 8000, (size_t)8192 * 2048, (j - 832) * 8, 8);
    }
}
__device__ __noinline__ void conv_item(LAS unsigned char* lds_, GAS unsigned char* ws_, int wave_, int l, int j) { const Frame F = make_frame(lds_, ws_, wave_); conv_item_body(F, l, j); }
PHASE_FN ph_attn_queue(PHASE_ARGS, int l, int rep) {
    PHASE_FRAME;
    unsigned* q = F.ctl + CW_QUEUE + l * 64 + rep * 8;
    LAS int* cw = (LAS int*)(F.lds + LDS_CTL);
    for (;;) {
        __syncthreads();
        if (F.tid == 0) cw[5] = (int)atomicAdd(q, 1u);
        __syncthreads();
        const int it = __builtin_amdgcn_readfirstlane(cw[5]);
        if (it >= 96 * 12) break;
        const int grp = it / 12, r = it - grp * 12, am = (r * 5 + 11) / 12;
        const Frame Fi = make_frame(F.lds, F.ws, F.wave);
        if (((r + 1) * 5 + 11) / 12 != am) mla_wg_item(Fi, grp * 5 + am);
        else conv_item(F.lds, F.ws, F.wave, l, grp * 7 + (r - am));
    }
    unsigned* q2 = F.ctl + CW_QUEUE + l * 64 + 32 + rep;
    for (;;) {
        __syncthreads();
        if (F.tid == 0) cw[5] = (int)atomicAdd(q2, 1u);
        __syncthreads();
        const int e = __builtin_amdgcn_readfirstlane(cw[5]);
        if (e >= 96 * 7) break;
        const int grp = e / 7, r = e - grp * 7;
        if ((r & 1) == 0) { const Frame Fi = make_frame(F.lds, F.ws, F.wave); dil_item(Fi, (grp * 4 + (r >> 1)) * 8 + F.wave); }
        else conv_item(F.lds, F.ws, F.wave, l, 672 + grp * 3 + (r >> 1));
    }
}
PHASE_FN ph_combine(PHASE_ARGS) {
    PHASE_FRAME;
    for (int it = F.wg * 8 + F.wave; it < 4096; it += F.G * 8) { if (it < 2048) dilc_item(F, it); else mla_combine_item(F, it - 2048); }
}
GEMM_FN ph_gemm_out(PHASE_ARGS, int l) {
    PHASE_FRAME; LAS int* utab = (LAS int*)(F.lds + LDS_UTAB);
    int n = 0;
    if (F.tid == 0) { int Lb = 0; pg8::build_dense(utab, n, Lb, WSP(bf16_t, WS_MIX), WSP(bf16_t, WS_WOUT) + (size_t)l * 2048 * 2048, WSP(bf16_t, WS_TMP), 2, T, 2048, 2048, D, F.G, F.wg); }
    n = finish_units(F, n);
    pg8::EpiBf16 E; pg8::gemm_phase<pg8::EpiBf16, false>(F.lds, F.tid, utab, n, nullptr, E);
}
PHASE_FN ph_ln1(PHASE_ARGS, int l, bool commit) { PHASE_FRAME; p_ln1_route(F, l, commit); }
GEMM_FN ph_moe(PHASE_ARGS, int l) {
    PHASE_FRAME; const int nn = __builtin_amdgcn_readfirstlane(moe_units(F.lds, F.ws, F.wave, l));
    const int n1 = nn & 255, n2 = nn >> 8;
    unsigned* rbcnt = F.ctl + CW_RBCNT + l * 128 * 16;
    { pg8::EpiGU E{rbcnt}; pg8::gemm_phase<pg8::EpiGU, true>(F.lds, F.tid, (const LAS int*)(F.lds + LDS_UTAB), n1, (const LAS int*)(F.lds + LDS_ROWL), E); }
    { pg8::EpiScatter E{(const LAS int*)(F.lds + LDS_ROWL) + n1 * 256};
      pg8::gemm_phase<pg8::EpiScatter, false, true>(F.lds, F.tid, (const LAS int*)(F.lds + LDS_UTAB) + n1 * pg8::UD, n2, (const LAS int*)(F.lds + LDS_ROWL) + n1 * 256, E, rbcnt); }
}
PHASE_FN ph_ln2(PHASE_ARGS, int l) { PHASE_FRAME; p_ln2(F, l); }
GEMM_FN ph_ple(PHASE_ARGS, int l, float* out_) {
    PHASE_FRAME; LAS int* utab = (LAS int*)(F.lds + LDS_UTAB);
    const bool lastl = (l == NL - 1);
    float* outp = (float*)(GAS float*)rfl64((unsigned long long)out_);
    int n = 0;
    if (F.tid == 0) { int Lb = 0; pg8::build_dense(utab, n, Lb, WSP(bf16_t, WS_X1BF), WSP(bf16_t, WS_WPG) + (size_t)l * 2048 * 2048, nullptr, 4, T, 2048, 2048, D, F.G, F.wg); }
    n = finish_units(F, n);
    pg8::EpiPle E{WSP(bf16_t, WS_X1BF), WSP(bf16_t, WS_PP), WSP(bf16_t, WS_XBF), lastl ? outp : (float*)nullptr};
    pg8::gemm_phase<pg8::EpiPle, false>(F.lds, F.tid, utab, n, nullptr, E);
}

constexpr int NPH = 10;
DI int lz(int l) { asm volatile("" : "+s"(l)); return l; }
typedef __attribute__((address_space(4))) const Params* kparams_t;
DI kparams_t kargs() { unsigned long long a = (unsigned long long)__builtin_amdgcn_kernarg_segment_ptr(); asm volatile("" : "+s"(a)); return (kparams_t)a; }
__global__ void __launch_bounds__(512, 2) mk_fwd(Params P) {
    extern __shared__ __attribute__((aligned(16))) unsigned char lds_raw[];
    const int wave_s = __builtin_amdgcn_readfirstlane((int)(threadIdx.x >> 6));
    {
        LAS unsigned char* lds0 = (LAS unsigned char*)lds_raw;
        if (threadIdx.x < 16) ((LAS unsigned*)(lds0 + LDS_CTL))[threadIdx.x] = 0u;
        if (threadIdx.x == 0) {
#pragma unroll
            for (int i = 0; i < 30; ++i) ((LAS unsigned long long*)(lds0 + LDS_INTAB))[i] = (unsigned long long)P.in[i]; }
        __syncthreads();
#if !MK_PER_PHASE
        (void)xcd_barrier_post((unsigned*)P.ws, (volatile LAS unsigned*)(lds0 + LDS_CTL), threadIdx.x == 0);
#endif
    }
#define KLDS ((LAS unsigned char*)lds_raw)
#define KWS ((GAS unsigned char*)kargs()->ws)
#if MK_PER_PHASE
#define GRID_BAR() do { } while (0)
#else
#define GRID_BAR() do { XcdBarrier bar_; bar_.bar = (unsigned*)kargs()->ws; bar_.x = xb_xcc_id(); bar_.st = (volatile LAS unsigned*)(KLDS + LDS_CTL); xcd_barrier(bar_, my_tid(wave_s) == 0); } while (0)
#endif
#ifndef PH_MASK
#define PH_MASK 0x7ff
#endif
#define IN(k) (kargs()->ph_lo <= (k) && (k) < kargs()->ph_hi)
#define ON(j) (((PH_MASK) >> (j)) & 1)
#ifndef DUP_MASK
#define DUP_MASK 0
#endif
#define REPS(j) ((((DUP_MASK) >> (j)) & 1) ? 2 : 1)
#ifndef TMUL
#define TMUL 8
#endif
#ifndef TBLK
#define TBLK 0
#endif
#define TS_B(j) do { if (TSEL == (j)) t_beg = __builtin_amdgcn_s_memrealtime(); } while (0)
#define TS_E(j) do { if (TSEL == (j)) t_acc += __builtin_amdgcn_s_memrealtime() - t_beg; } while (0)
#define SEAM(k) do { __syncthreads(); if (IN(k) && IN((k) + 1)) { GRID_BAR(); if (REPS(14) == 2) GRID_BAR(); } } while (0)

    unsigned long long t_beg = 0, t_acc = 0;
    TS_B(0);
    if (ON(0) && IN(0)) for (int rep = 0; rep < REPS(0); ++rep) { ph_prologue(KLDS, KWS, wave_s); __syncthreads(); }
    SEAM(0);
    TS_E(0);
    for (int l = 0; l < NL; ++l) {
        const int p0 = 1 + l * NPH;
        TS_B(1);
        if (ON(1) && IN(p0 + 0)) for (int rep = 0; rep < REPS(1); ++rep) { ph_gemm_in(KLDS, KWS, wave_s, lz(l)); __syncthreads(); }
        SEAM(p0 + 0);
        TS_E(1);
        TS_B(2);
        if (ON(2) && IN(p0 + 1)) for (int rep = 0; rep < REPS(2); ++rep) { ph_mla_prep(KLDS, KWS, wave_s, lz(l)); __syncthreads(); }
        SEAM(p0 + 1);
        TS_E(2);
        TS_B(3);
        if (ON(3) && IN(p0 + 2)) for (int rep = 0; rep < REPS(3); ++rep) { TS_B(12); for (int r2 = 0; r2 < REPS(15); ++r2) { ph_gemm_mla(KLDS, KWS, wave_s, lz(l)); __syncthreads(); } TS_E(12); TS_B(13); __syncthreads(); TS_E(13); TS_B(14); for (int r2 = 0; r2 < REPS(17); ++r2) { ph_rwkv1(KLDS, KWS, wave_s, lz(l)); __syncthreads(); } TS_E(14); }
        SEAM(p0 + 2);
        TS_E(3);
        TS_B(4);
        if (ON(4) && IN(p0 + 3)) for (int rep = 0; rep < REPS(4); ++rep) { TS_B(15); if (blockIdx.x < 96) for (int r2 = 0; r2 < REPS(11); ++r2) ph_scan(KLDS, KWS, wave_s, lz(l)); TS_E(15); TS_B(16); for (int r2 = 0; r2 < REPS(12); ++r2) ph_attn_queue(KLDS, KWS, wave_s, lz(l), rep * 2 + r2); __syncthreads(); TS_E(16); }
        SEAM(p0 + 3);
        TS_E(4);
        TS_B(11);
        if (ON(4) && IN(p0 + 4)) for (int rep = 0; rep < REPS(13); ++rep) { TS_B(17); ph_rwkv3(KLDS, KWS, wave_s, lz(l)); TS_E(17); TS_B(18); ph_combine(KLDS, KWS, wave_s); __syncthreads(); TS_E(18); }
        SEAM(p0 + 4);
        TS_E(11);
        TS_B(5);
        if (ON(5) && IN(p0 + 5)) for (int rep = 0; rep < REPS(5); ++rep) { ph_gemm_out(KLDS, KWS, wave_s, lz(l)); __syncthreads(); }
        SEAM(p0 + 5);
        TS_E(5);
        TS_B(6);
        if (ON(6) && IN(p0 + 6)) for (int rep = 0; rep < REPS(6); ++rep) { ph_ln1(KLDS, KWS, wave_s, lz(l), rep == 0); __syncthreads(); }
        SEAM(p0 + 6);
        TS_E(6);
        TS_B(7);
        if (ON(7) && IN(p0 + 7)) for (int rep = 0; rep < REPS(7); ++rep) { ph_moe(KLDS, KWS, wave_s, lz(l)); __syncthreads(); }
        SEAM(p0 + 7);
        TS_E(7);
        TS_B(9);
        if (ON(9) && IN(p0 + 8)) for (int rep = 0; rep < REPS(9); ++rep) { ph_ln2(KLDS, KWS, wave_s, lz(l)); __syncthreads(); }
        SEAM(p0 + 8);
        TS_E(9);
        TS_B(10);
        if (ON(10) && IN(p0 + 9)) for (int rep = 0; rep < REPS(10); ++rep) { ph_ple(KLDS, KWS, wave_s, lz(l), kargs()->out); __syncthreads(); }
        SEAM(p0 + 9);
        TS_E(10);
    }
    if (TSEL >= 0 && blockIdx.x == TBLK) { const unsigned long long t0 = __builtin_amdgcn_s_memrealtime(); const unsigned long long t_all = t_acc + *(LAS unsigned long long*)(KLDS + LDS_CTL + 32); while (__builtin_amdgcn_s_memrealtime() - t0 < (unsigned long long)TMUL * t_all) __builtin_amdgcn_s_sleep(8); }
#undef KLDS
#undef KWS
}

extern "C" void kernel_launch(void* const* d_in, const int* in_sizes, int n_in, void* d_out, int out_size, void* d_ws, size_t ws_size, hipStream_t stream) {
    static int grid = 0;
    if (grid == 0) {
        if (n_in != 30 || ws_size < WS_END) { fprintf(stderr, "kernel_launch: need 30 inputs and %zu bytes of workspace (got %d, %zu)\n", (size_t)WS_END, n_in, ws_size); grid = -1; return; }
        int dev = 0, cus = 0, per_cu = 0;
        if (hipGetDevice(&dev) != hipSuccess || hipDeviceGetAttribute(&cus, hipDeviceAttributeMultiprocessorCount, dev) != hipSuccess) { grid = -1; return; }
        if (hipFuncSetAttribute((const void*)mk_fwd, hipFuncAttributeMaxDynamicSharedMemorySize, LDS_BYTES) != hipSuccess) { fprintf(stderr, "kernel_launch: hipFuncSetAttribute failed\n"); grid = -1; return; }
        if (hipOccupancyMaxActiveBlocksPerMultiprocessor(&per_cu, (const void*)mk_fwd, 512, LDS_BYTES) != hipSuccess || per_cu < 1) { fprintf(stderr, "kernel_launch: occupancy query says %d\n", per_cu); }
        (void)hipGetLastError();
        grid = cus;
    }
    if (grid < 0) return;
    (void)hipMemsetAsync(d_ws, 0, CTL_BYTES, stream);
    Params p{};
    for (int i = 0; i < 30; ++i) p.in[i] = (const float*)d_in[i];
    p.out = (float*)d_out; p.ws = (unsigned char*)d_ws;
    const int nph = 1 + NL * NPH;
#if MK_PER_PHASE
    for (int k = 0; k < nph; ++k) { p.ph_lo = k; p.ph_hi = k + 1; hipLaunchKernelGGL(mk_fwd, dim3(grid), dim3(512), LDS_BYTES, stream, p); }
#else
    p.ph_lo = 0; p.ph_hi = nph;
    hipLaunchKernelGGL(mk_fwd, dim3(grid), dim3(512), LDS_BYTES, stream, p);
#endif
}
```

```cpp
#include <hip/hip_runtime.h>
#include <cstdio>
#include <cstdint>

#ifndef MK_PER_PHASE
#define MK_PER_PHASE 0
#endif

#define DI __device__ __forceinline__
#define LAS __attribute__((address_space(3)))
#define GAS __attribute__((address_space(1)))
typedef unsigned short bf16_t;
typedef short bf16x8 __attribute__((ext_vector_type(8)));
typedef short s16x4 __attribute__((ext_vector_type(4)));
typedef float f32x2 __attribute__((ext_vector_type(2)));
typedef float f32x4 __attribute__((ext_vector_type(4)));
typedef float f32x16 __attribute__((ext_vector_type(16)));
typedef unsigned u32x2 __attribute__((ext_vector_type(2)));
typedef unsigned u32x4 __attribute__((ext_vector_type(4)));
typedef __bf16 hbf2 __attribute__((ext_vector_type(2)));

DI unsigned pack2(float lo, float hi) { return __builtin_bit_cast(unsigned, __builtin_convertvector((f32x2){lo, hi}, hbf2)); }
DI float bf2f(bf16_t b) { return __uint_as_float(((unsigned)b) << 16); }
DI float bflo(unsigned w) { return __uint_as_float(w << 16); }
DI float bfhi(unsigned w) { return __uint_as_float(w & 0xffff0000u); }
DI bf16_t f2bf(float f) { return (bf16_t)(pack2(f, 0.f) & 0xffffu); }
template <int CTRL> DI float dppmov(float v) { return __int_as_float(__builtin_amdgcn_update_dpp(0, __float_as_int(v), CTRL, 0xF, 0xF, true)); }
DI float xhalf_sum(float v) { const auto r = __builtin_amdgcn_permlane32_swap(__float_as_uint(v), __float_as_uint(v), false, false); return __uint_as_float(r[0]) + __uint_as_float(r[1]); }
DI float xhalf_max(float v) { const auto r = __builtin_amdgcn_permlane32_swap(__float_as_uint(v), __float_as_uint(v), false, false); return fmaxf(__uint_as_float(r[0]), __uint_as_float(r[1])); }
DI float xrow_sum(float v) { const auto r = __builtin_amdgcn_permlane16_swap(__float_as_uint(v), __float_as_uint(v), false, false); return __uint_as_float(r[0]) + __uint_as_float(r[1]); }
DI float wave_sum(float v) {
    v += dppmov<0xB1>(v); v += dppmov<0x4E>(v);
    v += dppmov<0x141>(v); v += dppmov<0x140>(v);
    return xhalf_sum(xrow_sum(v)); }
DI float sigmoidf_(float x) { return __builtin_amdgcn_rcpf(1.0f + __expf(-x)); }
DI float tanhf_(float x) { const float e = __expf(2.0f * x); return 1.0f - 2.0f * __builtin_amdgcn_rcpf(e + 1.0f); }
#define MFMA32(a, b, c) __builtin_amdgcn_mfma_f32_32x32x16_bf16((a), (b), (c), 0, 0, 0)

constexpr int T = 8192, SEQ = 4096, D = 2048, NL = 4, PLE = 256;
constexpr int ZLD = 8192;
constexpr int ZC_DQ = 2560, ZC_DK = 4096, ZC_DV = 5632, ZC_QA = 7168, ZC_KVA = 7680, ZC_KR = 7936;
constexpr int NEXP = 32, DEXP = 512, HB_ROWS = 24576;
constexpr float ALPHA = 1.681792830507429f;
constexpr float LOG2E = 1.4426950408889634f;

constexpr size_t CTL_BYTES = 131072;
constexpr size_t WS_WIN = CTL_BYTES;                              constexpr size_t SZ_WIN = (size_t)NL * 8192 * 2048 * 2;
constexpr size_t WS_WOUT = WS_WIN + SZ_WIN;                       constexpr size_t SZ_WOUT = (size_t)NL * 2048 * 2048 * 2;
constexpr size_t WS_WPG = WS_WOUT + SZ_WOUT;                      constexpr size_t SZ_WPG = SZ_WOUT;
constexpr size_t WS_WPP = WS_WPG + SZ_WPG;                        constexpr size_t SZ_WPP = (size_t)NL * 2048 * 256 * 2;
constexpr size_t WS_WGU = WS_WPP + SZ_WPP;                        constexpr size_t SZ_WGU = (size_t)NL * 32 * 1024 * 2048 * 2;
constexpr size_t WS_WDN = WS_WGU + SZ_WGU;                        constexpr size_t SZ_WDN = (size_t)NL * 32 * 2048 * 512 * 2;
constexpr size_t WS_WUQ = WS_WDN + SZ_WDN;                        constexpr size_t SZ_WUQ = (size_t)NL * 1280 * 512 * 2;
constexpr size_t WS_WUKV = WS_WUQ + SZ_WUQ;                       constexpr size_t SZ_WUKV = (size_t)NL * 1536 * 256 * 2;
constexpr size_t WS_ROPE = WS_WUKV + SZ_WUKV;                     constexpr size_t SZ_ROPE = (size_t)4096 * 32 * 8;
constexpr size_t WS_PBF = WS_ROPE + SZ_ROPE;                      constexpr size_t SZ_PBF = (size_t)NL * T * 256 * 2;
constexpr size_t WS_XCUR = WS_PBF + SZ_PBF;                       constexpr size_t SZ_XF = (size_t)T * D * 4;
constexpr size_t WS_XBF = WS_XCUR + SZ_XF;                        constexpr size_t SZ_XB = (size_t)T * D * 2;
constexpr size_t WS_Z = WS_XBF + SZ_XB;                           constexpr size_t SZ_Z = (size_t)T * ZLD * 2;
constexpr size_t SZ_RW1 = (size_t)T * 768 * 4;
constexpr size_t WS_RW = WS_Z + SZ_Z;
constexpr size_t WS_RK = WS_RW + 7 * SZ_RW1;                      constexpr size_t SZ_RK = (size_t)2 * T * 16 * 4;
constexpr size_t WS_QN = WS_RK + SZ_RK;                           constexpr size_t SZ_QN = (size_t)T * 512 * 2;
constexpr size_t WS_KVN = WS_QN + SZ_QN;                          constexpr size_t SZ_KVN = (size_t)T * 256 * 2;
constexpr size_t WS_KROPE = WS_KVN + SZ_KVN;                      constexpr size_t SZ_KROPE = (size_t)T * 64 * 2;
constexpr size_t WS_VTD = WS_KROPE + SZ_KROPE;                    constexpr size_t SZ_VTD = (size_t)2 * 12 * 128 * 4096 * 2;
constexpr size_t WS_QB = WS_VTD + SZ_VTD;                         constexpr size_t SZ_QB = (size_t)T * 1280 * 2;
constexpr size_t WS_KC = WS_QB + SZ_QB;                           constexpr size_t SZ_KC = (size_t)T * 768 * 2;
constexpr size_t WS_VT = WS_KC + SZ_KC;                           constexpr size_t SZ_VT = (size_t)768 * 8192 * 2;
constexpr size_t WS_OP = WS_VT + SZ_VT;                           constexpr size_t SZ_OP = (size_t)3 * T * 512 * 2;
constexpr size_t WS_LSE = WS_OP + SZ_OP;                          constexpr size_t SZ_LSE = (size_t)3 * T * 4 * 4;
constexpr size_t WS_MIX = WS_LSE + SZ_LSE;                        constexpr size_t SZ_MIX = SZ_XB;
constexpr size_t WS_TMP = WS_MIX + SZ_MIX;
constexpr size_t WS_X1 = WS_TMP + SZ_XF;
constexpr size_t WS_X1BF = WS_X1 + SZ_XF;
constexpr size_t WS_PP = WS_X1BF + SZ_XB;
constexpr size_t WS_TOKL = WS_PP + SZ_XB;                         constexpr size_t SZ_TOKL = (size_t)32 * 8192 * 4;
constexpr size_t WS_GATE = WS_TOKL + SZ_TOKL;                     constexpr size_t SZ_GATE = (size_t)T * 2 * 4;
constexpr size_t WS_HB = WS_GATE + SZ_GATE;                       constexpr size_t SZ_HB = (size_t)HB_ROWS * 512 * 2;
constexpr size_t WS_YBT = WS_HB + SZ_HB;                          constexpr size_t SZ_YBT = (size_t)T * 2 * 2048 * 2;
constexpr size_t WS_AC = WS_YBT + SZ_YBT;                         constexpr size_t SZ_CH4 = (size_t)1536 * 64 * 64 * 4;
constexpr size_t WS_GC = WS_AC + SZ_CH4;
constexpr size_t WS_Y0 = WS_GC + SZ_CH4;
constexpr size_t WS_QC = WS_Y0 + SZ_CH4;                          constexpr size_t SZ_CH2 = (size_t)1536 * 64 * 64 * 2;
constexpr size_t WS_SST = WS_QC + SZ_CH2;
constexpr size_t WS_OPM = WS_SST + SZ_CH2;                        constexpr size_t SZ_OPM = (size_t)4 * T * 768 * 2;
constexpr size_t WS_LSEM = WS_OPM + SZ_OPM;                       constexpr size_t SZ_LSEM = (size_t)4 * T * 8 * 4;
constexpr size_t WS_LORA = WS_LSEM + SZ_LSEM;                     constexpr size_t SZ_LORA1 = (size_t)768 * 256 * 2;
constexpr size_t WS_RWT = WS_LORA + NL * SZ_LORA1;                 constexpr size_t SZ_RWT = (size_t)32 * 2048 * 4;
constexpr size_t WS_XL = WS_RWT + SZ_RWT;                         constexpr size_t SZ_XL = (size_t)T * 256 * 2;
constexpr size_t WS_RWG = WS_XL + SZ_XL;                          constexpr size_t SZ_RWG = (size_t)NL * 32 * 2048 * 4;
constexpr size_t WS_RC = WS_RWG + SZ_RWG;                         constexpr size_t SZ_RC = (size_t)NL * 64 * 4;
constexpr size_t WS_END = WS_RC + SZ_RC;
constexpr int CW_QUEUE = 3584;
constexpr int CW_RBCNT = 16384;
constexpr int CW_MOECNT = 4096;

constexpr int LDS_STAGE = 131072;
constexpr int LDS_CTL = 131072;
constexpr int LDS_UTAB = LDS_CTL + 64;
constexpr int LDS_MOE = LDS_UTAB + 1024;
constexpr int LDS_INTAB = LDS_MOE + 1536;
constexpr int LDS_ROWL = 131072 + 4096;
constexpr int LDS_BYTES = 131072 + 4096 + 8192;

#define XB_TMO      128
#define XB_XCNT(j)  (256  + 64 * (j))
#define XB_XSUB(j)  (1280 + 64 * (j))
#define XB_XGEN(j)  (2304 + 64 * (j))
#define XB_TOP      3328
#define XB_TOPGEN   3392
#define XCD_BAR_WORDS 3456
#define XB_SPIN_CAP (1u << 22)

__device__ __forceinline__ unsigned xb_ld(unsigned* p)              { return __hip_atomic_load(p, __ATOMIC_RELAXED, __HIP_MEMORY_SCOPE_AGENT); }
__device__ __forceinline__ unsigned xb_add(unsigned* p, unsigned v) { return __hip_atomic_fetch_add(p, v, __ATOMIC_RELAXED, __HIP_MEMORY_SCOPE_AGENT); }
__device__ __forceinline__ unsigned xb_xcc_id() { return (unsigned)__builtin_amdgcn_s_getreg((3 << 11) | 20) & 0xFu; }
#define XB_SPIN(cond, bar) do { unsigned _sp = 0; while (cond) { __builtin_amdgcn_s_sleep(1); \
    if ((++_sp & 255u) == 0u) { if (xb_ld(&(bar)[XB_TMO])) break; if (_sp > XB_SPIN_CAP) { atomicAdd(&(bar)[XB_TMO], 1u); break; } } } } while (0)

struct XcdBarrier { unsigned* bar; unsigned x; volatile LAS unsigned* st; };

__device__ __forceinline__ XcdBarrier xcd_barrier_post(unsigned* bar, volatile LAS unsigned* st, bool leader) {
    XcdBarrier b; b.bar = bar; b.x = xb_xcc_id(); b.st = st;
    if (leader) (void)xb_add(&bar[XB_XCNT(b.x)], 1u);
    return b;
}
__device__ __forceinline__ void xcd_barrier_complete(unsigned* bar, unsigned x, unsigned& nloc, unsigned& nx) {
    const unsigned G = gridDim.x * gridDim.y * gridDim.z;
    unsigned sum, cnt, mine, sp = 0u;
    for (;;) {
        sum = 0u; cnt = 0u; mine = 0u;
#pragma unroll
        for (unsigned j = 0; j < 16; ++j) { const unsigned c = xb_ld(&bar[XB_XCNT(j)]); sum += c; cnt += (c > 0u) ? 1u : 0u; mine = (j == x) ? c : mine; }
        if (sum == G) break;
        __builtin_amdgcn_s_sleep(1);
        if ((++sp & 255u) == 0u) { if (xb_ld(&bar[XB_TMO])) break; if (sp > XB_SPIN_CAP) { atomicAdd(&bar[XB_TMO], 1u); break; } }
    }
    nloc = mine > 0u ? mine : 1u; nx = cnt > 0u ? cnt : 1u;
}
__device__ __forceinline__ void xcd_barrier(const XcdBarrier& b, bool leader) {
    asm volatile("s_waitcnt vmcnt(0)" ::: "memory");
    __syncthreads();
    if (leader) {
        unsigned* bar = b.bar;
        __builtin_amdgcn_s_waitcnt(0);
        unsigned nloc = b.st[0], nx = b.st[1];
        if (nloc == 0u) { xcd_barrier_complete(bar, b.x, nloc, nx); b.st[0] = nloc; b.st[1] = nx; }
        const unsigned old = xb_add(&bar[XB_XSUB(b.x)], 1u);
        const unsigned gen = old / nloc;
        if (old + 1u == (gen + 1u) * nloc) {
            __builtin_amdgcn_fence(__ATOMIC_RELEASE, "agent");
            asm volatile("s_waitcnt vmcnt(0)" ::: "memory");
            const unsigned og = xb_add(&bar[XB_TOP], 1u);
            const unsigned tg = og / nx;
            if (og + 1u == (tg + 1u) * nx) xb_add(&bar[XB_TOPGEN], 1u);
            else XB_SPIN(xb_ld(&bar[XB_TOPGEN]) == tg, bar);
            __builtin_amdgcn_fence(__ATOMIC_ACQUIRE, "agent");
            xb_add(&bar[XB_XGEN(b.x)], 1u);
            asm volatile("s_waitcnt vmcnt(0)" ::: "memory");
        } else {
            XB_SPIN(xb_ld(&bar[XB_XGEN(b.x)]) == gen, bar);
            __builtin_amdgcn_fence(__ATOMIC_ACQUIRE, "agent");
            asm volatile("s_waitcnt vmcnt(0)" ::: "memory");
        }
    }
    __syncthreads();
}

namespace pg8 {
constexpr int BM = 256, BK = 64, HALF = 128, HTB = HALF * BK * 2, STAGE_BYTES = 8 * HTB, NXCD = 8, WGM = 8;
DI int lds_byte(int r, int c) { const int st = (r >> 4) * 2 + (c >> 5), rr = r & 15, cc = c & 31, ob = rr * 64 + cc * 2; return st * 1024 + (ob ^ (((ob >> 9) & 1) << 5)); }
DI void stage_rc(int b, int& R, int& C) { const int st = b / 1024, sb = b % 1024, swz = sb ^ (((sb >> 9) & 1) << 5); R = (st >> 1) * 16 + swz / 64; C = (st & 1) * 32 + (swz % 64) / 2; }
DI int perm32(int rho) { const int n = rho >> 4, i = rho & 15; return 8 * (i >> 2) + 4 * n + (i & 3); }

struct Unit { GAS const char* a; GAS const char* b; GAS char* out; int K, ldc, row0, col0, aux0, aux1; };
constexpr int UD = 12;
DI void unit_put(LAS int* tab, int i, const void* a, const void* b, void* o, int K, int ldc, int row0, int col0, int aux0, int aux1) {
    LAS int* p = tab + i * UD; const unsigned long long ua = (unsigned long long)a, ub = (unsigned long long)b, uo = (unsigned long long)o;
    p[0] = (int)(unsigned)ua; p[1] = (int)(unsigned)(ua >> 32); p[2] = (int)(unsigned)ub; p[3] = (int)(unsigned)(ub >> 32); p[4] = (int)(unsigned)uo; p[5] = (int)(unsigned)(uo >> 32);
    p[6] = K; p[7] = ldc; p[8] = row0; p[9] = col0; p[10] = aux0; p[11] = aux1;
}
DI void unit_get(const LAS int* tab, int i, Unit& u) {
    const LAS int* p = tab + i * UD; int v[UD];
#pragma unroll
    for (int j = 0; j < UD; ++j) v[j] = __builtin_amdgcn_readfirstlane(p[j]);
    u.a = (GAS const char*)(((unsigned long long)(unsigned)v[1] << 32) | (unsigned)v[0]);
    u.b = (GAS const char*)(((unsigned long long)(unsigned)v[3] << 32) | (unsigned)v[2]);
    u.out = (GAS char*)(((unsigned long long)(unsigned)v[5] << 32) | (unsigned)v[4]);
    u.K = v[6]; u.ldc = v[7]; u.row0 = v[8]; u.col0 = v[9]; u.aux0 = v[10]; u.aux1 = v[11];
}
DI void build_dense(LAS int* tab, int& n, int& Lbase, const void* A, const void* Bt, void* out, int esz, int M, int N, int K, int ldc, int G, int c) {
    const int nM = M / BM, nN = N / BM, nwg = nM * nN;
    int L = c; if (L < Lbase) L += ((Lbase - L + G - 1) / G) * G;
    for (; L < Lbase + nwg; L += G) {
        int wgid = L - Lbase; { const int q = nwg / NXCD, r = nwg % NXCD, xcd = wgid % NXCD, off = wgid / NXCD; wgid = (xcd < r ? xcd * (q + 1) : r * (q + 1) + (xcd - r) * q) + off; }
        const int nig = WGM * nN, gid = wgid / nig, fm = gid * WGM, gsz = (nM - fm) < WGM ? (nM - fm) : WGM;
        const int pm = fm + ((wgid % nig) % gsz), pn = (wgid % nig) / gsz;
        unit_put(tab, n, (const char*)A + (size_t)pm * BM * K * 2, (const char*)Bt + (size_t)pn * BM * K * 2, out, K, ldc, pm * BM, pn * BM, 0, BM); ++n;
    }
    Lbase += nwg;
}

DI void rb_wait(unsigned* rbcnt, int rb, int wid) {
    if (wid == 0) {
        unsigned sp = 0;
        while ((unsigned)__builtin_amdgcn_readfirstlane((int)__hip_atomic_load(rbcnt + rb * 16, __ATOMIC_RELAXED, __HIP_MEMORY_SCOPE_AGENT)) < 32u) { __builtin_amdgcn_s_sleep(2); if (++sp > (1u << 22)) break; }
        __builtin_amdgcn_fence(__ATOMIC_ACQUIRE, "agent");
        asm volatile("s_waitcnt vmcnt(0)" ::: "memory");
    }
    asm volatile("" ::: "memory"); __builtin_amdgcn_s_barrier(); asm volatile("" ::: "memory");
}
template <class Epi, bool GATHER, bool HOOK = false>
DI void gemm_phase(LAS unsigned char* lds, const int tid, const LAS int* utab, const int nunits, const LAS int* rowl, const Epi& E, unsigned* rbcnt = nullptr) {
    const int wid = __builtin_amdgcn_readfirstlane(tid >> 6), lane = tid & 63, wr = wid >> 2, wc = wid & 3, fr = lane & 15, fq = lane >> 4;
    const size_t kstep = (size_t)(BK * 2);
    const unsigned ldsw = (unsigned)wid * 1024u;
    const int aoff = lds_byte(wr * 64 + fr, fq * 8), boff = lds_byte(wc * 32 + fr, fq * 8);
#define PG8_SA(b, h) (((b) * 2 + (h)) * HTB)
#define PG8_SB(b, h) ((4 + (b) * 2 + (h)) * HTB)
#define PG8_STAGE(bufoff, gbase, voff) do { _Pragma("unroll") for (int _i = 0; _i < 2; ++_i) \
        __builtin_amdgcn_global_load_lds((GAS const unsigned*)((gbase) + (voff)[_i]), (LAS unsigned*)(lds + (bufoff) + ldsw + _i * 8192), 16, 0, 0); } while (0)
#define PG8_LDA(dst, b, h) do { _Pragma("unroll") for (int m = 0; m < 4; ++m) _Pragma("unroll") for (int k = 0; k < 2; ++k) dst[m][k] = *(const LAS bf16x8*)(lds + PG8_SA(b, h) + aoff + m * 2048 + k * 1024); } while (0)
#define PG8_LDB(dst, b, h) do { _Pragma("unroll") for (int n = 0; n < 2; ++n) _Pragma("unroll") for (int k = 0; k < 2; ++k) dst[n][k] = *(const LAS bf16x8*)(lds + PG8_SB(b, h) + boff + n * 2048 + k * 1024); } while (0)
#define PG8_MMA(ai, bj, At, Bt) do { __builtin_amdgcn_s_setprio(1); _Pragma("unroll") for (int m = 0; m < 4; ++m) _Pragma("unroll") for (int n = 0; n < 2; ++n) _Pragma("unroll") for (int k = 0; k < 2; ++k) \
        acc[ai][bj][m][n] = __builtin_amdgcn_mfma_f32_16x16x32_bf16(Bt[n][k], At[m][k], acc[ai][bj][m][n], 0, 0, 0); __builtin_amdgcn_s_setprio(0); } while (0)
#define PG8_WAIT_V(n) asm volatile("s_waitcnt vmcnt(" #n ")" ::: "memory")
#define PG8_WAIT_L(n) asm volatile("s_waitcnt lgkmcnt(" #n ")" ::: "memory")
#define PG8_BAR __builtin_amdgcn_s_barrier()
#define PG8_SCHED __builtin_amdgcn_sched_barrier(0)
#define PG8_RC(R_, C_, Rb_, i_) int R_, C_; { int t_ = tid; asm volatile("" : "+v"(t_)); stage_rc(t_ * 16 + (i_) * 8192, R_, C_); } const int Rb_ = Epi::PERM ? ((R_ & ~31) + perm32(R_ & 31)) : R_
#define PG8_VOFF_D(va, vb, K_) do { _Pragma("unroll") for (int _i = 0; _i < 2; ++_i) { PG8_RC(_R, _C, _Rb, _i); va[0][_i] = (unsigned)(_R * (K_) + _C) * 2u; va[1][_i] = va[0][_i]; vb[_i] = (unsigned)(_Rb * (K_) + _C) * 2u; } } while (0)
#define PG8_VOFF_G(va, K_, ui_) do { _Pragma("unroll") for (int _i = 0; _i < 2; ++_i) { PG8_RC(_R, _C, _Rb, _i); (void)_Rb; _Pragma("unroll") for (int _h = 0; _h < 2; ++_h) { \
        const int _r = rowl[(ui_) * BM + _h * HALF + _R]; va[_h][_i] = (unsigned)(_r * (K_) + _C) * 2u; } } } while (0)
    if (nunits <= 0) return;
    Unit cur, nxt; int ui = 0;
    unit_get(utab, 0, cur);
    f32x4 acc[2][2][4][2];
#pragma unroll
    for (int a = 0; a < 2; ++a)
#pragma unroll
        for (int b = 0; b < 2; ++b)
#pragma unroll
            for (int m = 0; m < 4; ++m)
#pragma unroll
                for (int n = 0; n < 2; ++n) acc[a][b][m][n] = (f32x4){0.f, 0.f, 0.f, 0.f};
    bf16x8 At[4][2], B0[2][2], B1[2][2];
    unsigned vc[2][2], vbc[2], vn[2][2];
    if (HOOK) rb_wait(rbcnt, cur.aux1 >> 16, wid);
    PG8_VOFF_D(vc, vbc, cur.K);
    if (GATHER) PG8_VOFF_G(vc, cur.K, 0);
    GAS const char* cA = cur.a; GAS const char* cB = cur.b;
    size_t hsc = (size_t)HALF * cur.K * 2;
    size_t hsa = GATHER ? (size_t)0 : hsc;
    PG8_STAGE(PG8_SB(0, 0), cB, vbc); PG8_STAGE(PG8_SA(0, 0), cA, vc[0]); PG8_STAGE(PG8_SB(0, 1), cB + hsc, vbc); PG8_STAGE(PG8_SA(0, 1), cA + hsa, vc[1]);
    if (wr == 1) PG8_BAR;
    PG8_WAIT_V(4); PG8_BAR;
    PG8_STAGE(PG8_SB(1, 0), cB + kstep, vbc); PG8_STAGE(PG8_SA(1, 0), cA + kstep, vc[0]); PG8_STAGE(PG8_SB(1, 1), cB + hsc + kstep, vbc);
    PG8_WAIT_V(6); PG8_BAR;
    for (;;) {
        const bool has_next = (ui + 1 < nunits);
        if (has_next) { unit_get(utab, ui + 1, nxt); if (GATHER) PG8_VOFF_G(vn, nxt.K, ui + 1); }
        else { nxt = cur;
            if (GATHER) {
#pragma unroll
                for (int i = 0; i < 2; ++i) { vn[0][i] = vc[0][i]; vn[1][i] = vc[1][i]; } } }
        GAS const char* nA = nxt.a; GAS const char* nB = nxt.b;
        const int nt = cur.K / BK;
        for (int t = 0; t < nt; t += 2) {
            const bool last = (t == nt - 2);
            GAS const char* a1 = cA + (size_t)(t + 1) * kstep;
            GAS const char* a2 = last ? nA : cA + (size_t)(t + 2) * kstep; GAS const char* b2 = last ? nB : cB + (size_t)(t + 2) * kstep;
            GAS const char* a3 = a2 + kstep; GAS const char* b3 = b2 + kstep;
            if (HOOK) { if (last && has_next) rb_wait(rbcnt, nxt.aux1 >> 16, wid); }
            PG8_LDB(B0, 0, 0); PG8_SCHED; PG8_LDA(At, 0, 0); PG8_STAGE(PG8_SA(1, 1), a1 + hsa, vc[1]);
            if (last) {
                if (GATHER) {
#pragma unroll
                    for (int i = 0; i < 2; ++i) { vc[0][i] = vn[0][i]; vc[1][i] = vn[1][i]; } }
                if (nxt.K != cur.K) {
                    if (!GATHER) PG8_VOFF_D(vc, vbc, nxt.K);
                    else {
#pragma unroll
                        for (int i = 0; i < 2; ++i) { PG8_RC(R_, C_, Rb_, i); (void)R_; vbc[i] = (unsigned)(Rb_ * nxt.K + C_) * 2u; } }
                    hsc = (size_t)HALF * nxt.K * 2; hsa = GATHER ? (size_t)0 : hsc; } }
            PG8_WAIT_L(8); PG8_BAR; PG8_WAIT_L(0); PG8_MMA(0, 0, At, B0); PG8_BAR; PG8_SCHED;
            PG8_LDB(B1, 0, 1); PG8_STAGE(PG8_SB(0, 0), b2, vbc);
            PG8_BAR; PG8_WAIT_L(0); PG8_MMA(0, 1, At, B1); PG8_BAR;
            PG8_LDA(At, 0, 1); PG8_STAGE(PG8_SA(0, 0), a2, vc[0]);
            PG8_BAR; PG8_WAIT_L(0); PG8_MMA(1, 0, At, B0); PG8_BAR; PG8_SCHED;
            PG8_STAGE(PG8_SB(0, 1), b2 + hsc, vbc);
            PG8_WAIT_V(6); PG8_BAR; PG8_MMA(1, 1, At, B1); PG8_BAR;
            PG8_LDB(B0, 1, 0); PG8_SCHED; PG8_LDA(At, 1, 0); PG8_STAGE(PG8_SA(0, 1), a2 + hsa, vc[1]);
            PG8_WAIT_L(8); PG8_BAR; PG8_WAIT_L(0); PG8_MMA(0, 0, At, B0); PG8_BAR; PG8_SCHED;
            PG8_LDB(B1, 1, 1); PG8_STAGE(PG8_SB(1, 0), b3, vbc);
            PG8_BAR; PG8_WAIT_L(0); PG8_MMA(0, 1, At, B1); PG8_BAR;
            PG8_LDA(At, 1, 1); PG8_STAGE(PG8_SA(1, 0), a3, vc[0]);
            PG8_BAR; PG8_WAIT_L(0); PG8_MMA(1, 0, At, B0); PG8_BAR; PG8_SCHED;
            PG8_STAGE(PG8_SB(1, 1), b3 + hsc, vbc);
            PG8_WAIT_V(6); PG8_BAR; PG8_MMA(1, 1, At, B1); PG8_BAR;
        }
        E(acc, cur, ui, wr, wc, fr, fq);
        E.done(cur, lane);
        if (!has_next) break;
#pragma unroll
        for (int a = 0; a < 2; ++a)
#pragma unroll
            for (int b = 0; b < 2; ++b)
#pragma unroll
                for (int m = 0; m < 4; ++m)
#pragma unroll
                    for (int n = 0; n < 2; ++n) acc[a][b][m][n] = (f32x4){0.f, 0.f, 0.f, 0.f};
        cur = nxt; cA = nA; cB = nB; ++ui;
    }
    PG8_WAIT_V(0);
    if (wr == 0) PG8_BAR;
    PG8_BAR;
#undef PG8_SA
#undef PG8_SB
#undef PG8_STAGE
#undef PG8_LDA
#undef PG8_LDB
#undef PG8_MMA
#undef PG8_WAIT_V
#undef PG8_WAIT_L
#undef PG8_BAR
#undef PG8_SCHED
#undef PG8_VOFF_D
#undef PG8_RC
#undef PG8_VOFF_G
}

struct EpiBf16 {
    static constexpr bool PERM = true;
    DI void done(const Unit&, int) const {}
    DI void operator()(const f32x4 (&acc)[2][2][4][2], const Unit& u, int, int wr, int wc, int fr, int fq) const {
        const int row0 = u.row0 + wr * 64 + fr, col0 = u.col0 + wc * 32 + 8 * fq; GAS bf16_t* O = (GAS bf16_t*)u.out; const int ldc = u.ldc;
#pragma unroll
        for (int ai = 0; ai < 2; ++ai)
#pragma unroll
            for (int m = 0; m < 4; ++m) { GAS bf16_t* rowp = O + (size_t)(row0 + ai * HALF + m * 16) * ldc + col0;
#pragma unroll
                for (int bj = 0; bj < 2; ++bj) { const f32x4 v0 = acc[ai][bj][m][0], v1 = acc[ai][bj][m][1];
                    u32x4 w; w.x = pack2(v0[0], v0[1]); w.y = pack2(v0[2], v0[3]); w.z = pack2(v1[0], v1[1]); w.w = pack2(v1[2], v1[3]);
                    *(GAS u32x4*)(rowp + bj * HALF) = w; } }
    }
};
struct EpiF32 {
    static constexpr bool PERM = false;
    DI void done(const Unit&, int) const {}
    DI void operator()(const f32x4 (&acc)[2][2][4][2], const Unit& u, int, int wr, int wc, int fr, int fq) const {
        const int row0 = u.row0 + wr * 64 + fr, col0 = u.col0 + wc * 32 + 4 * fq; GAS float* C = (GAS float*)u.out; const int ldc = u.ldc;
#pragma unroll
        for (int ai = 0; ai < 2; ++ai)
#pragma unroll
            for (int m = 0; m < 4; ++m) { GAS float* rowp = C + (size_t)(row0 + ai * HALF + m * 16) * ldc + col0;
#pragma unroll
                for (int bj = 0; bj < 2; ++bj)
#pragma unroll
                    for (int n = 0; n < 2; ++n) *(GAS f32x4*)(rowp + bj * HALF + n * 16) = acc[ai][bj][m][n]; }
    }
};
struct EpiGU {
    static constexpr bool PERM = true;
    unsigned* rbcnt;
    DI void operator()(const f32x4 (&acc)[2][2][4][2], const Unit& u, int, int wr, int wc, int fr, int fq) const {
        const int row0 = u.row0 + wr * 64 + fr, col0 = (u.col0 >> 1) + wc * 32 + 8 * fq; GAS bf16_t* H = (GAS bf16_t*)u.out;
#pragma unroll
        for (int ai = 0; ai < 2; ++ai)
#pragma unroll
            for (int m = 0; m < 4; ++m) { GAS bf16_t* rowp = H + (size_t)(row0 + ai * HALF + m * 16) * DEXP + col0;
                float o[8];
#pragma unroll
                for (int n = 0; n < 2; ++n)
#pragma unroll
                    for (int j = 0; j < 4; ++j) { const float g = acc[ai][0][m][n][j], up = acc[ai][1][m][n][j]; o[n * 4 + j] = g / (1.0f + __expf(-g)) * up; }
                const unsigned long long lo = ((unsigned long long)pack2(o[2], o[3]) << 32) | pack2(o[0], o[1]), hi = ((unsigned long long)pack2(o[6], o[7]) << 32) | pack2(o[4], o[5]);
                __hip_atomic_store((GAS unsigned long long*)rowp, lo, __ATOMIC_RELAXED, __HIP_MEMORY_SCOPE_AGENT);
                __hip_atomic_store((GAS unsigned long long*)rowp + 1, hi, __ATOMIC_RELAXED, __HIP_MEMORY_SCOPE_AGENT); }
    }
    DI void done(const Unit& u, int lane) const {
        asm volatile("s_waitcnt vmcnt(0)" ::: "memory");
        if (lane == 0) __hip_atomic_fetch_add(rbcnt + (u.aux1 >> 16) * 16, 1u, __ATOMIC_RELAXED, __HIP_MEMORY_SCOPE_AGENT);
    }
};
struct EpiScatter {
    static constexpr bool PERM = true;
    DI void done(const Unit&, int) const {}
    const LAS int* rowl;
    DI void operator()(const f32x4 (&acc)[2][2][4][2], const Unit& u, int ui, int wr, int wc, int fr, int fq) const {
        const int col0 = u.col0 + wc * 32 + 8 * fq; GAS bf16_t* Y = (GAS bf16_t*)u.out;
#pragma unroll
        for (int ai = 0; ai < 2; ++ai)
#pragma unroll
            for (int m = 0; m < 4; ++m) { const int t2 = rowl[ui * BM + ai * HALF + wr * 64 + m * 16 + fr];
                if (t2 >= 0) { GAS bf16_t* rowp = Y + (size_t)t2 * D + col0;
#pragma unroll
                    for (int bj = 0; bj < 2; ++bj) { const f32x4 v0 = acc[ai][bj][m][0], v1 = acc[ai][bj][m][1];
                        u32x4 w; w.x = pack2(v0[0], v0[1]); w.y = pack2(v0[2], v0[3]); w.z = pack2(v1[0], v1[1]); w.w = pack2(v1[2], v1[3]);
                        *(GAS u32x4*)(rowp + bj * HALF) = w; } }
                asm volatile("" ::: "memory"); }
    }
};
struct EpiPle {
    static constexpr bool PERM = true;
    DI void done(const Unit&, int) const {}
    const bf16_t* x2; const bf16_t* pp; bf16_t* xb; float* outf;
    DI void operator()(const f32x4 (&acc)[2][2][4][2], const Unit& u, int, int wr, int wc, int fr, int fq) const {
        const int row0 = u.row0 + wr * 64 + fr, col0 = u.col0 + wc * 32 + 8 * fq;
#pragma unroll
        for (int ai = 0; ai < 2; ++ai)
#pragma unroll
            for (int m = 0; m < 4; ++m) { const size_t ro = (size_t)(row0 + ai * HALF + m * 16) * D + col0;
#pragma unroll
                for (int bj = 0; bj < 2; ++bj) { const size_t o = ro + bj * HALF;
                    const u32x4 xw = *(const u32x4*)(x2 + o); const u32x4 pw = *(const u32x4*)(pp + o);
                    const unsigned xa[4] = {xw.x, xw.y, xw.z, xw.w}, pa[4] = {pw.x, pw.y, pw.z, pw.w};
                    float r[8];
#pragma unroll
                    for (int n = 0; n < 2; ++n)
#pragma unroll
                        for (int j2 = 0; j2 < 2; ++j2) { const f32x4 a = acc[ai][bj][m][n]; const int w = 2 * n + j2;
                            r[4 * n + 2 * j2] = bflo(xa[w]) + bflo(pa[w]) * __builtin_amdgcn_rcpf(1.0f + __expf(-a[2 * j2]));
                            r[4 * n + 2 * j2 + 1] = bfhi(xa[w]) + bfhi(pa[w]) * __builtin_amdgcn_rcpf(1.0f + __expf(-a[2 * j2 + 1])); }
                    if (outf) { *(f32x4*)(outf + o) = (f32x4){r[0], r[1], r[2], r[3]}; *(f32x4*)(outf + o + 4) = (f32x4){r[4], r[5], r[6], r[7]}; }
                    else *(u32x4*)(xb + o) = (u32x4){pack2(r[0], r[1]), pack2(r[2], r[3]), pack2(r[4], r[5]), pack2(r[6], r[7])}; }
                if (m & 1) asm volatile("" ::: "memory"); }
    }
};
}

struct Params { const float* in[30]; float* out; unsigned char* ws; int ph_lo, ph_hi; };
struct Frame {
    LAS unsigned char* lds; int tid, lane, wave, G, wg;
    GAS unsigned char* ws; unsigned* ctl;
};
#define WSP(T_, off) ((T_*)(GAS T_*)(F.ws + (off)))
#define INP(i_) ((const float*)(GAS const float*)rfl64(((const LAS unsigned long long*)(F.lds + LDS_INTAB))[i_]))
DI unsigned long long rfl64(unsigned long long v) {
    return ((unsigned long long)(unsigned)__builtin_amdgcn_readfirstlane((int)(unsigned)(v >> 32)) << 32) | (unsigned)__builtin_amdgcn_readfirstlane((int)(unsigned)v);
}
DI int my_tid(int wave) { return (wave << 6) | (int)__builtin_amdgcn_mbcnt_hi(~0u, __builtin_amdgcn_mbcnt_lo(~0u, 0u)); }
DI Frame make_frame(LAS unsigned char* lds, GAS unsigned char* ws, int wave) {
    Frame F;
    int wv = __builtin_amdgcn_readfirstlane(wave); asm volatile("" : "+s"(wv));
    int tid = my_tid(wv); asm volatile("" : "+v"(tid));
    unsigned l32 = (unsigned)__builtin_amdgcn_readfirstlane((int)(unsigned)(size_t)lds); asm volatile("" : "+s"(l32));
    unsigned long long w64 = rfl64((unsigned long long)ws); asm volatile("" : "+s"(w64));
    F.lds = (LAS unsigned char*)l32; F.tid = tid; F.lane = tid & 63; F.wave = wv;
    F.G = gridDim.x; F.wg = blockIdx.x;
    F.ws = (GAS unsigned char*)w64;
    F.ctl = (unsigned*)(GAS unsigned*)F.ws;
    return F;
}
#ifndef TSEL
#define TSEL -1
#endif
#define TSL_B(j) unsigned long long tsl_b_##j = 0; if (TSEL == (j)) tsl_b_##j = __builtin_amdgcn_s_memrealtime()
#define TSL_E(j) do { if (TSEL == (j) && F.tid == 0) *(LAS unsigned long long*)(F.lds + LDS_CTL + 32) += __builtin_amdgcn_s_memrealtime() - tsl_b_##j; } while (0)
#define PHASE_FN __device__ __forceinline__ void
#define GEMM_FN __device__ __forceinline__ void
#define PHASE_ARGS LAS unsigned char* lds_, GAS unsigned char* ws_, int wave_
#define PHASE_FRAME const Frame F = make_frame(lds_, ws_, wave_)

template <int MODE> DI int rowmap(int n, int which) {
    if (MODE == 0) return n;
    if (MODE == 1) return (n >> 7) * 256 + which * 128 + (n & 127);
    const int h = n >> 8, c = n & 255; return c < 128 ? h * 128 + c : 768 + h * 128 + (c - 128);
}
template <int MODE>
DI void convert_t(const Frame F, const float* src, int K, int N, bf16_t* dst, int which, int nmat, size_t src_ms, size_t dst_ms, int t_begin = -1, int t_end = 0, int t_step = 0) {
    LAS float* tile = (LAS float*)F.lds;
    const int nkt = K / 64, nnt = (N + 255) / 256, per = nkt * nnt, total = per * nmat;
    const int tid = F.tid;
    f32x4 reg[8];
    int ti = F.wg, tstep = F.G, tend = total;
    if (t_begin >= 0) { ti = t_begin; tstep = t_step; tend = t_end; }
#define CONV_ISSUE(t_) do { const int t__ = (t_); const int mat_ = t__ / per, rem_ = t__ - mat_ * per, kt_ = rem_ / nnt, ntl_ = rem_ - kt_ * nnt; \
        const float* s_ = src + (size_t)mat_ * src_ms + (size_t)(kt_ * 64) * N + ntl_ * 256; const int n4_ = tid & 63, n_ = ntl_ * 256 + n4_ * 4; \
        _Pragma("unroll") for (int i_ = 0; i_ < 8; ++i_) { const int kr_ = (tid >> 6) + 8 * i_; reg[i_] = (n_ < N) ? *(const f32x4*)(s_ + (size_t)kr_ * N + n4_ * 4) : (f32x4){0.f, 0.f, 0.f, 0.f}; } } while (0)
    if (ti < tend) CONV_ISSUE(ti);
    for (; ti < tend; ti += tstep) {
#pragma unroll
        for (int i = 0; i < 8; ++i) { const int kr = (tid >> 6) + 8 * i; *(LAS f32x4*)(tile + kr * 260 + (((tid & 63) * 4 + 8 * (kr >> 3)) & 255)) = reg[i]; }
        __syncthreads();
        const int mat = ti / per, rem = ti - mat * per, kt = rem / nnt, nt_ = rem - kt * nnt;
        if (ti + tstep < tend) CONV_ISSUE(ti + tstep);
        bf16_t* d = dst + (size_t)mat * dst_ms + kt * 64;
#pragma unroll
        for (int i = 0; i < 4; ++i) {
            const int nl = (tid >> 3) + 64 * i, kg = tid & 7, n = nt_ * 256 + nl;
            if (n < N) {
                float v[8];
#pragma unroll
                for (int j = 0; j < 8; ++j) v[j] = tile[(kg * 8 + j) * 260 + ((nl + 8 * kg) & 255)];
                u32x4 w; w.x = pack2(v[0], v[1]); w.y = pack2(v[2], v[3]); w.z = pack2(v[4], v[5]); w.w = pack2(v[6], v[7]);
                *(u32x4*)(d + (size_t)rowmap<MODE>(n, which) * K + kg * 8) = w;
            }
        }
        __syncthreads();
    }
}
template <int MODE>
DI void convert_dma(const Frame F, const float* src, int K, int N, bf16_t* dst, int which, size_t src_ms, size_t dst_ms, int t0, int nt) {
    const int nkt = K / 64, nnt = (N + 255) / 256, per = nkt * nnt;
    const int lane = F.lane, wave = F.wave, rr = lane >> 3, sl = lane & 7, nsub = lane >> 3, kg = lane & 7;
    LAS unsigned char* slot = F.lds + wave * 8192;
#define CD_ISSUE(t_, b_) do { const int t__ = (t_); const int mat_ = t__ / per, rem_ = t__ - mat_ * per, kt_ = rem_ / nnt, ntl_ = rem_ - kt_ * nnt; \
        const int cb_ = (ntl_ * 256 + wave * 32 < N) ? ntl_ * 256 + wave * 32 : 0; \
        const float* s_ = src + (size_t)mat_ * src_ms + (size_t)(kt_ * 64 + rr) * N + cb_; \
        _Pragma("unroll") for (int i_ = 0; i_ < 8; ++i_) __builtin_amdgcn_global_load_lds((GAS const unsigned*)(s_ + (size_t)(i_ * 8) * N + 4 * ((sl - i_) & 7)), (LAS unsigned*)(slot + (b_) * 65536 + i_ * 1024), 16, 0, 0); } while (0)
    CD_ISSUE(t0, 0);
    if (nt > 1) CD_ISSUE(t0 + 1, 1);
#pragma unroll 1
    for (int i = 0; i < nt; ++i) {
        const int b = i & 1, tc = t0 + i;
        if (i + 1 < nt) asm volatile("s_waitcnt vmcnt(8)" ::: "memory"); else asm volatile("s_waitcnt vmcnt(0)" ::: "memory");
        const int mat = tc / per, rem = tc - mat * per, kt = rem / nnt, ntl = rem - kt * nnt;
        bf16_t* d = dst + (size_t)mat * dst_ms + kt * 64 + kg * 8;
        const LAS float* blk = (const LAS float*)(slot + b * 65536 + kg * 1024);
        float v[4][8];
#pragma unroll
        for (int p = 0; p < 4; ++p)
#pragma unroll
            for (int j = 0; j < 8; ++j) v[p][j] = blk[j * 32 + ((p * 8 + nsub + 4 * kg) & 31)];
        asm volatile("s_waitcnt lgkmcnt(0)" ::: "memory");
        if (ntl * 256 + wave * 32 < N) {
#pragma unroll
            for (int p = 0; p < 4; ++p) {
                u32x4 w; w.x = pack2(v[p][0], v[p][1]); w.y = pack2(v[p][2], v[p][3]); w.z = pack2(v[p][4], v[p][5]); w.w = pack2(v[p][6], v[p][7]);
                *(u32x4*)(d + (size_t)rowmap<MODE>(ntl * 256 + wave * 32 + p * 8 + nsub, which) * K) = w;
            }
        }
        if (i + 2 < nt) CD_ISSUE(tc + 2, b);
    }
#undef CD_ISSUE
}
DI void zero_rows(const Frame F, bf16_t* dst, size_t nelem) {
    for (size_t i = ((size_t)F.wg * 512 + F.tid) * 8; i < nelem; i += (size_t)F.G * 512 * 8) *(u32x4*)(dst + i) = (u32x4){0u, 0u, 0u, 0u};
}
DI void cvt_plain(const Frame F, const float* src, bf16_t* dst, size_t nelem) {
    for (size_t i = ((size_t)F.wg * 512 + F.tid) * 4; i < nelem; i += (size_t)F.G * 512 * 4) {
        const f32x4 v = *(const f32x4*)(src + i); u32x2 w; w.x = pack2(v[0], v[1]); w.y = pack2(v[2], v[3]); *(u32x2*)(dst + i) = w; }
}
DI void p_prologue(const Frame F) {
    convert_t<0>(F, INP(2), 2048, 8000, WSP(bf16_t, WS_WIN), 0, 1, (size_t)2048 * 8000, (size_t)8192 * 2048);
    for (int l = 0; l < NL; ++l) zero_rows(F, WSP(bf16_t, WS_WIN) + (size_t)l * 8192 * 2048 + (size_t)8000 * 2048, (size_t)192 * 2048);
    convert_t<0>(F, INP(28), 256, 2048, WSP(bf16_t, WS_WPP), 0, NL, (size_t)256 * 2048, (size_t)2048 * 256);
    convert_t<0>(F, INP(15), 512, 1152, WSP(bf16_t, WS_WUQ), 0, NL, (size_t)512 * 1152, (size_t)1280 * 512);
    for (int l = 0; l < NL; ++l) zero_rows(F, WSP(bf16_t, WS_WUQ) + (size_t)l * 1280 * 512 + (size_t)1152 * 512, (size_t)128 * 512);
    convert_t<2>(F, INP(17), 256, 1536, WSP(bf16_t, WS_WUKV), 0, NL, (size_t)256 * 1536, (size_t)1536 * 256);
    convert_t<0>(F, INP(5), 64, 768, WSP(bf16_t, WS_LORA), 0, NL, (size_t)64 * 768, (size_t)768 * 256);
    convert_t<0>(F, INP(7), 64, 768, WSP(bf16_t, WS_LORA) + (size_t)768 * 64, 0, NL, (size_t)64 * 768, (size_t)768 * 256);
    convert_t<0>(F, INP(8), 128, 768, WSP(bf16_t, WS_LORA) + (size_t)768 * 128, 0, NL, (size_t)128 * 768, (size_t)768 * 256);
    cvt_plain(F, INP(0), WSP(bf16_t, WS_XBF), (size_t)T * D);
    cvt_plain(F, INP(1), WSP(bf16_t, WS_PBF), (size_t)NL * T * PLE);
    for (int i = F.wg * 512 + F.tid; i < 32 * 2048; i += F.G * 512) { const int e = i >> 11, k = i & 2047; WSP(float, WS_RWT)[i] = INP(21)[(size_t)k * 32 + e]; }
    for (int i = F.wg * 512 + F.tid; i < NL * 32 * 2048; i += F.G * 512) { const int j4 = i & 3, ln = (i >> 2) & 63, k4 = (i >> 8) & 7, q = (i >> 11) & 3, w = (i >> 13) & 7, l = i >> 16;
        const int e = ln & 31, k = 256 * w + 64 * q + 32 * (ln >> 5) + 4 * k4 + j4; WSP(float, WS_RWG)[i] = INP(19)[(size_t)l * D + k] * INP(21)[(size_t)k * 32 + e]; }
    for (int p = F.wg * 8 + F.wave; p < NL * 32; p += F.G * 8) { const int l = p >> 5, e = p & 31; float s1 = 0.f, s2 = 0.f;
        for (int k = F.lane; k < 2048; k += 64) { const float w = INP(21)[(size_t)k * 32 + e]; s1 += INP(19)[(size_t)l * D + k] * w; s2 += INP(20)[(size_t)l * D + k] * w; }
        s1 = wave_sum(s1); s2 = wave_sum(s2); if (F.lane == 0) { WSP(float, WS_RC)[l * 64 + e] = s1; WSP(float, WS_RC)[l * 64 + 32 + e] = s2; } }
    for (int i = F.wg * 512 + F.tid; i < 4096 * 32; i += F.G * 512) {
        const int pos = i >> 5, k = i & 31; const double ang = (double)pos * pow(10000.0, -(double)k / 32.0);
        WSP(f32x2, WS_ROPE)[i] = (f32x2){(float)cos(ang), (float)sin(ang)}; }
}

DI void p_rwkv_prep(const Frame F, int l) {
    const bf16_t* z = WSP(bf16_t, WS_Z);
    const float* mu = INP(3) + (size_t)l * 2560; const float* w0 = INP(4) + (size_t)l * 768; const float* a0 = INP(6) + (size_t)l * 768;
    const float* k_k = INP(9) + (size_t)l * 768; const float* k_a = INP(10) + (size_t)l * 768; const float* r_k = INP(11) + (size_t)l * 768;
    const bf16_t* wT = WSP(bf16_t, WS_LORA) + (size_t)l * 768 * 256; const bf16_t* aT = wT + 768 * 64; const bf16_t* gT = wT + 768 * 128;
    float* R = WSP(float, WS_RW); float* LWo = R + (size_t)T * 768; float* K2 = LWo + (size_t)T * 768; float* V = K2 + (size_t)T * 768;
    float* AA = V + (size_t)T * 768; float* BB = AA + (size_t)T * 768; float* GG = BB + (size_t)T * 768; float* RK = WSP(float, WS_RK);
    LAS bf16_t* X = (LAS bf16_t*)F.lds;
    LAS f32x2* part = (LAS f32x2*)(F.lds + 32 * 264 * 2);
    const int tid = F.tid, lane = F.lane, wave = F.wave, c = lane & 31, hh = lane >> 5;
    for (int tile = F.wg; tile < T / 32; tile += F.G) {
        const int t0 = tile * 32;
        __syncthreads();
        {
            const int tk = tid >> 4, cg = tid & 15, t = t0 + tk, c0 = 2304 + 16 * cg;
            const bool first = (t & (SEQ - 1)) == 0;
            unsigned ow[8];
#pragma unroll
            for (int hf = 0; hf < 2; ++hf) {
                const u32x4 za = *(const u32x4*)(z + (size_t)t * ZLD + c0 + 8 * hf);
                const u32x4 zp = first ? (u32x4){0u, 0u, 0u, 0u} : *(const u32x4*)(z + (size_t)(t - 1) * ZLD + c0 + 8 * hf);
                const f32x4 m0 = *(const f32x4*)(mu + c0 + 8 * hf), m1 = *(const f32x4*)(mu + c0 + 8 * hf + 4);
                const unsigned aw[4] = {za.x, za.y, za.z, za.w}, pw[4] = {zp.x, zp.y, zp.z, zp.w}; const float mm[8] = {m0[0], m0[1], m0[2], m0[3], m1[0], m1[1], m1[2], m1[3]};
                float v[8];
#pragma unroll
                for (int j = 0; j < 4; ++j) { const float a_lo = bflo(aw[j]), a_hi = bfhi(aw[j]); v[2 * j] = a_lo + (bflo(pw[j]) - a_lo) * mm[2 * j]; v[2 * j + 1] = a_hi + (bfhi(pw[j]) - a_hi) * mm[2 * j + 1]; }
#pragma unroll
                for (int j = 0; j < 8; ++j) v[j] = (cg < 4) ? tanhf(v[j]) : ((cg < 8) ? v[j] : sigmoidf_(v[j]));
#pragma unroll
                for (int j = 0; j < 4; ++j) ow[4 * hf + j] = pack2(v[2 * j], v[2 * j + 1]);
            }
            *(LAS u32x4*)(X + tk * 264 + 16 * cg) = (u32x4){ow[0], ow[1], ow[2], ow[3]};
            *(LAS u32x4*)(X + tk * 264 + 16 * cg + 8) = (u32x4){ow[4], ow[5], ow[6], ow[7]};
        }
        __syncthreads();
        const int t = t0 + c; const bool first = (t & (SEQ - 1)) == 0;
        const size_t zt = (size_t)t * ZLD, zq = (size_t)(first ? t : t - 1) * ZLD;
#pragma unroll 1
        for (int i = 0; i < 3; ++i) {
            const int g = 3 * wave + i, cb = 32 * g;
            f32x16 accw, acca, accg;
#pragma unroll
            for (int j = 0; j < 16; ++j) { accw[j] = 0.f; acca[j] = 0.f; accg[j] = 0.f; }
#pragma unroll
            for (int ks = 0; ks < 4; ++ks) {
                accw = MFMA32(*(const bf16x8*)(wT + (size_t)(cb + c) * 64 + 16 * ks + 8 * hh), *(const LAS bf16x8*)(X + c * 264 + 16 * ks + 8 * hh), accw);
                acca = MFMA32(*(const bf16x8*)(aT + (size_t)(cb + c) * 64 + 16 * ks + 8 * hh), *(const LAS bf16x8*)(X + c * 264 + 64 + 16 * ks + 8 * hh), acca); }
#pragma unroll
            for (int ks = 0; ks < 8; ++ks)
                accg = MFMA32(*(const bf16x8*)(gT + (size_t)(cb + c) * 128 + 16 * ks + 8 * hh), *(const LAS bf16x8*)(X + c * 264 + 128 + 16 * ks + 8 * hh), accg);
            float ss = 0.f, rs = 0.f;
#pragma unroll
            for (int rg = 0; rg < 4; ++rg) {
                const int ch0 = cb + 8 * rg + 4 * hh;
                const f32x4 w0v = *(const f32x4*)(w0 + ch0), a0v = *(const f32x4*)(a0 + ch0), kkc = *(const f32x4*)(k_k + ch0), kac = *(const f32x4*)(k_a + ch0), rkc = *(const f32x4*)(r_k + ch0);
                const f32x4 mur = *(const f32x4*)(mu + ch0), muk = *(const f32x4*)(mu + 768 + ch0), muv = *(const f32x4*)(mu + 1536 + ch0);
                const u32x2 r_t = *(const u32x2*)(z + zt + ch0), r_p = *(const u32x2*)(z + zq + ch0), k_t = *(const u32x2*)(z + zt + 768 + ch0), k_p = *(const u32x2*)(z + zq + 768 + ch0), v_t = *(const u32x2*)(z + zt + 1536 + ch0), v_p = *(const u32x2*)(z + zq + 1536 + ch0);
                const float rt4[4] = {bflo(r_t.x), bfhi(r_t.x), bflo(r_t.y), bfhi(r_t.y)}, rp4[4] = {bflo(r_p.x), bfhi(r_p.x), bflo(r_p.y), bfhi(r_p.y)};
                const float kt4[4] = {bflo(k_t.x), bfhi(k_t.x), bflo(k_t.y), bfhi(k_t.y)}, kp4[4] = {bflo(k_p.x), bfhi(k_p.x), bflo(k_p.y), bfhi(k_p.y)};
                const float vt4[4] = {bflo(v_t.x), bfhi(v_t.x), bflo(v_t.y), bfhi(v_t.y)}, vp4[4] = {bflo(v_p.x), bfhi(v_p.x), bflo(v_p.y), bfhi(v_p.y)};
                f32x4 oR, oL, oK, oV, oG, oA, oB;
#pragma unroll
                for (int e = 0; e < 4; ++e) {
                    const int rr = 4 * rg + e;
                    const float zr = rt4[e] + ((first ? 0.f : rp4[e]) - rt4[e]) * mur[e], zk = kt4[e] + ((first ? 0.f : kp4[e]) - kt4[e]) * muk[e], zv = vt4[e] + ((first ? 0.f : vp4[e]) - vt4[e]) * muv[e];
                    const float xw = -(w0v[e] + accw[rr]);
                    const float sp = (xw > 15.f) ? xw : log1pf(__expf(xw));
                    const float lw = -__expf(-sp - 0.5f);
                    const float a = sigmoidf_(a0v[e] + acca[rr]);
                    const float kk1 = zk * kkc[e];
                    const float k2 = zk * (1.0f + (a - 1.0f) * kac[e]);
                    ss += kk1 * kk1; rs += zr * k2 * rkc[e];
                    oR[e] = zr; oL[e] = lw; oK[e] = k2; oV[e] = zv; oG[e] = accg[rr]; oA[e] = -kk1; oB[e] = kk1 * a;
                }
                const size_t o = (size_t)t * 768 + ch0;
                *(f32x4*)(R + o) = oR; *(f32x4*)(LWo + o) = oL; *(f32x4*)(K2 + o) = oK; *(f32x4*)(V + o) = oV; *(f32x4*)(GG + o) = oG; *(f32x4*)(AA + o) = oA; *(f32x4*)(BB + o) = oB;
                asm volatile("" ::: "memory");
            }
            ss = xhalf_sum(ss); rs = xhalf_sum(rs);
            if (hh == 0) part[g * 32 + c] = (f32x2){ss, rs};
        }
        __syncthreads();
        if (tid < 384) { const int tk = tid & 31, h = tid >> 5; const f32x2 p0 = part[(2 * h) * 32 + tk], p1 = part[(2 * h + 1) * 32 + tk];
            RK[(size_t)(t0 + tk) * 16 + h] = p0.y + p1.y; RK[(size_t)T * 16 + (size_t)(t0 + tk) * 16 + h] = 1.0f / fmaxf(sqrtf(p0.x + p1.x), 1e-12f); }
    }
}

DI void p_mla_prep(const Frame F, int l) {
    const bf16_t* z = WSP(bf16_t, WS_Z);
    const float* qa_g = INP(14) + (size_t)l * 512; const float* kva_g = INP(16) + (size_t)l * 256;
    bf16_t* qn = WSP(bf16_t, WS_QN); bf16_t* kvn = WSP(bf16_t, WS_KVN); bf16_t* kr = WSP(bf16_t, WS_KROPE);
    const f32x2* rope = WSP(f32x2, WS_ROPE);
    const float* mu = INP(3) + (size_t)l * 2560; bf16_t* xl = WSP(bf16_t, WS_XL);
    const int lane = F.lane;
#pragma unroll 2
    for (int t = F.wg * 8 + F.wave; t < T; t += F.G * 8) {
        const bf16_t* zr = z + (size_t)t * ZLD;
        {
            const bool first = (t & (SEQ - 1)) == 0;
            const u32x2 za = *(const u32x2*)(zr + 2304 + 4 * lane); const u32x2 zp = first ? (u32x2){0u, 0u} : *(const u32x2*)(zr - ZLD + 2304 + 4 * lane);
            const f32x4 m4 = *(const f32x4*)(mu + 2304 + 4 * lane);
            float v[4] = {bflo(za.x), bfhi(za.x), bflo(za.y), bfhi(za.y)}; const float p[4] = {bflo(zp.x), bfhi(zp.x), bflo(zp.y), bfhi(zp.y)};
#pragma unroll
            for (int q = 0; q < 4; ++q) { v[q] = v[q] + (p[q] - v[q]) * m4[q]; v[q] = (lane < 16) ? tanhf_(v[q]) : ((lane < 32) ? v[q] : sigmoidf_(v[q])); }
            u32x2 o; o.x = pack2(v[0], v[1]); o.y = pack2(v[2], v[3]); *(u32x2*)(xl + (size_t)t * 256 + 4 * lane) = o; }
        { const u32x4 w = *(const u32x4*)(zr + ZC_QA + lane * 8); float v[8] = {bflo(w.x), bfhi(w.x), bflo(w.y), bfhi(w.y), bflo(w.z), bfhi(w.z), bflo(w.w), bfhi(w.w)};
          float ss = 0.f;
#pragma unroll
          for (int j = 0; j < 8; ++j) ss += v[j] * v[j];
          ss = wave_sum(ss); const float rs = rsqrtf(ss * (1.0f / 512.0f) + 1e-6f);
          const f32x4 g0 = *(const f32x4*)(qa_g + lane * 8), g1 = *(const f32x4*)(qa_g + lane * 8 + 4);
          u32x4 o; o.x = pack2(v[0] * rs * g0[0], v[1] * rs * g0[1]); o.y = pack2(v[2] * rs * g0[2], v[3] * rs * g0[3]); o.z = pack2(v[4] * rs * g1[0], v[5] * rs * g1[1]); o.w = pack2(v[6] * rs * g1[2], v[7] * rs * g1[3]);
          *(u32x4*)(qn + (size_t)t * 512 + lane * 8) = o; }
        { const u32x2 w = *(const u32x2*)(zr + ZC_KVA + lane * 4); float v[4] = {bflo(w.x), bfhi(w.x), bflo(w.y), bfhi(w.y)};
          float ss = v[0] * v[0] + v[1] * v[1] + v[2] * v[2] + v[3] * v[3];
          ss = wave_sum(ss); const float rs = rsqrtf(ss * (1.0f / 256.0f) + 1e-6f);
          const f32x4 g0 = *(const f32x4*)(kva_g + lane * 4);
          u32x2 o; o.x = pack2(v[0] * rs * g0[0], v[1] * rs * g0[1]); o.y = pack2(v[2] * rs * g0[2], v[3] * rs * g0[3]);
          *(u32x2*)(kvn + (size_t)t * 256 + lane * 4) = o; }
        { const int i = lane & 31; const float t1 = bf2f(zr[ZC_KR + i]), t2 = bf2f(zr[ZC_KR + 32 + i]); const f32x2 cs = rope[(t & (SEQ - 1)) * 32 + i];
          const float o = (lane < 32) ? (t1 * cs.x - t2 * cs.y) : (t1 * cs.y + t2 * cs.x);
          kr[(size_t)t * 64 + lane] = f2bf(o); }
    }
}

DI void p_vtd_prep(const Frame F) {
    const bf16_t* z = WSP(bf16_t, WS_Z); bf16_t* vtd = WSP(bf16_t, WS_VTD);
    LAS bf16_t* buf = (LAS bf16_t*)(F.lds + F.wave * 8704);
    const int lane = F.lane;
    for (int tile = F.wg * 8 + F.wave; tile < 2 * 12 * 128; tile += F.G * 8) {
        const int pt = tile & 127, hd = (tile >> 7) % 12, b = tile / (128 * 12);
        const int g = hd >> 2, d = 1 << (2 * g), Ls = SEQ / d;
        const int pos0 = pt * 32, r = pos0 / Ls, j0 = pos0 - r * Ls;
#pragma unroll
        for (int i = 0; i < 8; ++i) { const int p = lane + 64 * i, row = p >> 4, seg = p & 15;
            const size_t tok = (size_t)b * SEQ + (size_t)(j0 + row) * d + r;
            const u32x4 w = *(const u32x4*)(z + tok * ZLD + ZC_DV + hd * 128 + seg * 8);
            *(LAS u32x4*)(buf + row * 136 + seg * 8) = w; }
        __builtin_amdgcn_s_waitcnt(0);
#pragma unroll
        for (int i = 0; i < 8; ++i) { const int p = lane + 64 * i, dv = p >> 2, seg = p & 3;
            unsigned short v[8];
#pragma unroll
            for (int j = 0; j < 8; ++j) v[j] = buf[(seg * 8 + j) * 136 + dv];
            u32x4 w; w.x = v[0] | ((unsigned)v[1] << 16); w.y = v[2] | ((unsigned)v[3] << 16); w.z = v[4] | ((unsigned)v[5] << 16); w.w = v[6] | ((unsigned)v[7] << 16);
            *(u32x4*)(vtd + ((size_t)(b * 12 + hd) * 128 + dv) * SEQ + pos0 + seg * 8) = w; }
        __builtin_amdgcn_s_waitcnt(0);
    }
}

DI int swap23(int i) { return (i & ~12) | ((i & 4) << 1) | ((i & 8) >> 1); }
DI int crow(int reg, int h) { return (reg & 3) + 8 * (reg >> 2) + 4 * h; }
DI bf16x8 packp(const f32x16& p, int s) {
    u32x4 w; w.x = pack2(p[8 * s], p[8 * s + 1]); w.y = pack2(p[8 * s + 2], p[8 * s + 3]); w.z = pack2(p[8 * s + 4], p[8 * s + 5]); w.w = pack2(p[8 * s + 6], p[8 * s + 7]);
    return __builtin_bit_cast(bf16x8, w);
}

DI void dil_item(const Frame F, int item) {
    const bf16_t* z = WSP(bf16_t, WS_Z); const bf16_t* vtd = WSP(bf16_t, WS_VTD);
    bf16_t* op = WSP(bf16_t, WS_OP); float* lse = WSP(float, WS_LSE);
    const int lane = F.lane, c = lane & 31, hh = lane >> 5;
    const int bgh = item >> 7, rem = item & 127, b = bgh / 12, hd = bgh % 12, g = hd >> 2, hs = hd & 3;
    const int d = 1 << (2 * g), Ls = SEQ / d, ntile = Ls / 32, r = rem / ntile, jt = rem % ntile;
    const float slope2 = exp2f(-8.0f * (float)(hd + 1) / 12.0f) * LOG2E * (float)d;
    const float sc = 0.08838834764831845f * LOG2E;
    const int jq = jt * 32 + c;
    const size_t tq = (size_t)b * SEQ + (size_t)jq * d + r;
    bf16x8 qf[8];
#pragma unroll
    for (int ks = 0; ks < 8; ++ks) qf[ks] = *(const bf16x8*)(z + tq * ZLD + ZC_DQ + hd * 128 + 16 * ks + 8 * hh);
    f32x16 O[4];
#pragma unroll
    for (int i = 0; i < 4; ++i)
#pragma unroll
        for (int j = 0; j < 16; ++j) O[i][j] = 0.f;
    float m = -1e30f, lsum = 0.f;
    const int kt0 = jt - 4 < 0 ? 0 : jt - 4;
    LAS unsigned char* kpatch = F.lds + F.wave * 16384; LAS unsigned char* vpatch = kpatch + 8192;
    const int krr = lane >> 4, ksl = lane & 15;
    const bf16_t* kg0 = z + ((size_t)b * SEQ + r) * ZLD + ZC_DK + hd * 128; const bf16_t* vz0 = z + ((size_t)b * SEQ + r) * ZLD + ZC_DV + hd * 128;
    const int vc7 = (lane >> 2) & 7, ve_ = (lane & 3) ^ (vc7 >> 2);
    const size_t voff0 = (size_t)(vc7 * d) * ZLD + 8 * (4 * (lane >> 5) + ve_), voff1 = (size_t)(vc7 * d) * ZLD + 8 * (4 * (lane >> 5) + (ve_ ^ 2));
    const int tq_ = (lane & 15) >> 2, tp_ = lane & 3, tx_ = 2 * ((lane >> 4) & 1) + (tp_ >> 1);
    const LAS unsigned char* vb0 = vpatch + 2048 * hh + 64 * tq_ + 8 * (tp_ & 1) + 16 * (tx_ ^ ((2 * hh) & 3));
    const LAS unsigned char* vb1 = vpatch + 2048 * hh + 64 * tq_ + 8 * (tp_ & 1) + 16 * (tx_ ^ ((2 * hh + 1) & 3)) + 256;
#define DIL_DMA(kt_) do { \
        _Pragma("unroll") for (int i_ = 0; i_ < 8; ++i_) { const int row_ = 4 * i_ + krr; \
            __builtin_amdgcn_global_load_lds((GAS const unsigned*)(kg0 + (size_t)(((kt_) * 32 + row_) * d) * ZLD + 8 * (ksl ^ (row_ & 15))), (LAS unsigned*)(kpatch + i_ * 1024), 16, 0, 0); } \
        _Pragma("unroll") for (int i_ = 0; i_ < 8; ++i_) \
            __builtin_amdgcn_global_load_lds((GAS const unsigned*)(vz0 + (size_t)(((kt_) * 32 + 8 * (i_ >> 1)) * d) * ZLD + 64 * (i_ & 1) + (((i_ >> 1) & 1) ? voff1 : voff0)), (LAS unsigned*)(vpatch + i_ * 1024), 16, 0, 0); } while (0)
    DIL_DMA(kt0);
    const int krow = swap23(c);
    for (int kt = kt0; kt <= jt; ++kt) {
        bf16x8 kf[8], vf[4][2];
        asm volatile("s_waitcnt vmcnt(0)" ::: "memory");
#pragma unroll
        for (int ks = 0; ks < 8; ++ks) kf[ks] = *(const LAS bf16x8*)(kpatch + krow * 256 + 16 * ((2 * ks + hh) ^ (krow & 15)));
#pragma unroll
        for (int dvt = 0; dvt < 4; ++dvt)
#pragma unroll
            for (int s = 0; s < 2; ++s) {
                const s16x4 h0 = __builtin_amdgcn_ds_read_tr16_b64_v4i16((LAS s16x4*)(vb0 + 4096 * s + 512 * dvt));
                const s16x4 h1 = __builtin_amdgcn_ds_read_tr16_b64_v4i16((LAS s16x4*)(vb1 + 4096 * s + 512 * dvt));
                vf[dvt][s] = __builtin_shufflevector(h0, h1, 0, 1, 2, 3, 4, 5, 6, 7); }
        asm volatile("s_waitcnt lgkmcnt(0)" ::: "memory");
        if (kt < jt) DIL_DMA(kt + 1);
        f32x16 S;
#pragma unroll
        for (int j = 0; j < 16; ++j) S[j] = 0.f;
#pragma unroll
        for (int ks = 0; ks < 8; ++ks) S = MFMA32(kf[ks], qf[ks], S);
        float mx = -1e30f;
#pragma unroll
        for (int i = 0; i < 16; ++i) { const int rel = jq - (kt * 32 + swap23(crow(i, hh)));
            float s = S[i] * sc - slope2 * (float)rel; s = (rel >= 0 && rel <= 128) ? s : -1e30f; S[i] = s; mx = fmaxf(mx, s); }
        mx = xhalf_max(mx);
        const float mn = (mx > m + 8.0f) ? mx : m, al = __builtin_amdgcn_exp2f(m - mn); m = mn;
        float ps = 0.f;
#pragma unroll
        for (int i = 0; i < 16; ++i) { const float p = __builtin_amdgcn_exp2f(S[i] - mn); S[i] = p; ps += p; }
        lsum = lsum * al + ps;
        if (__any(al != 1.0f)) {
#pragma unroll
            for (int i = 0; i < 4; ++i)
#pragma unroll
                for (int j = 0; j < 16; ++j) O[i][j] *= al; }
        const bf16x8 p0 = packp(S, 0), p1 = packp(S, 1);
#pragma unroll
        for (int dvt = 0; dvt < 4; ++dvt) { O[dvt] = MFMA32(vf[dvt][0], p0, O[dvt]); O[dvt] = MFMA32(vf[dvt][1], p1, O[dvt]); }
    }
#undef DIL_DMA
    const float lt = xhalf_sum(lsum), inv = 1.0f / lt;
    bf16_t* orow = op + ((size_t)g * T + tq) * 512 + hs * 128;
#pragma unroll
    for (int dvt = 0; dvt < 4; ++dvt)
#pragma unroll
        for (int k2 = 0; k2 < 4; k2 += 2) {
            const unsigned a0 = pack2(O[dvt][4 * k2] * inv, O[dvt][4 * k2 + 1] * inv), a1 = pack2(O[dvt][4 * k2 + 2] * inv, O[dvt][4 * k2 + 3] * inv);
            const unsigned b0 = pack2(O[dvt][4 * k2 + 4] * inv, O[dvt][4 * k2 + 5] * inv), b1 = pack2(O[dvt][4 * k2 + 6] * inv, O[dvt][4 * k2 + 7] * inv);
            const auto r0 = __builtin_amdgcn_permlane32_swap(a0, b0, false, false); const auto r1 = __builtin_amdgcn_permlane32_swap(a1, b1, false, false);
            *(u32x4*)(orow + dvt * 32 + 8 * k2 + 8 * hh) = (u32x4){r0[0], r1[0], r0[1], r1[1]}; }
    if (hh == 0) lse[((size_t)g * T + tq) * 4 + hs] = m + __builtin_amdgcn_logf(lt);
}

constexpr int AK_P = 200, AV_P = 40;
constexpr int AST = 32 * AK_P * 2 + 128 * AV_P * 2;
DI void mla_decode(int item, int& bh, int& qb, int& kc, int& nst) {
    if (item < 336) { bh = item / 28; int r = item % 28; qb = 3; for (;;) { const int n = (qb + 1) >> 2; if (r < n) break; r -= n; ++qb; } kc = r; nst = 32; }
    else { const int x = item - 336, cls = x / 48, y = x % 48; bh = y >> 2; const int m = y & 3; qb = 4 * m + (2 - cls); kc = m; nst = (3 - cls) * 8; }
}
DI void mla_wg_item(const Frame F, int item) {
    const bf16_t* qbuf = WSP(bf16_t, WS_QB); const bf16_t* kcb = WSP(bf16_t, WS_KC); const bf16_t* krp = WSP(bf16_t, WS_KROPE); const bf16_t* vt = WSP(bf16_t, WS_VT);
    const f32x2* rope = WSP(f32x2, WS_ROPE); bf16_t* mix = WSP(bf16_t, WS_MIX); bf16_t* opm = WSP(bf16_t, WS_OPM); float* lsem = WSP(float, WS_LSEM);
    const int tid = F.tid, lane = F.lane, wave = F.wave, c = lane & 31, hh = lane >> 5;
    int bh, qb, kc, nst; mla_decode(item, bh, qb, kc, nst);
    const int b = bh / 6, h = bh % 6;
    const int q0 = qb * 256 + wave * 32;
    const size_t tq = (size_t)b * SEQ + q0 + c;
    const float sc = 0.07216878364870322f * LOG2E;
    const int key_base = kc * 1024;
    const int ka_row = tid >> 4, ka_seg = tid & 15;
    const int kb_row = (tid & 255) >> 3, kb_seg = tid & 7;
    const int vb_p = tid - 256, vc_p = tid + 256;
    u32x4 ra0, rb0, rc0, ra1, rb1, rc1;
#define MLA_ISSUE(ra, rb_, rc, s_) do { const int k0_ = key_base + (s_) * 32; const size_t tk0_ = (size_t)b * SEQ + k0_; \
        ra = *(const u32x4*)(kcb + (tk0_ + ka_row) * 768 + h * 128 + ka_seg * 8); \
        if (tid < 256) { rb_ = *(const u32x4*)(krp + (tk0_ + kb_row) * 64 + kb_seg * 8); rc = *(const u32x4*)(vt + (size_t)(h * 128 + (vc_p >> 2)) * T + tk0_ + (vc_p & 3) * 8); } \
        else { rb_ = *(const u32x4*)(vt + (size_t)(h * 128 + (vb_p >> 2)) * T + tk0_ + (vb_p & 3) * 8); } } while (0)
#define MLA_WRITE(ra, rb_, rc, s_) do { LAS bf16_t* kb_ = (LAS bf16_t*)(F.lds + ((s_) & 3) * AST); LAS bf16_t* vb_ = kb_ + 32 * AK_P; \
        *(LAS u32x4*)(kb_ + ka_row * AK_P + ka_seg * 8) = ra; \
        if (tid < 256) { *(LAS u32x4*)(kb_ + kb_row * AK_P + 128 + kb_seg * 8) = rb_; *(LAS u32x4*)(vb_ + (vc_p >> 2) * AV_P + (vc_p & 3) * 8) = rc; } \
        else { *(LAS u32x4*)(vb_ + (vb_p >> 2) * AV_P + (vb_p & 3) * 8) = rb_; } } while (0)
    __syncthreads();
    MLA_ISSUE(ra0, rb0, rc0, 0); MLA_WRITE(ra0, rb0, rc0, 0);
    MLA_ISSUE(ra1, rb1, rc1, 1); MLA_WRITE(ra1, rb1, rc1, 1);
    MLA_ISSUE(ra0, rb0, rc0, 2); MLA_ISSUE(ra1, rb1, rc1, 3);
    bf16x8 qf[12];
#pragma unroll
    for (int ks = 0; ks < 12; ++ks) qf[ks] = *(const bf16x8*)(qbuf + tq * 1280 + h * 192 + 16 * ks + 8 * hh);
#pragma unroll
    for (int kk = 0; kk < 2; ++kk) {
        const u32x4 w1 = __builtin_bit_cast(u32x4, qf[8 + kk]), w2 = __builtin_bit_cast(u32x4, qf[10 + kk]);
        const unsigned a1[4] = {w1.x, w1.y, w1.z, w1.w}, a2[4] = {w2.x, w2.y, w2.z, w2.w};
        unsigned o1[4], o2[4];
#pragma unroll
        for (int jj = 0; jj < 4; ++jj) {
            const int i0 = 16 * kk + 8 * hh + 2 * jj;
            const f32x2 cs0 = rope[(q0 + c) * 32 + i0], cs1 = rope[(q0 + c) * 32 + i0 + 1];
            const float t1a = bflo(a1[jj]), t1b = bfhi(a1[jj]), t2a = bflo(a2[jj]), t2b = bfhi(a2[jj]);
            o1[jj] = pack2(t1a * cs0.x - t2a * cs0.y, t1b * cs1.x - t2b * cs1.y);
            o2[jj] = pack2(t1a * cs0.y + t2a * cs0.x, t1b * cs1.y + t2b * cs1.x);
        }
        qf[8 + kk] = __builtin_bit_cast(bf16x8, (u32x4){o1[0], o1[1], o1[2], o1[3]});
        qf[10 + kk] = __builtin_bit_cast(bf16x8, (u32x4){o2[0], o2[1], o2[2], o2[3]});
    }
    f32x16 O[4];
#pragma unroll
    for (int i = 0; i < 4; ++i)
#pragma unroll
        for (int jx = 0; jx < 16; ++jx) O[i][jx] = 0.f;
    float m = -1e30f, lsum = 0.f;
    __syncthreads();
#define MLA_SB __builtin_amdgcn_sched_barrier(0)
#define MLA_LDK(dst, base_, ks0_) do { _Pragma("unroll") for (int q_ = 0; q_ < 4; ++q_) dst[q_] = *(const LAS bf16x8*)((base_) + krow * AK_P + 16 * ((ks0_) + q_) + 8 * hh); } while (0)
#define MLA_LDV(dst, base_, off_) do { _Pragma("unroll") for (int q_ = 0; q_ < 4; ++q_) dst[q_] = *(const LAS bf16x8*)((base_) + (q_ * 32 + c) * AV_P + (off_) + 8 * hh); } while (0)
#define MLA_COMPUTE(s_) do { const int s = (s_); const int k0 = key_base + s * 32; \
        if (k0 <= q0 + 31) {                                 \
            const LAS bf16_t* kb = (const LAS bf16_t*)(F.lds + (s & 3) * AST); const LAS bf16_t* vb = kb + 32 * AK_P; \
            f32x16 S; bf16x8 fA[4], fB[4]; \
            _Pragma("unroll") for (int jx = 0; jx < 16; ++jx) S[jx] = 0.f; \
            MLA_LDK(fA, kb, 0); MLA_SB; \
            MLA_LDK(fB, kb, 4); _Pragma("unroll") for (int q_ = 0; q_ < 4; ++q_) S = MFMA32(fA[q_], qf[q_], S); MLA_SB; \
            MLA_LDK(fA, kb, 8); _Pragma("unroll") for (int q_ = 0; q_ < 4; ++q_) S = MFMA32(fB[q_], qf[4 + q_], S); MLA_SB; \
            MLA_LDV(fB, vb, 0); _Pragma("unroll") for (int q_ = 0; q_ < 4; ++q_) S = MFMA32(fA[q_], qf[8 + q_], S); MLA_SB; \
            MLA_LDV(fA, vb, 16); \
            const bool diag = (k0 + 31 > q0); \
            float mx = -3.0e38f; \
            if (diag) { _Pragma("unroll") for (int i = 0; i < 16; ++i) if (k0 + swap23(crow(i, hh)) > q0 + c) S[i] = -3.0e38f; } \
            _Pragma("unroll") for (int i = 0; i < 16; ++i) mx = fmaxf(mx, S[i]); \
            mx = xhalf_max(mx); \
            const float mc = mx * sc, mn = (mc > m + 8.0f) ? mc : m, al = __builtin_amdgcn_exp2f(m - mn); m = mn;     \
            float ps = 0.f; \
            _Pragma("unroll") for (int i = 0; i < 16; ++i) { const float p = __builtin_amdgcn_exp2f(fmaf(S[i], sc, -mn)); S[i] = p; ps += p; } \
            lsum = lsum * al + ps; \
            if (__any(al != 1.0f)) { \
                _Pragma("unroll") for (int i = 0; i < 4; ++i) _Pragma("unroll") for (int jx = 0; jx < 16; ++jx) O[i][jx] *= al; } \
            const bf16x8 p0 = packp(S, 0), p1 = packp(S, 1); \
            MLA_SB; \
            _Pragma("unroll") for (int dvt = 0; dvt < 4; ++dvt) O[dvt] = MFMA32(fB[dvt], p0, O[dvt]); \
            _Pragma("unroll") for (int dvt = 0; dvt < 4; ++dvt) O[dvt] = MFMA32(fA[dvt], p1, O[dvt]); \
        } } while (0)
    const int krow = swap23(c);
    for (int s2 = 0; s2 < nst; s2 += 2) {
        if (s2 + 2 < nst) { MLA_WRITE(ra0, rb0, rc0, s2 + 2); MLA_WRITE(ra1, rb1, rc1, s2 + 3); }
        if (s2 + 4 < nst) { MLA_ISSUE(ra0, rb0, rc0, s2 + 4); MLA_ISSUE(ra1, rb1, rc1, s2 + 5); }
        MLA_COMPUTE(s2); MLA_COMPUTE(s2 + 1);
        asm volatile("s_waitcnt lgkmcnt(0)\n\ts_barrier" ::: "memory");
    }
#undef MLA_COMPUTE
#undef MLA_LDK
#undef MLA_LDV
#undef MLA_SB
#undef MLA_ISSUE
#undef MLA_WRITE
    const float lt = xhalf_sum(lsum), inv = 1.0f / lt;
    const bool single = (qb < 4);
    bf16_t* orow = single ? (mix + tq * D + 1280 + h * 128) : (opm + ((size_t)kc * T + tq) * 768 + h * 128);
#pragma unroll
    for (int dvt = 0; dvt < 4; ++dvt)
#pragma unroll
        for (int k2 = 0; k2 < 4; k2 += 2) {
            const unsigned a0 = pack2(O[dvt][4 * k2] * inv, O[dvt][4 * k2 + 1] * inv), a1 = pack2(O[dvt][4 * k2 + 2] * inv, O[dvt][4 * k2 + 3] * inv);
            const unsigned b0 = pack2(O[dvt][4 * k2 + 4] * inv, O[dvt][4 * k2 + 5] * inv), b1 = pack2(O[dvt][4 * k2 + 6] * inv, O[dvt][4 * k2 + 7] * inv);
            const auto r0 = __builtin_amdgcn_permlane32_swap(a0, b0, false, false); const auto r1 = __builtin_amdgcn_permlane32_swap(a1, b1, false, false);
            *(u32x4*)(orow + dvt * 32 + 8 * k2 + 8 * hh) = (u32x4){r0[0], r1[0], r0[1], r1[1]}; }
    if (!single && hh == 0) lsem[((size_t)kc * T + tq) * 8 + h] = m + __builtin_amdgcn_logf(lt);
}
DI void mla_combine_item(const Frame F, int item) {
    const bf16_t* opm = WSP(bf16_t, WS_OPM); const float* lsem = WSP(float, WS_LSEM); bf16_t* mix = WSP(bf16_t, WS_MIX);
    const int t0 = item * 4, qb = (t0 & (SEQ - 1)) >> 8, np = (qb >> 2) + 1;
    if (np == 1) return;
#pragma unroll 2
    for (int i = 0; i < 6; ++i) {
        const int task = i * 64 + F.lane, tl = task / 96, rem = task % 96, h = rem >> 4, oc = rem & 15;
        const size_t t = (size_t)t0 + tl;
        float lv[4], mx = -3.0e38f;
#pragma unroll
        for (int k = 0; k < 4; ++k) { lv[k] = (k < np) ? lsem[((size_t)k * T + t) * 8 + h] : -3.0e38f; mx = fmaxf(mx, lv[k]); }
        float wsum = 0.f, acc[8];
#pragma unroll
        for (int jx = 0; jx < 8; ++jx) acc[jx] = 0.f;
#pragma unroll
        for (int k = 0; k < 4; ++k) if (k < np) {
            const float w = __builtin_amdgcn_exp2f(lv[k] - mx); wsum += w;
            const u32x4 a = *(const u32x4*)(opm + ((size_t)k * T + t) * 768 + h * 128 + oc * 8); const unsigned aw[4] = {a.x, a.y, a.z, a.w};
#pragma unroll
            for (int jx = 0; jx < 4; ++jx) { acc[2 * jx] += w * bflo(aw[jx]); acc[2 * jx + 1] += w * bfhi(aw[jx]); } }
        const float inv = 1.0f / wsum;
        *(u32x4*)(mix + t * D + 1280 + h * 128 + oc * 8) = (u32x4){pack2(acc[0] * inv, acc[1] * inv), pack2(acc[2] * inv, acc[3] * inv), pack2(acc[4] * inv, acc[5] * inv), pack2(acc[6] * inv, acc[7] * inv)};
    }
}

DI void dilc_item(const Frame F, int item) {
    const bf16_t* op = WSP(bf16_t, WS_OP); const float* lse = WSP(float, WS_LSE); bf16_t* mix = WSP(bf16_t, WS_MIX);
#pragma unroll
    for (int i = 0; i < 4; ++i) {
        const int task = i * 64 + F.lane, tl = task >> 6, rem = task & 63, hs = rem >> 4, oc = rem & 15;
        const size_t t = (size_t)item * 4 + tl;
        const float l0 = lse[((size_t)0 * T + t) * 4 + hs], l1 = lse[((size_t)1 * T + t) * 4 + hs], l2 = lse[((size_t)2 * T + t) * 4 + hs];
        const float mx = fmaxf(l0, fmaxf(l1, l2));
        float w0 = __builtin_amdgcn_exp2f(l0 - mx), w1 = __builtin_amdgcn_exp2f(l1 - mx), w2 = __builtin_amdgcn_exp2f(l2 - mx);
        const float inv = 1.0f / (w0 + w1 + w2); w0 *= inv; w1 *= inv; w2 *= inv;
        const u32x4 a = *(const u32x4*)(op + ((size_t)0 * T + t) * 512 + hs * 128 + oc * 8), bq = *(const u32x4*)(op + ((size_t)1 * T + t) * 512 + hs * 128 + oc * 8), cq = *(const u32x4*)(op + ((size_t)2 * T + t) * 512 + hs * 128 + oc * 8);
        const unsigned aw[4] = {a.x, a.y, a.z, a.w}, bw[4] = {bq.x, bq.y, bq.z, bq.w}, cw[4] = {cq.x, cq.y, cq.z, cq.w}; unsigned o[4];
#pragma unroll
        for (int j = 0; j < 4; ++j) o[j] = pack2(w0 * bflo(aw[j]) + w1 * bflo(bw[j]) + w2 * bflo(cw[j]), w0 * bfhi(aw[j]) + w1 * bfhi(bw[j]) + w2 * bfhi(cw[j]));
        *(u32x4*)(mix + t * D + 768 + hs * 128 + oc * 8) = (u32x4){o[0], o[1], o[2], o[3]};
    }
}

DI float dppf(float x, int ctrl_sel) {
    const int v = __float_as_int(x); int r;
    if (ctrl_sel == 0) r = __builtin_amdgcn_mov_dpp(v, 0xB1, 0xF, 0xF, true);
    else if (ctrl_sel == 1) r = __builtin_amdgcn_mov_dpp(v, 0x4E, 0xF, 0xF, true);
    else r = __builtin_amdgcn_mov_dpp(v, 0x141, 0xF, 0xF, true);
    return __int_as_float(r);
}
DI float reduce8(float x) { x += dppf(x, 0); x += dppf(x, 1); x += dppf(x, 2); return x; }
constexpr int RTS = 32;
DI void p_rwkv_scan(const Frame F, int l, int bh) {
    const float* R = WSP(float, WS_RW); const float* DEC = R + (size_t)T * 768; const float* K2 = DEC + (size_t)T * 768; const float* V = K2 + (size_t)T * 768;
    const float* AA = V + (size_t)T * 768; const float* BB = AA + (size_t)T * 768; const float* GG = BB + (size_t)T * 768; const float* RK = WSP(float, WS_RK);
    const float* gn_g = INP(12) + (size_t)l * 768; const float* gn_b = INP(13) + (size_t)l * 768;
    bf16_t* mix = WSP(bf16_t, WS_MIX);
    const int b = bh / 12, h = bh % 12, tid = F.tid, i = tid >> 3, jg = tid & 7;
    LAS float* sb = (LAS float*)F.lds;
    LAS float* yb = sb + 2 * 6 * RTS * 64;
    f32x4 reg[6];
    const int st_step = tid >> 4, st_c4 = (tid & 15) * 4;
#define SCAN_ISSUE(chunk_) do { const size_t tok_ = (size_t)b * SEQ + (size_t)(chunk_) * RTS + st_step; \
        reg[0] = *(const f32x4*)(R + tok_ * 768 + h * 64 + st_c4); reg[1] = *(const f32x4*)(DEC + tok_ * 768 + h * 64 + st_c4); reg[2] = *(const f32x4*)(K2 + tok_ * 768 + h * 64 + st_c4); \
        reg[3] = *(const f32x4*)(V + tok_ * 768 + h * 64 + st_c4); reg[4] = *(const f32x4*)(AA + tok_ * 768 + h * 64 + st_c4); reg[5] = *(const f32x4*)(BB + tok_ * 768 + h * 64 + st_c4); } while (0)
    float s[8];
#pragma unroll
    for (int j = 0; j < 8; ++j) s[j] = 0.f;
    SCAN_ISSUE(0);
    __syncthreads();
#pragma unroll
    for (int a = 0; a < 6; ++a) *(LAS f32x4*)(sb + (0 * 6 + a) * RTS * 64 + st_step * 64 + st_c4) = reg[a];
    __syncthreads();
    const int nchunk = SEQ / RTS;
    for (int ch = 0; ch < nchunk; ++ch) {
        const int cb = ch & 1;
        if (ch + 1 < nchunk) SCAN_ISSUE(ch + 1);
        const LAS float* pr = sb + (cb * 6 + 0) * RTS * 64 + jg * 8; const LAS float* pw = sb + (cb * 6 + 1) * RTS * 64 + jg * 8;
        const LAS float* pk = sb + (cb * 6 + 2) * RTS * 64 + jg * 8; const LAS float* pv = sb + (cb * 6 + 3) * RTS * 64 + i;
        const LAS float* pa = sb + (cb * 6 + 4) * RTS * 64 + jg * 8; const LAS float* pb = sb + (cb * 6 + 5) * RTS * 64 + jg * 8;
#pragma unroll 4
        for (int st = 0; st < RTS; ++st) {
            const f32x4 a0 = *(const LAS f32x4*)(pa + st * 64), a1 = *(const LAS f32x4*)(pa + st * 64 + 4);
            const f32x4 w0 = *(const LAS f32x4*)(pw + st * 64), w1 = *(const LAS f32x4*)(pw + st * 64 + 4);
            const f32x4 b0 = *(const LAS f32x4*)(pb + st * 64), b1 = *(const LAS f32x4*)(pb + st * 64 + 4);
            const f32x4 k0 = *(const LAS f32x4*)(pk + st * 64), k1 = *(const LAS f32x4*)(pk + st * 64 + 4);
            const f32x4 r0 = *(const LAS f32x4*)(pr + st * 64), r1 = *(const LAS f32x4*)(pr + st * 64 + 4);
            const float vv = pv[st * 64];
            float sa = (s[0] * a0[0] + s[1] * a0[1]) + (s[2] * a0[2] + s[3] * a0[3]) + (s[4] * a1[0] + s[5] * a1[1]) + (s[6] * a1[2] + s[7] * a1[3]);
            sa = reduce8(sa);
#pragma unroll
            for (int j = 0; j < 4; ++j) { s[j] = s[j] * w0[j] + (sa * b0[j] + vv * k0[j]); s[4 + j] = s[4 + j] * w1[j] + (sa * b1[j] + vv * k1[j]); }
            float y = (s[0] * r0[0] + s[1] * r0[1]) + (s[2] * r0[2] + s[3] * r0[3]) + (s[4] * r1[0] + s[5] * r1[1]) + (s[6] * r1[2] + s[7] * r1[3]);
            y = reduce8(y);
            if (jg == 0) yb[st * 64 + i] = y;
        }
        __syncthreads();
#pragma unroll
        for (int q = 0; q < RTS / 8; ++q) {
            const int st = F.wave * (RTS / 8) + q, lane = F.lane;
            const size_t tok = (size_t)b * SEQ + (size_t)ch * RTS + st;
            const float y = yb[st * 64 + lane];
            const float mean = wave_sum(y) * (1.0f / 64.0f); const float dlt = y - mean; const float var = wave_sum(dlt * dlt) * (1.0f / 64.0f);
            const int cidx = h * 64 + lane;
            float o = dlt * rsqrtf(var + 64e-5f) * gn_g[cidx] + gn_b[cidx];
            o += RK[tok * 16 + h] * sb[(cb * 6 + 3) * RTS * 64 + st * 64 + lane];
            o *= GG[tok * 768 + cidx];
            mix[tok * D + cidx] = f2bf(o);
        }
        if (ch + 1 < nchunk) {
#pragma unroll
            for (int a = 0; a < 6; ++a) *(LAS f32x4*)(sb + ((cb ^ 1) * 6 + a) * RTS * 64 + st_step * 64 + st_c4) = reg[a];
        }
        __syncthreads();
    }
}

constexpr int MP = 72;
constexpr int MBUF = 64 * MP * 2;
DI bf16x8 ldfrag(const LAS bf16_t* M, int rb, int ks, int lane) { return *(const LAS bf16x8*)(M + (rb * 16 + (lane & 15)) * MP + ks * 32 + 8 * (lane >> 4)); }
DI f32x4 mm_tile(const LAS bf16_t* X, const LAS bf16_t* Y, int rb, int cb, int lane, f32x4 acc) {
#pragma unroll
    for (int ks = 0; ks < 2; ++ks) acc = __builtin_amdgcn_mfma_f32_16x16x32_bf16(ldfrag(X, rb, ks, lane), ldfrag(Y, cb, ks, lane), acc, 0, 0, 0);
    return acc;
}
DI void st_T(LAS bf16_t* M, int rb, int cb, int lane, f32x4 v) {
    u32x2 w; w.x = pack2(v[0], v[1]); w.y = pack2(v[2], v[3]);
    *(LAS u32x2*)(M + (cb * 16 + (lane & 15)) * MP + rb * 16 + 4 * (lane >> 4)) = w;
}
DI void st_N(LAS bf16_t* M, int rb, int cb, int lane, f32x4 v) {
#pragma unroll
    for (int q = 0; q < 4; ++q) M[(rb * 16 + 4 * (lane >> 4) + q) * MP + cb * 16 + (lane & 15)] = f2bf(v[q]);
}
DI void p_rwkv_pass1(const Frame F, int l) {
    const bf16_t* z = WSP(bf16_t, WS_Z);
    const float* mu = INP(3) + (size_t)l * 2560; const float* w0 = INP(4) + (size_t)l * 768; const float* a0 = INP(6) + (size_t)l * 768;
    const float* k_k = INP(9) + (size_t)l * 768; const float* k_a = INP(10) + (size_t)l * 768; const float* r_k = INP(11) + (size_t)l * 768;
    const bf16_t* wT = WSP(bf16_t, WS_LORA) + (size_t)l * 768 * 256; const bf16_t* aT = wT + 768 * 64; const bf16_t* gT = wT + 768 * 128;
    bf16_t* Vb = WSP(bf16_t, WS_RW); bf16_t* Gb = Vb + (size_t)T * 768; float* RK = WSP(float, WS_RK);
    float* ACg = WSP(float, WS_AC); float* GCg = WSP(float, WS_GC); float* Y0g = WSP(float, WS_Y0); bf16_t* QCg = WSP(bf16_t, WS_QC);
    LAS bf16_t* b0 = (LAS bf16_t*)F.lds;
    LAS bf16_t* b1 = (LAS bf16_t*)(F.lds + 1 * MBUF);
    LAS bf16_t* b2 = (LAS bf16_t*)(F.lds + 2 * MBUF);
    LAS bf16_t* b3 = (LAS bf16_t*)(F.lds + 3 * MBUF);
    LAS bf16_t* b4 = (LAS bf16_t*)(F.lds + 4 * MBUF);
    LAS bf16_t* b5 = (LAS bf16_t*)(F.lds + 5 * MBUF);
    LAS bf16_t* b6 = (LAS bf16_t*)(F.lds + 6 * MBUF);
    LAS bf16_t* b7 = (LAS bf16_t*)(F.lds + 7 * MBUF);
    LAS bf16_t* b8 = (LAS bf16_t*)(F.lds + 8 * MBUF);
    LAS bf16_t* b9 = (LAS bf16_t*)(F.lds + 9 * MBUF);
    LAS bf16_t* b10 = (LAS bf16_t*)(F.lds + 10 * MBUF);
    LAS bf16_t* b11 = (LAS bf16_t*)(F.lds + 11 * MBUF);
    LAS float* part = (LAS float*)(F.lds + 12 * MBUF);
    LAS bf16_t* XB = b8;
    LAS float* LO = (LAS float*)F.lds;
    const int tid = F.tid, lane = F.lane, wave = F.wave, rb = wave >> 1, cb0 = 2 * (wave & 1);
    const int j = tid & 63, tg = tid >> 6;
    const f32x4 z4 = (f32x4){0.f, 0.f, 0.f, 0.f};
    for (int ch = F.wg; ch < 1536; ch += F.G) {
        const int cidx = ch / 12, h = ch - cidx * 12, b = cidx >> 6, c = cidx & 63, bh = b * 12 + h;
        const int tok0 = b * SEQ + c * 64;
        const int cj = h * 64 + j;
        TSL_B(20);
        float zr_[9], zk_[9], zv_[9];
#pragma unroll
        for (int q = 0; q < 9; ++q) { const int t = tok0 + tg * 8 + q - 1; const bool ok = !(q == 0 && ((t + 1) & (SEQ - 1)) == 0);
            const size_t zo = (size_t)(ok ? t : t + 1) * ZLD + cj;
            zr_[q] = ok ? bf2f(z[zo]) : 0.f; zk_[q] = ok ? bf2f(z[zo + 768]) : 0.f; zv_[q] = ok ? bf2f(z[zo + 1536]) : 0.f; }
        __syncthreads();
        {
            const bf16_t* xl = WSP(bf16_t, WS_XL) + (size_t)tok0 * 256;
#pragma unroll
            for (int i = 0; i < 4; ++i) { const int p = tid + 512 * i, tk = p >> 5, sg = p & 31; *(LAS u32x4*)(XB + tk * 264 + sg * 8) = *(const u32x4*)(xl + (size_t)tk * 256 + sg * 8); }
        }
        __syncthreads();
        {
            const int c32 = lane & 31, hh = lane >> 5, ct = (wave >> 1) & 1, tt = wave & 1;
            const size_t arow = (size_t)(h * 64 + ct * 32 + c32);
            f32x16 acc0, acc1;
#pragma unroll
            for (int q = 0; q < 16; ++q) { acc0[q] = 0.f; acc1[q] = 0.f; }
            if (wave < 4) {
#pragma unroll
                for (int ks = 0; ks < 4; ++ks) {
                    acc0 = MFMA32(*(const bf16x8*)(wT + arow * 64 + 16 * ks + 8 * hh), *(const LAS bf16x8*)(XB + (tt * 32 + c32) * 264 + 16 * ks + 8 * hh), acc0);
                    acc1 = MFMA32(*(const bf16x8*)(aT + arow * 64 + 16 * ks + 8 * hh), *(const LAS bf16x8*)(XB + (tt * 32 + c32) * 264 + 64 + 16 * ks + 8 * hh), acc1); }
            } else {
#pragma unroll
                for (int ks = 0; ks < 8; ++ks)
                    acc0 = MFMA32(*(const bf16x8*)(gT + arow * 128 + 16 * ks + 8 * hh), *(const LAS bf16x8*)(XB + (tt * 32 + c32) * 264 + 128 + 16 * ks + 8 * hh), acc0);
            }
            LAS float* o0 = LO + ((wave < 4) ? 0 : 2) * 64 * 68 + (tt * 32 + c32) * 68 + ct * 32 + 4 * hh;
#pragma unroll
            for (int rg = 0; rg < 4; ++rg) { *(LAS f32x4*)(o0 + 8 * rg) = (f32x4){acc0[4 * rg], acc0[4 * rg + 1], acc0[4 * rg + 2], acc0[4 * rg + 3]};
                if (wave < 4) *(LAS f32x4*)(o0 + 64 * 68 + 8 * rg) = (f32x4){acc1[4 * rg], acc1[4 * rg + 1], acc1[4 * rg + 2], acc1[4 * rg + 3]}; }
        }
        __syncthreads();
        float lw[8], lam[8], va[8], vb[8], vk[8], vr[8], vv[8];
        {
            const float mur = mu[cj], muk = mu[768 + cj], muv = mu[1536 + cj], w0c = w0[cj], a0c = a0[cj], kkc = k_k[cj], kac = k_a[cj], rkc = r_k[cj];
            float lo_w[8], lo_a[8], lo_g[8];
#pragma unroll
            for (int q = 0; q < 8; ++q) { const int tl = tg * 8 + q; lo_w[q] = LO[tl * 68 + j]; lo_a[q] = LO[64 * 68 + tl * 68 + j]; lo_g[q] = LO[2 * 64 * 68 + tl * 68 + j]; }
            __syncthreads();
            float ss[8], rs[8], kk1v[8], av_[8];
#pragma unroll
            for (int q = 0; q < 8; ++q) {
                const float zr = zr_[q + 1] + (zr_[q] - zr_[q + 1]) * mur, zk = zk_[q + 1] + (zk_[q] - zk_[q + 1]) * muk, zv = zv_[q + 1] + (zv_[q] - zv_[q + 1]) * muv;
                const float xw = -(w0c + lo_w[q]);
                const float sp = (xw > 15.f) ? xw : __logf(1.0f + __expf(xw));
                lw[q] = -__expf(-sp - 0.5f);
                const float a = sigmoidf_(a0c + lo_a[q]);
                const float kk1 = zk * kkc;
                const float k2 = zk * (1.0f + (a - 1.0f) * kac);
                ss[q] = kk1 * kk1; rs[q] = zr * k2 * rkc; kk1v[q] = kk1; av_[q] = a;
                vk[q] = k2; vr[q] = zr; vv[q] = zv;
            }
#pragma unroll
            for (int q = 0; q < 8; ++q) { ss[q] = wave_sum(ss[q]); rs[q] = wave_sum(rs[q]); }
#pragma unroll
            for (int q = 0; q < 8; ++q) {
                const size_t t = (size_t)tok0 + tg * 8 + q;
                const float kh = kk1v[q] * __builtin_amdgcn_rsqf(fmaxf(ss[q], 1e-24f));
                va[q] = -kh; vb[q] = kh * av_[q];
                Vb[t * 768 + cj] = f2bf(vv[q]); Gb[t * 768 + cj] = f2bf(lo_g[q]);
                if (j == 0) RK[t * 16 + h] = rs[q];
            }
        }
        lam[0] = lw[0];
#pragma unroll
        for (int q = 1; q < 8; ++q) lam[q] = lam[q - 1] + lw[q];
        part[tg * 64 + j] = lam[7];
        __syncthreads();
        float off = 0.f, tot = 0.f;
#pragma unroll
        for (int q = 0; q < 8; ++q) { const float p = part[q * 64 + j]; off += (q < tg) ? p : 0.f; tot += p; }
        if (tg == 0) part[512 + j] = __expf(tot);
        {
#pragma unroll
            for (int q = 0; q < 8; ++q) { const float L_ = off + lam[q], ep = __expf(L_), en = __expf(-L_), epv = __expf(L_ - lw[q]);
                va[q] *= epv; vb[q] *= en; vk[q] *= en; vr[q] *= ep; }
#pragma unroll
            for (int q = 0; q < 8; ++q) { const int t = tg * 8 + q; b0[t * MP + j] = f2bf(va[q]); b1[t * MP + j] = f2bf(vb[q]); b2[t * MP + j] = f2bf(vk[q]); b3[t * MP + j] = f2bf(vr[q]); }
            u32x4 w;
            w.x = pack2(va[0], va[1]); w.y = pack2(va[2], va[3]); w.z = pack2(va[4], va[5]); w.w = pack2(va[6], va[7]); *(LAS u32x4*)(b4 + j * MP + tg * 8) = w;
            w.x = pack2(vb[0], vb[1]); w.y = pack2(vb[2], vb[3]); w.z = pack2(vb[4], vb[5]); w.w = pack2(vb[6], vb[7]); *(LAS u32x4*)(b5 + j * MP + tg * 8) = w;
            w.x = pack2(vk[0], vk[1]); w.y = pack2(vk[2], vk[3]); w.z = pack2(vk[4], vk[5]); w.w = pack2(vk[6], vk[7]); *(LAS u32x4*)(b6 + j * MP + tg * 8) = w;
            w.x = pack2(vv[0], vv[1]); w.y = pack2(vv[2], vv[3]); w.z = pack2(vv[4], vv[5]); w.w = pack2(vv[6], vv[7]); *(LAS u32x4*)(b7 + j * MP + tg * 8) = w;
        }
        __syncthreads();
        TSL_E(20); TSL_B(21);
        f32x4 Tt[2], lak[2], mrb[2], mrk[2];
#pragma unroll
        for (int q = 0; q < 2; ++q) { const int cb = cb0 + q;
            Tt[q] = mm_tile(b0, b1, rb, cb, lane, z4); lak[q] = mm_tile(b0, b2, rb, cb, lane, z4); mrb[q] = mm_tile(b3, b1, rb, cb, lane, z4); mrk[q] = mm_tile(b3, b2, rb, cb, lane, z4);
#pragma unroll
            for (int e = 0; e < 4; ++e) { const int tr = rb * 16 + 4 * (lane >> 4) + e, sc = cb * 16 + (lane & 15);
                if (!(tr > sc)) { Tt[q][e] = 0.f; lak[q][e] = 0.f; }
                if (!(tr >= sc)) { mrb[q][e] = 0.f; mrk[q][e] = 0.f; } } }
        float rtv[2][4];
#pragma unroll
        for (int q = 0; q < 2; ++q)
#pragma unroll
            for (int e = 0; e < 4; ++e) rtv[q][e] = bf2f(b3[(rb * 16 + 4 * (lane >> 4) + e) * MP + (cb0 + q) * 16 + (lane & 15)]);
        __syncthreads();
        LAS bf16_t* bx = (LAS bf16_t*)(F.lds + 12 * MBUF + 2304);
#pragma unroll
        for (int q = 0; q < 2; ++q) { const int cb = cb0 + q;
            st_N(b0, rb, cb, lane, Tt[q]); st_T(b1, rb, cb, lane, Tt[q]);
            st_N(b8, rb, cb, lane, lak[q]); st_N(b9, rb, cb, lane, mrb[q]); st_N(b10, rb, cb, lane, mrk[q]);
#pragma unroll
            for (int e = 0; e < 4; ++e) { const int tr = rb * 16 + 4 * (lane >> 4) + e, sc = cb * 16 + (lane & 15); if (tr == sc) Tt[q][e] += 1.0f; }
            st_N(b2, rb, cb, lane, Tt[q]); }
        __syncthreads();
        {
            f32x4 p2[2];
#pragma unroll
            for (int q = 0; q < 2; ++q) p2[q] = mm_tile(b0, b1, rb, cb0 + q, lane, z4);
#pragma unroll
            for (int q = 0; q < 2; ++q) { st_N(b3, rb, cb0 + q, lane, p2[q]); st_T(bx, rb, cb0 + q, lane, p2[q]); }
            __syncthreads();
#pragma unroll
            for (int k = 1; k <= 5; ++k) {
                LAS bf16_t* Pn_c = (k & 1) ? b3 : b0; LAS bf16_t* Pt_c = (k & 1) ? bx : b1; LAS bf16_t* Pn_n = (k & 1) ? b0 : b3; LAS bf16_t* Pt_n = (k & 1) ? b1 : bx;
                LAS bf16_t* Tb_c = ((k - 1) & 1) ? b11 : b2; LAS bf16_t* Tb_n = ((k - 1) & 1) ? b2 : b11;
#pragma unroll
                for (int q = 0; q < 2; ++q) { Tt[q] = mm_tile(Tb_c, Pt_c, rb, cb0 + q, lane, Tt[q]); if (k < 5) p2[q] = mm_tile(Pn_c, Pt_c, rb, cb0 + q, lane, z4); }
#pragma unroll
                for (int q = 0; q < 2; ++q) { st_N(Tb_n, rb, cb0 + q, lane, Tt[q]); if (k < 5) { st_N(Pn_n, rb, cb0 + q, lane, p2[q]); st_T(Pt_n, rb, cb0 + q, lane, p2[q]); } }
                __syncthreads();
            }
        }
#pragma unroll
        for (int q = 0; q < 2; ++q) { const int cb = cb0 + q;
            st_T(b0, rb, cb, lane, mm_tile(b11, b4, rb, cb, lane, z4));
            st_T(b1, rb, cb, lane, mm_tile(b8, b7, rb, cb, lane, z4)); }
        __syncthreads();
#pragma unroll
        for (int q = 0; q < 2; ++q) st_T(b8, rb, cb0 + q, lane, mm_tile(b11, b1, rb, cb0 + q, lane, z4));
        __syncthreads();
        TSL_E(21); TSL_B(22);
        const size_t cho = (size_t)(bh * 64 + c) * 4096;
#pragma unroll
        for (int q = 0; q < 2; ++q) { const int cb = cb0 + q; const int col = cb * 16 + (lane & 15), row0 = rb * 16 + 4 * (lane >> 4);
            f32x4 ac = mm_tile(b5, b0, rb, cb, lane, z4);
            f32x4 gc = mm_tile(b6, b7, rb, cb, lane, mm_tile(b5, b8, rb, cb, lane, z4));
#pragma unroll
            for (int e = 0; e < 4; ++e) { const float gm = part[512 + row0 + e];
                ACg[cho + (size_t)(row0 + e) * 64 + col] = (ac[e] + ((row0 + e) == col ? 1.0f : 0.f)) * gm;
                GCg[cho + (size_t)(row0 + e) * 64 + col] = gc[e] * gm; }
            f32x4 qc = mm_tile(b9, b0, rb, cb, lane, z4);
#pragma unroll
            for (int e = 0; e < 4; ++e) QCg[cho + (size_t)(row0 + e) * 64 + col] = f2bf(qc[e] + rtv[q][e]);
            const f32x4 y0 = mm_tile(b10, b7, rb, cb, lane, mm_tile(b9, b8, rb, cb, lane, z4));
            *(f32x4*)(Y0g + cho + (size_t)((wave * 2 + q) * 64 + lane) * 4) = y0; }
        TSL_E(22);
    }
}
DI void p_rwkv_pass2(const Frame F, int unit) {
    const float* ACg = WSP(float, WS_AC); const float* GCg = WSP(float, WS_GC); bf16_t* SST = WSP(bf16_t, WS_SST);
    const int lane = F.lane, wave = F.wave, cb = wave & 3, n = lane & 15, kk = lane >> 4;
    const int u2 = 2 * unit + (wave >> 2);
    LAS float* Sb = (LAS float*)F.lds + (wave >> 2) * 2 * 16 * 68;
    const int bh = u2 >> 2, rb = u2 & 3;
    const bool act = true;
    f32x4 St = (f32x4){0.f, 0.f, 0.f, 0.f};
    __syncthreads();
    if (act) {
#pragma unroll
        for (int e = 0; e < 4; ++e) Sb[(4 * kk + e) * 68 + cb * 16 + n] = 0.f; }
    __syncthreads();
    f32x4 bvA[4], gvA, bvB[4], gvB, bvC[4], gvC, bvD[4], gvD, bvE[4], gvE, bvF[4], gvF;
#define P2_LOAD(bv, gv, c_) do { const size_t cho_ = (size_t)(bh * 64 + (c_)) * 4096; \
        _Pragma("unroll") for (int m4 = 0; m4 < 4; ++m4) bv[m4] = *(const f32x4*)(ACg + cho_ + (size_t)(cb * 16 + n) * 64 + 16 * kk + 4 * m4); \
        gv = *(const f32x4*)(GCg + cho_ + (size_t)(cb * 16 + n) * 64 + rb * 16 + 4 * kk); } while (0)
#define P2_STEP(bc, gc, bn, gn, c_) do { const int cc_ = (c_); const size_t cho = (size_t)(bh * 64 + cc_) * 4096; \
        const LAS float* Sc = Sb + (cc_ & 1) * 16 * 68; LAS float* Sn = Sb + ((cc_ + 1) & 1) * 16 * 68; \
        if (act) { \
            _Pragma("unroll") for (int e = 0; e < 4; ++e) SST[cho + (size_t)(rb * 16 + 4 * kk + e) * 64 + cb * 16 + n] = f2bf(St[e]); \
            if (cc_ + 5 < 64) P2_LOAD(bn, gn, cc_ + 5); \
            f32x4 av[4]; _Pragma("unroll") for (int m4 = 0; m4 < 4; ++m4) av[m4] = *(const LAS f32x4*)(Sc + n * 68 + 16 * kk + 4 * m4); \
            f32x4 acc0 = gc, acc1 = (f32x4){0.f, 0.f, 0.f, 0.f}; \
            _Pragma("unroll") for (int m4 = 0; m4 < 4; m4 += 2) _Pragma("unroll") for (int e = 0; e < 4; ++e) { \
                acc0 = __builtin_amdgcn_mfma_f32_16x16x4f32(av[m4][e], bc[m4][e], acc0, 0, 0, 0); \
                acc1 = __builtin_amdgcn_mfma_f32_16x16x4f32(av[m4 + 1][e], bc[m4 + 1][e], acc1, 0, 0, 0); } \
            St = acc0 + acc1; \
            _Pragma("unroll") for (int e = 0; e < 4; ++e) Sn[(4 * kk + e) * 68 + cb * 16 + n] = St[e]; } \
        asm volatile("s_waitcnt lgkmcnt(0)\n\ts_barrier" ::: "memory"); } while (0)
    if (act) { P2_LOAD(bvA, gvA, 0); P2_LOAD(bvB, gvB, 1); P2_LOAD(bvC, gvC, 2); P2_LOAD(bvD, gvD, 3); P2_LOAD(bvE, gvE, 4); }
    for (int c = 0; c < 60; c += 6) { P2_STEP(bvA, gvA, bvF, gvF, c); P2_STEP(bvB, gvB, bvA, gvA, c + 1); P2_STEP(bvC, gvC, bvB, gvB, c + 2);
                                       P2_STEP(bvD, gvD, bvC, gvC, c + 3); P2_STEP(bvE, gvE, bvD, gvD, c + 4); P2_STEP(bvF, gvF, bvE, gvE, c + 5); }
    P2_STEP(bvA, gvA, bvF, gvF, 60); P2_STEP(bvB, gvB, bvA, gvA, 61); P2_STEP(bvC, gvC, bvB, gvB, 62); P2_STEP(bvD, gvD, bvC, gvC, 63);
#undef P2_LOAD
#undef P2_STEP
}
DI void p_rwkv_pass3(const Frame F, int l) {
    const bf16_t* Vb = WSP(bf16_t, WS_RW); const bf16_t* Gb = Vb + (size_t)T * 768; const float* RK = WSP(float, WS_RK);
    const float* Y0g = WSP(float, WS_Y0); const bf16_t* QCg = WSP(bf16_t, WS_QC); const bf16_t* SST = WSP(bf16_t, WS_SST);
    const float* gn_g = INP(12) + (size_t)l * 768; const float* gn_b = INP(13) + (size_t)l * 768;
    bf16_t* mix = WSP(bf16_t, WS_MIX);
    LAS float* ybuf = (LAS float*)F.lds;
    const int lane = F.lane, wave = F.wave, rb = wave >> 1, cb0 = 2 * (wave & 1), n = lane & 15, kk = lane >> 4;
    bf16x8 qaA[2], ssA[2][2], qaB[2], ssB[2][2]; f32x4 y0A[2], y0B[2]; float rkA[8], rkB[8]; bf16_t vA[8], gA[8], vB[8], gB[8];
#define P3_LOAD(qa, ss, y0, rk, vv, gg, ch_) do { const int ch__ = (ch_); const size_t cho_ = (size_t)ch__ * 4096; const int bh_ = ch__ >> 6, c_ = ch__ & 63, b_ = bh_ / 12, h_ = bh_ % 12; \
        _Pragma("unroll") for (int ks = 0; ks < 2; ++ks) qa[ks] = *(const bf16x8*)(QCg + cho_ + (size_t)(rb * 16 + n) * 64 + ks * 32 + 8 * kk); \
        _Pragma("unroll") for (int q = 0; q < 2; ++q) { y0[q] = *(const f32x4*)(Y0g + cho_ + (size_t)((wave * 2 + q) * 64 + lane) * 4); \
            _Pragma("unroll") for (int ks = 0; ks < 2; ++ks) ss[q][ks] = *(const bf16x8*)(SST + cho_ + (size_t)((cb0 + q) * 16 + n) * 64 + ks * 32 + 8 * kk); } \
        _Pragma("unroll") for (int q = 0; q < 8; ++q) { const size_t tok_ = (size_t)b_ * SEQ + (size_t)c_ * 64 + wave * 8 + q; \
            rk[q] = RK[tok_ * 16 + h_]; vv[q] = Vb[tok_ * 768 + h_ * 64 + lane]; gg[q] = Gb[tok_ * 768 + h_ * 64 + lane]; } } while (0)
#define P3_BODY(qa, ss, y0, rk, vv, gg, ch_, par_) do { const int ch__ = (ch_); const int bh_ = ch__ >> 6, c_ = ch__ & 63, b_ = bh_ / 12, h_ = bh_ % 12; \
        LAS float* yb = ybuf + (par_) * 64 * 68; \
        _Pragma("unroll") for (int q = 0; q < 2; ++q) { f32x4 acc = y0[q]; \
            _Pragma("unroll") for (int ks = 0; ks < 2; ++ks) acc = __builtin_amdgcn_mfma_f32_16x16x32_bf16(qa[ks], ss[q][ks], acc, 0, 0, 0); \
            _Pragma("unroll") for (int e = 0; e < 4; ++e) yb[(rb * 16 + 4 * kk + e) * 68 + (cb0 + q) * 16 + n] = acc[e]; } \
        __syncthreads(); \
        float yv[8], s1[8], s2[8]; \
        _Pragma("unroll") for (int q = 0; q < 8; ++q) { yv[q] = yb[(wave * 8 + q) * 68 + lane]; s1[q] = yv[q]; s2[q] = yv[q] * yv[q]; } \
        _Pragma("unroll") for (int q = 0; q < 8; ++q) { s1[q] = wave_sum(s1[q]); s2[q] = wave_sum(s2[q]); } \
        const int cidx = h_ * 64 + lane; const float gng = gn_g[cidx], gnb = gn_b[cidx]; \
        _Pragma("unroll") for (int q = 0; q < 8; ++q) { const size_t tok_ = (size_t)b_ * SEQ + (size_t)c_ * 64 + wave * 8 + q; \
            const float mean = s1[q] * (1.0f / 64.0f), var = fmaxf(s2[q] * (1.0f / 64.0f) - mean * mean, 0.f); \
            float o = (yv[q] - mean) * rsqrtf(var + 64e-5f) * gng + gnb; \
            o += rk[q] * bf2f(vv[q]); o *= bf2f(gg[q]); \
            mix[tok_ * D + cidx] = f2bf(o); } } while (0)
    if (F.wg < 1536) P3_LOAD(qaA, ssA, y0A, rkA, vA, gA, F.wg);
    for (int ch = F.wg; ch < 1536; ch += 2 * F.G) {
        if (ch + F.G < 1536) P3_LOAD(qaB, ssB, y0B, rkB, vB, gB, ch + F.G);
        P3_BODY(qaA, ssA, y0A, rkA, vA, gA, ch, 0);
        if (ch + 2 * F.G < 1536) P3_LOAD(qaA, ssA, y0A, rkA, vA, gA, ch + 2 * F.G);
        if (ch + F.G < 1536) P3_BODY(qaB, ssB, y0B, rkB, vB, gB, ch + F.G, 1);
    }
#undef P3_LOAD
#undef P3_BODY
}

DI void p_ln1_route(const Frame F, int l, bool commit) {
    const bf16_t* xin = WSP(bf16_t, WS_XBF); const bf16_t* tmp = WSP(bf16_t, WS_TMP); bf16_t* x1b = WSP(bf16_t, WS_X1BF);
    const float* g = INP(19) + (size_t)l * D; const float* bta = INP(20) + (size_t)l * D;
    const float* rwg = WSP(float, WS_RWG) + (size_t)l * 32 * 2048; const float* rc = WSP(float, WS_RC) + l * 64; const float* rb = INP(22);
    unsigned* cnt = F.ctl + CW_MOECNT + l * 32 * 64; int* tokl = WSP(int, WS_TOKL); float* gate = WSP(float, WS_GATE);
    const int lane = F.lane, wave = F.wave;
    LAS float* red = (LAS float*)F.lds;
    LAS f32x2* stat = (LAS f32x2*)(F.lds + 32768);
    for (int tile = F.wg; tile < T / 32; tile += F.G) {
        const int t0 = tile * 32;
        TSL_B(23);
        {
            const int c = lane & 31, hh = lane >> 5, lr = lane >> 3, lc = lane & 7;
            LAS unsigned char* patch = F.lds + 40960 + wave * 9216;
            const f32x4* bfr = (const f32x4*)rwg + (size_t)wave * 4 * 8 * 64 + lane;
            const bf16_t* xg = xin + (size_t)(t0 + lr) * D + 256 * wave + 8 * lc; const bf16_t* mg = tmp + (size_t)(t0 + lr) * D + 256 * wave + 8 * lc;
            f32x16 acc;
#pragma unroll
            for (int i = 0; i < 16; ++i) acc[i] = 0.f;
            u32x4 gxA[4], gmA[4], gxB[4], gmB[4]; f32x4 bA[8], bB[8];
#define RT_LOAD(gx, gm, bb, q_) do { \
                _Pragma("unroll") for (int i = 0; i < 4; ++i) { gx[i] = *(const u32x4*)(xg + (size_t)(8 * i) * D + 64 * (q_)); gm[i] = *(const u32x4*)(mg + (size_t)(8 * i) * D + 64 * (q_)); } \
                _Pragma("unroll") for (int k4 = 0; k4 < 8; ++k4) bb[k4] = bfr[((q_) * 8 + k4) * 64]; } while (0)
#define RT_COMP(gx, gm, bb) do { \
                _Pragma("unroll") for (int i = 0; i < 4; ++i) { *(LAS u32x4*)(patch + (8 * i + lr) * 144 + 16 * lc) = gx[i]; *(LAS u32x4*)(patch + 4608 + (8 * i + lr) * 144 + 16 * lc) = gm[i]; } \
                u32x4 xq[4], mq[4]; \
                _Pragma("unroll") for (int i = 0; i < 4; ++i) { xq[i] = *(const LAS u32x4*)(patch + c * 144 + 64 * hh + 16 * i); mq[i] = *(const LAS u32x4*)(patch + 4608 + c * 144 + 64 * hh + 16 * i); } \
                _Pragma("unroll") for (int i = 0; i < 4; ++i) { const unsigned xw[4] = {xq[i].x, xq[i].y, xq[i].z, xq[i].w}, mw[4] = {mq[i].x, mq[i].y, mq[i].z, mq[i].w}; \
                    _Pragma("unroll") for (int p = 0; p < 4; ++p) { \
                        acc = __builtin_amdgcn_mfma_f32_32x32x2f32(ALPHA * bflo(xw[p]) + bflo(mw[p]), bb[2 * i + (p >> 1)][2 * (p & 1)], acc, 0, 0, 0); \
                        acc = __builtin_amdgcn_mfma_f32_32x32x2f32(ALPHA * bfhi(xw[p]) + bfhi(mw[p]), bb[2 * i + (p >> 1)][2 * (p & 1) + 1], acc, 0, 0, 0); } } } while (0)
            RT_LOAD(gxA, gmA, bA, 0); RT_LOAD(gxB, gmB, bB, 1);
            RT_COMP(gxA, gmA, bA); RT_LOAD(gxA, gmA, bA, 2);
            RT_COMP(gxB, gmB, bB); RT_LOAD(gxB, gmB, bB, 3);
            RT_COMP(gxA, gmA, bA);
            RT_COMP(gxB, gmB, bB);
#undef RT_LOAD
#undef RT_COMP
#pragma unroll
            for (int i = 0; i < 16; ++i) red[wave * 1024 + crow(i, hh) * 32 + c] = acc[i];
        }
#pragma unroll 1
        for (int up = 0; up < 4; up += 2) {
            float xv[2][32], sm[2], sq[2];
#pragma unroll
            for (int u = 0; u < 2; ++u) { const size_t t = (size_t)t0 + wave * 4 + up + u; sm[u] = 0.f;
#pragma unroll
                for (int i = 0; i < 8; ++i) { const u32x2 a = *(const u32x2*)(xin + t * D + 256 * i + 4 * lane), m = *(const u32x2*)(tmp + t * D + 256 * i + 4 * lane);
                    xv[u][4 * i] = ALPHA * bflo(a.x) + bflo(m.x); xv[u][4 * i + 1] = ALPHA * bfhi(a.x) + bfhi(m.x); xv[u][4 * i + 2] = ALPHA * bflo(a.y) + bflo(m.y); xv[u][4 * i + 3] = ALPHA * bfhi(a.y) + bfhi(m.y);
                    sm[u] += (xv[u][4 * i] + xv[u][4 * i + 1]) + (xv[u][4 * i + 2] + xv[u][4 * i + 3]); } }
#pragma unroll
            for (int u = 0; u < 2; ++u) sm[u] = wave_sum(sm[u]);
#pragma unroll
            for (int u = 0; u < 2; ++u) { sm[u] *= (1.0f / 2048.0f); sq[u] = 0.f;
#pragma unroll
                for (int i = 0; i < 32; ++i) { const float dl = xv[u][i] - sm[u]; sq[u] += dl * dl; } }
#pragma unroll
            for (int u = 0; u < 2; ++u) sq[u] = wave_sum(sq[u]);
#pragma unroll
            for (int u = 0; u < 2; ++u) { sq[u] = rsqrtf(sq[u] * (1.0f / 2048.0f) + 1e-5f); if (lane == 0) stat[wave * 4 + up + u] = (f32x2){sm[u], sq[u]}; }
#pragma unroll
            for (int i = 0; i < 8; ++i) { const f32x4 gg = *(const f32x4*)(g + 256 * i + 4 * lane), bb = *(const f32x4*)(bta + 256 * i + 4 * lane);
#pragma unroll
                for (int u = 0; u < 2; ++u) { const size_t t = (size_t)t0 + wave * 4 + up + u; f32x4 o;
#pragma unroll
                    for (int j = 0; j < 4; ++j) o[j] = (xv[u][4 * i + j] - sm[u]) * sq[u] * gg[j] + bb[j];
                    u32x2 w; w.x = pack2(o[0], o[1]); w.y = pack2(o[2], o[3]); *(u32x2*)(x1b + t * D + 256 * i + 4 * lane) = w; } }
        }
        __syncthreads();
        TSL_E(23); TSL_B(24);
#pragma unroll 1
        for (int p = 0; p < 2; ++p) {
            const int e = lane & 31, tl = wave * 4 + 2 * p + (lane >> 5);
            float dot = 0.f;
#pragma unroll
            for (int w2 = 0; w2 < 8; ++w2) dot += red[w2 * 1024 + tl * 32 + e];
            const f32x2 st = stat[tl];
            const float logit = st.y * (dot - st.x * rc[e]) + rc[32 + e];
        const float score = 1.0f / (1.0f + expf(-logit)), sel = score + rb[e];
            const int gb = lane & ~3;
            const float s0 = dppmov<0x00>(sel), s1 = dppmov<0x55>(sel), s2 = dppmov<0xAA>(sel), s3 = dppmov<0xFF>(sel);
            const float ha = fmaxf(s0, s1), hb = fminf(s0, s1), hc = fmaxf(s2, s3), hd = fminf(s2, s3);
            float gv = fmaxf(ha, hc) + fmaxf(fminf(ha, hc), fmaxf(hb, hd)); int gi = e >> 2;
            { float ov = dppmov<0x141>(gv); int oi = __float_as_int(dppmov<0x141>(__int_as_float(gi))); if (ov > gv || (ov == gv && oi < gi)) { gv = ov; gi = oi; }
              ov = dppmov<0x140>(gv); oi = __float_as_int(dppmov<0x140>(__int_as_float(gi))); if (ov > gv || (ov == gv && oi < gi)) { gv = ov; gi = oi; }
              const auto rv = __builtin_amdgcn_permlane16_swap(__float_as_uint(gv), __float_as_uint(gv), false, false); const auto ri = __builtin_amdgcn_permlane16_swap((unsigned)gi, (unsigned)gi, false, false);
              ov = __uint_as_float((lane & 16) ? rv[0] : rv[1]); oi = (int)((lane & 16) ? ri[0] : ri[1]); if (ov > gv || (ov == gv && oi < gi)) { gv = ov; gi = oi; } }
            const int base = (lane & 32) + 4 * gi;
            float a[4], sc4[4];
#pragma unroll
            for (int k = 0; k < 4; ++k) { a[k] = __shfl(sel, base + k); sc4[k] = __shfl(score, base + k); }
            int i1 = 0; float v1 = a[0];
#pragma unroll
            for (int k = 1; k < 4; ++k) if (a[k] > v1) { v1 = a[k]; i1 = k; }
            int i2 = -1; float v2 = -3.0e38f;
#pragma unroll
            for (int k = 0; k < 4; ++k) if (k != i1 && a[k] > v2) { v2 = a[k]; i2 = k; }
            float g1 = 0.f, g2 = 0.f;
#pragma unroll
            for (int k = 0; k < 4; ++k) { if (k == i1) g1 = sc4[k]; if (k == i2) g2 = sc4[k]; }
            if (e == 0 && commit) {
                const int t = t0 + tl; const int e1 = 4 * gi + i1, e2 = 4 * gi + i2; const float dn = g1 + g2;
                const unsigned r1 = atomicAdd(cnt + e1 * 64, 1u); tokl[e1 * 8192 + r1] = 2 * t;
                const unsigned r2 = atomicAdd(cnt + e2 * 64, 1u); tokl[e2 * 8192 + r2] = 2 * t + 1;
                gate[2 * t] = g1 / dn; gate[2 * t + 1] = g2 / dn;
            }
        }
        __syncthreads();
        TSL_E(24);
    }
}

DI void p_ln2(const Frame F, int l) {
    const bf16_t* ybt = WSP(bf16_t, WS_YBT); const float* gate = WSP(float, WS_GATE);
    bf16_t* xb = WSP(bf16_t, WS_X1BF);
    const float* g = INP(26) + (size_t)l * D; const float* bta = INP(27) + (size_t)l * D;
    const int lane = F.lane;
    for (int tb = F.wg * 8 + F.wave; tb < T; tb += F.G * 8 * 2) {
        float xv[2][32], sm[2], sq[2], gg0[2], gg1[2];
#pragma unroll
        for (int k = 0; k < 2; ++k) { const int t = tb + k * F.G * 8; gg0[k] = gate[2 * t]; gg1[k] = gate[2 * t + 1]; sm[k] = 0.f;
#pragma unroll
            for (int i = 0; i < 8; ++i) { const size_t o = 256 * i + 4 * lane; const u32x2 a = *(const u32x2*)(xb + (size_t)t * D + o);
                const u32x2 y0 = *(const u32x2*)(ybt + (size_t)(2 * t) * D + o), y1 = *(const u32x2*)(ybt + (size_t)(2 * t + 1) * D + o);
                xv[k][4 * i] = ALPHA * bflo(a.x) + (gg0[k] * bflo(y0.x) + gg1[k] * bflo(y1.x)); xv[k][4 * i + 1] = ALPHA * bfhi(a.x) + (gg0[k] * bfhi(y0.x) + gg1[k] * bfhi(y1.x));
                xv[k][4 * i + 2] = ALPHA * bflo(a.y) + (gg0[k] * bflo(y0.y) + gg1[k] * bflo(y1.y)); xv[k][4 * i + 3] = ALPHA * bfhi(a.y) + (gg0[k] * bfhi(y0.y) + gg1[k] * bfhi(y1.y));
                sm[k] += (xv[k][4 * i] + xv[k][4 * i + 1]) + (xv[k][4 * i + 2] + xv[k][4 * i + 3]); } }
#pragma unroll
            for (int k = 0; k < 2; ++k) sm[k] = wave_sum(sm[k]);
#pragma unroll
        for (int k = 0; k < 2; ++k) { sm[k] *= (1.0f / 2048.0f); sq[k] = 0.f;
#pragma unroll
            for (int i = 0; i < 32; ++i) { const float dl = xv[k][i] - sm[k]; sq[k] += dl * dl; } }
#pragma unroll
            for (int k = 0; k < 2; ++k) sq[k] = wave_sum(sq[k]);
#pragma unroll
        for (int i = 0; i < 8; ++i) { const size_t o = 256 * i + 4 * lane; const f32x4 gg = *(const f32x4*)(g + o), bb = *(const f32x4*)(bta + o);
#pragma unroll
            for (int k = 0; k < 2; ++k) { const int t = tb + k * F.G * 8; const float rstd = rsqrtf(sq[k] * (1.0f / 2048.0f) + 1e-5f); f32x4 r;
#pragma unroll
                for (int j = 0; j < 4; ++j) r[j] = (xv[k][4 * i + j] - sm[k]) * rstd * gg[j] + bb[j];
                u32x2 w; w.x = pack2(r[0], r[1]); w.y = pack2(r[2], r[3]); *(u32x2*)(xb + (size_t)t * D + o) = w; } }
    }
}

DI int finish_units(const Frame F, int n) {
    LAS int* cw = (LAS int*)(F.lds + LDS_CTL);
    if (F.tid == 0) cw[4] = n;
    __syncthreads();
    return __builtin_amdgcn_readfirstlane(cw[4]);
}
DI int moe_units_body(const Frame F, int l) {
    LAS int* mt = (LAS int*)(F.lds + LDS_MOE); LAS int* utab = (LAS int*)(F.lds + LDS_UTAB); LAS int* rowl = (LAS int*)(F.lds + LDS_ROWL);
    const int* tokl = WSP(int, WS_TOKL);
    int n1 = 0, n2 = 0;
    if (F.tid < 32) { int c = (int)__hip_atomic_load(F.ctl + CW_MOECNT + (l * 32 + F.tid) * 64, __ATOMIC_RELAXED, __HIP_MEMORY_SCOPE_AGENT); mt[F.tid] = c > 8192 ? 8192 : c; }
    __syncthreads();
    if (F.tid == 0) {
        int hb = 0, nrb = 0;
        for (int e = 0; e < 32; ++e) { const int c = mt[e];
            mt[32 + e] = hb; const int nb = (c + 255) >> 8;
            for (int j = 0; j < nb && nrb < 128; ++j) { mt[64 + nrb] = e; mt[192 + nrb] = j; ++nrb; }
            hb += nb * 256; }
        for (int L = F.wg; L < nrb * 4 && n1 < 2; L += F.G) {
            const int rb = L >> 2, pn = L & 3, e = mt[64 + rb], j = mt[192 + rb], cnt = mt[e], row0 = mt[32 + e] + j * 256;
            const int valid = (cnt - j * 256) < 256 ? (cnt - j * 256) : 256;
            pg8::unit_put(utab, n1, WSP(bf16_t, WS_X1BF), WSP(bf16_t, WS_WGU) + ((size_t)(l * 32 + e) * 1024 + (size_t)pn * 256) * 2048, WSP(bf16_t, WS_HB), 2048, DEXP, row0, pn * 256, e * 8192 + j * 256, valid | (rb << 16));
            ++n1; }
        int heavy = nrb * 4 - F.G; if (heavy < 0) heavy = 0; if (heavy > F.G - 1) heavy = F.G - 1;
        const int nl = F.G - heavy;
        if (F.wg >= heavy) for (int u2 = F.wg - heavy; u2 < nrb * 8 && n2 < 6; u2 += nl) {
            const int rb = u2 >> 3, pn = u2 & 7, e = mt[64 + rb], j = mt[192 + rb], cnt = mt[e], row0 = mt[32 + e] + j * 256;
            const int valid = (cnt - j * 256) < 256 ? (cnt - j * 256) : 256;
            pg8::unit_put(utab, n1 + n2, WSP(bf16_t, WS_HB) + (size_t)row0 * DEXP, WSP(bf16_t, WS_WDN) + ((size_t)(l * 32 + e) * 2048 + (size_t)pn * 256) * 512, WSP(bf16_t, WS_YBT), 512, D, row0, pn * 256, e * 8192 + j * 256, valid | (rb << 16));
            ++n2; }
    }
    const int nn = finish_units(F, n1 | (n2 << 8));
    n1 = nn & 255; n2 = nn >> 8;
    for (int x = F.tid; x < (n1 + n2) * 256; x += 512) { const int ui = x >> 8, r = x & 255, a0 = utab[ui * pg8::UD + 10], a1 = utab[ui * pg8::UD + 11] & 0xffff;
        const int v = (r < a1) ? tokl[a0 + r] : -1; rowl[x] = (ui < n1) ? (v < 0 ? 0 : (v >> 1)) : v; }
    __syncthreads();
    return nn;
}

__device__ __noinline__ int moe_units(LAS unsigned char* lds_, GAS unsigned char* ws_, int wave_, int l) { const Frame F = make_frame(lds_, ws_, wave_); return moe_units_body(F, l); }
PHASE_FN ph_prologue(PHASE_ARGS) { PHASE_FRAME; p_prologue(F); }
GEMM_FN ph_gemm_in(PHASE_ARGS, int l) {
    PHASE_FRAME; LAS int* utab = (LAS int*)(F.lds + LDS_UTAB);
    int n = 0;
    if (F.tid == 0) { int Lb = 0;
        pg8::build_dense(utab, n, Lb, WSP(bf16_t, WS_XBF), WSP(bf16_t, WS_WIN) + (size_t)l * 8192 * 2048, WSP(bf16_t, WS_Z), 2, T, 8192, 2048, ZLD, F.G, F.wg);
        pg8::build_dense(utab, n, Lb, WSP(bf16_t, WS_PBF) + (size_t)l * T * PLE, WSP(bf16_t, WS_WPP) + (size_t)l * 2048 * 256, WSP(bf16_t, WS_PP), 2, T, 2048, 256, D, F.G, F.wg); }
    n = finish_units(F, n);
    pg8::EpiBf16 E; pg8::gemm_phase<pg8::EpiBf16, false>(F.lds, F.tid, utab, n, nullptr, E);
}
PHASE_FN ph_rwkv_prep(PHASE_ARGS, int l) { PHASE_FRAME; p_rwkv_prep(F, l); }
PHASE_FN ph_mla_prep(PHASE_ARGS, int l) { PHASE_FRAME; p_mla_prep(F, l); }
GEMM_FN ph_gemm_mla(PHASE_ARGS, int l) {
    PHASE_FRAME; LAS int* utab = (LAS int*)(F.lds + LDS_UTAB);
    int n = 0;
    if (F.tid == 0) { int Lb = 0;
        pg8::build_dense(utab, n, Lb, WSP(bf16_t, WS_QN), WSP(bf16_t, WS_WUQ) + (size_t)l * 1280 * 512, WSP(bf16_t, WS_QB), 2, T, 1280, 512, 1280, F.G, F.wg);
        pg8::build_dense(utab, n, Lb, WSP(bf16_t, WS_KVN), WSP(bf16_t, WS_WUKV) + (size_t)l * 1536 * 256, WSP(bf16_t, WS_KC), 2, T, 768, 256, 768, F.G, F.wg);
        Lb += 160;
        pg8::build_dense(utab, n, Lb, WSP(bf16_t, WS_WUKV) + (size_t)l * 1536 * 256 + (size_t)768 * 256, WSP(bf16_t, WS_KVN), WSP(bf16_t, WS_VT), 2, 768, T, 256, T, F.G, F.wg); }
    n = finish_units(F, n);
    pg8::EpiBf16 E; pg8::gemm_phase<pg8::EpiBf16, false>(F.lds, F.tid, utab, n, nullptr, E);
}
PHASE_FN ph_dil(PHASE_ARGS) { PHASE_FRAME; for (int it = F.wg * 8 + F.wave; it < 2 * 12 * 128; it += F.G * 8) dil_item(F, it); }
PHASE_FN ph_scan(PHASE_ARGS, int l) { PHASE_FRAME; p_rwkv_pass2(F, F.wg); }
PHASE_FN ph_rwkv1(PHASE_ARGS, int l) { PHASE_FRAME; p_rwkv_pass1(F, l); }
PHASE_FN ph_rwkv3(PHASE_ARGS, int l) { PHASE_FRAME; p_rwkv_pass3(F, l); }
DI void conv_item_body(const Frame F, int l, int j) {
    if (j < 768) {
        const int set = j >> 8, t0 = (j & 255) * 8;
        if (set == 0)      convert_dma<1>(F, INP(23) + (size_t)l * 32 * 2048 * 512, 2048, 512, WSP(bf16_t, WS_WGU) + (size_t)l * 32 * 1024 * 2048, 0, (size_t)2048 * 512, (size_t)1024 * 2048, t0, 8);
        else if (set == 1) convert_dma<1>(F, INP(24) + (size_t)l * 32 * 2048 * 512, 2048, 512, WSP(bf16_t, WS_WGU) + (size_t)l * 32 * 1024 * 2048, 1, (size_t)2048 * 512, (size_t)1024 * 2048, t0, 8);
        else               convert_dma<0>(F, INP(25) + (size_t)l * 32 * 512 * 2048, 512, 2048, WSP(bf16_t, WS_WDN) + (size_t)l * 32 * 2048 * 512, 0, (size_t)512 * 2048, (size_t)2048 * 512, t0, 8);
    } else if (j < 800) {
        convert_dma<0>(F, INP(18) + (size_t)l * 2048 * 2048, 2048, 2048, WSP(bf16_t, WS_WOUT) + (size_t)l * 2048 * 2048, 0, (size_t)2048 * 2048, (size_t)2048 * 2048, (j - 768) * 8, 8);
    } else if (j < 832) {
        convert_dma<0>(F, INP(29) + (size_t)l * 2048 * 2048, 2048, 2048, WSP(bf16_t, WS_WPG) + (size_t)l * 2048 * 2048, 0, (size_t)2048 * 2048, (size_t)2048 * 2048, (j - 800) * 8, 8);
    } else if (l + 1 < NL) {
        convert_dma<0>(F, INP(2) + (size_t)(l + 1) * 2048 * 8000, 2048, 8000, WSP(bf16_t, WS_WIN) + (size_t)(l + 1) * 8192 * 2048, 0, (size_t)2048 * 8000, (size_t)8192 * 2048, (j - 832) * 8, 8);
    }
}
__device__ __noinline__ void conv_item(LAS unsigned char* lds_, GAS unsigned char* ws_, int wave_, int l, int j) { const Frame F = make_frame(lds_, ws_, wave_); conv_item_body(F, l, j); }
PHASE_FN ph_attn_queue(PHASE_ARGS, int l, int rep) {
    PHASE_FRAME;
    unsigned* q = F.ctl + CW_QUEUE + l * 64 + rep * 8;
    LAS int* cw = (LAS int*)(F.lds + LDS_CTL);
    for (;;) {
        __syncthreads();
        if (F.tid == 0) cw[5] = (int)atomicAdd(q, 1u);
        __syncthreads();
        const int it = __builtin_amdgcn_readfirstlane(cw[5]);
        if (it >= 96 * 15) break;
        const int grp = it / 15, r = it - grp * 15, r3 = r / 3;
        const Frame Fi = make_frame(F.lds, F.ws, F.wave);
        if (r == 3 * r3) mla_wg_item(Fi, grp * 5 + r3);
        else conv_item(F.lds, F.ws, F.wave, l, grp * 10 + (r - r3 - 1));
    }
    unsigned* q2 = F.ctl + CW_QUEUE + l * 64 + 32 + rep;
    for (;;) {
        __syncthreads();
        if (F.tid == 0) cw[5] = (int)atomicAdd(q2, 8u);
        __syncthreads();
        const int it = __builtin_amdgcn_readfirstlane(cw[5]) + F.wave;
        if (it - F.wave >= 2 * 12 * 128) break;
        if (it < 2 * 12 * 128) dil_item(F, it);
    }
}
PHASE_FN ph_combine(PHASE_ARGS) {
    PHASE_FRAME;
    for (int it = F.wg * 8 + F.wave; it < 4096; it += F.G * 8) { if (it < 2048) dilc_item(F, it); else mla_combine_item(F, it - 2048); }
}
GEMM_FN ph_gemm_out(PHASE_ARGS, int l) {
    PHASE_FRAME; LAS int* utab = (LAS int*)(F.lds + LDS_UTAB);
    int n = 0;
    if (F.tid == 0) { int Lb = 0; pg8::build_dense(utab, n, Lb, WSP(bf16_t, WS_MIX), WSP(bf16_t, WS_WOUT) + (size_t)l * 2048 * 2048, WSP(bf16_t, WS_TMP), 2, T, 2048, 2048, D, F.G, F.wg); }
    n = finish_units(F, n);
    pg8::EpiBf16 E; pg8::gemm_phase<pg8::EpiBf16, false>(F.lds, F.tid, utab, n, nullptr, E);
}
PHASE_FN ph_ln1(PHASE_ARGS, int l, bool commit) { PHASE_FRAME; p_ln1_route(F, l, commit); }
GEMM_FN ph_moe(PHASE_ARGS, int l) {
    PHASE_FRAME; const int nn = __builtin_amdgcn_readfirstlane(moe_units(F.lds, F.ws, F.wave, l));
    const int n1 = nn & 255, n2 = nn >> 8;
    unsigned* rbcnt = F.ctl + CW_RBCNT + l * 128 * 16;
    { pg8::EpiGU E{rbcnt}; pg8::gemm_phase<pg8::EpiGU, true>(F.lds, F.tid, (const LAS int*)(F.lds + LDS_UTAB), n1, (const LAS int*)(F.lds + LDS_ROWL), E); }
    { pg8::EpiScatter E{(const LAS int*)(F.lds + LDS_ROWL) + n1 * 256};
      pg8::gemm_phase<pg8::EpiScatter, false, true>(F.lds, F.tid, (const LAS int*)(F.lds + LDS_UTAB) + n1 * pg8::UD, n2, (const LAS int*)(F.lds + LDS_ROWL) + n1 * 256, E, rbcnt); }
}
PHASE_FN ph_ln2(PHASE_ARGS, int l) { PHASE_FRAME; p_ln2(F, l); }
GEMM_FN ph_ple(PHASE_ARGS, int l, float* out_) {
    PHASE_FRAME; LAS int* utab = (LAS int*)(F.lds + LDS_UTAB);
    const bool lastl = (l == NL - 1);
    float* outp = (float*)(GAS float*)rfl64((unsigned long long)out_);
    int n = 0;
    if (F.tid == 0) { int Lb = 0; pg8::build_dense(utab, n, Lb, WSP(bf16_t, WS_X1BF), WSP(bf16_t, WS_WPG) + (size_t)l * 2048 * 2048, nullptr, 4, T, 2048, 2048, D, F.G, F.wg); }
    n = finish_units(F, n);
    pg8::EpiPle E{WSP(bf16_t, WS_X1BF), WSP(bf16_t, WS_PP), WSP(bf16_t, WS_XBF), lastl ? outp : (float*)nullptr};
    pg8::gemm_phase<pg8::EpiPle, false>(F.lds, F.tid, utab, n, nullptr, E);
}

constexpr int NPH = 10;
DI int lz(int l) { asm volatile("" : "+s"(l)); return l; }
typedef __attribute__((address_space(4))) const Params* kparams_t;
DI kparams_t kargs() { unsigned long long a = (unsigned long long)__builtin_amdgcn_kernarg_segment_ptr(); asm volatile("" : "+s"(a)); return (kparams_t)a; }
__global__ void __launch_bounds__(512, 2) mk_fwd(Params P) {
    extern __shared__ __attribute__((aligned(16))) unsigned char lds_raw[];
    const int wave_s = __builtin_amdgcn_readfirstlane((int)(threadIdx.x >> 6));
    {
        LAS unsigned char* lds0 = (LAS unsigned char*)lds_raw;
        if (threadIdx.x < 16) ((LAS unsigned*)(lds0 + LDS_CTL))[threadIdx.x] = 0u;
        if (threadIdx.x == 0) {
#pragma unroll
            for (int i = 0; i < 30; ++i) ((LAS unsigned long long*)(lds0 + LDS_INTAB))[i] = (unsigned long long)P.in[i]; }
        __syncthreads();
#if !MK_PER_PHASE
        (void)xcd_barrier_post((unsigned*)P.ws, (volatile LAS unsigned*)(lds0 + LDS_CTL), threadIdx.x == 0);
#endif
    }
#define KLDS ((LAS unsigned char*)lds_raw)
#define KWS ((GAS unsigned char*)kargs()->ws)
#if MK_PER_PHASE
#define GRID_BAR() do { } while (0)
#else
#define GRID_BAR() do { XcdBarrier bar_; bar_.bar = (unsigned*)kargs()->ws; bar_.x = xb_xcc_id(); bar_.st = (volatile LAS unsigned*)(KLDS + LDS_CTL); xcd_barrier(bar_, my_tid(wave_s) == 0); } while (0)
#endif
#ifndef PH_MASK
#define PH_MASK 0x7ff
#endif
#define IN(k) (kargs()->ph_lo <= (k) && (k) < kargs()->ph_hi)
#define ON(j) (((PH_MASK) >> (j)) & 1)
#ifndef DUP_MASK
#define DUP_MASK 0
#endif
#define REPS(j) ((((DUP_MASK) >> (j)) & 1) ? 2 : 1)
#ifndef TMUL
#define TMUL 8
#endif
#ifndef TBLK
#define TBLK 0
#endif
#define TS_B(j) do { if (TSEL == (j)) t_beg = __builtin_amdgcn_s_memrealtime(); } while (0)
#define TS_E(j) do { if (TSEL == (j)) t_acc += __builtin_amdgcn_s_memrealtime() - t_beg; } while (0)
#define SEAM(k) do { __syncthreads(); if (IN(k) && IN((k) + 1)) { GRID_BAR(); if (REPS(14) == 2) GRID_BAR(); } } while (0)

    unsigned long long t_beg = 0, t_acc = 0;
    TS_B(0);
    if (ON(0) && IN(0)) for (int rep = 0; rep < REPS(0); ++rep) { ph_prologue(KLDS, KWS, wave_s); __syncthreads(); }
    SEAM(0);
    TS_E(0);
    for (int l = 0; l < NL; ++l) {
        const int p0 = 1 + l * NPH;
        TS_B(1);
        if (ON(1) && IN(p0 + 0)) for (int rep = 0; rep < REPS(1); ++rep) { ph_gemm_in(KLDS, KWS, wave_s, lz(l)); __syncthreads(); }
        SEAM(p0 + 0);
        TS_E(1);
        TS_B(2);
        if (ON(2) && IN(p0 + 1)) for (int rep = 0; rep < REPS(2); ++rep) { ph_mla_prep(KLDS, KWS, wave_s, lz(l)); __syncthreads(); }
        SEAM(p0 + 1);
        TS_E(2);
        TS_B(3);
        if (ON(3) && IN(p0 + 2)) for (int rep = 0; rep < REPS(3); ++rep) { TS_B(12); for (int r2 = 0; r2 < REPS(15); ++r2) { ph_gemm_mla(KLDS, KWS, wave_s, lz(l)); __syncthreads(); } TS_E(12); TS_B(13); __syncthreads(); TS_E(13); TS_B(14); for (int r2 = 0; r2 < REPS(17); ++r2) { ph_rwkv1(KLDS, KWS, wave_s, lz(l)); __syncthreads(); } TS_E(14); }
        SEAM(p0 + 2);
        TS_E(3);
        TS_B(4);
        if (ON(4) && IN(p0 + 3)) for (int rep = 0; rep < REPS(4); ++rep) { TS_B(15); if (blockIdx.x < 48) for (int r2 = 0; r2 < REPS(11); ++r2) ph_scan(KLDS, KWS, wave_s, lz(l)); TS_E(15); TS_B(16); for (int r2 = 0; r2 < REPS(12); ++r2) ph_attn_queue(KLDS, KWS, wave_s, lz(l), rep * 2 + r2); __syncthreads(); TS_E(16); }
        SEAM(p0 + 3);
        TS_E(4);
        TS_B(11);
        if (ON(4) && IN(p0 + 4)) for (int rep = 0; rep < REPS(13); ++rep) { TS_B(17); ph_rwkv3(KLDS, KWS, wave_s, lz(l)); TS_E(17); TS_B(18); ph_combine(KLDS, KWS, wave_s); __syncthreads(); TS_E(18); }
        SEAM(p0 + 4);
        TS_E(11);
        TS_B(5);
        if (ON(5) && IN(p0 + 5)) for (int rep = 0; rep < REPS(5); ++rep) { ph_gemm_out(KLDS, KWS, wave_s, lz(l)); __syncthreads(); }
        SEAM(p0 + 5);
        TS_E(5);
        TS_B(6);
        if (ON(6) && IN(p0 + 6)) for (int rep = 0; rep < REPS(6); ++rep) { ph_ln1(KLDS, KWS, wave_s, lz(l), rep == 0); __syncthreads(); }
        SEAM(p0 + 6);
        TS_E(6);
        TS_B(7);
        if (ON(7) && IN(p0 + 7)) for (int rep = 0; rep < REPS(7); ++rep) { ph_moe(KLDS, KWS, wave_s, lz(l)); __syncthreads(); }
        SEAM(p0 + 7);
        TS_E(7);
        TS_B(9);
        if (ON(9) && IN(p0 + 8)) for (int rep = 0; rep < REPS(9); ++rep) { ph_ln2(KLDS, KWS, wave_s, lz(l)); __syncthreads(); }
        SEAM(p0 + 8);
        TS_E(9);
        TS_B(10);
        if (ON(10) && IN(p0 + 9)) for (int rep = 0; rep < REPS(10); ++rep) { ph_ple(KLDS, KWS, wave_s, lz(l), kargs()->out); __syncthreads(); }
        SEAM(p0 + 9);
        TS_E(10);
    }
    if (TSEL >= 0 && blockIdx.x == TBLK) { const unsigned long long t0 = __builtin_amdgcn_s_memrealtime(); const unsigned long long t_all = t_acc + *(LAS unsigned long long*)(KLDS + LDS_CTL + 32); while (__builtin_amdgcn_s_memrealtime() - t0 < (unsigned long long)TMUL * t_all) __builtin_amdgcn_s_sleep(8); }
#undef KLDS
#undef KWS
}

extern "C" void kernel_launch(void* const* d_in, const int* in_sizes, int n_in, void* d_out, int out_size, void* d_ws, size_t ws_size, hipStream_t stream) {
    static int grid = 0;
    if (grid == 0) {
        if (n_in != 30 || ws_size < WS_END) { fprintf(stderr, "kernel_launch: need 30 inputs and %zu bytes of workspace (got %d, %zu)\n", (size_t)WS_END, n_in, ws_size); grid = -1; return; }
        int dev = 0, cus = 0, per_cu = 0;
        if (hipGetDevice(&dev) != hipSuccess || hipDeviceGetAttribute(&cus, hipDeviceAttributeMultiprocessorCount, dev) != hipSuccess) { grid = -1; return; }
        if (hipFuncSetAttribute((const void*)mk_fwd, hipFuncAttributeMaxDynamicSharedMemorySize, LDS_BYTES) != hipSuccess) { fprintf(stderr, "kernel_launch: hipFuncSetAttribute failed\n"); grid = -1; return; }
        if (hipOccupancyMaxActiveBlocksPerMultiprocessor(&per_cu, (const void*)mk_fwd, 512, LDS_BYTES) != hipSuccess || per_cu < 1) { fprintf(stderr, "kernel_launch: occupancy query says %d\n", per_cu); }
        (void)hipGetLastError();
        grid = cus;
    }
    if (grid < 0) return;
    (void)hipMemsetAsync(d_ws, 0, CTL_BYTES, stream);
    Params p{};
    for (int i = 0; i < 30; ++i) p.in[i] = (const float*)d_in[i];
    p.out = (float*)d_out; p.ws = (unsigned char*)d_ws;
    const int nph = 1 + NL * NPH;
#if MK_PER_PHASE
    for (int k = 0; k < nph; ++k) { p.ph_lo = k; p.ph_hi = k + 1; hipLaunchKernelGGL(mk_fwd, dim3(grid), dim3(512), LDS_BYTES, stream, p); }
#else
    p.ph_lo = 0; p.ph_hi = nph;
    hipLaunchKernelGGL(mk_fwd, dim3(grid), dim3(512), LDS_BYTES, stream, p);
#endif
}
```
